# Optimizing an MI355X kernel written in HIP

```python
import jax, jax.numpy as jnp
from jax import lax
import numpy as np

D_MODEL = 1024
BATCH = 1
SEQ = 16384
DEPTH = 1
DEC_BATCH = 128
DEC_SEQ = 4
PAST_LEN = 8192
PAGE_SIZE = 128

HEAD_DIM = 64
N_ATT_HEADS = 8
ATT_WIDTH = N_ATT_HEADS * HEAD_DIM
ROT_DIM = HEAD_DIM // 4
ROPE_THETA = 500000.0
DILATED_BRANCHES = ((128, 1), (512, 4), (2048, 16))
WIN_MAX = 2048
QB = 128
N_RET_HEADS = 4
RET_DK = 64
RET_DV = 128
RET_QK = N_RET_HEADS * RET_DK
RET_V = N_RET_HEADS * RET_DV
RET_THETA = 10000.0
RET_CHUNK = 128
MIX_WIDTH = ATT_WIDTH + RET_V
IN_WIDTH = 3 * ATT_WIDTH + 2 * RET_QK + 2 * RET_V
D_FF = 2816
NORM_EPS = 1e-6
NEG = -1e30

kernel_name = 'hymba_dilated_retnet_decoder_step'


def rmsnorm(x, g):
    xf = x.astype(jnp.float32)
    y = xf * lax.rsqrt(jnp.mean(xf * xf, axis=-1, keepdims=True) + NORM_EPS)
    return (y * g.astype(jnp.float32)).astype(x.dtype)


def swiglu(u, w_gate, w_up, w_down):
    return (jax.nn.silu(u @ w_gate) * (u @ w_up)) @ w_down


def rope(x, pos, rot_dim, theta):
    half = rot_dim // 2
    inv = theta ** (-jnp.arange(half, dtype=jnp.float32) * (2.0 / rot_dim))
    ang = pos.astype(jnp.float32)[:, None] * inv[None, :]
    cos = jnp.cos(ang)[:, None, :].astype(x.dtype)
    sin = jnp.sin(ang)[:, None, :].astype(x.dtype)
    x1 = x[..., :half]
    x2 = x[..., half:rot_dim]
    return jnp.concatenate([x1 * cos - x2 * sin, x2 * cos + x1 * sin, x[..., rot_dim:]], axis=-1)


def masked_softmax_stats(scores, mask, v, spec):
    scores = jnp.where(mask, scores, NEG)
    m = jnp.max(scores, axis=-1)
    p = jnp.where(mask, jnp.exp(scores - m[..., None]), 0.0)
    s = jnp.sum(p, axis=-1)
    o = jnp.einsum(spec, p, v) / s[..., None]
    return m, s, o


def combine_branches(stats):
    ms = jnp.stack([st[0] for st in stats])
    ss = jnp.stack([st[1] for st in stats])
    os_ = jnp.stack([st[2] for st in stats])
    w = ss * jnp.exp(ms - jnp.max(ms, axis=0))
    return jnp.sum(w[..., None] * os_, axis=0) / jnp.sum(w, axis=0)[..., None]


def dilated_branch_prompt(q, k, v, window, dilation):
    B, S, H, E = q.shape
    steps = window // dilation
    L = S // dilation
    nb = -(-L // QB)
    Lp = nb * QB

    def blocks(t):
        t = t.reshape(B, L, dilation, H, E).transpose(0, 2, 3, 1, 4)
        t = jnp.pad(t, ((0, 0), (0, 0), (0, 0), (0, Lp - L), (0, 0)))
        return t.reshape(B, dilation, H, nb, QB, E)

    def with_prev(t):
        prev = jnp.pad(t, ((0, 0), (0, 0), (0, 0), (1, 0), (0, 0), (0, 0)))[:, :, :, :nb]
        return jnp.concatenate([prev, t], axis=4)

    qb = blocks(q)
    kk = with_prev(blocks(k))
    vv = with_prev(blocks(v))
    scores = jnp.einsum('brhnqe,brhnke->brhnqk', qb, kk) * (E ** -0.5)
    a = jnp.arange(QB)[:, None]
    c = jnp.arange(2 * QB)[None, :]
    dist = QB + a - c
    band = (dist >= 0) & (dist <= steps)
    mask = band[None] & ((jnp.arange(nb)[:, None, None] > 0) | (c[None] >= QB))
    m, s, o = masked_softmax_stats(scores, mask, vv, 'brhnqk,brhnke->brhnqe')
    o = o.reshape(B, dilation, H, Lp, E)[:, :, :, :L].transpose(0, 3, 1, 2, 4).reshape(B, S, H, E)

    def back(t):
        return t.reshape(B, dilation, H, Lp)[..., :L].transpose(0, 3, 1, 2).reshape(B, S, H)

    return back(m), back(s), o


def dilated_branch_sample(q, kc, vc, window, dilation, pos0):
    T = q.shape[1]
    E = q.shape[-1]
    w_tot = kc.shape[1]
    wb = w_tot - T
    steps = window // dilation
    i = jnp.arange(T)[:, None]
    j = jnp.arange(steps + 1)[None, :]
    idx = wb + i - j * dilation
    pos = pos0 + i - j * dilation
    valid = (idx >= 0) & (pos >= 0)
    idx = jnp.clip(idx, 0, w_tot - 1)
    kg = kc[:, idx]
    vg = vc[:, idx]
    scores = jnp.einsum('bthe,btjhe->bthj', q, kg) * (E ** -0.5)
    return masked_softmax_stats(scores, valid[:, None, :], vg, 'bthj,btjhe->bthe')


def attend_prompt(q, k, v):
    return combine_branches([dilated_branch_prompt(q, k, v, w, d) for (w, d) in DILATED_BRANCHES])


def attend_sample(q, k, v, ck, cv):
    kc = jnp.concatenate([ck.astype(jnp.float32), k], axis=1)
    vc = jnp.concatenate([cv.astype(jnp.float32), v], axis=1)
    return combine_branches([dilated_branch_sample(q, kc, vc, w, d, PAST_LEN) for (w, d) in DILATED_BRANCHES])


def retention(q, k, v, s0, chunk):
    B, S, H, DK = q.shape
    DV = v.shape[-1]
    n = S // chunk
    qf = q.astype(jnp.float32).reshape(B, n, chunk, H, DK)
    kf = k.astype(jnp.float32).reshape(B, n, chunk, H, DK)
    vf = v.astype(jnp.float32).reshape(B, n, chunk, H, DV)
    log_g = jnp.log1p(-jnp.exp2(-5.0 - jnp.arange(H, dtype=jnp.float32)))
    i = jnp.arange(chunk, dtype=jnp.float32)
    diff = i[:, None] - i[None, :]
    decay = jnp.where(diff[None] >= 0, jnp.exp(diff[None] * log_g[:, None, None]), 0.0)
    inner = jnp.einsum('bnihd,bnjhd->bnhij', qf, kf) * decay
    o = jnp.einsum('bnhij,bnjhe->bnihe', inner, vf)
    w_tail = jnp.exp((chunk - 1.0 - i)[None, :] * log_g[:, None])
    upd = jnp.einsum('bnjhd,bnjhe,hj->nbhde', kf, vf, w_tail)
    g_chunk = jnp.exp(chunk * log_g)[:, None, None]

    def step(state, u):
        return g_chunk * state + u, state

    s_final, s_prev = lax.scan(step, s0.astype(jnp.float32), upd)
    w_head = jnp.exp((i + 1.0)[:, None] * log_g[None, :])
    cross = jnp.einsum('bnihd,nbhde->bnihe', qf, s_prev) * w_head[None, None, :, :, None]
    return (o + cross).reshape(B, S, H, DV), s_final


def token_mixer(u, pos, attend, s0, chunk, w_in, gn_w, w_out):
    B, S, _ = u.shape
    sizes = (ATT_WIDTH, ATT_WIDTH, ATT_WIDTH, RET_QK, RET_QK, RET_V, RET_V)
    cuts = [int(c) for c in np.cumsum(sizes)[:-1]]
    q_a, k_a, v_a, q_r, k_r, v_r, g_r = jnp.split(u @ w_in, cuts, axis=-1)
    q_a = rope(q_a.reshape(B, S, N_ATT_HEADS, HEAD_DIM), pos, ROT_DIM, ROPE_THETA)
    k_a = rope(k_a.reshape(B, S, N_ATT_HEADS, HEAD_DIM), pos, ROT_DIM, ROPE_THETA)
    v_a = v_a.reshape(B, S, N_ATT_HEADS, HEAD_DIM)
    q_r = rope(q_r.reshape(B, S, N_RET_HEADS, RET_DK), pos, RET_DK, RET_THETA)
    k_r = rope(k_r.reshape(B, S, N_RET_HEADS, RET_DK), pos, RET_DK, RET_THETA) * (RET_DK ** -0.5)
    v_r = v_r.reshape(B, S, N_RET_HEADS, RET_DV)
    o_att = attend(q_a.astype(jnp.float32), k_a.astype(jnp.float32), v_a.astype(jnp.float32))
    o_ret, s_new = retention(q_r, k_r, v_r, s0, chunk)
    mu = jnp.mean(o_ret, axis=-1, keepdims=True)
    var = jnp.mean(jnp.square(o_ret - mu), axis=-1, keepdims=True)
    y_ret = ((o_ret - mu) * lax.rsqrt(var + NORM_EPS)).reshape(B, S, RET_V) * gn_w.astype(jnp.float32)
    y_ret = jax.nn.silu(g_r.astype(jnp.float32)) * y_ret
    mixed = jnp.concatenate([o_att.reshape(B, S, ATT_WIDTH), y_ret], axis=-1).astype(u.dtype)
    return mixed @ w_out, k_a, v_a, s_new


def decoder_layer(h, pos, attend, s0, chunk, g1a, g1b, w1g, w1u, w1d, gma, gmb, w_in, gn_w, w_out,
                  g2a, g2b, w2g, w2u, w2d):
    h = h + 0.5 * rmsnorm(swiglu(rmsnorm(h, g1a), w1g, w1u, w1d), g1b)
    y, k, v, s = token_mixer(rmsnorm(h, gma), pos, attend, s0, chunk, w_in, gn_w, w_out)
    h = h + rmsnorm(y, gmb)
    h = h + 0.5 * rmsnorm(swiglu(rmsnorm(h, g2a), w2g, w2u, w2d), g2b)
    return h, k, v, s


def setup_inputs(seed: int = 0) -> dict:
    key = jax.random.key(seed)
    ks = jax.random.split(key, 24)
    f32 = jnp.float32
    wb = min(WIN_MAX, PAST_LEN)

    def nrm(k, shape, scale):
        return jax.random.normal(k, shape, f32) * scale

    def gain(k, n):
        return 1.0 + 0.05 * jax.random.normal(k, (DEPTH, n), f32)

    return {
        'x_prompt': nrm(ks[0], (BATCH, SEQ, D_MODEL), 1.0),
        'x_sample': nrm(ks[1], (DEC_BATCH, DEC_SEQ, D_MODEL), 1.0),
        'cache_k': nrm(ks[2], (DEPTH, DEC_BATCH, wb, N_ATT_HEADS, HEAD_DIM), 1.0),
        'cache_v': nrm(ks[3], (DEPTH, DEC_BATCH, wb, N_ATT_HEADS, HEAD_DIM), 1.0),
        'state_ret': nrm(ks[4], (DEPTH, DEC_BATCH, N_RET_HEADS, RET_DK, RET_DV), 0.5),
        'g_ffn1_pre': gain(ks[5], D_MODEL),
        'g_ffn1_post': gain(ks[6], D_MODEL),
        'w1_gate': nrm(ks[7], (DEPTH, D_MODEL, D_FF), D_MODEL ** -0.5),
        'w1_up': nrm(ks[8], (DEPTH, D_MODEL, D_FF), D_MODEL ** -0.5),
        'w1_down': nrm(ks[9], (DEPTH, D_FF, D_MODEL), D_FF ** -0.5),
        'g_mix_pre': gain(ks[10], D_MODEL),
        'g_mix_post': gain(ks[11], D_MODEL),
        'w_in': nrm(ks[12], (DEPTH, D_MODEL, IN_WIDTH), D_MODEL ** -0.5),
        'gn_w': gain(ks[13], RET_V),
        'w_out': nrm(ks[14], (DEPTH, MIX_WIDTH, D_MODEL), MIX_WIDTH ** -0.5),
        'g_ffn2_pre': gain(ks[15], D_MODEL),
        'g_ffn2_post': gain(ks[16], D_MODEL),
        'w2_gate': nrm(ks[17], (DEPTH, D_MODEL, D_FF), D_MODEL ** -0.5),
        'w2_up': nrm(ks[18], (DEPTH, D_MODEL, D_FF), D_MODEL ** -0.5),
        'w2_down': nrm(ks[19], (DEPTH, D_FF, D_MODEL), D_FF ** -0.5),
    }


def reference(x_prompt, x_sample, cache_k, cache_v, state_ret,
              g_ffn1_pre, g_ffn1_post, w1_gate, w1_up, w1_down,
              g_mix_pre, g_mix_post, w_in, gn_w, w_out,
              g_ffn2_pre, g_ffn2_post, w2_gate, w2_up, w2_down):
    b_p, s_p = x_prompt.shape[0], x_prompt.shape[1]
    t_s = x_sample.shape[1]
    pos_p = jnp.arange(s_p)
    pos_s = PAST_LEN + jnp.arange(t_s)
    keep = min(WIN_MAX, s_p)
    hp, hs = x_prompt, x_sample
    kp_l, vp_l, sp_l, ks_l, vs_l, ss_l = [], [], [], [], [], []
    for l in range(DEPTH):
        lw = (g_ffn1_pre[l], g_ffn1_post[l], w1_gate[l], w1_up[l], w1_down[l],
              g_mix_pre[l], g_mix_post[l], w_in[l], gn_w[l], w_out[l],
              g_ffn2_pre[l], g_ffn2_post[l], w2_gate[l], w2_up[l], w2_down[l])
        s0_p = jnp.zeros((b_p, N_RET_HEADS, RET_DK, RET_DV), jnp.float32)
        hp, kp, vp, sp = decoder_layer(hp, pos_p, attend_prompt, s0_p, RET_CHUNK, *lw)
        ck, cv = cache_k[l], cache_v[l]
        hs, kn, vn, sn = decoder_layer(hs, pos_s, lambda q, k, v: attend_sample(q, k, v, ck, cv),
                                       state_ret[l], t_s, *lw)
        kp_l.append(kp[:, s_p - keep:])
        vp_l.append(vp[:, s_p - keep:])
        sp_l.append(sp)
        ks_l.append(kn)
        vs_l.append(vn)
        ss_l.append(sn)
    new_k_prompt = jnp.stack(kp_l)
    new_v_prompt = jnp.stack(vp_l)
    new_state_prompt = jnp.stack(sp_l)
    new_k_sample = jnp.stack(ks_l)
    new_v_sample = jnp.stack(vs_l)
    new_state_sample = jnp.stack(ss_l)
    return (hp, hs, new_k_prompt, new_v_prompt, new_state_prompt, new_k_sample, new_v_sample, new_state_sample)
```

```cpp
#include <hip/hip_runtime.h>
#include <stdint.h>

namespace {
constexpr int D = 1024, SEQ = 16384, DBATCH = 128, TS = 4, MP = SEQ, MS = DBATCH * TS, M = MP + MS;
constexpr int DFF = 2816, INW = 3072, PAST = 8192, WB = 2048, KEEP = 2048;
constexpr int NH = 8, HD = 64, RH = 4, RDK = 64, RDV = 128;
constexpr float EPS = 1e-6f;
constexpr int C_QA = 0, C_KA = 512, C_VA = 1024, C_QR = 1536, C_KR = 1792, C_VR = 2048, C_GR = 2560;
constexpr size_t O_Y = 0, O_KP = (size_t)M * D, O_VP = O_KP + (size_t)KEEP * 512, O_SP = O_VP + (size_t)KEEP * 512,
                 O_KS = O_SP + 32768, O_VS = O_KS + (size_t)MS * 512, O_SS = O_VS + (size_t)MS * 512, O_END = O_SS + (size_t)DBATCH * 32768;

__constant__ float INVF[40] = {
    1.f, 0.193922743f, 0.0376060307f, 0.00729266461f, 0.00141421356f, 0.000274248188f, 5.3182961e-05f, 1.03133862e-05f,
    1.f, 0.749894261f, 0.562341332f, 0.421696514f, 0.316227764f, 0.237137377f, 0.177827939f, 0.133352131f, 0.100000001f, 0.0749894157f,
    0.0562341325f, 0.0421696529f, 0.0316227749f, 0.0237137377f, 0.0177827943f, 0.0133352149f, 0.00999999978f, 0.00749894185f,
    0.00562341325f, 0.00421696482f, 0.00316227763f, 0.00237137359f, 0.00177827943f, 0.00133352145f, 0.00100000005f, 0.000749894243f,
    0.000562341302f, 0.000421696517f, 0.000316227757f, 0.00023713737f, 0.00017782794f, 0.00013335215f};
__device__ __forceinline__ float log_g(int h) {
    return h == 0 ? -0.0317486983145803f : h == 1 ? -0.015748356968139168f : h == 2 ? -0.007843177461025893f : -0.003913899321136329f;
}

__device__ __forceinline__ float wave_sum(float v) {
#pragma unroll
    for (int o = 32; o >= 1; o >>= 1) v += __shfl_xor(v, o);
    return v;
}
__device__ __forceinline__ float wave_max(float v) {
#pragma unroll
    for (int o = 32; o >= 1; o >>= 1) v = fmaxf(v, __shfl_xor(v, o));
    return v;
}

template <int MODE>
__global__ __launch_bounds__(256) void gemm_f32(const float* __restrict__ A, int lda, const float* __restrict__ B1, const float* __restrict__ B2, int ldb,
                                                float* __restrict__ C, int ldc, int K) {
    __shared__ float As[16][132];
    __shared__ float Bs1[16][128];
    __shared__ float Bs2[MODE ? 16 : 1][128];
    const int tid = threadIdx.x, tx = tid & 15, ty = tid >> 4;
    const int m0 = blockIdx.y * 128, n0 = blockIdx.x * 128;
    float acc[8][8], acc2[8][8];
#pragma unroll
    for (int i = 0; i < 8; ++i)
#pragma unroll
        for (int j = 0; j < 8; ++j) { acc[i][j] = 0.f; acc2[i][j] = 0.f; }
    for (int k0 = 0; k0 < K; k0 += 16) {
#pragma unroll
        for (int i = 0; i < 2; ++i) {
            const int idx = tid + i * 256;
            { const int row = idx >> 2, kq = (idx & 3) * 4;
              const float4 a = *(const float4*)(A + (size_t)(m0 + row) * lda + k0 + kq);
              As[kq + 0][row] = a.x; As[kq + 1][row] = a.y; As[kq + 2][row] = a.z; As[kq + 3][row] = a.w; }
            { const int kk = idx >> 5, nq = (idx & 31) * 4;
              *(float4*)&Bs1[kk][nq] = *(const float4*)(B1 + (size_t)(k0 + kk) * ldb + n0 + nq);
              if (MODE) *(float4*)&Bs2[kk][nq] = *(const float4*)(B2 + (size_t)(k0 + kk) * ldb + n0 + nq); }
        }
        __syncthreads();
#pragma unroll
        for (int kk = 0; kk < 16; ++kk) {
            float a[8], b[8], b2[8];
#pragma unroll
            for (int i = 0; i < 8; ++i) a[i] = As[kk][ty * 8 + i];
#pragma unroll
            for (int j = 0; j < 8; ++j) { b[j] = Bs1[kk][tx * 8 + j]; b2[j] = MODE ? Bs2[kk][tx * 8 + j] : 0.f; }
#pragma unroll
            for (int i = 0; i < 8; ++i)
#pragma unroll
                for (int j = 0; j < 8; ++j) { acc[i][j] += a[i] * b[j]; if (MODE) acc2[i][j] += a[i] * b2[j]; }
        }
        __syncthreads();
    }
#pragma unroll
    for (int i = 0; i < 8; ++i) {
        float* crow = C + (size_t)(m0 + ty * 8 + i) * ldc + n0 + tx * 8;
#pragma unroll
        for (int j = 0; j < 8; ++j) {
            float v = acc[i][j];
            if (MODE) { const float s = v / (1.f + expf(-v)); v = s * acc2[i][j]; }
            crow[j] = v;
        }
    }
}

__global__ __launch_bounds__(256) void k_norm_in(const float* __restrict__ xp, const float* __restrict__ xs, const float* __restrict__ g, float* __restrict__ XN) {
    const int lane = threadIdx.x & 63, gw = (blockIdx.x * blockDim.x + threadIdx.x) >> 6, nw = (gridDim.x * blockDim.x) >> 6;
    for (int r = gw; r < M; r += nw) {
        const float4* x = (const float4*)(r < MP ? xp + (size_t)r * D : xs + (size_t)(r - MP) * D);
        float4 v[4]; float ss = 0.f;
#pragma unroll
        for (int j = 0; j < 4; ++j) { v[j] = x[lane + 64 * j]; ss += v[j].x * v[j].x + v[j].y * v[j].y + v[j].z * v[j].z + v[j].w * v[j].w; }
        const float rstd = 1.f / sqrtf(wave_sum(ss) * (1.f / D) + EPS);
        float4* o = (float4*)(XN + (size_t)r * D);
#pragma unroll
        for (int j = 0; j < 4; ++j) { const float4 gg = ((const float4*)g)[lane + 64 * j];
            o[lane + 64 * j] = make_float4(v[j].x * rstd * gg.x, v[j].y * rstd * gg.y, v[j].z * rstd * gg.z, v[j].w * rstd * gg.w); }
    }
}
__global__ __launch_bounds__(256) void k_norm_res(const float* resA, const float* resB, const float* __restrict__ Y, const float* __restrict__ gpost, float scale,
                                                  float* hout, const float* __restrict__ gnext, float* __restrict__ XN) {
    const int lane = threadIdx.x & 63, gw = (blockIdx.x * blockDim.x + threadIdx.x) >> 6, nw = (gridDim.x * blockDim.x) >> 6;
    for (int r = gw; r < M; r += nw) {
        const float4* x = (const float4*)(r < MP ? resA + (size_t)r * D : resB + (size_t)(r - MP) * D);
        const float4* y = (const float4*)(Y + (size_t)r * D);
        float4 v[4], hv[4]; float ss = 0.f;
#pragma unroll
        for (int j = 0; j < 4; ++j) { v[j] = y[lane + 64 * j]; hv[j] = x[lane + 64 * j]; ss += v[j].x * v[j].x + v[j].y * v[j].y + v[j].z * v[j].z + v[j].w * v[j].w; }
        const float rstd = scale / sqrtf(wave_sum(ss) * (1.f / D) + EPS);
        float s2 = 0.f;
#pragma unroll
        for (int j = 0; j < 4; ++j) { const float4 gg = ((const float4*)gpost)[lane + 64 * j];
            hv[j].x += v[j].x * rstd * gg.x; hv[j].y += v[j].y * rstd * gg.y; hv[j].z += v[j].z * rstd * gg.z; hv[j].w += v[j].w * rstd * gg.w;
            s2 += hv[j].x * hv[j].x + hv[j].y * hv[j].y + hv[j].z * hv[j].z + hv[j].w * hv[j].w; }
        float4* ho = (float4*)(hout + (size_t)r * D);
#pragma unroll
        for (int j = 0; j < 4; ++j) ho[lane + 64 * j] = hv[j];
        if (gnext) {
            const float r2 = 1.f / sqrtf(wave_sum(s2) * (1.f / D) + EPS);
            float4* o = (float4*)(XN + (size_t)r * D);
#pragma unroll
            for (int j = 0; j < 4; ++j) { const float4 gg = ((const float4*)gnext)[lane + 64 * j];
                o[lane + 64 * j] = make_float4(hv[j].x * r2 * gg.x, hv[j].y * r2 * gg.y, hv[j].z * r2 * gg.z, hv[j].w * r2 * gg.w); }
        }
    }
}

__global__ void k_tab(float2* __restrict__ tab) {
    const int idx = blockIdx.x * blockDim.x + threadIdx.x;
    if (idx >= SEQ * 40) return;
    const int pos = idx / 40, f = idx % 40;
    const float ang = (float)pos * INVF[f];
    const double rev = (double)ang * 0.15915494309189535;
    const float fr = (float)(rev - rint(rev));
    tab[idx] = make_float2(__builtin_amdgcn_cosf(fr), __builtin_amdgcn_sinf(fr));
}
__global__ __launch_bounds__(256) void k_rope(float* __restrict__ QKV, const float2* __restrict__ tab, float* __restrict__ out) {
    const int r = blockIdx.x, tid = threadIdx.x;
    const int pos = r < MP ? r : PAST + ((r - MP) & 3);
    float* row = QKV + (size_t)r * INW;
    if (tid < 128) {
        const int tsel = tid >> 6, hd = (tid >> 3) & 7, i = tid & 7, base = tsel * 512 + hd * 64;
        const float2 cs = tab[pos * 40 + i];
        const float x1 = row[base + i], x2 = row[base + 8 + i];
        row[base + i] = x1 * cs.x - x2 * cs.y; row[base + 8 + i] = x2 * cs.x + x1 * cs.y;
    }
    {
        const int tsel = tid >> 7, h = (tid >> 5) & 3, i = tid & 31, base = C_QR + tsel * 256 + h * 64;
        const float2 cs = tab[pos * 40 + 8 + i];
        const float sc = tsel ? 0.125f : 1.f;
        const float x1 = row[base + i], x2 = row[base + 32 + i];
        row[base + i] = (x1 * cs.x - x2 * cs.y) * sc; row[base + 32 + i] = (x2 * cs.x + x1 * cs.y) * sc;
    }
    __syncthreads();
    float *ko = nullptr, *vo = nullptr;
    if (r >= MP) { ko = out + O_KS + (size_t)(r - MP) * 512; vo = out + O_VS + (size_t)(r - MP) * 512; }
    else if (r >= MP - KEEP) { ko = out + O_KP + (size_t)(r - (MP - KEEP)) * 512; vo = out + O_VP + (size_t)(r - (MP - KEEP)) * 512; }
    if (ko) { ko[tid] = row[C_KA + tid]; ko[tid + 256] = row[C_KA + tid + 256]; vo[tid] = row[C_VA + tid]; vo[tid + 256] = row[C_VA + tid + 256]; }
}

template <bool SAMPLE>
__global__ __launch_bounds__(256) void k_attn(const float* __restrict__ QKV, const float* __restrict__ ck, const float* __restrict__ cv, float* __restrict__ MIX) {
    __shared__ float qs[4][64];
    __shared__ float ps[4][3][132];
    const int lane = threadIdx.x & 63, w = threadIdx.x >> 6;
    const int item = blockIdx.x * 4 + w;
    const int h = item & 7, qi = item >> 3;
    const int qrow = SAMPLE ? MP + qi : qi;
    const int b = qi >> 2, ii = qi & 3;
    qs[w][lane] = QKV[(size_t)qrow * INW + C_QA + h * 64 + lane];
    __syncthreads();
    float sc[3][3]; float mx = -1e30f;
#pragma unroll
    for (int br = 0; br < 3; ++br) {
        const int d = 1 << (2 * br);
#pragma unroll
        for (int s = 0; s < 3; ++s) {
            const int j = lane + 64 * s;
            sc[br][s] = -1e30f;
            if (j <= 128) {
                const float* kp = nullptr;
                if (SAMPLE) { const int idx = WB + ii - j * d;
                    if (idx >= WB) kp = QKV + (size_t)(MP + b * 4 + (idx - WB)) * INW + C_KA + h * 64;
                    else if (idx >= 0) kp = ck + ((size_t)(b * WB + idx) * NH + h) * 64; }
                else { const int tk = qi - j * d; if (tk >= 0) kp = QKV + (size_t)tk * INW + C_KA + h * 64; }
                if (kp) {
                    float dot = 0.f;
#pragma unroll
                    for (int c = 0; c < 16; ++c) { const float4 kk = ((const float4*)kp)[c]; const float4 qq = *(const float4*)&qs[w][4 * c];
                        dot += kk.x * qq.x + kk.y * qq.y + kk.z * qq.z + kk.w * qq.w; }
                    sc[br][s] = dot * 0.125f;
                }
            }
            mx = fmaxf(mx, sc[br][s]);
        }
    }
    mx = wave_max(mx);
    float l = 0.f;
#pragma unroll
    for (int br = 0; br < 3; ++br)
#pragma unroll
        for (int s = 0; s < 3; ++s) {
            const int j = lane + 64 * s;
            const float p = sc[br][s] > -1e29f ? expf(sc[br][s] - mx) : 0.f;
            l += p;
            if (j <= 128) ps[w][br][j] = p;
        }
    l = wave_sum(l);
    __syncthreads();
    float o = 0.f;
#pragma unroll
    for (int br = 0; br < 3; ++br) {
        const int d = 1 << (2 * br);
        for (int j = 0; j <= 128; ++j) {
            const float* vp = nullptr;
            if (SAMPLE) { const int idx = WB + ii - j * d;
                if (idx >= WB) vp = QKV + (size_t)(MP + b * 4 + (idx - WB)) * INW + C_VA + h * 64;
                else if (idx >= 0) vp = cv + ((size_t)(b * WB + idx) * NH + h) * 64; }
            else { const int tk = qi - j * d; if (tk >= 0) vp = QKV + (size_t)tk * INW + C_VA + h * 64; }
            if (vp) o += ps[w][br][j] * vp[lane];
        }
    }
    MIX[(size_t)qrow * D + h * 64 + lane] = o / l;
}

__global__ __launch_bounds__(256) void k_ret_upd(const float* __restrict__ QKV, float* __restrict__ UPD) {
    __shared__ float kc[128][64];
    const int n = blockIdx.x >> 2, h = blockIdx.x & 3, tid = threadIdx.x;
    const float lg = log_g(h);
    for (int e = tid; e < 128 * 64; e += 256) { const int j = e >> 6, dk = e & 63;
        kc[j][dk] = QKV[(size_t)(n * 128 + j) * INW + C_KR + h * 64 + dk] * expf((float)(127 - j) * lg); }
    __syncthreads();
    const int dv = tid & 127, half = tid >> 7;
    float acc[32];
#pragma unroll
    for (int i = 0; i < 32; ++i) acc[i] = 0.f;
    for (int j = 0; j < 128; ++j) {
        const float vj = QKV[(size_t)(n * 128 + j) * INW + C_VR + h * 128 + dv];
#pragma unroll
        for (int i = 0; i < 32; ++i) acc[i] += kc[j][half * 32 + i] * vj;
    }
#pragma unroll
    for (int i = 0; i < 32; ++i) UPD[((size_t)(n * 4 + h) * 64 + half * 32 + i) * 128 + dv] = acc[i];
}
__global__ __launch_bounds__(256) void k_ret_scan(const float* __restrict__ UPD, float* __restrict__ SPREV, float* __restrict__ out) {
    const int e = blockIdx.x * 256 + threadIdx.x;
    const int h = e >> 13;
    const float G = expf(128.f * log_g(h));
    float S = 0.f;
    for (int n = 0; n < 128; ++n) { SPREV[(size_t)n * 32768 + e] = S; S = G * S + UPD[(size_t)n * 32768 + e]; }
    out[O_SP + e] = S;
}
__device__ __forceinline__ float silu_f(float x) { return x / (1.f + expf(-x)); }
__global__ __launch_bounds__(128) void k_ret_out(const float* __restrict__ QKV, const float* __restrict__ SPREV, const float* __restrict__ gnw, float* __restrict__ MIX) {
    __shared__ float qs[64]; __shared__ float ss[128]; __shared__ float red[4];
    const int i = blockIdx.x & 127, h = (blockIdx.x >> 7) & 3, n = blockIdx.x >> 9, tid = threadIdx.x;
    const float lg = log_g(h);
    const int row = n * 128 + i;
    if (tid < 64) qs[tid] = QKV[(size_t)row * INW + C_QR + h * 64 + tid];
    __syncthreads();
    { const int j = tid; float s = 0.f;
      if (j <= i) { const float* kp = QKV + (size_t)(n * 128 + j) * INW + C_KR + h * 64; float dot = 0.f;
#pragma unroll
          for (int c = 0; c < 16; ++c) { const float4 kk = ((const float4*)kp)[c]; dot += kk.x * qs[4 * c] + kk.y * qs[4 * c + 1] + kk.z * qs[4 * c + 2] + kk.w * qs[4 * c + 3]; }
          s = dot * expf((float)(i - j) * lg); }
      ss[j] = s; }
    __syncthreads();
    const int dv = tid;
    float o = 0.f;
    for (int j = 0; j <= i; ++j) o += ss[j] * QKV[(size_t)(n * 128 + j) * INW + C_VR + h * 128 + dv];
    float c = 0.f;
    const float* sp = SPREV + (size_t)(n * 4 + h) * 64 * 128 + dv;
    for (int dk = 0; dk < 64; ++dk) c += qs[dk] * sp[dk * 128];
    o += c * expf((float)(i + 1) * lg);
    float s1 = wave_sum(o);
    if ((tid & 63) == 0) red[tid >> 6] = s1;
    __syncthreads();
    const float mu = (red[0] + red[1]) * (1.f / 128.f);
    const float dlt = o - mu;
    float s2 = wave_sum(dlt * dlt);
    if ((tid & 63) == 0) red[2 + (tid >> 6)] = s2;
    __syncthreads();
    const float var = (red[2] + red[3]) * (1.f / 128.f);
    const float y = dlt / sqrtf(var + EPS) * gnw[h * 128 + dv];
    const float g = QKV[(size_t)row * INW + C_GR + h * 128 + dv];
    MIX[(size_t)row * D + 512 + h * 128 + dv] = silu_f(g) * y;
}
__global__ __launch_bounds__(128) void k_ret_sample(const float* __restrict__ QKV, const float* __restrict__ state, const float* __restrict__ gnw, float* __restrict__ MIX, float* __restrict__ out) {
    __shared__ float qs[4][64]; __shared__ float ks[4][64]; __shared__ float red[16];
    const int b = blockIdx.x >> 2, h = blockIdx.x & 3, tid = threadIdx.x, dv = tid;
    const float g = 1.f - exp2f(-5.f - (float)h);
    const float g2 = g * g, g3 = g2 * g, g4 = g2 * g2;
    const int row0 = MP + b * 4;
    for (int e = tid; e < 256; e += 128) { const int i = e >> 6, dk = e & 63;
        qs[i][dk] = QKV[(size_t)(row0 + i) * INW + C_QR + h * 64 + dk]; ks[i][dk] = QKV[(size_t)(row0 + i) * INW + C_KR + h * 64 + dk]; }
    __syncthreads();
    float v[4];
#pragma unroll
    for (int i = 0; i < 4; ++i) v[i] = QKV[(size_t)(row0 + i) * INW + C_VR + h * 128 + dv];
    const float* s0p = state + (size_t)(b * 4 + h) * 64 * 128 + dv;
    float* snp = out + O_SS + (size_t)(b * 4 + h) * 64 * 128 + dv;
    float c[4] = {0.f, 0.f, 0.f, 0.f};
    for (int dk = 0; dk < 64; ++dk) {
        const float s0 = s0p[dk * 128];
#pragma unroll
        for (int i = 0; i < 4; ++i) c[i] += qs[i][dk] * s0;
        snp[dk * 128] = g4 * s0 + g3 * ks[0][dk] * v[0] + g2 * ks[1][dk] * v[1] + g * ks[2][dk] * v[2] + ks[3][dk] * v[3];
    }
    const float gp[5] = {1.f, g, g2, g3, g4};
    float o[4];
#pragma unroll
    for (int i = 0; i < 4; ++i) {
        float acc = gp[i + 1] * c[i];
#pragma unroll
        for (int j = 0; j <= i; ++j) { float dot = 0.f;
#pragma unroll 8
            for (int dk = 0; dk < 64; ++dk) dot += qs[i][dk] * ks[j][dk];
            acc += gp[i - j] * dot * v[j]; }
        o[i] = acc;
    }
#pragma unroll
    for (int i = 0; i < 4; ++i) { const float s1 = wave_sum(o[i]); if ((tid & 63) == 0) red[i * 2 + (tid >> 6)] = s1; }
    __syncthreads();
    float dl[4];
#pragma unroll
    for (int i = 0; i < 4; ++i) { const float mu = (red[i * 2] + red[i * 2 + 1]) * (1.f / 128.f); dl[i] = o[i] - mu; }
    __syncthreads();
#pragma unroll
    for (int i = 0; i < 4; ++i) { const float s2 = wave_sum(dl[i] * dl[i]); if ((tid & 63) == 0) red[8 + i * 2 + (tid >> 6)] = s2; }
    __syncthreads();
#pragma unroll
    for (int i = 0; i < 4; ++i) {
        const float var = (red[8 + i * 2] + red[8 + i * 2 + 1]) * (1.f / 128.f);
        const float y = dl[i] / sqrtf(var + EPS) * gnw[h * 128 + dv];
        const float gg = QKV[(size_t)(row0 + i) * INW + C_GR + h * 128 + dv];
        MIX[(size_t)(row0 + i) * D + 512 + h * 128 + dv] = silu_f(gg) * y;
    }
}
}

extern "C" void kernel_launch(void* const* d_in, const int* in_sizes, int n_in, void* d_out, int out_size, void* d_ws, size_t ws_size, hipStream_t stream) {
    const float* xp = (const float*)d_in[0]; const float* xs = (const float*)d_in[1];
    const float* ck = (const float*)d_in[2]; const float* cv = (const float*)d_in[3]; const float* st = (const float*)d_in[4];
    const float* g1a = (const float*)d_in[5]; const float* g1b = (const float*)d_in[6];
    const float* w1g = (const float*)d_in[7]; const float* w1u = (const float*)d_in[8]; const float* w1d = (const float*)d_in[9];
    const float* gma = (const float*)d_in[10]; const float* gmb = (const float*)d_in[11];
    const float* win = (const float*)d_in[12]; const float* gnw = (const float*)d_in[13]; const float* wout = (const float*)d_in[14];
    const float* g2a = (const float*)d_in[15]; const float* g2b = (const float*)d_in[16];
    const float* w2g = (const float*)d_in[17]; const float* w2u = (const float*)d_in[18]; const float* w2d = (const float*)d_in[19];
    float* out = (float*)d_out;
    float* ws = (float*)d_ws;
    size_t off = 0;
    auto carve = [&](size_t n) { float* p = ws + off; off += (n + 63) & ~(size_t)63; return p; };
    float* XN = carve((size_t)M * D);
    float* H = carve((size_t)M * DFF);
    float* Y = carve((size_t)M * D);
    float* HRES = carve((size_t)M * D);
    float* QKV = carve((size_t)M * INW);
    float* MIX = carve((size_t)M * D);
    float* UPD = carve((size_t)128 * 32768);
    float* SPREV = carve((size_t)128 * 32768);
    float2* TAB = (float2*)carve((size_t)SEQ * 40 * 2);

    k_tab<<<(SEQ * 40 + 255) / 256, 256, 0, stream>>>(TAB);
    k_norm_in<<<2048, 256, 0, stream>>>(xp, xs, g1a, XN);
    gemm_f32<1><<<dim3(DFF / 128, M / 128), 256, 0, stream>>>(XN, D, w1g, w1u, DFF, H, DFF, D);
    gemm_f32<0><<<dim3(D / 128, M / 128), 256, 0, stream>>>(H, DFF, w1d, nullptr, D, Y, D, DFF);
    k_norm_res<<<2048, 256, 0, stream>>>(xp, xs, Y, g1b, 0.5f, HRES, gma, XN);
    gemm_f32<0><<<dim3(INW / 128, M / 128), 256, 0, stream>>>(XN, D, win, nullptr, INW, QKV, INW, D);
    k_rope<<<M, 256, 0, stream>>>(QKV, TAB, out);
    k_attn<false><<<MP * NH / 4, 256, 0, stream>>>(QKV, ck, cv, MIX);
    k_attn<true><<<MS * NH / 4, 256, 0, stream>>>(QKV, ck, cv, MIX);
    k_ret_upd<<<128 * 4, 256, 0, stream>>>(QKV, UPD);
    k_ret_scan<<<32768 / 256, 256, 0, stream>>>(UPD, SPREV, out);
    k_ret_out<<<128 * 4 * 128, 128, 0, stream>>>(QKV, SPREV, gnw, MIX);
    k_ret_sample<<<DBATCH * 4, 128, 0, stream>>>(QKV, st, gnw, MIX, out);
    gemm_f32<0><<<dim3(D / 128, M / 128), 256, 0, stream>>>(MIX, D, wout, nullptr, D, Y, D, D);
    k_norm_res<<<2048, 256, 0, stream>>>(HRES, HRES + (size_t)MP * D, Y, gmb, 1.0f, HRES, g2a, XN);
    gemm_f32<1><<<dim3(DFF / 128, M / 128), 256, 0, stream>>>(XN, D, w2g, w2u, DFF, H, DFF, D);
    gemm_f32<0><<<dim3(D / 128, M / 128), 256, 0, stream>>>(H, DFF, w2d, nullptr, D, Y, D, DFF);
    k_norm_res<<<2048, 256, 0, stream>>>(HRES, HRES + (size_t)MP * D, Y, g2b, 0.5f, out + O_Y, nullptr, nullptr);
}
```

```cpp
#include <hip/hip_runtime.h>
#include <cstdio>
#include <cstdint>
namespace pg8 {
#define PG8_LAS __attribute__((address_space(3)))
typedef unsigned short bf16_t;
typedef short bf16x8 __attribute__((ext_vector_type(8)));
typedef float f32x4 __attribute__((ext_vector_type(4)));
typedef unsigned u32x4 __attribute__((ext_vector_type(4)));
constexpr int BM = 256, BK = 64, HALF = 128, HTB = HALF * BK * 2  , STAGE_BYTES = 8 * HTB, NXCD = 8, WGM = 8;

__host__ __device__ __forceinline__ int lds_byte(int r, int c) { const int st = (r >> 4) * 2 + (c >> 5), rr = r & 15, cc = c & 31, ob = rr * 64 + cc * 2; return st * 1024 + (ob ^ (((ob >> 9) & 1) << 5)); }
__host__ __device__ __forceinline__ void stage_rc(int b, int& R, int& C) { const int st = b / 1024, sb = b % 1024, swz = sb ^ (((sb >> 9) & 1) << 5); R = (st >> 1) * 16 + swz / 64; C = (st & 1) * 32 + (swz % 64) / 2; }
__host__ __device__ __forceinline__ int perm32(int rho) { const int n = rho >> 4, i = rho & 15; return 8 * (i >> 2) + 4 * n + (i & 3); }

struct Unit { int pm, pn; };
struct Gemm { const bf16_t* A; const bf16_t* Bt; int M, N, K; };

struct StaticOrder {
    int nM, nN, nwg, G, c;
    __host__ __device__ void init(int M, int N, int G_, int c_) { nM = M / BM; nN = N / BM; nwg = nM * nN; G = G_; c = c_; }
    __host__ __device__ bool next(int i, Unit& u) const {
        const long L = (long)i * G + c; if (L >= nwg) return false;
        int wgid = (int)L; { const int q = nwg / NXCD, r = nwg % NXCD, xcd = wgid % NXCD, off = wgid / NXCD; wgid = (xcd < r ? xcd * (q + 1) : r * (q + 1) + (xcd - r) * q) + off; }
        const int nig = WGM * nN, gid = wgid / nig, fm = gid * WGM, gsz = (nM - fm) < WGM ? (nM - fm) : WGM;
        u.pm = fm + ((wgid % nig) % gsz); u.pn = (wgid % nig) / gsz; return true;
    }
    __device__ __forceinline__ void a_ready(const Unit&) const {}
    __device__ __forceinline__ void done(const Unit&) const {}
};

__device__ __forceinline__ unsigned cvt_pk_bf16(float lo, float hi) { unsigned r; asm volatile("v_cvt_pk_bf16_f32 %0, %1, %2" : "=v"(r) : "v"(lo), "v"(hi)); return r; }
typedef float f32x2 __attribute__((ext_vector_type(2)));
__device__ __forceinline__ float silu_fast(float x) { return x * __builtin_amdgcn_rcpf(1.0f + __builtin_amdgcn_exp2f(-1.4426950408889634f * x)); }
struct EpiSwiglu {
    static constexpr bool PERM = true, AFTER_DRAIN = false;
    bf16_t* O; int ldc;
    __device__ __forceinline__ void operator()(const f32x4 (&acc)[2][2][4][2], const Unit& u, int wr, int wc, int fr, int fq) const {
        const int row0 = u.pm * BM + wr * 64 + fr, col0 = u.pn * HALF + wc * 32 + 8 * fq;
#pragma unroll
        for (int ai = 0; ai < 2; ++ai)
#pragma unroll
            for (int m = 0; m < 4; ++m) {
                bf16_t* rowp = O + (size_t)(row0 + ai * HALF + m * 16) * ldc + col0;
                const f32x4 g0 = acc[ai][0][m][0], g1 = acc[ai][0][m][1], u0 = acc[ai][1][m][0], u1 = acc[ai][1][m][1];
                u32x4 w;
                w.x = cvt_pk_bf16(silu_fast(g0[0]) * u0[0], silu_fast(g0[1]) * u0[1]); w.y = cvt_pk_bf16(silu_fast(g0[2]) * u0[2], silu_fast(g0[3]) * u0[3]);
                w.z = cvt_pk_bf16(silu_fast(g1[0]) * u1[0], silu_fast(g1[1]) * u1[1]); w.w = cvt_pk_bf16(silu_fast(g1[2]) * u1[2], silu_fast(g1[3]) * u1[3]);
                *(u32x4*)rowp = w;
            }
    }
};
struct EpiF32 {
    static constexpr bool PERM = false, AFTER_DRAIN = false;
    float* O; int ldc;
    __device__ __forceinline__ void operator()(const f32x4 (&acc)[2][2][4][2], const Unit& u, int wr, int wc, int fr, int fq) const {
        const int row0 = u.pm * BM + wr * 64 + fr, col0 = u.pn * BM + wc * 32 + 4 * fq;
#pragma unroll
        for (int ai = 0; ai < 2; ++ai)
#pragma unroll
            for (int m = 0; m < 4; ++m) {
                float* rowp = O + (size_t)(row0 + ai * HALF + m * 16) * ldc + col0;
#pragma unroll
                for (int bj = 0; bj < 2; ++bj)
#pragma unroll
                    for (int n = 0; n < 2; ++n) *(f32x4*)(rowp + bj * HALF + n * 16) = acc[ai][bj][m][n];
            }
    }
};
template <class Epi, class Sched, bool ALIGN_EPI = false, bool SP2 = false>
__device__ __forceinline__ void gemm_phase(PG8_LAS unsigned char* lds, const Gemm g, const Sched& S, const Epi& E) {
    const int tid = threadIdx.x, wid = __builtin_amdgcn_readfirstlane(tid >> 6), lane = tid & 63, wr = wid >> 2, wc = wid & 3, fr = lane & 15, fq = lane >> 4;
    const int K = g.K, nt = K / BK;
    unsigned voffA[2], voffB[2];
#pragma unroll
    for (int i = 0; i < 2; ++i) { int R, C; stage_rc(tid * 16 + i * 8192, R, C); const int Rb = Epi::PERM ? ((R & ~31) + perm32(R & 31)) : R;
        voffA[i] = (unsigned)(R * K + C) * 2u; voffB[i] = (unsigned)(Rb * K + C) * 2u; }
    const size_t kstep = (size_t)(BK * 2);
    const size_t hstep = (size_t)HALF * K * 2;
    const size_t tstep = 2 * hstep;
    const unsigned ldsw = (unsigned)wid * 1024u;
    const int aoff = lds_byte(wr * 64 + fr, fq * 8), boff = lds_byte(wc * 32 + fr, fq * 8);
#define PG8_SA(b, h) (((b) * 2 + (h)) * HTB)
#define PG8_SB(b, h) ((4 + (b) * 2 + (h)) * HTB)
#define PG8_STAGE(bufoff, gbase, voff) do { _Pragma("unroll") for (int _i = 0; _i < 2; ++_i) \
        __builtin_amdgcn_global_load_lds((const unsigned*)((const char*)(gbase) + (voff)[_i]), (PG8_LAS unsigned*)(lds + (bufoff) + ldsw + _i * 8192), 16, 0, 0); } while (0)
#define PG8_LDA(dst, b, h) do { _Pragma("unroll") for (int m = 0; m < 4; ++m) _Pragma("unroll") for (int k = 0; k < 2; ++k) dst[m][k] = *(const PG8_LAS bf16x8*)(lds + PG8_SA(b, h) + aoff + m * 2048 + k * 1024); } while (0)
#define PG8_LDB(dst, b, h) do { _Pragma("unroll") for (int n = 0; n < 2; ++n) _Pragma("unroll") for (int k = 0; k < 2; ++k) dst[n][k] = *(const PG8_LAS bf16x8*)(lds + PG8_SB(b, h) + boff + n * 2048 + k * 1024); } while (0)
#define PG8_MMA(ai, bj, At, Bt) do { __builtin_amdgcn_s_setprio(1); _Pragma("unroll") for (int m = 0; m < 4; ++m) _Pragma("unroll") for (int n = 0; n < 2; ++n) _Pragma("unroll") for (int k = 0; k < 2; ++k) \
        acc[ai][bj][m][n] = __builtin_amdgcn_mfma_f32_16x16x32_bf16(Bt[n][k], At[m][k], acc[ai][bj][m][n], 0, 0, 0); __builtin_amdgcn_s_setprio(0); } while (0)
#define PG8_WAIT_V(n) asm volatile("s_waitcnt vmcnt(" #n ")" ::: "memory")
#define PG8_WAIT_L(n) asm volatile("s_waitcnt lgkmcnt(" #n ")" ::: "memory")
#define PG8_BAR __builtin_amdgcn_s_barrier()
#define PG8_SCHED __builtin_amdgcn_sched_barrier(0)
    Unit cur, nxt; int ui = 0;
    if (!S.next(0, cur)) return;
    f32x4 acc[2][2][4][2];
#pragma unroll
    for (int a = 0; a < 2; ++a)
#pragma unroll
        for (int b = 0; b < 2; ++b)
#pragma unroll
            for (int m = 0; m < 4; ++m)
#pragma unroll
                for (int n = 0; n < 2; ++n) acc[a][b][m][n] = (f32x4){0.f, 0.f, 0.f, 0.f};
    bf16x8 At[4][2], B0[2][2], B1[2][2];
    const char* cA = (const char*)g.A + (size_t)cur.pm * tstep; const char* cB = (const char*)g.Bt + (size_t)cur.pn * tstep;
    S.a_ready(cur);
    if constexpr (SP2) {
        PG8_STAGE(PG8_SB(0, 0), cB, voffB); PG8_STAGE(PG8_SB(0, 1), cB + hstep, voffB); PG8_STAGE(PG8_SA(0, 0), cA, voffA); PG8_STAGE(PG8_SA(0, 1), cA + hstep, voffA);
        if (wr == 1) PG8_BAR;
        PG8_WAIT_V(2); PG8_BAR;
        PG8_STAGE(PG8_SB(1, 0), cB + kstep, voffB); PG8_STAGE(PG8_SA(1, 0), cA + kstep, voffA); PG8_STAGE(PG8_SB(1, 1), cB + hstep + kstep, voffB);
        PG8_WAIT_V(6); PG8_BAR;
    } else {
        PG8_STAGE(PG8_SB(0, 0), cB, voffB); PG8_STAGE(PG8_SA(0, 0), cA, voffA); PG8_STAGE(PG8_SB(0, 1), cB + hstep, voffB); PG8_STAGE(PG8_SA(0, 1), cA + hstep, voffA);
        if (wr == 1) PG8_BAR;
        PG8_WAIT_V(4); PG8_BAR;
        PG8_STAGE(PG8_SB(1, 0), cB + kstep, voffB); PG8_STAGE(PG8_SA(1, 0), cA + kstep, voffA); PG8_STAGE(PG8_SB(1, 1), cB + hstep + kstep, voffB);
        PG8_WAIT_V(6); PG8_BAR;
    }
    for (;;) {
        const bool has_next = S.next(ui + 1, nxt);
        const char* nA = has_next ? (const char*)g.A + (size_t)nxt.pm * tstep : cA; const char* nB = has_next ? (const char*)g.Bt + (size_t)nxt.pn * tstep : cB;
        for (int t = 0; t < nt; t += 2) {
            const bool last = (t == nt - 2);
            const char* a1 = cA + (size_t)(t + 1) * kstep;
            const char* a2 = last ? nA : cA + (size_t)(t + 2) * kstep; const char* b2 = last ? nB : cB + (size_t)(t + 2) * kstep;
            const char* a3 = a2 + kstep; const char* b3 = b2 + kstep;
            if (last && has_next) S.a_ready(nxt);
            if constexpr (SP2) {
            PG8_LDB(B0, 0, 0); PG8_LDB(B1, 0, 1); PG8_SCHED; PG8_LDA(At, 0, 0); PG8_STAGE(PG8_SA(1, 1), a1 + hstep, voffA);
            PG8_WAIT_V(8); PG8_WAIT_L(0); PG8_BAR; PG8_MMA(0, 0, At, B0); PG8_MMA(0, 1, At, B1); PG8_BAR; PG8_SCHED;
            PG8_LDA(At, 0, 1); PG8_STAGE(PG8_SB(0, 0), b2, voffB); PG8_STAGE(PG8_SB(0, 1), b2 + hstep, voffB); PG8_STAGE(PG8_SA(0, 0), a2, voffA);
            PG8_WAIT_V(8); PG8_WAIT_L(0); PG8_BAR; PG8_MMA(1, 0, At, B0); PG8_MMA(1, 1, At, B1); PG8_BAR; PG8_SCHED;
            PG8_LDB(B0, 1, 0); PG8_LDB(B1, 1, 1); PG8_SCHED; PG8_LDA(At, 1, 0); PG8_STAGE(PG8_SA(0, 1), a2 + hstep, voffA);
            PG8_WAIT_V(8); PG8_WAIT_L(0); PG8_BAR; PG8_MMA(0, 0, At, B0); PG8_MMA(0, 1, At, B1); PG8_BAR; PG8_SCHED;
            PG8_LDA(At, 1, 1); PG8_STAGE(PG8_SB(1, 0), b3, voffB); PG8_STAGE(PG8_SB(1, 1), b3 + hstep, voffB); PG8_STAGE(PG8_SA(1, 0), a3, voffA);
            PG8_WAIT_V(8); PG8_WAIT_L(0); PG8_BAR; PG8_MMA(1, 0, At, B0); PG8_MMA(1, 1, At, B1); PG8_BAR; PG8_SCHED;
            } else {
            PG8_LDB(B0, 0, 0); PG8_SCHED; PG8_LDA(At, 0, 0); PG8_STAGE(PG8_SA(1, 1), a1 + hstep, voffA);
            PG8_WAIT_L(8); PG8_BAR; PG8_WAIT_L(0); PG8_MMA(0, 0, At, B0); PG8_BAR; PG8_SCHED;
            PG8_LDB(B1, 0, 1); PG8_STAGE(PG8_SB(0, 0), b2, voffB);
            PG8_BAR; PG8_WAIT_L(0); PG8_MMA(0, 1, At, B1); PG8_BAR;
            PG8_LDA(At, 0, 1); PG8_STAGE(PG8_SA(0, 0), a2, voffA);
            PG8_BAR; PG8_WAIT_L(0); PG8_MMA(1, 0, At, B0); PG8_BAR; PG8_SCHED;
            PG8_STAGE(PG8_SB(0, 1), b2 + hstep, voffB);
            PG8_WAIT_V(6); PG8_BAR; PG8_MMA(1, 1, At, B1); PG8_BAR;
            PG8_LDB(B0, 1, 0); PG8_SCHED; PG8_LDA(At, 1, 0); PG8_STAGE(PG8_SA(0, 1), a2 + hstep, voffA);
            PG8_WAIT_L(8); PG8_BAR; PG8_WAIT_L(0); PG8_MMA(0, 0, At, B0); PG8_BAR; PG8_SCHED;
            PG8_LDB(B1, 1, 1); PG8_STAGE(PG8_SB(1, 0), b3, voffB);
            PG8_BAR; PG8_WAIT_L(0); PG8_MMA(0, 1, At, B1); PG8_BAR;
            PG8_LDA(At, 1, 1); PG8_STAGE(PG8_SA(1, 0), a3, voffA);
            PG8_BAR; PG8_WAIT_L(0); PG8_MMA(1, 0, At, B0); PG8_BAR; PG8_SCHED;
            PG8_STAGE(PG8_SB(1, 1), b3 + hstep, voffB);
            PG8_WAIT_V(6); PG8_BAR; PG8_MMA(1, 1, At, B1); PG8_BAR;
            }
        }
        if constexpr (ALIGN_EPI) { if (wr == 0) PG8_BAR; }
        if constexpr (!Epi::AFTER_DRAIN) { E(acc, cur, wr, wc, fr, fq); S.done(cur); }
        if (!has_next) break;
#pragma unroll
        for (int a = 0; a < 2; ++a)
#pragma unroll
            for (int b = 0; b < 2; ++b)
#pragma unroll
                for (int m = 0; m < 4; ++m)
#pragma unroll
                    for (int n = 0; n < 2; ++n) acc[a][b][m][n] = (f32x4){0.f, 0.f, 0.f, 0.f};
        cur = nxt; cA = nA; cB = nB; ++ui;
        if constexpr (ALIGN_EPI) { if (wr == 1) PG8_BAR; }
    }
    PG8_WAIT_V(0);
    if constexpr (!ALIGN_EPI) { if (wr == 0) PG8_BAR; }
    PG8_BAR;
    if constexpr (Epi::AFTER_DRAIN) { E.fused(acc, cur, wr, wc, fr, fq, lds, wid, lane); S.done(cur); }
#undef PG8_SA
#undef PG8_SB
#undef PG8_STAGE
#undef PG8_LDA
#undef PG8_LDB
#undef PG8_MMA
#undef PG8_WAIT_V
#undef PG8_WAIT_L
#undef PG8_BAR
#undef PG8_SCHED
}
}
#define GAS __attribute__((address_space(1)))
#define LAS __attribute__((address_space(3)))
typedef unsigned short bf16;
typedef unsigned v4u __attribute__((ext_vector_type(4)));
typedef float f32x4 __attribute__((ext_vector_type(4)));
typedef short bf16x8 __attribute__((ext_vector_type(8)));
typedef GAS unsigned gu32;
typedef GAS unsigned long long gu64;
#define RLX_AGENT __ATOMIC_RELAXED, __HIP_MEMORY_SCOPE_AGENT
#define LDS_WAIT() asm volatile("s_waitcnt lgkmcnt(0)" ::: "memory")
#define VM_WAIT() asm volatile("s_waitcnt vmcnt(0)" ::: "memory")
__device__ __forceinline__ unsigned long long rt() { return __builtin_amdgcn_s_memrealtime(); }
__device__ __forceinline__ unsigned f2bf(float f) { unsigned u = __builtin_bit_cast(unsigned, f); return (u + 0x7fffu + ((u >> 16) & 1u)) >> 16; }
__device__ __forceinline__ unsigned pk2(float lo, float hi) { return f2bf(lo) | (f2bf(hi) << 16); }
#define XB_TMO      128
#define XB_XCNT(j)  (256  + 64 * (j))
#define XB_XSUB(j)  (1280 + 64 * (j))
#define XB_XGEN(j)  (2304 + 64 * (j))
#define XB_TOP      3328
#define XB_TOPGEN   3392
#define XCD_BAR_WORDS 3456
#define XB_SPIN_CAP (1u << 18)

__device__ __forceinline__ unsigned xb_ld(unsigned* p)              { return __hip_atomic_load(p, __ATOMIC_RELAXED, __HIP_MEMORY_SCOPE_AGENT); }
__device__ __forceinline__ unsigned xb_add(unsigned* p, unsigned v) { return __hip_atomic_fetch_add(p, v, __ATOMIC_RELAXED, __HIP_MEMORY_SCOPE_AGENT); }
__device__ __forceinline__ unsigned xb_xcc_id() { return (unsigned)__builtin_amdgcn_s_getreg((3 << 11) | 20) & 0xFu; }
#define XB_SPIN(cond, bar) do { unsigned _sp = 0; while (cond) { __builtin_amdgcn_s_sleep(1); \
    if ((++_sp & 255u) == 0u) { if (xb_ld(&(bar)[XB_TMO])) break; if (_sp > XB_SPIN_CAP) { atomicAdd(&(bar)[XB_TMO], 1u); break; } } } } while (0)

struct XcdBarrier {
    unsigned* bar; unsigned x;
    volatile LAS unsigned* st;
};

__device__ __forceinline__ XcdBarrier xcd_barrier_post(unsigned* bar, volatile LAS unsigned* st) {
    XcdBarrier b; b.bar = bar; b.x = xb_xcc_id(); b.st = st;
    if (threadIdx.x == 0) (void)xb_add(&bar[XB_XCNT(b.x)], 1u);
    return b;
}
__device__ __forceinline__ void xcd_barrier_complete(unsigned* bar, unsigned x, unsigned& nloc, unsigned& nx) {
    const unsigned G = gridDim.x * gridDim.y * gridDim.z;
    unsigned sum, cnt, mine, sp = 0u;
    for (;;) {
        sum = 0u; cnt = 0u; mine = 0u;
#pragma unroll
        for (unsigned j = 0; j < 16; ++j) { const unsigned c = xb_ld(&bar[XB_XCNT(j)]); sum += c; cnt += (c > 0u) ? 1u : 0u; mine = (j == x) ? c : mine; }
        if (sum == G) break;
        __builtin_amdgcn_s_sleep(1);
        if ((++sp & 255u) == 0u) { if (xb_ld(&bar[XB_TMO])) break; if (sp > XB_SPIN_CAP) { atomicAdd(&bar[XB_TMO], 1u); break; } }
    }
    nloc = mine > 0u ? mine : 1u; nx = cnt > 0u ? cnt : 1u;
}

__device__ __forceinline__ void xcd_barrier(const XcdBarrier& b) {
    asm volatile("s_waitcnt vmcnt(0)" ::: "memory");
    __syncthreads();
    if (threadIdx.x == 0) {
        unsigned* bar = b.bar;
        __builtin_amdgcn_s_waitcnt(0);
        unsigned nloc = b.st[0], nx = b.st[1];
        if (nloc == 0u) { xcd_barrier_complete(bar, b.x, nloc, nx); b.st[0] = nloc; b.st[1] = nx; }
        const unsigned old = xb_add(&bar[XB_XSUB(b.x)], 1u);
        const unsigned gen = old / nloc;
        if (old + 1u == (gen + 1u) * nloc) {
            __builtin_amdgcn_fence(__ATOMIC_RELEASE, "agent");
            asm volatile("s_waitcnt vmcnt(0)" ::: "memory");
            const unsigned og = xb_add(&bar[XB_TOP], 1u);
            const unsigned tg = og / nx;
            if (og + 1u == (tg + 1u) * nx) xb_add(&bar[XB_TOPGEN], 1u);
            else XB_SPIN(xb_ld(&bar[XB_TOPGEN]) == tg, bar);
            __builtin_amdgcn_fence(__ATOMIC_ACQUIRE, "agent");
            xb_add(&bar[XB_XGEN(b.x)], 1u);
            asm volatile("s_waitcnt vmcnt(0)" ::: "memory");
        } else {
            XB_SPIN(xb_ld(&bar[XB_XGEN(b.x)]) == gen, bar);
            __builtin_amdgcn_fence(__ATOMIC_ACQUIRE, "agent");
            asm volatile("s_waitcnt vmcnt(0)" ::: "memory");
        }
    }
    __syncthreads();
}
constexpr int NWAVES = 8, NTHR = 512;
constexpr int D = 1024, SEQ = 16384, DBATCH = 128, MP = SEQ, MS = 512, M = MP + MS;
constexpr int DFF = 2816, INW = 3072, PAST = 8192, WB = 2048, KEEP = 2048, NH = 8;
constexpr float EPS = 1e-6f;
constexpr int C_QA = 0, C_KA = 512, C_VA = 1024, C_QR = 1536, C_KR = 1792, C_VR = 2048, C_GR = 2560;
constexpr size_t O_Y = 0, O_KP = (size_t)M * D, O_VP = O_KP + (size_t)KEEP * 512, O_SP = O_VP + (size_t)KEEP * 512,
                 O_KS = O_SP + 32768, O_VS = O_KS + (size_t)MS * 512, O_SS = O_VS + (size_t)MS * 512, O_END = O_SS + (size_t)DBATCH * 32768;
constexpr size_t MiB = 1u << 20;
constexpr size_t WS_CTL = 0, CTL_ZERO_BYTES = 1 * MiB;
constexpr size_t WS_W1GU = 1 * MiB, WS_W1D = 12 * MiB, WS_WIN = 18 * MiB, WS_WOUT = 24 * MiB, WS_W2GU = 26 * MiB, WS_W2D = 37 * MiB, WS_TAB = 43 * MiB;
constexpr size_t WS_XN = 48 * MiB, WS_H = 81 * MiB, WS_Y = 172 * MiB, WS_HRES = 238 * MiB, WS_QKV = 304 * MiB, WS_MIX = 502 * MiB, WS_UPD = 535 * MiB, WS_SPREV = 551 * MiB, WS_END = 567 * MiB;
constexpr int CW_BAR = 4096;
constexpr int RING_BYTES = 131072, LDSCTL_OFF = RING_BYTES, MISC_OFF = LDSCTL_OFF + 320, LDS_BYTES = 147456;

__constant__ float INVF[40] = {
    1.f, 0.193922743f, 0.0376060307f, 0.00729266461f, 0.00141421356f, 0.000274248188f, 5.3182961e-05f, 1.03133862e-05f,
    1.f, 0.749894261f, 0.562341332f, 0.421696514f, 0.316227764f, 0.237137377f, 0.177827939f, 0.133352131f, 0.100000001f, 0.0749894157f,
    0.0562341325f, 0.0421696529f, 0.0316227749f, 0.0237137377f, 0.0177827943f, 0.0133352149f, 0.00999999978f, 0.00749894185f,
    0.00562341325f, 0.00421696482f, 0.00316227763f, 0.00237137359f, 0.00177827943f, 0.00133352145f, 0.00100000005f, 0.000749894243f,
    0.000562341302f, 0.000421696517f, 0.000316227757f, 0.00023713737f, 0.00017782794f, 0.00013335215f};
__device__ __forceinline__ float log_g(int h) { return h == 0 ? -0.0317486983145803f : h == 1 ? -0.015748356968139168f : h == 2 ? -0.007843177461025893f : -0.003913899321136329f; }
__device__ __forceinline__ float wave_sum(float v) {
#pragma unroll
    for (int o = 32; o >= 1; o >>= 1) v += __shfl_xor(v, o);
    return v;
}
__device__ __forceinline__ float wave_max(float v) {
#pragma unroll
    for (int o = 32; o >= 1; o >>= 1) v = fmaxf(v, __shfl_xor(v, o));
    return v;
}
__device__ __forceinline__ float silu_f(float x) { return x / (1.f + expf(-x)); }

__device__ __forceinline__ void tr_item(const float* W, int K, int N, bf16* WT, int mode, LAS float* scr, int item, int lane) {
    const int nblk = N / 32, kb = item / nblk, nb = item % nblk, k0 = 64 * kb, n0 = 32 * nb;
    const int rbase = mode == 0 ? n0 : (256 * (n0 >> 7) + (n0 & 127) + (mode == 2 ? 128 : 0));
#pragma unroll 8
    for (int i = 0; i < 32; ++i) { const int kk = 2 * i + (lane >> 5); scr[kk * 33 + (lane & 31)] = W[(size_t)(k0 + kk) * N + n0 + (lane & 31)]; }
    LDS_WAIT(); asm volatile("" ::: "memory");
    const int c = lane & 7;
#pragma unroll
    for (int j = 0; j < 4; ++j) { const int n = (lane >> 3) + 8 * j; const LAS float* s = scr + (8 * c) * 33 + n;
        v4u o; o.x = pk2(s[0 * 33], s[1 * 33]); o.y = pk2(s[2 * 33], s[3 * 33]); o.z = pk2(s[4 * 33], s[5 * 33]); o.w = pk2(s[6 * 33], s[7 * 33]);
        *(GAS v4u*)(WT + (size_t)(rbase + n) * K + k0 + 8 * c) = o; }
    LDS_WAIT(); asm volatile("" ::: "memory");
}
struct Ptrs {
    const float *xp, *xs, *ck, *cv, *st, *g1a, *g1b, *w1g, *w1u, *w1d, *gma, *gmb, *win, *gnw, *wout, *g2a, *g2b, *w2g, *w2u, *w2d;
    float* out;
    bf16 *W1GU, *W1D, *WIN, *WOUT, *W2GU, *W2D, *XN, *H, *MIX;
    float2* TAB; float *Y, *HRES, *QKV, *UPD, *SPREV;
};
__device__ __forceinline__ void p0_prologue(const Ptrs& P, LAS unsigned char* lds, int gw, int NGW, int wave, int lane, int gtid, int NGT) {
    LAS float* scr = (LAS float*)(lds + wave * 16384);
    constexpr int I_GU = 16 * 88, I_D = 44 * 32, I_IN = 16 * 96, I_OUT = 16 * 32;
    constexpr int NITEMS = 6 * I_GU + I_IN + I_OUT;
    static_assert(I_D == I_GU, "items");
    for (int it = gw; it < NITEMS; it += NGW) {
        int r = it;
        if (r < I_GU) { tr_item(P.w1g, D, DFF, P.W1GU, 1, scr, r, lane); continue; } r -= I_GU;
        if (r < I_GU) { tr_item(P.w1u, D, DFF, P.W1GU, 2, scr, r, lane); continue; } r -= I_GU;
        if (r < I_D) { tr_item(P.w1d, DFF, D, P.W1D, 0, scr, r, lane); continue; } r -= I_D;
        if (r < I_GU) { tr_item(P.w2g, D, DFF, P.W2GU, 1, scr, r, lane); continue; } r -= I_GU;
        if (r < I_GU) { tr_item(P.w2u, D, DFF, P.W2GU, 2, scr, r, lane); continue; } r -= I_GU;
        if (r < I_D) { tr_item(P.w2d, DFF, D, P.W2D, 0, scr, r, lane); continue; } r -= I_D;
        if (r < I_IN) { tr_item(P.win, D, INW, P.WIN, 0, scr, r, lane); continue; } r -= I_IN;
        tr_item(P.wout, D, D, P.WOUT, 0, scr, r, lane);
    }
    for (int idx = gtid; idx < SEQ * 40; idx += NGT) {
        const int pos = idx / 40, f = idx % 40;
        const float ang = (float)pos * INVF[f];
        const double rev = (double)ang * 0.15915494309189535;
        const float fr = (float)(rev - rint(rev));
        P.TAB[idx] = make_float2(__builtin_amdgcn_cosf(fr), __builtin_amdgcn_sinf(fr));
    }
    for (int r = gw; r < M; r += NGW) {
        const float4* x = (const float4*)(r < MP ? P.xp + (size_t)r * D : P.xs + (size_t)(r - MP) * D);
        float4 v[4]; float ss = 0.f;
#pragma unroll
        for (int j = 0; j < 4; ++j) { v[j] = x[lane + 64 * j]; ss += v[j].x * v[j].x + v[j].y * v[j].y + v[j].z * v[j].z + v[j].w * v[j].w; }
        const float rstd = 1.f / sqrtf(wave_sum(ss) * (1.f / D) + EPS);
        uint2* o = (uint2*)(P.XN + (size_t)r * D);
#pragma unroll
        for (int j = 0; j < 4; ++j) { const float4 gg = ((const float4*)P.g1a)[lane + 64 * j];
            o[lane + 64 * j] = make_uint2(pk2(v[j].x * rstd * gg.x, v[j].y * rstd * gg.y), pk2(v[j].z * rstd * gg.z, v[j].w * rstd * gg.w)); }
    }
}
__device__ __forceinline__ void norm_res_phase(const float* resA, const float* resB, const float* Y, const float* gpost, float scale, float* hout, const float* gnext, bf16* XN, int gw, int NGW, int lane) {
    for (int r = gw; r < M; r += NGW) {
        const float4* x = (const float4*)(r < MP ? resA + (size_t)r * D : resB + (size_t)(r - MP) * D);
        const float4* y = (const float4*)(Y + (size_t)r * D);
        float4 v[4], hv[4]; float ss = 0.f;
#pragma unroll
        for (int j = 0; j < 4; ++j) { v[j] = y[lane + 64 * j]; hv[j] = x[lane + 64 * j]; ss += v[j].x * v[j].x + v[j].y * v[j].y + v[j].z * v[j].z + v[j].w * v[j].w; }
        const float rstd = scale / sqrtf(wave_sum(ss) * (1.f / D) + EPS);
        float s2 = 0.f;
#pragma unroll
        for (int j = 0; j < 4; ++j) { const float4 gg = ((const float4*)gpost)[lane + 64 * j];
            hv[j].x += v[j].x * rstd * gg.x; hv[j].y += v[j].y * rstd * gg.y; hv[j].z += v[j].z * rstd * gg.z; hv[j].w += v[j].w * rstd * gg.w;
            s2 += hv[j].x * hv[j].x + hv[j].y * hv[j].y + hv[j].z * hv[j].z + hv[j].w * hv[j].w; }
        float4* ho = (float4*)(hout + (size_t)r * D);
#pragma unroll
        for (int j = 0; j < 4; ++j) ho[lane + 64 * j] = hv[j];
        if (gnext) {
            const float r2 = 1.f / sqrtf(wave_sum(s2) * (1.f / D) + EPS);
            uint2* o = (uint2*)(XN + (size_t)r * D);
#pragma unroll
            for (int j = 0; j < 4; ++j) { const float4 gg = ((const float4*)gnext)[lane + 64 * j];
                o[lane + 64 * j] = make_uint2(pk2(hv[j].x * r2 * gg.x, hv[j].y * r2 * gg.y), pk2(hv[j].z * r2 * gg.z, hv[j].w * r2 * gg.w)); }
        }
    }
}
__device__ __forceinline__ void rope_phase(float* QKV, const float2* tab, float* out, int gw, int NGW, int lane) {
    for (int r = gw; r < M; r += NGW) {
        const int pos = r < MP ? r : PAST + ((r - MP) & 3);
        float* row = QKV + (size_t)r * INW;
        float *ko = nullptr, *vo = nullptr;
        if (r >= MP) { ko = out + O_KS + (size_t)(r - MP) * 512; vo = out + O_VS + (size_t)(r - MP) * 512; }
        else if (r >= MP - KEEP) { ko = out + O_KP + (size_t)(r - (MP - KEEP)) * 512; vo = out + O_VP + (size_t)(r - (MP - KEEP)) * 512; }
#pragma unroll
        for (int s = 0; s < 2; ++s) {
            const int i = lane & 7, hb = (lane >> 3) * 64, base = s * 512 + hb;
            const float2 cs = tab[pos * 40 + i];
            const float x1 = row[base + i], x2 = row[base + 8 + i];
            const float y1 = x1 * cs.x - x2 * cs.y, y2 = x2 * cs.x + x1 * cs.y;
            row[base + i] = y1; row[base + 8 + i] = y2;
            if (s == 1 && ko) { ko[hb + i] = y1; ko[hb + 8 + i] = y2; }
        }
#pragma unroll
        for (int s = 0; s < 4; ++s) {
            const int i = lane & 31, h = ((s & 1) << 1) | (lane >> 5), base = C_QR + (s >> 1) * 256 + h * 64;
            const float2 cs = tab[pos * 40 + 8 + i];
            const float sc = (s >> 1) ? 0.125f : 1.f;
            const float x1 = row[base + i], x2 = row[base + 32 + i];
            row[base + i] = (x1 * cs.x - x2 * cs.y) * sc; row[base + 32 + i] = (x2 * cs.x + x1 * cs.y) * sc;
        }
        if (ko) {
#pragma unroll
            for (int e = lane; e < 512; e += 64) { if ((e & 63) >= 16) ko[e] = row[C_KA + e]; vo[e] = row[C_VA + e]; }
        }
    }
}
__device__ __forceinline__ void attn_naive_phase(LAS unsigned char* lds, const float* QKV, const float* ck, const float* cv, bf16* MIX, int gw, int NGW, int wave, int lane) {
    LAS float* qs = (LAS float*)(lds + wave * 2048);
    LAS float* ps = qs + 64;
    for (int item = gw; item < M * NH; item += NGW) {
        const int h = item & 7, r = item >> 3;
        const bool samp = r >= MP;
        const int b = (r - MP) >> 2, ii = (r - MP) & 3;
        qs[lane] = QKV[(size_t)r * INW + C_QA + h * 64 + lane];
        LDS_WAIT(); asm volatile("" ::: "memory");
        float sc[3][3]; float mx = -1e30f;
#pragma unroll
        for (int br = 0; br < 3; ++br) {
            const int d = 1 << (2 * br);
#pragma unroll
            for (int s = 0; s < 3; ++s) {
                const int j = lane + 64 * s;
                sc[br][s] = -1e30f;
                if (j <= 128) {
                    const float* kp = nullptr;
                    if (samp) { const int idx = WB + ii - j * d;
                        if (idx >= WB) kp = QKV + (size_t)(MP + b * 4 + (idx - WB)) * INW + C_KA + h * 64;
                        else if (idx >= 0) kp = ck + ((size_t)(b * WB + idx) * NH + h) * 64; }
                    else { const int tk = r - j * d; if (tk >= 0) kp = QKV + (size_t)tk * INW + C_KA + h * 64; }
                    if (kp) {
                        float dot = 0.f;
#pragma unroll
                        for (int c = 0; c < 16; ++c) { const float4 kk = ((const float4*)kp)[c]; const f32x4 qq = *(const LAS f32x4*)&qs[4 * c];
                            dot += kk.x * qq[0] + kk.y * qq[1] + kk.z * qq[2] + kk.w * qq[3]; }
                        sc[br][s] = dot * 0.125f;
                    }
                }
                mx = fmaxf(mx, sc[br][s]);
            }
        }
        mx = wave_max(mx);
        float l = 0.f;
#pragma unroll
        for (int br = 0; br < 3; ++br)
#pragma unroll
            for (int s = 0; s < 3; ++s) {
                const int j = lane + 64 * s;
                const float p = sc[br][s] > -1e29f ? expf(sc[br][s] - mx) : 0.f;
                l += p;
                if (j <= 128) ps[br * 132 + j] = p;
            }
        l = wave_sum(l);
        LDS_WAIT(); asm volatile("" ::: "memory");
        float o = 0.f;
#pragma unroll
        for (int br = 0; br < 3; ++br) {
            const int d = 1 << (2 * br);
            for (int j = 0; j <= 128; ++j) {
                const float* vp = nullptr;
                if (samp) { const int idx = WB + ii - j * d;
                    if (idx >= WB) vp = QKV + (size_t)(MP + b * 4 + (idx - WB)) * INW + C_VA + h * 64;
                    else if (idx >= 0) vp = cv + ((size_t)(b * WB + idx) * NH + h) * 64; }
                else { const int tk = r - j * d; if (tk >= 0) vp = QKV + (size_t)tk * INW + C_VA + h * 64; }
                if (vp) o += ps[br * 132 + j] * vp[lane];
            }
        }
        MIX[(size_t)r * D + h * 64 + lane] = (bf16)f2bf(o / l);
        LDS_WAIT(); asm volatile("" ::: "memory");
    }
}
__device__ __forceinline__ void ret_upd_phase(LAS unsigned char* lds, const float* QKV, float* UPD, int tid) {
    LAS float* kc = (LAS float*)lds;
    for (int it = blockIdx.x; it < 512; it += gridDim.x) {
        const int n = it >> 2, h = it & 3;
        const float lg = log_g(h);
        for (int e = tid; e < 128 * 64; e += NTHR) { const int j = e >> 6, dk = e & 63;
            kc[e] = QKV[(size_t)(n * 128 + j) * INW + C_KR + h * 64 + dk] * expf((float)(127 - j) * lg); }
        __syncthreads();
        const int dv = tid & 127, qt = tid >> 7;
        float acc[16];
#pragma unroll
        for (int i = 0; i < 16; ++i) acc[i] = 0.f;
        for (int j = 0; j < 128; ++j) {
            const float vj = QKV[(size_t)(n * 128 + j) * INW + C_VR + h * 128 + dv];
#pragma unroll
            for (int i = 0; i < 16; ++i) acc[i] += kc[j * 64 + qt * 16 + i] * vj;
        }
#pragma unroll
        for (int i = 0; i < 16; ++i) UPD[((size_t)(n * 4 + h) * 64 + qt * 16 + i) * 128 + dv] = acc[i];
        __syncthreads();
    }
}
__device__ __forceinline__ void ret_scan_phase(const float* UPD, float* SPREV, float* out, int tid) {
    const int e = blockIdx.x * NTHR + tid;
    if (e < 32768) {
        const int h = e >> 13;
        const float G = expf(128.f * log_g(h));
        float S = 0.f;
        for (int n = 0; n < 128; ++n) { SPREV[(size_t)n * 32768 + e] = S; S = G * S + UPD[(size_t)n * 32768 + e]; }
        out[O_SP + e] = S;
    }
}
__device__ __forceinline__ void ret_out_phase(LAS unsigned char* lds, const float* QKV, const float* SPREV, const float* gnw, bf16* MIX, int tid) {
    const int grp = tid >> 7, t = tid & 127;
    LAS float* qs = (LAS float*)(lds + grp * 2048);
    LAS float* ss = qs + 64;
    LAS float* red = ss + 128;
    for (int it = blockIdx.x; it < 16384; it += gridDim.x) {
        const int sub = it * 4 + grp;
        const int i = sub & 127, h = (sub >> 7) & 3, n = sub >> 9;
        const float lg = log_g(h);
        const int row = n * 128 + i;
        if (t < 64) qs[t] = QKV[(size_t)row * INW + C_QR + h * 64 + t];
        __syncthreads();
        { const int j = t; float s = 0.f;
          if (j <= i) { const float* kp = QKV + (size_t)(n * 128 + j) * INW + C_KR + h * 64; float dot = 0.f;
#pragma unroll
              for (int c = 0; c < 16; ++c) { const float4 kk = ((const float4*)kp)[c]; dot += kk.x * qs[4 * c] + kk.y * qs[4 * c + 1] + kk.z * qs[4 * c + 2] + kk.w * qs[4 * c + 3]; }
              s = dot * expf((float)(i - j) * lg); }
          ss[j] = s; }
        __syncthreads();
        const int dv = t;
        float o = 0.f;
        for (int j = 0; j <= i; ++j) o += ss[j] * QKV[(size_t)(n * 128 + j) * INW + C_VR + h * 128 + dv];
        float c = 0.f;
        const float* sp = SPREV + (size_t)(n * 4 + h) * 64 * 128 + dv;
        for (int dk = 0; dk < 64; ++dk) c += qs[dk] * sp[dk * 128];
        o += c * expf((float)(i + 1) * lg);
        const float s1 = wave_sum(o);
        if ((t & 63) == 0) red[t >> 6] = s1;
        __syncthreads();
        const float mu = (red[0] + red[1]) * (1.f / 128.f);
        const float dlt = o - mu;
        const float s2 = wave_sum(dlt * dlt);
        if ((t & 63) == 0) red[2 + (t >> 6)] = s2;
        __syncthreads();
        const float var = (red[2] + red[3]) * (1.f / 128.f);
        const float y = dlt / sqrtf(var + EPS) * gnw[h * 128 + dv];
        const float g = QKV[(size_t)row * INW + C_GR + h * 128 + dv];
        MIX[(size_t)row * D + 512 + h * 128 + dv] = (bf16)f2bf(silu_f(g) * y);
        __syncthreads();
    }
}
__device__ __forceinline__ void ret_sample_phase(LAS unsigned char* lds, const float* QKV, const float* state, const float* gnw, bf16* MIX, float* out, int tid) {
    const int grp = tid >> 7, t = tid & 127, dv = t;
    LAS float* qs = (LAS float*)(lds + grp * 4096);
    LAS float* ks = qs + 256;
    LAS float* red = ks + 256;
    for (int it = blockIdx.x; it < 128; it += gridDim.x) {
        const int sub = it * 4 + grp, b = sub >> 2, h = sub & 3;
        const float g = 1.f - exp2f(-5.f - (float)h);
        const float g2 = g * g, g3 = g2 * g, g4 = g2 * g2;
        const int row0 = MP + b * 4;
        for (int e = t; e < 256; e += 128) { const int i = e >> 6, dk = e & 63;
            qs[e] = QKV[(size_t)(row0 + i) * INW + C_QR + h * 64 + dk]; ks[e] = QKV[(size_t)(row0 + i) * INW + C_KR + h * 64 + dk]; }
        __syncthreads();
        float v[4];
#pragma unroll
        for (int i = 0; i < 4; ++i) v[i] = QKV[(size_t)(row0 + i) * INW + C_VR + h * 128 + dv];
        const float* s0p = state + (size_t)(b * 4 + h) * 64 * 128 + dv;
        float* snp = out + O_SS + (size_t)(b * 4 + h) * 64 * 128 + dv;
        float c0 = 0.f, c1 = 0.f, c2 = 0.f, c3 = 0.f;
        for (int dk = 0; dk < 64; ++dk) {
            const float s0 = s0p[dk * 128];
            c0 += qs[dk] * s0; c1 += qs[64 + dk] * s0; c2 += qs[128 + dk] * s0; c3 += qs[192 + dk] * s0;
            snp[dk * 128] = g4 * s0 + g3 * ks[dk] * v[0] + g2 * ks[64 + dk] * v[1] + g * ks[128 + dk] * v[2] + ks[192 + dk] * v[3];
        }
        float d00 = 0.f, d10 = 0.f, d11 = 0.f, d20 = 0.f, d21 = 0.f, d22 = 0.f, d30 = 0.f, d31 = 0.f, d32 = 0.f, d33 = 0.f;
        for (int dk = 0; dk < 64; ++dk) {
            const float q0 = qs[dk], q1 = qs[64 + dk], q2 = qs[128 + dk], q3 = qs[192 + dk];
            const float k0 = ks[dk], k1 = ks[64 + dk], k2 = ks[128 + dk], k3 = ks[192 + dk];
            d00 += q0 * k0; d10 += q1 * k0; d11 += q1 * k1; d20 += q2 * k0; d21 += q2 * k1; d22 += q2 * k2;
            d30 += q3 * k0; d31 += q3 * k1; d32 += q3 * k2; d33 += q3 * k3;
        }
        float o[4];
        o[0] = g * c0 + d00 * v[0];
        o[1] = g2 * c1 + g * d10 * v[0] + d11 * v[1];
        o[2] = g3 * c2 + g2 * d20 * v[0] + g * d21 * v[1] + d22 * v[2];
        o[3] = g4 * c3 + g3 * d30 * v[0] + g2 * d31 * v[1] + g * d32 * v[2] + d33 * v[3];
#pragma unroll
        for (int i = 0; i < 4; ++i) { const float s1 = wave_sum(o[i]); if ((t & 63) == 0) red[i * 2 + (t >> 6)] = s1; }
        __syncthreads();
        float dl[4];
#pragma unroll
        for (int i = 0; i < 4; ++i) { const float mu = (red[i * 2] + red[i * 2 + 1]) * (1.f / 128.f); dl[i] = o[i] - mu; }
#pragma unroll
        for (int i = 0; i < 4; ++i) { const float s2 = wave_sum(dl[i] * dl[i]); if ((t & 63) == 0) red[8 + i * 2 + (t >> 6)] = s2; }
        __syncthreads();
#pragma unroll
        for (int i = 0; i < 4; ++i) {
            const float var = (red[8 + i * 2] + red[8 + i * 2 + 1]) * (1.f / 128.f);
            const float y = dl[i] / sqrtf(var + EPS) * gnw[h * 128 + dv];
            const float gg = QKV[(size_t)(row0 + i) * INW + C_GR + h * 128 + dv];
            MIX[(size_t)(row0 + i) * D + 512 + h * 128 + dv] = (bf16)f2bf(silu_f(gg) * y);
        }
        __syncthreads();
    }
}

struct Args { const float* in[20]; float* out; unsigned char* ws; };
__global__ void __launch_bounds__(NTHR, 2) mk_fwd(Args a) {
    extern __shared__ __attribute__((aligned(16))) unsigned char lds_raw[];
    LAS unsigned char* lds = (LAS unsigned char*)lds_raw;
    volatile LAS unsigned* MISC = (volatile LAS unsigned*)(lds + MISC_OFF);
    const int tid = threadIdx.x, lane = tid & 63, wave = __builtin_amdgcn_readfirstlane(tid >> 6);
    const int G = gridDim.x;
    const int gw = blockIdx.x * NWAVES + wave, NGW = G * NWAVES, gtid = blockIdx.x * NTHR + tid, NGT = G * NTHR;
    unsigned char* ws = a.ws;
    Ptrs P;
    P.xp = a.in[0]; P.xs = a.in[1]; P.ck = a.in[2]; P.cv = a.in[3]; P.st = a.in[4]; P.g1a = a.in[5]; P.g1b = a.in[6]; P.w1g = a.in[7]; P.w1u = a.in[8]; P.w1d = a.in[9];
    P.gma = a.in[10]; P.gmb = a.in[11]; P.win = a.in[12]; P.gnw = a.in[13]; P.wout = a.in[14]; P.g2a = a.in[15]; P.g2b = a.in[16]; P.w2g = a.in[17]; P.w2u = a.in[18]; P.w2d = a.in[19];
    P.out = a.out;
    P.W1GU = (bf16*)(ws + WS_W1GU); P.W1D = (bf16*)(ws + WS_W1D); P.WIN = (bf16*)(ws + WS_WIN); P.WOUT = (bf16*)(ws + WS_WOUT); P.W2GU = (bf16*)(ws + WS_W2GU); P.W2D = (bf16*)(ws + WS_W2D);
    P.XN = (bf16*)(ws + WS_XN); P.H = (bf16*)(ws + WS_H); P.MIX = (bf16*)(ws + WS_MIX);
    P.TAB = (float2*)(ws + WS_TAB); P.Y = (float*)(ws + WS_Y); P.HRES = (float*)(ws + WS_HRES); P.QKV = (float*)(ws + WS_QKV); P.UPD = (float*)(ws + WS_UPD); P.SPREV = (float*)(ws + WS_SPREV);
    for (int u = tid; u < (LDS_BYTES - LDSCTL_OFF) / 4; u += NTHR) ((LAS unsigned*)(lds + LDSCTL_OFF))[u] = 0u;
    __syncthreads();
    XcdBarrier bar = xcd_barrier_post((unsigned*)(ws + WS_CTL) + CW_BAR, MISC + 8);

    p0_prologue(P, lds, gw, NGW, wave, lane, gtid, NGT);
    xcd_barrier(bar);
    { pg8::Gemm g{P.XN, P.W1GU, M, 2 * DFF, D}; pg8::StaticOrder S; S.init(M, 2 * DFF, G, (int)blockIdx.x); pg8::EpiSwiglu E{P.H, DFF};
      pg8::gemm_phase<pg8::EpiSwiglu, pg8::StaticOrder, true, true>(lds, g, S, E); }
    xcd_barrier(bar);
    { pg8::Gemm g{P.H, P.W1D, M, D, DFF}; pg8::StaticOrder S; S.init(M, D, G, (int)blockIdx.x); pg8::EpiF32 E{P.Y, D};
      pg8::gemm_phase<pg8::EpiF32, pg8::StaticOrder, true, true>(lds, g, S, E); }
    xcd_barrier(bar);
    norm_res_phase(P.xp, P.xs, P.Y, P.g1b, 0.5f, P.HRES, P.gma, P.XN, gw, NGW, lane);
    xcd_barrier(bar);
    { pg8::Gemm g{P.XN, P.WIN, M, INW, D}; pg8::StaticOrder S; S.init(M, INW, G, (int)blockIdx.x); pg8::EpiF32 E{P.QKV, INW};
      pg8::gemm_phase<pg8::EpiF32, pg8::StaticOrder, true, true>(lds, g, S, E); }
    xcd_barrier(bar);
    rope_phase(P.QKV, P.TAB, P.out, gw, NGW, lane);
    xcd_barrier(bar);
    ret_upd_phase(lds, P.QKV, P.UPD, tid);
    ret_sample_phase(lds, P.QKV, P.st, P.gnw, P.MIX, P.out, tid);
    attn_naive_phase(lds, P.QKV, P.ck, P.cv, P.MIX, gw, NGW, wave, lane);
    xcd_barrier(bar);
    ret_scan_phase(P.UPD, P.SPREV, P.out, tid);
    xcd_barrier(bar);
    ret_out_phase(lds, P.QKV, P.SPREV, P.gnw, P.MIX, tid);
    xcd_barrier(bar);
    { pg8::Gemm g{P.MIX, P.WOUT, M, D, D}; pg8::StaticOrder S; S.init(M, D, G, (int)blockIdx.x); pg8::EpiF32 E{P.Y, D};
      pg8::gemm_phase<pg8::EpiF32, pg8::StaticOrder, true, true>(lds, g, S, E); }
    xcd_barrier(bar);
    norm_res_phase(P.HRES, P.HRES + (size_t)MP * D, P.Y, P.gmb, 1.0f, P.HRES, P.g2a, P.XN, gw, NGW, lane);
    xcd_barrier(bar);
    { pg8::Gemm g{P.XN, P.W2GU, M, 2 * DFF, D}; pg8::StaticOrder S; S.init(M, 2 * DFF, G, (int)blockIdx.x); pg8::EpiSwiglu E{P.H, DFF};
      pg8::gemm_phase<pg8::EpiSwiglu, pg8::StaticOrder, true, true>(lds, g, S, E); }
    xcd_barrier(bar);
    { pg8::Gemm g{P.H, P.W2D, M, D, DFF}; pg8::StaticOrder S; S.init(M, D, G, (int)blockIdx.x); pg8::EpiF32 E{P.Y, D};
      pg8::gemm_phase<pg8::EpiF32, pg8::StaticOrder, true, true>(lds, g, S, E); }
    xcd_barrier(bar);
    norm_res_phase(P.HRES, P.HRES + (size_t)MP * D, P.Y, P.g2b, 0.5f, P.out + O_Y, nullptr, nullptr, gw, NGW, lane);
}

extern "C" void kernel_launch(void* const* d_in, const int* in_sizes, int n_in, void* d_out, int out_size, void* d_ws, size_t ws_size, hipStream_t stream) {
    static int grid = 0;
    if (grid == 0) {
        if (n_in != 20 || (size_t)out_size != O_END || ws_size < WS_END) { fprintf(stderr, "kernel_launch: unexpected sizes (n_in %d out %d ws %zu)\n", n_in, out_size, ws_size); grid = -1; return; }
        int dev = 0, cus = 0;
        if (hipGetDevice(&dev) != hipSuccess || hipDeviceGetAttribute(&cus, hipDeviceAttributeMultiprocessorCount, dev) != hipSuccess) { grid = -1; return; }
        if (hipFuncSetAttribute((const void*)mk_fwd, hipFuncAttributeMaxDynamicSharedMemorySize, LDS_BYTES) != hipSuccess) { fprintf(stderr, "kernel_launch: hipFuncSetAttribute failed\n"); grid = -1; return; }
        int per_cu = 0;
        if (hipOccupancyMaxActiveBlocksPerMultiprocessor(&per_cu, (const void*)mk_fwd, NTHR, LDS_BYTES) != hipSuccess || per_cu < 1) fprintf(stderr, "kernel_launch: occupancy query says %d\n", per_cu);
        (void)hipGetLastError();
        grid = cus;
    }
    if (grid < 0) return;
    (void)hipMemsetAsync((char*)d_ws + WS_CTL, 0, CTL_ZERO_BYTES, stream);
    Args a{};
    for (int i = 0; i < 20; ++i) a.in[i] = (const float*)d_in[i];
    a.out = (float*)d_out; a.ws = (unsigned char*)d_ws;
    hipLaunchKernelGGL(mk_fwd, dim3(grid), dim3(NTHR), LDS_BYTES, stream, a);
}
```

```cpp
#include <hip/hip_runtime.h>
#include <cstdio>
#include <cstdint>
namespace pg8 {
#define PG8_LAS __attribute__((address_space(3)))
typedef unsigned short bf16_t;
typedef short bf16x8 __attribute__((ext_vector_type(8)));
typedef float f32x4 __attribute__((ext_vector_type(4)));
typedef unsigned u32x4 __attribute__((ext_vector_type(4)));
constexpr int BM = 256, BK = 64, HALF = 128, HTB = HALF * BK * 2  , STAGE_BYTES = 8 * HTB, NXCD = 8, WGM = 8;

__host__ __device__ __forceinline__ int lds_byte(int r, int c) { const int st = (r >> 4) * 2 + (c >> 5), rr = r & 15, cc = c & 31, ob = rr * 64 + cc * 2; return st * 1024 + (ob ^ (((ob >> 9) & 1) << 5)); }
__host__ __device__ __forceinline__ void stage_rc(int b, int& R, int& C) { const int st = b / 1024, sb = b % 1024, swz = sb ^ (((sb >> 9) & 1) << 5); R = (st >> 1) * 16 + swz / 64; C = (st & 1) * 32 + (swz % 64) / 2; }
__host__ __device__ __forceinline__ int perm32(int rho) { const int n = rho >> 4, i = rho & 15; return 8 * (i >> 2) + 4 * n + (i & 3); }

struct Unit { int pm, pn; };
struct Gemm { const bf16_t* A; const bf16_t* Bt; int M, N, K; };

struct StaticOrder {
    int nM, nN, nwg, G, c;
    __host__ __device__ void init(int M, int N, int G_, int c_) { nM = M / BM; nN = N / BM; nwg = nM * nN; G = G_; c = c_; }
    __host__ __device__ bool next(int i, Unit& u) const {
        const long L = (long)i * G + c; if (L >= nwg) return false;
        int wgid = (int)L; { const int q = nwg / NXCD, r = nwg % NXCD, xcd = wgid % NXCD, off = wgid / NXCD; wgid = (xcd < r ? xcd * (q + 1) : r * (q + 1) + (xcd - r) * q) + off; }
        const int nig = WGM * nN, gid = wgid / nig, fm = gid * WGM, gsz = (nM - fm) < WGM ? (nM - fm) : WGM;
        u.pm = fm + ((wgid % nig) % gsz); u.pn = (wgid % nig) / gsz; return true;
    }
    __device__ __forceinline__ void a_ready(const Unit&) const {}
    __device__ __forceinline__ void done(const Unit&) const {}
};

__device__ __forceinline__ unsigned cvt_pk_bf16(float lo, float hi) { unsigned r; asm volatile("v_cvt_pk_bf16_f32 %0, %1, %2" : "=v"(r) : "v"(lo), "v"(hi)); return r; }
typedef float f32x2 __attribute__((ext_vector_type(2)));
__device__ __forceinline__ float silu_fast(float x) { return x * __builtin_amdgcn_rcpf(1.0f + __builtin_amdgcn_exp2f(-1.4426950408889634f * x)); }
struct EpiSwiglu {
    static constexpr bool PERM = true, AFTER_DRAIN = false;
    bf16_t* O; int ldc;
    __device__ __forceinline__ void operator()(const f32x4 (&acc)[2][2][4][2], const Unit& u, int wr, int wc, int fr, int fq) const {
        const int row0 = u.pm * BM + wr * 64 + fr, col0 = u.pn * HALF + wc * 32 + 8 * fq;
#pragma unroll
        for (int ai = 0; ai < 2; ++ai)
#pragma unroll
            for (int m = 0; m < 4; ++m) {
                bf16_t* rowp = O + (size_t)(row0 + ai * HALF + m * 16) * ldc + col0;
                const f32x4 g0 = acc[ai][0][m][0], g1 = acc[ai][0][m][1], u0 = acc[ai][1][m][0], u1 = acc[ai][1][m][1];
                u32x4 w;
                w.x = cvt_pk_bf16(silu_fast(g0[0]) * u0[0], silu_fast(g0[1]) * u0[1]); w.y = cvt_pk_bf16(silu_fast(g0[2]) * u0[2], silu_fast(g0[3]) * u0[3]);
                w.z = cvt_pk_bf16(silu_fast(g1[0]) * u1[0], silu_fast(g1[1]) * u1[1]); w.w = cvt_pk_bf16(silu_fast(g1[2]) * u1[2], silu_fast(g1[3]) * u1[3]);
                *(u32x4*)rowp = w;
            }
    }
};
struct EpiF32 {
    static constexpr bool PERM = false, AFTER_DRAIN = false;
    float* O; int ldc;
    __device__ __forceinline__ void operator()(const f32x4 (&acc)[2][2][4][2], const Unit& u, int wr, int wc, int fr, int fq) const {
        const int row0 = u.pm * BM + wr * 64 + fr, col0 = u.pn * BM + wc * 32 + 4 * fq;
#pragma unroll
        for (int ai = 0; ai < 2; ++ai)
#pragma unroll
            for (int m = 0; m < 4; ++m) {
                float* rowp = O + (size_t)(row0 + ai * HALF + m * 16) * ldc + col0;
#pragma unroll
                for (int bj = 0; bj < 2; ++bj)
#pragma unroll
                    for (int n = 0; n < 2; ++n) *(f32x4*)(rowp + bj * HALF + n * 16) = acc[ai][bj][m][n];
            }
    }
};
template <class Epi, class Sched, bool ALIGN_EPI = false, bool SP2 = false>
__device__ __forceinline__ void gemm_phase(PG8_LAS unsigned char* lds, const Gemm g, const Sched& S, const Epi& E) {
    const int tid = threadIdx.x, wid = __builtin_amdgcn_readfirstlane(tid >> 6), lane = tid & 63, wr = wid >> 2, wc = wid & 3, fr = lane & 15, fq = lane >> 4;
    const int K = g.K, nt = K / BK;
    unsigned voffA[2], voffB[2];
#pragma unroll
    for (int i = 0; i < 2; ++i) { int R, C; stage_rc(tid * 16 + i * 8192, R, C); const int Rb = Epi::PERM ? ((R & ~31) + perm32(R & 31)) : R;
        voffA[i] = (unsigned)(R * K + C) * 2u; voffB[i] = (unsigned)(Rb * K + C) * 2u; }
    const size_t kstep = (size_t)(BK * 2);
    const size_t hstep = (size_t)HALF * K * 2;
    const size_t tstep = 2 * hstep;
    const unsigned ldsw = (unsigned)wid * 1024u;
    const int aoff = lds_byte(wr * 64 + fr, fq * 8), boff = lds_byte(wc * 32 + fr, fq * 8);
#define PG8_SA(b, h) (((b) * 2 + (h)) * HTB)
#define PG8_SB(b, h) ((4 + (b) * 2 + (h)) * HTB)
#define PG8_STAGE(bufoff, gbase, voff) do { _Pragma("unroll") for (int _i = 0; _i < 2; ++_i) \
        __builtin_amdgcn_global_load_lds((const unsigned*)((const char*)(gbase) + (voff)[_i]), (PG8_LAS unsigned*)(lds + (bufoff) + ldsw + _i * 8192), 16, 0, 0); } while (0)
#define PG8_LDA(dst, b, h) do { _Pragma("unroll") for (int m = 0; m < 4; ++m) _Pragma("unroll") for (int k = 0; k < 2; ++k) dst[m][k] = *(const PG8_LAS bf16x8*)(lds + PG8_SA(b, h) + aoff + m * 2048 + k * 1024); } while (0)
#define PG8_LDB(dst, b, h) do { _Pragma("unroll") for (int n = 0; n < 2; ++n) _Pragma("unroll") for (int k = 0; k < 2; ++k) dst[n][k] = *(const PG8_LAS bf16x8*)(lds + PG8_SB(b, h) + boff + n * 2048 + k * 1024); } while (0)
#define PG8_MMA(ai, bj, At, Bt) do { __builtin_amdgcn_s_setprio(1); _Pragma("unroll") for (int m = 0; m < 4; ++m) _Pragma("unroll") for (int n = 0; n < 2; ++n) _Pragma("unroll") for (int k = 0; k < 2; ++k) \
        acc[ai][bj][m][n] = __builtin_amdgcn_mfma_f32_16x16x32_bf16(Bt[n][k], At[m][k], acc[ai][bj][m][n], 0, 0, 0); __builtin_amdgcn_s_setprio(0); } while (0)
#define PG8_WAIT_V(n) asm volatile("s_waitcnt vmcnt(" #n ")" ::: "memory")
#define PG8_WAIT_L(n) asm volatile("s_waitcnt lgkmcnt(" #n ")" ::: "memory")
#define PG8_BAR __builtin_amdgcn_s_barrier()
#define PG8_SCHED __builtin_amdgcn_sched_barrier(0)
    Unit cur, nxt; int ui = 0;
    if (!S.next(0, cur)) return;
    f32x4 acc[2][2][4][2];
#pragma unroll
    for (int a = 0; a < 2; ++a)
#pragma unroll
        for (int b = 0; b < 2; ++b)
#pragma unroll
            for (int m = 0; m < 4; ++m)
#pragma unroll
                for (int n = 0; n < 2; ++n) acc[a][b][m][n] = (f32x4){0.f, 0.f, 0.f, 0.f};
    bf16x8 At[4][2], B0[2][2], B1[2][2];
    const char* cA = (const char*)g.A + (size_t)cur.pm * tstep; const char* cB = (const char*)g.Bt + (size_t)cur.pn * tstep;
    S.a_ready(cur);
    if constexpr (SP2) {
        PG8_STAGE(PG8_SB(0, 0), cB, voffB); PG8_STAGE(PG8_SB(0, 1), cB + hstep, voffB); PG8_STAGE(PG8_SA(0, 0), cA, voffA); PG8_STAGE(PG8_SA(0, 1), cA + hstep, voffA);
        if (wr == 1) PG8_BAR;
        PG8_WAIT_V(2); PG8_BAR;
        PG8_STAGE(PG8_SB(1, 0), cB + kstep, voffB); PG8_STAGE(PG8_SA(1, 0), cA + kstep, voffA); PG8_STAGE(PG8_SB(1, 1), cB + hstep + kstep, voffB);
        PG8_WAIT_V(6); PG8_BAR;
    } else {
        PG8_STAGE(PG8_SB(0, 0), cB, voffB); PG8_STAGE(PG8_SA(0, 0), cA, voffA); PG8_STAGE(PG8_SB(0, 1), cB + hstep, voffB); PG8_STAGE(PG8_SA(0, 1), cA + hstep, voffA);
        if (wr == 1) PG8_BAR;
        PG8_WAIT_V(4); PG8_BAR;
        PG8_STAGE(PG8_SB(1, 0), cB + kstep, voffB); PG8_STAGE(PG8_SA(1, 0), cA + kstep, voffA); PG8_STAGE(PG8_SB(1, 1), cB + hstep + kstep, voffB);
        PG8_WAIT_V(6); PG8_BAR;
    }
    for (;;) {
        const bool has_next = S.next(ui + 1, nxt);
        const char* nA = has_next ? (const char*)g.A + (size_t)nxt.pm * tstep : cA; const char* nB = has_next ? (const char*)g.Bt + (size_t)nxt.pn * tstep : cB;
        for (int t = 0; t < nt; t += 2) {
            const bool last = (t == nt - 2);
            const char* a1 = cA + (size_t)(t + 1) * kstep;
            const char* a2 = last ? nA : cA + (size_t)(t + 2) * kstep; const char* b2 = last ? nB : cB + (size_t)(t + 2) * kstep;
            const char* a3 = a2 + kstep; const char* b3 = b2 + kstep;
            if (last && has_next) S.a_ready(nxt);
            if constexpr (SP2) {
            PG8_LDB(B0, 0, 0); PG8_LDB(B1, 0, 1); PG8_SCHED; PG8_LDA(At, 0, 0); PG8_STAGE(PG8_SA(1, 1), a1 + hstep, voffA);
            PG8_WAIT_V(8); PG8_WAIT_L(0); PG8_BAR; PG8_MMA(0, 0, At, B0); PG8_MMA(0, 1, At, B1); PG8_BAR; PG8_SCHED;
            PG8_LDA(At, 0, 1); PG8_STAGE(PG8_SB(0, 0), b2, voffB); PG8_STAGE(PG8_SB(0, 1), b2 + hstep, voffB); PG8_STAGE(PG8_SA(0, 0), a2, voffA);
            PG8_WAIT_V(8); PG8_WAIT_L(0); PG8_BAR; PG8_MMA(1, 0, At, B0); PG8_MMA(1, 1, At, B1); PG8_BAR; PG8_SCHED;
            PG8_LDB(B0, 1, 0); PG8_LDB(B1, 1, 1); PG8_SCHED; PG8_LDA(At, 1, 0); PG8_STAGE(PG8_SA(0, 1), a2 + hstep, voffA);
            PG8_WAIT_V(8); PG8_WAIT_L(0); PG8_BAR; PG8_MMA(0, 0, At, B0); PG8_MMA(0, 1, At, B1); PG8_BAR; PG8_SCHED;
            PG8_LDA(At, 1, 1); PG8_STAGE(PG8_SB(1, 0), b3, voffB); PG8_STAGE(PG8_SB(1, 1), b3 + hstep, voffB); PG8_STAGE(PG8_SA(1, 0), a3, voffA);
            PG8_WAIT_V(8); PG8_WAIT_L(0); PG8_BAR; PG8_MMA(1, 0, At, B0); PG8_MMA(1, 1, At, B1); PG8_BAR; PG8_SCHED;
            } else {
            PG8_LDB(B0, 0, 0); PG8_SCHED; PG8_LDA(At, 0, 0); PG8_STAGE(PG8_SA(1, 1), a1 + hstep, voffA);
            PG8_WAIT_L(8); PG8_BAR; PG8_WAIT_L(0); PG8_MMA(0, 0, At, B0); PG8_BAR; PG8_SCHED;
            PG8_LDB(B1, 0, 1); PG8_STAGE(PG8_SB(0, 0), b2, voffB);
            PG8_BAR; PG8_WAIT_L(0); PG8_MMA(0, 1, At, B1); PG8_BAR;
            PG8_LDA(At, 0, 1); PG8_STAGE(PG8_SA(0, 0), a2, voffA);
            PG8_BAR; PG8_WAIT_L(0); PG8_MMA(1, 0, At, B0); PG8_BAR; PG8_SCHED;
            PG8_STAGE(PG8_SB(0, 1), b2 + hstep, voffB);
            PG8_WAIT_V(6); PG8_BAR; PG8_MMA(1, 1, At, B1); PG8_BAR;
            PG8_LDB(B0, 1, 0); PG8_SCHED; PG8_LDA(At, 1, 0); PG8_STAGE(PG8_SA(0, 1), a2 + hstep, voffA);
            PG8_WAIT_L(8); PG8_BAR; PG8_WAIT_L(0); PG8_MMA(0, 0, At, B0); PG8_BAR; PG8_SCHED;
            PG8_LDB(B1, 1, 1); PG8_STAGE(PG8_SB(1, 0), b3, voffB);
            PG8_BAR; PG8_WAIT_L(0); PG8_MMA(0, 1, At, B1); PG8_BAR;
            PG8_LDA(At, 1, 1); PG8_STAGE(PG8_SA(1, 0), a3, voffA);
            PG8_BAR; PG8_WAIT_L(0); PG8_MMA(1, 0, At, B0); PG8_BAR; PG8_SCHED;
            PG8_STAGE(PG8_SB(1, 1), b3 + hstep, voffB);
            PG8_WAIT_V(6); PG8_BAR; PG8_MMA(1, 1, At, B1); PG8_BAR;
            }
        }
        if constexpr (ALIGN_EPI) { if (wr == 0) PG8_BAR; }
        if constexpr (!Epi::AFTER_DRAIN) { E(acc, cur, wr, wc, fr, fq); S.done(cur); }
        if (!has_next) break;
#pragma unroll
        for (int a = 0; a < 2; ++a)
#pragma unroll
            for (int b = 0; b < 2; ++b)
#pragma unroll
                for (int m = 0; m < 4; ++m)
#pragma unroll
                    for (int n = 0; n < 2; ++n) acc[a][b][m][n] = (f32x4){0.f, 0.f, 0.f, 0.f};
        cur = nxt; cA = nA; cB = nB; ++ui;
        if constexpr (ALIGN_EPI) { if (wr == 1) PG8_BAR; }
    }
    PG8_WAIT_V(0);
    if constexpr (!ALIGN_EPI) { if (wr == 0) PG8_BAR; }
    PG8_BAR;
    if constexpr (Epi::AFTER_DRAIN) { E.fused(acc, cur, wr, wc, fr, fq, lds, wid, lane); S.done(cur); }
#undef PG8_SA
#undef PG8_SB
#undef PG8_STAGE
#undef PG8_LDA
#undef PG8_LDB
#undef PG8_MMA
#undef PG8_WAIT_V
#undef PG8_WAIT_L
#undef PG8_BAR
#undef PG8_SCHED
}
}
#define GAS __attribute__((address_space(1)))
#define LAS __attribute__((address_space(3)))
typedef unsigned short bf16;
typedef unsigned v4u __attribute__((ext_vector_type(4)));
typedef float f32x4 __attribute__((ext_vector_type(4)));
typedef short bf16x8 __attribute__((ext_vector_type(8)));
typedef GAS unsigned gu32;
typedef GAS unsigned long long gu64;
#define RLX_AGENT __ATOMIC_RELAXED, __HIP_MEMORY_SCOPE_AGENT
#define LDS_WAIT() asm volatile("s_waitcnt lgkmcnt(0)" ::: "memory")
#define VM_WAIT() asm volatile("s_waitcnt vmcnt(0)" ::: "memory")
__device__ __forceinline__ unsigned long long rt() { return __builtin_amdgcn_s_memrealtime(); }
__device__ __forceinline__ unsigned f2bf(float f) { unsigned u = __builtin_bit_cast(unsigned, f); return (u + 0x7fffu + ((u >> 16) & 1u)) >> 16; }
__device__ __forceinline__ unsigned pk2(float lo, float hi) { return f2bf(lo) | (f2bf(hi) << 16); }
#define XB_TMO      128
#define XB_XCNT(j)  (256  + 64 * (j))
#define XB_XSUB(j)  (1280 + 64 * (j))
#define XB_XGEN(j)  (2304 + 64 * (j))
#define XB_TOP      3328
#define XB_TOPGEN   3392
#define XCD_BAR_WORDS 3456
#define XB_SPIN_CAP (1u << 18)

__device__ __forceinline__ unsigned xb_ld(unsigned* p)              { return __hip_atomic_load(p, __ATOMIC_RELAXED, __HIP_MEMORY_SCOPE_AGENT); }
__device__ __forceinline__ unsigned xb_add(unsigned* p, unsigned v) { return __hip_atomic_fetch_add(p, v, __ATOMIC_RELAXED, __HIP_MEMORY_SCOPE_AGENT); }
__device__ __forceinline__ unsigned xb_xcc_id() { return (unsigned)__builtin_amdgcn_s_getreg((3 << 11) | 20) & 0xFu; }
#define XB_SPIN(cond, bar) do { unsigned _sp = 0; while (cond) { __builtin_amdgcn_s_sleep(1); \
    if ((++_sp & 255u) == 0u) { if (xb_ld(&(bar)[XB_TMO])) break; if (_sp > XB_SPIN_CAP) { atomicAdd(&(bar)[XB_TMO], 1u); break; } } } } while (0)

struct XcdBarrier {
    unsigned* bar; unsigned x;
    volatile LAS unsigned* st;
};

__device__ __forceinline__ XcdBarrier xcd_barrier_post(unsigned* bar, volatile LAS unsigned* st) {
    XcdBarrier b; b.bar = bar; b.x = xb_xcc_id(); b.st = st;
    if (threadIdx.x == 0) (void)xb_add(&bar[XB_XCNT(b.x)], 1u);
    return b;
}
__device__ __forceinline__ void xcd_barrier_complete(unsigned* bar, unsigned x, unsigned& nloc, unsigned& nx) {
    const unsigned G = gridDim.x * gridDim.y * gridDim.z;
    unsigned sum, cnt, mine, sp = 0u;
    for (;;) {
        sum = 0u; cnt = 0u; mine = 0u;
#pragma unroll
        for (unsigned j = 0; j < 16; ++j) { const unsigned c = xb_ld(&bar[XB_XCNT(j)]); sum += c; cnt += (c > 0u) ? 1u : 0u; mine = (j == x) ? c : mine; }
        if (sum == G) break;
        __builtin_amdgcn_s_sleep(1);
        if ((++sp & 255u) == 0u) { if (xb_ld(&bar[XB_TMO])) break; if (sp > XB_SPIN_CAP) { atomicAdd(&bar[XB_TMO], 1u); break; } }
    }
    nloc = mine > 0u ? mine : 1u; nx = cnt > 0u ? cnt : 1u;
}

__device__ __forceinline__ void xcd_barrier(const XcdBarrier& b) {
    asm volatile("s_waitcnt vmcnt(0)" ::: "memory");
    __syncthreads();
    if (threadIdx.x == 0) {
        unsigned* bar = b.bar;
        __builtin_amdgcn_s_waitcnt(0);
        unsigned nloc = b.st[0], nx = b.st[1];
        if (nloc == 0u) { xcd_barrier_complete(bar, b.x, nloc, nx); b.st[0] = nloc; b.st[1] = nx; }
        const unsigned old = xb_add(&bar[XB_XSUB(b.x)], 1u);
        const unsigned gen = old / nloc;
        if (old + 1u == (gen + 1u) * nloc) {
            __builtin_amdgcn_fence(__ATOMIC_RELEASE, "agent");
            asm volatile("s_waitcnt vmcnt(0)" ::: "memory");
            const unsigned og = xb_add(&bar[XB_TOP], 1u);
            const unsigned tg = og / nx;
            if (og + 1u == (tg + 1u) * nx) xb_add(&bar[XB_TOPGEN], 1u);
            else XB_SPIN(xb_ld(&bar[XB_TOPGEN]) == tg, bar);
            __builtin_amdgcn_fence(__ATOMIC_ACQUIRE, "agent");
            xb_add(&bar[XB_XGEN(b.x)], 1u);
            asm volatile("s_waitcnt vmcnt(0)" ::: "memory");
        } else {
            XB_SPIN(xb_ld(&bar[XB_XGEN(b.x)]) == gen, bar);
            __builtin_amdgcn_fence(__ATOMIC_ACQUIRE, "agent");
            asm volatile("s_waitcnt vmcnt(0)" ::: "memory");
        }
    }
    __syncthreads();
}
constexpr int NWAVES = 8, NTHR = 512;
constexpr int D = 1024, SEQ = 16384, DBATCH = 128, MP = SEQ, MS = 512, M = MP + MS;
constexpr int DFF = 2816, INW = 3072, PAST = 8192, WB = 2048, KEEP = 2048, NH = 8;
constexpr float EPS = 1e-6f;
constexpr int C_QA = 0, C_KA = 512, C_VA = 1024, C_QR = 1536, C_KR = 1792, C_VR = 2048, C_GR = 2560;
constexpr size_t O_Y = 0, O_KP = (size_t)M * D, O_VP = O_KP + (size_t)KEEP * 512, O_SP = O_VP + (size_t)KEEP * 512,
                 O_KS = O_SP + 32768, O_VS = O_KS + (size_t)MS * 512, O_SS = O_VS + (size_t)MS * 512, O_END = O_SS + (size_t)DBATCH * 32768;
constexpr size_t MiB = 1u << 20;
constexpr size_t WS_CTL = 0, CTL_ZERO_BYTES = 1 * MiB;
constexpr size_t WS_W1GU = 1 * MiB, WS_W1D = 12 * MiB, WS_WIN = 18 * MiB, WS_WOUT = 24 * MiB, WS_W2GU = 26 * MiB, WS_W2D = 37 * MiB, WS_TAB = 43 * MiB;
constexpr size_t WS_XN = 48 * MiB, WS_H = 81 * MiB, WS_Y = 172 * MiB, WS_HRES = 238 * MiB, WS_QKV = 304 * MiB, WS_MIX = 502 * MiB, WS_UPD = 535 * MiB, WS_SPREV = 551 * MiB, WS_QKVB = 567 * MiB, WS_OPART = 667 * MiB, WS_ML = 716 * MiB, WS_END = 720 * MiB;
constexpr int CW_BAR = 4096;
constexpr int RING_BYTES = 131072, LDSCTL_OFF = RING_BYTES, MISC_OFF = LDSCTL_OFF + 320, LDS_BYTES = 147456;

__constant__ float INVF[40] = {
    1.f, 0.193922743f, 0.0376060307f, 0.00729266461f, 0.00141421356f, 0.000274248188f, 5.3182961e-05f, 1.03133862e-05f,
    1.f, 0.749894261f, 0.562341332f, 0.421696514f, 0.316227764f, 0.237137377f, 0.177827939f, 0.133352131f, 0.100000001f, 0.0749894157f,
    0.0562341325f, 0.0421696529f, 0.0316227749f, 0.0237137377f, 0.0177827943f, 0.0133352149f, 0.00999999978f, 0.00749894185f,
    0.00562341325f, 0.00421696482f, 0.00316227763f, 0.00237137359f, 0.00177827943f, 0.00133352145f, 0.00100000005f, 0.000749894243f,
    0.000562341302f, 0.000421696517f, 0.000316227757f, 0.00023713737f, 0.00017782794f, 0.00013335215f};
__device__ __forceinline__ float log_g(int h) { return h == 0 ? -0.0317486983145803f : h == 1 ? -0.015748356968139168f : h == 2 ? -0.007843177461025893f : -0.003913899321136329f; }
__device__ __forceinline__ float wave_sum(float v) {
#pragma unroll
    for (int o = 32; o >= 1; o >>= 1) v += __shfl_xor(v, o);
    return v;
}
__device__ __forceinline__ float wave_max(float v) {
#pragma unroll
    for (int o = 32; o >= 1; o >>= 1) v = fmaxf(v, __shfl_xor(v, o));
    return v;
}
__device__ __forceinline__ float silu_f(float x) { return x / (1.f + expf(-x)); }

__device__ __forceinline__ void tr_item(const float* W, int K, int N, bf16* WT, int mode, LAS float* scr, int item, int lane) {
    const int nblk = N / 32, kb = item / nblk, nb = item % nblk, k0 = 64 * kb, n0 = 32 * nb;
    const int rbase = mode == 0 ? n0 : (256 * (n0 >> 7) + (n0 & 127) + (mode == 2 ? 128 : 0));
#pragma unroll 8
    for (int i = 0; i < 32; ++i) { const int kk = 2 * i + (lane >> 5); scr[kk * 33 + (lane & 31)] = W[(size_t)(k0 + kk) * N + n0 + (lane & 31)]; }
    LDS_WAIT(); asm volatile("" ::: "memory");
    const int c = lane & 7;
#pragma unroll
    for (int j = 0; j < 4; ++j) { const int n = (lane >> 3) + 8 * j; const LAS float* s = scr + (8 * c) * 33 + n;
        v4u o; o.x = pk2(s[0 * 33], s[1 * 33]); o.y = pk2(s[2 * 33], s[3 * 33]); o.z = pk2(s[4 * 33], s[5 * 33]); o.w = pk2(s[6 * 33], s[7 * 33]);
        *(GAS v4u*)(WT + (size_t)(rbase + n) * K + k0 + 8 * c) = o; }
    LDS_WAIT(); asm volatile("" ::: "memory");
}
struct Ptrs {
    const float *xp, *xs, *ck, *cv, *st, *g1a, *g1b, *w1g, *w1u, *w1d, *gma, *gmb, *win, *gnw, *wout, *g2a, *g2b, *w2g, *w2u, *w2d;
    float* out;
    bf16 *W1GU, *W1D, *WIN, *WOUT, *W2GU, *W2D, *XN, *H, *MIX;
    float2* TAB; float *Y, *HRES, *QKV, *UPD; bf16 *SPT, *QKVb, *OPART; float2* ML;
};
__device__ __forceinline__ void p0_prologue(const Ptrs& P, LAS unsigned char* lds, int gw, int NGW, int wave, int lane, int gtid, int NGT) {
    LAS float* scr = (LAS float*)(lds + wave * 16384);
    constexpr int I_GU = 16 * 88, I_D = 44 * 32, I_IN = 16 * 96, I_OUT = 16 * 32;
    constexpr int NITEMS = 6 * I_GU + I_IN + I_OUT;
    static_assert(I_D == I_GU, "items");
    for (int it = gw; it < NITEMS; it += NGW) {
        int r = it;
        if (r < I_GU) { tr_item(P.w1g, D, DFF, P.W1GU, 1, scr, r, lane); continue; } r -= I_GU;
        if (r < I_GU) { tr_item(P.w1u, D, DFF, P.W1GU, 2, scr, r, lane); continue; } r -= I_GU;
        if (r < I_D) { tr_item(P.w1d, DFF, D, P.W1D, 0, scr, r, lane); continue; } r -= I_D;
        if (r < I_GU) { tr_item(P.w2g, D, DFF, P.W2GU, 1, scr, r, lane); continue; } r -= I_GU;
        if (r < I_GU) { tr_item(P.w2u, D, DFF, P.W2GU, 2, scr, r, lane); continue; } r -= I_GU;
        if (r < I_D) { tr_item(P.w2d, DFF, D, P.W2D, 0, scr, r, lane); continue; } r -= I_D;
        if (r < I_IN) { tr_item(P.win, D, INW, P.WIN, 0, scr, r, lane); continue; } r -= I_IN;
        tr_item(P.wout, D, D, P.WOUT, 0, scr, r, lane);
    }
    for (int idx = gtid; idx < SEQ * 40; idx += NGT) {
        const int pos = idx / 40, f = idx % 40;
        const float ang = (float)pos * INVF[f];
        const double rev = (double)ang * 0.15915494309189535;
        const float fr = (float)(rev - rint(rev));
        P.TAB[idx] = make_float2(__builtin_amdgcn_cosf(fr), __builtin_amdgcn_sinf(fr));
    }
    for (int r = gw; r < M; r += NGW) {
        const float4* x = (const float4*)(r < MP ? P.xp + (size_t)r * D : P.xs + (size_t)(r - MP) * D);
        float4 v[4]; float ss = 0.f;
#pragma unroll
        for (int j = 0; j < 4; ++j) { v[j] = x[lane + 64 * j]; ss += v[j].x * v[j].x + v[j].y * v[j].y + v[j].z * v[j].z + v[j].w * v[j].w; }
        const float rstd = 1.f / sqrtf(wave_sum(ss) * (1.f / D) + EPS);
        uint2* o = (uint2*)(P.XN + (size_t)r * D);
#pragma unroll
        for (int j = 0; j < 4; ++j) { const float4 gg = ((const float4*)P.g1a)[lane + 64 * j];
            o[lane + 64 * j] = make_uint2(pk2(v[j].x * rstd * gg.x, v[j].y * rstd * gg.y), pk2(v[j].z * rstd * gg.z, v[j].w * rstd * gg.w)); }
    }
}
__device__ __forceinline__ void norm_res_phase(const float* resA, const float* resB, const float* Y, const float* gpost, float scale, float* hout, const float* gnext, bf16* XN, int gw, int NGW, int lane) {
    for (int r = gw; r < M; r += NGW) {
        const float4* x = (const float4*)(r < MP ? resA + (size_t)r * D : resB + (size_t)(r - MP) * D);
        const float4* y = (const float4*)(Y + (size_t)r * D);
        float4 v[4], hv[4]; float ss = 0.f;
#pragma unroll
        for (int j = 0; j < 4; ++j) { v[j] = y[lane + 64 * j]; hv[j] = x[lane + 64 * j]; ss += v[j].x * v[j].x + v[j].y * v[j].y + v[j].z * v[j].z + v[j].w * v[j].w; }
        const float rstd = scale / sqrtf(wave_sum(ss) * (1.f / D) + EPS);
        float s2 = 0.f;
#pragma unroll
        for (int j = 0; j < 4; ++j) { const float4 gg = ((const float4*)gpost)[lane + 64 * j];
            hv[j].x += v[j].x * rstd * gg.x; hv[j].y += v[j].y * rstd * gg.y; hv[j].z += v[j].z * rstd * gg.z; hv[j].w += v[j].w * rstd * gg.w;
            s2 += hv[j].x * hv[j].x + hv[j].y * hv[j].y + hv[j].z * hv[j].z + hv[j].w * hv[j].w; }
        float4* ho = (float4*)(hout + (size_t)r * D);
#pragma unroll
        for (int j = 0; j < 4; ++j) ho[lane + 64 * j] = hv[j];
        if (gnext) {
            const float r2 = 1.f / sqrtf(wave_sum(s2) * (1.f / D) + EPS);
            uint2* o = (uint2*)(XN + (size_t)r * D);
#pragma unroll
            for (int j = 0; j < 4; ++j) { const float4 gg = ((const float4*)gnext)[lane + 64 * j];
                o[lane + 64 * j] = make_uint2(pk2(hv[j].x * r2 * gg.x, hv[j].y * r2 * gg.y), pk2(hv[j].z * r2 * gg.z, hv[j].w * r2 * gg.w)); }
        }
    }
}
typedef float f32x16 __attribute__((ext_vector_type(16)));
typedef short s16x4 __attribute__((ext_vector_type(4)));
typedef float f32x2_t __attribute__((ext_vector_type(2)));
typedef __bf16 bf16x2_t __attribute__((ext_vector_type(2)));
__device__ __forceinline__ unsigned cvtpk(float lo, float hi) { f32x2_t v = {lo, hi}; bf16x2_t b = __builtin_convertvector(v, bf16x2_t); return __builtin_bit_cast(unsigned, b); }
__device__ __forceinline__ s16x4 vtr(const LAS unsigned char* p) { return __builtin_bit_cast(s16x4, __builtin_amdgcn_ds_read_tr16_b64_v4i16((LAS s16x4*)p)); }
#define MFMA32(a, b, c) __builtin_amdgcn_mfma_f32_32x32x16_bf16((a), (b), (c), 0, 0, 0)
__device__ __forceinline__ int crow(int reg, int hh) { return (reg & 3) + 8 * (reg >> 2) + 4 * hh; }
__device__ __forceinline__ float bf_lo(unsigned u) { return __builtin_bit_cast(float, u << 16); }
__device__ __forceinline__ float bf_hi(unsigned u) { return __builtin_bit_cast(float, u & 0xffff0000u); }
constexpr float QSCALE = 0.125f * 1.4426950408889634f;

__device__ __forceinline__ void rope_phase(float* QKV, bf16* QKVb, const float2* tab, float* out, int gw, int NGW, int lane) {
    for (int r = gw; r < M; r += NGW) {
        const int pos = r < MP ? r : PAST + ((r - MP) & 3);
        float* row = QKV + (size_t)r * INW;
        bf16* rowb = QKVb + (size_t)r * INW;
        float *ko = nullptr, *vo = nullptr;
        if (r >= MP) { ko = out + O_KS + (size_t)(r - MP) * 512; vo = out + O_VS + (size_t)(r - MP) * 512; }
        else if (r >= MP - KEEP) { ko = out + O_KP + (size_t)(r - (MP - KEEP)) * 512; vo = out + O_VP + (size_t)(r - (MP - KEEP)) * 512; }
        {
            const int s = lane >> 5, hd = (lane >> 2) & 7, qd = lane & 3, base = s * 512 + hd * 64 + qd * 16;
            float v[16];
#pragma unroll
            for (int c = 0; c < 4; ++c) { const float4 t = *(const float4*)(row + base + 4 * c); v[4 * c] = t.x; v[4 * c + 1] = t.y; v[4 * c + 2] = t.z; v[4 * c + 3] = t.w; }
            if (qd == 0) {
#pragma unroll
                for (int e = 0; e < 8; ++e) { const float2 cs = tab[pos * 40 + e]; const float x1 = v[e], x2 = v[8 + e]; v[e] = x1 * cs.x - x2 * cs.y; v[8 + e] = x2 * cs.x + x1 * cs.y; }
#pragma unroll
                for (int c = 0; c < 4; ++c) *(float4*)(row + base + 4 * c) = make_float4(v[4 * c], v[4 * c + 1], v[4 * c + 2], v[4 * c + 3]);
            }
            if (s == 1 && ko) {
#pragma unroll
                for (int c = 0; c < 4; ++c) *(float4*)(ko + hd * 64 + qd * 16 + 4 * c) = make_float4(v[4 * c], v[4 * c + 1], v[4 * c + 2], v[4 * c + 3]);
            }
            const float sc = s == 0 ? QSCALE : 1.f;
            v4u w0, w1;
            w0.x = cvtpk(v[0] * sc, v[1] * sc); w0.y = cvtpk(v[2] * sc, v[3] * sc); w0.z = cvtpk(v[4] * sc, v[5] * sc); w0.w = cvtpk(v[6] * sc, v[7] * sc);
            w1.x = cvtpk(v[8] * sc, v[9] * sc); w1.y = cvtpk(v[10] * sc, v[11] * sc); w1.z = cvtpk(v[12] * sc, v[13] * sc); w1.w = cvtpk(v[14] * sc, v[15] * sc);
            *(v4u*)(rowb + base) = w0; *(v4u*)(rowb + base + 8) = w1;
        }
#pragma unroll
        for (int t = 0; t < 3; ++t) {
            const int base = (t == 0 ? C_VA : t == 1 ? C_VR : C_GR) + 8 * lane;
            const float4 a = *(const float4*)(row + base), b = *(const float4*)(row + base + 4);
            v4u w; w.x = cvtpk(a.x, a.y); w.y = cvtpk(a.z, a.w); w.z = cvtpk(b.x, b.y); w.w = cvtpk(b.z, b.w);
            *(v4u*)(rowb + base) = w;
            if (t == 0 && vo) { *(float4*)(vo + 8 * lane) = a; *(float4*)(vo + 8 * lane + 4) = b; }
        }
        {
            const int s = lane >> 5, h = (lane >> 3) & 3, ig = lane & 7, base = C_QR + s * 256 + h * 64;
            const float4 a = *(const float4*)(row + base + 4 * ig), b = *(const float4*)(row + base + 32 + 4 * ig);
            const float sc = s ? 0.125f : 1.f;
            const float2 c0 = tab[pos * 40 + 8 + 4 * ig], c1 = tab[pos * 40 + 9 + 4 * ig], c2 = tab[pos * 40 + 10 + 4 * ig], c3 = tab[pos * 40 + 11 + 4 * ig];
            const float4 y1 = make_float4((a.x * c0.x - b.x * c0.y) * sc, (a.y * c1.x - b.y * c1.y) * sc, (a.z * c2.x - b.z * c2.y) * sc, (a.w * c3.x - b.w * c3.y) * sc);
            const float4 y2 = make_float4((b.x * c0.x + a.x * c0.y) * sc, (b.y * c1.x + a.y * c1.y) * sc, (b.z * c2.x + a.z * c2.y) * sc, (b.w * c3.x + a.w * c3.y) * sc);
            *(float4*)(row + base + 4 * ig) = y1; *(float4*)(row + base + 32 + 4 * ig) = y2;
            *(uint2*)(rowb + base + 4 * ig) = make_uint2(cvtpk(y1.x, y1.y), cvtpk(y1.z, y1.w));
            *(uint2*)(rowb + base + 32 + 4 * ig) = make_uint2(cvtpk(y2.x, y2.y), cvtpk(y2.z, y2.w));
        }
    }
}

__device__ __forceinline__ void attn_mfma_phase(LAS unsigned char* lds, const bf16* QKVb, bf16* OPART, float2* ML, int gw, int NGW, int wave, int lane) {
    LAS unsigned char* vt = lds + wave * 6144;
    const int i = lane & 31, hh = lane >> 5, i16 = lane & 15, tq = i16 >> 2, tp = i16 & 3, blk = (lane >> 4) & 1;
    constexpr int NITEM = 3 * 4096;
    const int per = (NITEM + NGW - 1) / NGW;
    const int i_beg = gw * per, i_end = (i_beg + per < NITEM) ? i_beg + per : NITEM;
    for (int idx = i_beg; idx < i_end; ++idx) {
        const int b = idx >> 12, rem = idx & 4095, h = rem >> 9, within = rem & 511;
        const int dsh = 2 * b, d = 1 << dsh, r = within >> (9 - dsh), qt = within & ((512 >> dsh) - 1), l0 = qt * 32;
        const int tok_q = (l0 + i) * d + r;
        const bf16* qp = QKVb + (size_t)tok_q * INW + C_QA + h * 64 + 8 * hh;
        bf16x8 qf[4];
#pragma unroll
        for (int ks = 0; ks < 4; ++ks) qf[ks] = *(const bf16x8*)(qp + 16 * ks);
        f32x16 o0, o1;
#pragma unroll
        for (int e = 0; e < 16; ++e) { o0[e] = 0.f; o1[e] = 0.f; }
        float m = -1e30f, l = 0.f;
        const int kt0 = l0 >= 128 ? 0 : ((128 - l0) >> 5);
        for (int kt = kt0; kt < 5; ++kt) {
            const int lk0 = l0 - 128 + 32 * kt;
            const bf16* kp = QKVb + (size_t)((lk0 + i) * d + r) * INW + C_KA + h * 64 + 8 * hh;
            bf16x8 kf[4];
#pragma unroll
            for (int ks = 0; ks < 4; ++ks) kf[ks] = *(const bf16x8*)(kp + 16 * ks);
            v4u vreg[4];
#pragma unroll
            for (int c = 0; c < 4; ++c) { const int rowk = (lane >> 3) + 8 * c;
                vreg[c] = *(const v4u*)(QKVb + (size_t)((lk0 + rowk) * d + r) * INW + C_VA + h * 64 + 8 * (lane & 7)); }
            f32x16 s;
#pragma unroll
            for (int e = 0; e < 16; ++e) s[e] = 0.f;
#pragma unroll
            for (int ks = 0; ks < 4; ++ks) s = MFMA32(kf[ks], qf[ks], s);
#pragma unroll
            for (int c = 0; c < 4; ++c) { const int rowk = (lane >> 3) + 8 * c; *(LAS v4u*)(vt + rowk * 192 + 16 * (lane & 7)) = vreg[c]; }
            float tm = -1e30f;
#pragma unroll
            for (int e = 0; e < 16; ++e) { const int j = crow(e, hh); const bool bad = (kt == 0 && j < i) || (kt == 4 && j > i); s[e] = bad ? -1e30f : s[e]; tm = fmaxf(tm, s[e]); }
            tm = fmaxf(tm, __shfl_xor(tm, 32));
            const float mn = fmaxf(m, tm), scl = __builtin_amdgcn_exp2f(m - mn);
            m = mn; l *= scl;
#pragma unroll
            for (int e = 0; e < 16; ++e) { o0[e] *= scl; o1[e] *= scl; }
            float psum = 0.f;
#pragma unroll
            for (int e = 0; e < 16; ++e) { s[e] = __builtin_amdgcn_exp2f(s[e] - mn); psum += s[e]; }
            l += psum;
            v4u pw0, pw1;
            pw0.x = cvtpk(s[0], s[1]); pw0.y = cvtpk(s[2], s[3]); pw0.z = cvtpk(s[4], s[5]); pw0.w = cvtpk(s[6], s[7]);
            pw1.x = cvtpk(s[8], s[9]); pw1.y = cvtpk(s[10], s[11]); pw1.z = cvtpk(s[12], s[13]); pw1.w = cvtpk(s[14], s[15]);
            const bf16x8 pf0 = __builtin_bit_cast(bf16x8, pw0), pf1 = __builtin_bit_cast(bf16x8, pw1);
            asm volatile("" ::: "memory");
#pragma unroll
            for (int st = 0; st < 2; ++st) {
                const LAS unsigned char* a0 = vt + (16 * st + 4 * hh + tq) * 192 + (16 * blk + 4 * tp) * 2;
                const s16x4 lo0 = vtr(a0), hi0 = vtr(a0 + 8 * 192), lo1 = vtr(a0 + 64), hi1 = vtr(a0 + 8 * 192 + 64);
                const bf16x8 v0 = __builtin_shufflevector(lo0, hi0, 0, 1, 2, 3, 4, 5, 6, 7), v1 = __builtin_shufflevector(lo1, hi1, 0, 1, 2, 3, 4, 5, 6, 7);
                o0 = MFMA32(v0, st == 0 ? pf0 : pf1, o0);
                o1 = MFMA32(v1, st == 0 ? pf0 : pf1, o1);
            }
            asm volatile("" ::: "memory");
        }
        const float lt = l + __shfl_xor(l, 32), inv = 1.f / lt;
        bf16* op = OPART + ((size_t)b * MP + tok_q) * 512 + h * 64 + 4 * hh;
#pragma unroll
        for (int g = 0; g < 4; ++g) {
            *(uint2*)(op + 8 * g) = make_uint2(cvtpk(o0[4 * g] * inv, o0[4 * g + 1] * inv), cvtpk(o0[4 * g + 2] * inv, o0[4 * g + 3] * inv));
            *(uint2*)(op + 32 + 8 * g) = make_uint2(cvtpk(o1[4 * g] * inv, o1[4 * g + 1] * inv), cvtpk(o1[4 * g + 2] * inv, o1[4 * g + 3] * inv));
        }
        if (hh == 0) ML[((size_t)b * MP + tok_q) * 8 + h] = make_float2(m, lt);
    }
}
__device__ __forceinline__ void attn_combine_phase(const bf16* OPART, const float2* ML, bf16* MIX, int gtid, int NGT) {
    for (int idx = gtid; idx < MP * 64; idx += NGT) {
        const int tok = idx >> 6, h = (idx >> 3) & 7, c = idx & 7;
        const float2 a0 = ML[((size_t)0 * MP + tok) * 8 + h], a1 = ML[((size_t)1 * MP + tok) * 8 + h], a2 = ML[((size_t)2 * MP + tok) * 8 + h];
        const float mx = fmaxf(a0.x, fmaxf(a1.x, a2.x));
        float w0 = a0.y * __builtin_amdgcn_exp2f(a0.x - mx), w1 = a1.y * __builtin_amdgcn_exp2f(a1.x - mx), w2 = a2.y * __builtin_amdgcn_exp2f(a2.x - mx);
        const float iw = 1.f / (w0 + w1 + w2); w0 *= iw; w1 *= iw; w2 *= iw;
        const v4u x0 = *(const v4u*)(OPART + ((size_t)0 * MP + tok) * 512 + h * 64 + 8 * c);
        const v4u x1 = *(const v4u*)(OPART + ((size_t)1 * MP + tok) * 512 + h * 64 + 8 * c);
        const v4u x2 = *(const v4u*)(OPART + ((size_t)2 * MP + tok) * 512 + h * 64 + 8 * c);
        v4u o;
        o.x = cvtpk(w0 * bf_lo(x0.x) + w1 * bf_lo(x1.x) + w2 * bf_lo(x2.x), w0 * bf_hi(x0.x) + w1 * bf_hi(x1.x) + w2 * bf_hi(x2.x));
        o.y = cvtpk(w0 * bf_lo(x0.y) + w1 * bf_lo(x1.y) + w2 * bf_lo(x2.y), w0 * bf_hi(x0.y) + w1 * bf_hi(x1.y) + w2 * bf_hi(x2.y));
        o.z = cvtpk(w0 * bf_lo(x0.z) + w1 * bf_lo(x1.z) + w2 * bf_lo(x2.z), w0 * bf_hi(x0.z) + w1 * bf_hi(x1.z) + w2 * bf_hi(x2.z));
        o.w = cvtpk(w0 * bf_lo(x0.w) + w1 * bf_lo(x1.w) + w2 * bf_lo(x2.w), w0 * bf_hi(x0.w) + w1 * bf_hi(x1.w) + w2 * bf_hi(x2.w));
        *(v4u*)(MIX + (size_t)tok * D + h * 64 + 8 * c) = o;
    }
}
__device__ __forceinline__ void ret_out_mfma_phase(LAS unsigned char* lds, const bf16* QKVb, const bf16* SPT, const float* gnw, bf16* MIX, int tid, int wave, int lane) {
    constexpr int RSV = 272;
    const int grp = wave >> 2, itile = wave & 3;
    LAS unsigned char* vb = lds + grp * (128 * RSV);
    const int i = lane & 31, hh = lane >> 5, i16 = lane & 15, tq = i16 >> 2, tp = i16 & 3, blk = (lane >> 4) & 1;
    for (int it = blockIdx.x; it < 256; it += gridDim.x) {
        const int item = it * 2 + grp, n = item >> 2, h = item & 3;
        const float lg2 = log_g(h) * 1.4426950408889634f;
        {
            const int t4 = tid & 255;
#pragma unroll
            for (int c = 0; c < 8; ++c) { const int e = t4 + 256 * c, rowk = e >> 4, ch = e & 15;
                *(LAS v4u*)(vb + rowk * RSV + 16 * ch) = *(const v4u*)(QKVb + (size_t)(n * 128 + rowk) * INW + C_VR + h * 128 + 8 * ch); }
        }
        __syncthreads();
        const int row_i = n * 128 + 32 * itile + i;
        bf16x8 qf[4];
#pragma unroll
        for (int ks = 0; ks < 4; ++ks) qf[ks] = *(const bf16x8*)(QKVb + (size_t)row_i * INW + C_QR + h * 64 + 16 * ks + 8 * hh);
        f32x16 acc[4];
#pragma unroll
        for (int dt = 0; dt < 4; ++dt) {
#pragma unroll
            for (int e = 0; e < 16; ++e) acc[dt][e] = 0.f;
#pragma unroll
            for (int ks = 0; ks < 4; ++ks) { const bf16x8 a = *(const bf16x8*)(SPT + ((size_t)(n * 4 + h) * 128 + 32 * dt + i) * 64 + 16 * ks + 8 * hh); acc[dt] = MFMA32(a, qf[ks], acc[dt]); }
        }
        const float wh = __builtin_amdgcn_exp2f((float)(32 * itile + i + 1) * lg2);
#pragma unroll
        for (int dt = 0; dt < 4; ++dt)
#pragma unroll
            for (int e = 0; e < 16; ++e) acc[dt][e] *= wh;
        for (int jt = 0; jt <= itile; ++jt) {
            bf16x8 kf[4];
#pragma unroll
            for (int ks = 0; ks < 4; ++ks) kf[ks] = *(const bf16x8*)(QKVb + (size_t)(n * 128 + 32 * jt + i) * INW + C_KR + h * 64 + 16 * ks + 8 * hh);
            f32x16 s;
#pragma unroll
            for (int e = 0; e < 16; ++e) s[e] = 0.f;
#pragma unroll
            for (int ks = 0; ks < 4; ++ks) s = MFMA32(kf[ks], qf[ks], s);
#pragma unroll
            for (int e = 0; e < 16; ++e) { const int dl = 32 * (itile - jt) + i - crow(e, hh); s[e] = dl >= 0 ? s[e] * __builtin_amdgcn_exp2f((float)dl * lg2) : 0.f; }
            v4u pw0, pw1;
            pw0.x = cvtpk(s[0], s[1]); pw0.y = cvtpk(s[2], s[3]); pw0.z = cvtpk(s[4], s[5]); pw0.w = cvtpk(s[6], s[7]);
            pw1.x = cvtpk(s[8], s[9]); pw1.y = cvtpk(s[10], s[11]); pw1.z = cvtpk(s[12], s[13]); pw1.w = cvtpk(s[14], s[15]);
            const bf16x8 pf0 = __builtin_bit_cast(bf16x8, pw0), pf1 = __builtin_bit_cast(bf16x8, pw1);
#pragma unroll
            for (int st = 0; st < 2; ++st) {
                const LAS unsigned char* a0 = vb + (32 * jt + 16 * st + 4 * hh + tq) * RSV + (16 * blk + 4 * tp) * 2;
#pragma unroll
                for (int dt = 0; dt < 4; ++dt) {
                    const s16x4 lo = vtr(a0 + 64 * dt), hi = vtr(a0 + 8 * RSV + 64 * dt);
                    const bf16x8 vf = __builtin_shufflevector(lo, hi, 0, 1, 2, 3, 4, 5, 6, 7);
                    acc[dt] = MFMA32(vf, st == 0 ? pf0 : pf1, acc[dt]);
                }
            }
        }
        float s1 = 0.f;
#pragma unroll
        for (int dt = 0; dt < 4; ++dt)
#pragma unroll
            for (int e = 0; e < 16; ++e) s1 += acc[dt][e];
        s1 += __shfl_xor(s1, 32);
        const float mu = s1 * (1.f / 128.f);
        float s2 = 0.f;
#pragma unroll
        for (int dt = 0; dt < 4; ++dt)
#pragma unroll
            for (int e = 0; e < 16; ++e) { const float dd = acc[dt][e] - mu; s2 += dd * dd; }
        s2 += __shfl_xor(s2, 32);
        const float rstd = 1.f / sqrtf(s2 * (1.f / 128.f) + EPS);
#pragma unroll
        for (int dt = 0; dt < 4; ++dt)
#pragma unroll
            for (int g = 0; g < 4; ++g) {
                const int dv0 = 32 * dt + 8 * g + 4 * hh;
                const uint2 gr = *(const uint2*)(QKVb + (size_t)row_i * INW + C_GR + h * 128 + dv0);
                const float4 gw4 = *(const float4*)(gnw + h * 128 + dv0);
                const float y0 = (acc[dt][4 * g] - mu) * rstd * gw4.x * silu_f(bf_lo(gr.x)), y1 = (acc[dt][4 * g + 1] - mu) * rstd * gw4.y * silu_f(bf_hi(gr.x));
                const float y2 = (acc[dt][4 * g + 2] - mu) * rstd * gw4.z * silu_f(bf_lo(gr.y)), y3 = (acc[dt][4 * g + 3] - mu) * rstd * gw4.w * silu_f(bf_hi(gr.y));
                *(uint2*)(MIX + (size_t)row_i * D + 512 + h * 128 + dv0) = make_uint2(cvtpk(y0, y1), cvtpk(y2, y3));
            }
        __syncthreads();
    }
}
__device__ __forceinline__ void attn_naive_phase(LAS unsigned char* lds, const float* QKV, const float* ck, const float* cv, bf16* MIX, int gw, int NGW, int wave, int lane) {
    LAS float* qs = (LAS float*)(lds + wave * 2048);
    LAS float* ps = qs + 64;
    for (int item = gw; item < MS * NH; item += NGW) {
        const int h = item & 7, r = MP + (item >> 3);
        const bool samp = r >= MP;
        const int b = (r - MP) >> 2, ii = (r - MP) & 3;
        qs[lane] = QKV[(size_t)r * INW + C_QA + h * 64 + lane];
        LDS_WAIT(); asm volatile("" ::: "memory");
        float sc[3][3]; float mx = -1e30f;
#pragma unroll
        for (int br = 0; br < 3; ++br) {
            const int d = 1 << (2 * br);
#pragma unroll
            for (int s = 0; s < 3; ++s) {
                const int j = lane + 64 * s;
                sc[br][s] = -1e30f;
                if (j <= 128) {
                    const float* kp = nullptr;
                    if (samp) { const int idx = WB + ii - j * d;
                        if (idx >= WB) kp = QKV + (size_t)(MP + b * 4 + (idx - WB)) * INW + C_KA + h * 64;
                        else if (idx >= 0) kp = ck + ((size_t)(b * WB + idx) * NH + h) * 64; }
                    else { const int tk = r - j * d; if (tk >= 0) kp = QKV + (size_t)tk * INW + C_KA + h * 64; }
                    if (kp) {
                        float dot = 0.f;
#pragma unroll
                        for (int c = 0; c < 16; ++c) { const float4 kk = ((const float4*)kp)[c]; const f32x4 qq = *(const LAS f32x4*)&qs[4 * c];
                            dot += kk.x * qq[0] + kk.y * qq[1] + kk.z * qq[2] + kk.w * qq[3]; }
                        sc[br][s] = dot * 0.125f;
                    }
                }
                mx = fmaxf(mx, sc[br][s]);
            }
        }
        mx = wave_max(mx);
        float l = 0.f;
#pragma unroll
        for (int br = 0; br < 3; ++br)
#pragma unroll
            for (int s = 0; s < 3; ++s) {
                const int j = lane + 64 * s;
                const float p = sc[br][s] > -1e29f ? expf(sc[br][s] - mx) : 0.f;
                l += p;
                if (j <= 128) ps[br * 132 + j] = p;
            }
        l = wave_sum(l);
        LDS_WAIT(); asm volatile("" ::: "memory");
        float o = 0.f;
#pragma unroll
        for (int br = 0; br < 3; ++br) {
            const int d = 1 << (2 * br);
            for (int j = 0; j <= 128; ++j) {
                const float* vp = nullptr;
                if (samp) { const int idx = WB + ii - j * d;
                    if (idx >= WB) vp = QKV + (size_t)(MP + b * 4 + (idx - WB)) * INW + C_VA + h * 64;
                    else if (idx >= 0) vp = cv + ((size_t)(b * WB + idx) * NH + h) * 64; }
                else { const int tk = r - j * d; if (tk >= 0) vp = QKV + (size_t)tk * INW + C_VA + h * 64; }
                if (vp) o += ps[br * 132 + j] * vp[lane];
            }
        }
        MIX[(size_t)r * D + h * 64 + lane] = (bf16)f2bf(o / l);
        LDS_WAIT(); asm volatile("" ::: "memory");
    }
}
__device__ __forceinline__ void ret_upd_phase(LAS unsigned char* lds, const float* QKV, float* UPD, int tid) {
    LAS float* kc = (LAS float*)lds;
    for (int it = blockIdx.x; it < 512; it += gridDim.x) {
        const int n = it >> 2, h = it & 3;
        const float lg = log_g(h);
        for (int e = tid; e < 128 * 64; e += NTHR) { const int j = e >> 6, dk = e & 63;
            kc[e] = QKV[(size_t)(n * 128 + j) * INW + C_KR + h * 64 + dk] * expf((float)(127 - j) * lg); }
        __syncthreads();
        const int dv = tid & 127, qt = tid >> 7;
        float acc[16];
#pragma unroll
        for (int i = 0; i < 16; ++i) acc[i] = 0.f;
        for (int j = 0; j < 128; ++j) {
            const float vj = QKV[(size_t)(n * 128 + j) * INW + C_VR + h * 128 + dv];
#pragma unroll
            for (int i = 0; i < 16; ++i) acc[i] += kc[j * 64 + qt * 16 + i] * vj;
        }
#pragma unroll
        for (int i = 0; i < 16; i += 4) *(float4*)(UPD + ((size_t)(n * 4 + h) * 128 + dv) * 64 + qt * 16 + i) = make_float4(acc[i], acc[i + 1], acc[i + 2], acc[i + 3]);
        __syncthreads();
    }
}
__device__ __forceinline__ void ret_scan_phase(const float* UPDT, bf16* SPT, float* out, int tid) {
    const int e = blockIdx.x * NTHR + tid;
    if (e < 32768) {
        const int h = e >> 13, dv = (e >> 6) & 127, dk = e & 63;
        const float G = expf(128.f * log_g(h));
        float S = 0.f;
        for (int n = 0; n < 128; ++n) { SPT[(size_t)n * 32768 + e] = (bf16)f2bf(S); S = G * S + UPDT[(size_t)n * 32768 + e]; }
        out[O_SP + h * 8192 + dk * 128 + dv] = S;
    }
}
__device__ __forceinline__ void ret_sample_phase(LAS unsigned char* lds, const float* QKV, const float* state, const float* gnw, bf16* MIX, float* out, int tid) {
    const int grp = tid >> 7, t = tid & 127, dv = t;
    LAS float* qs = (LAS float*)(lds + grp * 4096);
    LAS float* ks = qs + 256;
    LAS float* red = ks + 256;
    for (int it = blockIdx.x; it < 128; it += gridDim.x) {
        const int sub = it * 4 + grp, b = sub >> 2, h = sub & 3;
        const float g = 1.f - exp2f(-5.f - (float)h);
        const float g2 = g * g, g3 = g2 * g, g4 = g2 * g2;
        const int row0 = MP + b * 4;
        for (int e = t; e < 256; e += 128) { const int i = e >> 6, dk = e & 63;
            qs[e] = QKV[(size_t)(row0 + i) * INW + C_QR + h * 64 + dk]; ks[e] = QKV[(size_t)(row0 + i) * INW + C_KR + h * 64 + dk]; }
        __syncthreads();
        float v[4];
#pragma unroll
        for (int i = 0; i < 4; ++i) v[i] = QKV[(size_t)(row0 + i) * INW + C_VR + h * 128 + dv];
        const float* s0p = state + (size_t)(b * 4 + h) * 64 * 128 + dv;
        float* snp = out + O_SS + (size_t)(b * 4 + h) * 64 * 128 + dv;
        float c0 = 0.f, c1 = 0.f, c2 = 0.f, c3 = 0.f;
        for (int dk = 0; dk < 64; ++dk) {
            const float s0 = s0p[dk * 128];
            c0 += qs[dk] * s0; c1 += qs[64 + dk] * s0; c2 += qs[128 + dk] * s0; c3 += qs[192 + dk] * s0;
            snp[dk * 128] = g4 * s0 + g3 * ks[dk] * v[0] + g2 * ks[64 + dk] * v[1] + g * ks[128 + dk] * v[2] + ks[192 + dk] * v[3];
        }
        float d00 = 0.f, d10 = 0.f, d11 = 0.f, d20 = 0.f, d21 = 0.f, d22 = 0.f, d30 = 0.f, d31 = 0.f, d32 = 0.f, d33 = 0.f;
        for (int dk = 0; dk < 64; ++dk) {
            const float q0 = qs[dk], q1 = qs[64 + dk], q2 = qs[128 + dk], q3 = qs[192 + dk];
            const float k0 = ks[dk], k1 = ks[64 + dk], k2 = ks[128 + dk], k3 = ks[192 + dk];
            d00 += q0 * k0; d10 += q1 * k0; d11 += q1 * k1; d20 += q2 * k0; d21 += q2 * k1; d22 += q2 * k2;
            d30 += q3 * k0; d31 += q3 * k1; d32 += q3 * k2; d33 += q3 * k3;
        }
        float o[4];
        o[0] = g * c0 + d00 * v[0];
        o[1] = g2 * c1 + g * d10 * v[0] + d11 * v[1];
        o[2] = g3 * c2 + g2 * d20 * v[0] + g * d21 * v[1] + d22 * v[2];
        o[3] = g4 * c3 + g3 * d30 * v[0] + g2 * d31 * v[1] + g * d32 * v[2] + d33 * v[3];
#pragma unroll
        for (int i = 0; i < 4; ++i) { const float s1 = wave_sum(o[i]); if ((t & 63) == 0) red[i * 2 + (t >> 6)] = s1; }
        __syncthreads();
        float dl[4];
#pragma unroll
        for (int i = 0; i < 4; ++i) { const float mu = (red[i * 2] + red[i * 2 + 1]) * (1.f / 128.f); dl[i] = o[i] - mu; }
#pragma unroll
        for (int i = 0; i < 4; ++i) { const float s2 = wave_sum(dl[i] * dl[i]); if ((t & 63) == 0) red[8 + i * 2 + (t >> 6)] = s2; }
        __syncthreads();
#pragma unroll
        for (int i = 0; i < 4; ++i) {
            const float var = (red[8 + i * 2] + red[8 + i * 2 + 1]) * (1.f / 128.f);
            const float y = dl[i] / sqrtf(var + EPS) * gnw[h * 128 + dv];
            const float gg = QKV[(size_t)(row0 + i) * INW + C_GR + h * 128 + dv];
            MIX[(size_t)(row0 + i) * D + 512 + h * 128 + dv] = (bf16)f2bf(silu_f(gg) * y);
        }
        __syncthreads();
    }
}

struct Args { const float* in[20]; float* out; unsigned char* ws; };
__global__ void __launch_bounds__(NTHR, 2) mk_fwd(Args a) {
    extern __shared__ __attribute__((aligned(16))) unsigned char lds_raw[];
    LAS unsigned char* lds = (LAS unsigned char*)lds_raw;
    volatile LAS unsigned* MISC = (volatile LAS unsigned*)(lds + MISC_OFF);
    const int tid = threadIdx.x, lane = tid & 63, wave = __builtin_amdgcn_readfirstlane(tid >> 6);
    const int G = gridDim.x;
    const int gw = blockIdx.x * NWAVES + wave, NGW = G * NWAVES, gtid = blockIdx.x * NTHR + tid, NGT = G * NTHR;
    unsigned char* ws = a.ws;
    Ptrs P;
    P.xp = a.in[0]; P.xs = a.in[1]; P.ck = a.in[2]; P.cv = a.in[3]; P.st = a.in[4]; P.g1a = a.in[5]; P.g1b = a.in[6]; P.w1g = a.in[7]; P.w1u = a.in[8]; P.w1d = a.in[9];
    P.gma = a.in[10]; P.gmb = a.in[11]; P.win = a.in[12]; P.gnw = a.in[13]; P.wout = a.in[14]; P.g2a = a.in[15]; P.g2b = a.in[16]; P.w2g = a.in[17]; P.w2u = a.in[18]; P.w2d = a.in[19];
    P.out = a.out;
    P.W1GU = (bf16*)(ws + WS_W1GU); P.W1D = (bf16*)(ws + WS_W1D); P.WIN = (bf16*)(ws + WS_WIN); P.WOUT = (bf16*)(ws + WS_WOUT); P.W2GU = (bf16*)(ws + WS_W2GU); P.W2D = (bf16*)(ws + WS_W2D);
    P.XN = (bf16*)(ws + WS_XN); P.H = (bf16*)(ws + WS_H); P.MIX = (bf16*)(ws + WS_MIX);
    P.TAB = (float2*)(ws + WS_TAB); P.Y = (float*)(ws + WS_Y); P.HRES = (float*)(ws + WS_HRES); P.QKV = (float*)(ws + WS_QKV); P.UPD = (float*)(ws + WS_UPD); P.SPT = (bf16*)(ws + WS_SPREV); P.QKVb = (bf16*)(ws + WS_QKVB); P.OPART = (bf16*)(ws + WS_OPART); P.ML = (float2*)(ws + WS_ML);
    for (int u = tid; u < (LDS_BYTES - LDSCTL_OFF) / 4; u += NTHR) ((LAS unsigned*)(lds + LDSCTL_OFF))[u] = 0u;
    __syncthreads();
    XcdBarrier bar = xcd_barrier_post((unsigned*)(ws + WS_CTL) + CW_BAR, MISC + 8);

    p0_prologue(P, lds, gw, NGW, wave, lane, gtid, NGT);
    xcd_barrier(bar);
    { pg8::Gemm g{P.XN, P.W1GU, M, 2 * DFF, D}; pg8::StaticOrder S; S.init(M, 2 * DFF, G, (int)blockIdx.x); pg8::EpiSwiglu E{P.H, DFF};
      pg8::gemm_phase<pg8::EpiSwiglu, pg8::StaticOrder, true, true>(lds, g, S, E); }
    xcd_barrier(bar);
    { pg8::Gemm g{P.H, P.W1D, M, D, DFF}; pg8::StaticOrder S; S.init(M, D, G, (int)blockIdx.x); pg8::EpiF32 E{P.Y, D};
      pg8::gemm_phase<pg8::EpiF32, pg8::StaticOrder, true, true>(lds, g, S, E); }
    xcd_barrier(bar);
    norm_res_phase(P.xp, P.xs, P.Y, P.g1b, 0.5f, P.HRES, P.gma, P.XN, gw, NGW, lane);
    xcd_barrier(bar);
    { pg8::Gemm g{P.XN, P.WIN, M, INW, D}; pg8::StaticOrder S; S.init(M, INW, G, (int)blockIdx.x); pg8::EpiF32 E{P.QKV, INW};
      pg8::gemm_phase<pg8::EpiF32, pg8::StaticOrder, true, true>(lds, g, S, E); }
    xcd_barrier(bar);
    rope_phase(P.QKV, P.QKVb, P.TAB, P.out, gw, NGW, lane);
    xcd_barrier(bar);
    ret_upd_phase(lds, P.QKV, P.UPD, tid);
    ret_sample_phase(lds, P.QKV, P.st, P.gnw, P.MIX, P.out, tid);
    attn_naive_phase(lds, P.QKV, P.ck, P.cv, P.MIX, gw, NGW, wave, lane);
    __syncthreads();
    attn_mfma_phase(lds, P.QKVb, P.OPART, P.ML, gw, NGW, wave, lane);
    xcd_barrier(bar);
    ret_scan_phase(P.UPD, P.SPT, P.out, tid);
    attn_combine_phase(P.OPART, P.ML, P.MIX, gtid, NGT);
    xcd_barrier(bar);
    ret_out_mfma_phase(lds, P.QKVb, P.SPT, P.gnw, P.MIX, tid, wave, lane);
    xcd_barrier(bar);
    { pg8::Gemm g{P.MIX, P.WOUT, M, D, D}; pg8::StaticOrder S; S.init(M, D, G, (int)blockIdx.x); pg8::EpiF32 E{P.Y, D};
      pg8::gemm_phase<pg8::EpiF32, pg8::StaticOrder, true, true>(lds, g, S, E); }
    xcd_barrier(bar);
    norm_res_phase(P.HRES, P.HRES + (size_t)MP * D, P.Y, P.gmb, 1.0f, P.HRES, P.g2a, P.XN, gw, NGW, lane);
    xcd_barrier(bar);
    { pg8::Gemm g{P.XN, P.W2GU, M, 2 * DFF, D}; pg8::StaticOrder S; S.init(M, 2 * DFF, G, (int)blockIdx.x); pg8::EpiSwiglu E{P.H, DFF};
      pg8::gemm_phase<pg8::EpiSwiglu, pg8::StaticOrder, true, true>(lds, g, S, E); }
    xcd_barrier(bar);
    { pg8::Gemm g{P.H, P.W2D, M, D, DFF}; pg8::StaticOrder S; S.init(M, D, G, (int)blockIdx.x); pg8::EpiF32 E{P.Y, D};
      pg8::gemm_phase<pg8::EpiF32, pg8::StaticOrder, true, true>(lds, g, S, E); }
    xcd_barrier(bar);
    norm_res_phase(P.HRES, P.HRES + (size_t)MP * D, P.Y, P.g2b, 0.5f, P.out + O_Y, nullptr, nullptr, gw, NGW, lane);
}

extern "C" void kernel_launch(void* const* d_in, const int* in_sizes, int n_in, void* d_out, int out_size, void* d_ws, size_t ws_size, hipStream_t stream) {
    static int grid = 0;
    if (grid == 0) {
        if (n_in != 20 || (size_t)out_size != O_END || ws_size < WS_END) { fprintf(stderr, "kernel_launch: unexpected sizes (n_in %d out %d ws %zu)\n", n_in, out_size, ws_size); grid = -1; return; }
        int dev = 0, cus = 0;
        if (hipGetDevice(&dev) != hipSuccess || hipDeviceGetAttribute(&cus, hipDeviceAttributeMultiprocessorCount, dev) != hipSuccess) { grid = -1; return; }
        if (hipFuncSetAttribute((const void*)mk_fwd, hipFuncAttributeMaxDynamicSharedMemorySize, LDS_BYTES) != hipSuccess) { fprintf(stderr, "kernel_launch: hipFuncSetAttribute failed\n"); grid = -1; return; }
        int per_cu = 0;
        if (hipOccupancyMaxActiveBlocksPerMultiprocessor(&per_cu, (const void*)mk_fwd, NTHR, LDS_BYTES) != hipSuccess || per_cu < 1) fprintf(stderr, "kernel_launch: occupancy query says %d\n", per_cu);
        (void)hipGetLastError();
        grid = cus;
    }
    if (grid < 0) return;
    (void)hipMemsetAsync((char*)d_ws + WS_CTL, 0, CTL_ZERO_BYTES, stream);
    Args a{};
    for (int i = 0; i < 20; ++i) a.in[i] = (const float*)d_in[i];
    a.out = (float*)d_out; a.ws = (unsigned char*)d_ws;
    hipLaunchKernelGGL(mk_fwd, dim3(grid), dim3(NTHR), LDS_BYTES, stream, a);
}
```

```cpp
#include <hip/hip_runtime.h>
#include <cstdio>
#include <cstdint>
namespace pg8 {
#define PG8_LAS __attribute__((address_space(3)))
typedef unsigned short bf16_t;
typedef short bf16x8 __attribute__((ext_vector_type(8)));
typedef float f32x4 __attribute__((ext_vector_type(4)));
typedef unsigned u32x4 __attribute__((ext_vector_type(4)));
constexpr int BM = 256, BK = 64, HALF = 128, HTB = HALF * BK * 2  , STAGE_BYTES = 8 * HTB, NXCD = 8, WGM = 8;

__host__ __device__ __forceinline__ int lds_byte(int r, int c) { const int st = (r >> 4) * 2 + (c >> 5), rr = r & 15, cc = c & 31, ob = rr * 64 + cc * 2; return st * 1024 + (ob ^ (((ob >> 9) & 1) << 5)); }
__host__ __device__ __forceinline__ void stage_rc(int b, int& R, int& C) { const int st = b / 1024, sb = b % 1024, swz = sb ^ (((sb >> 9) & 1) << 5); R = (st >> 1) * 16 + swz / 64; C = (st & 1) * 32 + (swz % 64) / 2; }
__host__ __device__ __forceinline__ int perm32(int rho) { const int n = rho >> 4, i = rho & 15; return 8 * (i >> 2) + 4 * n + (i & 3); }

struct Unit { int pm, pn; };
struct Gemm { const bf16_t* A; const bf16_t* Bt; int M, N, K; };

struct StaticOrder {
    int nM, nN, nwg, G, c;
    __host__ __device__ void init(int M, int N, int G_, int c_) { nM = M / BM; nN = N / BM; nwg = nM * nN; G = G_; c = c_; }
    __host__ __device__ bool next(int i, Unit& u) const {
        const long L = (long)i * G + c; if (L >= nwg) return false;
        int wgid = (int)L; { const int q = nwg / NXCD, r = nwg % NXCD, xcd = wgid % NXCD, off = wgid / NXCD; wgid = (xcd < r ? xcd * (q + 1) : r * (q + 1) + (xcd - r) * q) + off; }
        const int nig = WGM * nN, gid = wgid / nig, fm = gid * WGM, gsz = (nM - fm) < WGM ? (nM - fm) : WGM;
        u.pm = fm + ((wgid % nig) % gsz); u.pn = (wgid % nig) / gsz; return true;
    }
    __device__ __forceinline__ void a_ready(const Unit&) const {}
    __device__ __forceinline__ void done(const Unit&) const {}
};

__device__ __forceinline__ unsigned cvt_pk_bf16(float lo, float hi) { unsigned r; asm volatile("v_cvt_pk_bf16_f32 %0, %1, %2" : "=v"(r) : "v"(lo), "v"(hi)); return r; }
typedef float f32x2 __attribute__((ext_vector_type(2)));
__device__ __forceinline__ float silu_fast(float x) { return x * __builtin_amdgcn_rcpf(1.0f + __builtin_amdgcn_exp2f(-1.4426950408889634f * x)); }
struct EpiSwiglu {
    static constexpr bool PERM = true, AFTER_DRAIN = false;
    bf16_t* O; int ldc;
    __device__ __forceinline__ void operator()(const f32x4 (&acc)[2][2][4][2], const Unit& u, int wr, int wc, int fr, int fq) const {
        const int row0 = u.pm * BM + wr * 64 + fr, col0 = u.pn * HALF + wc * 32 + 8 * fq;
#pragma unroll
        for (int ai = 0; ai < 2; ++ai)
#pragma unroll
            for (int m = 0; m < 4; ++m) {
                bf16_t* rowp = O + (size_t)(row0 + ai * HALF + m * 16) * ldc + col0;
                const f32x4 g0 = acc[ai][0][m][0], g1 = acc[ai][0][m][1], u0 = acc[ai][1][m][0], u1 = acc[ai][1][m][1];
                u32x4 w;
                w.x = cvt_pk_bf16(silu_fast(g0[0]) * u0[0], silu_fast(g0[1]) * u0[1]); w.y = cvt_pk_bf16(silu_fast(g0[2]) * u0[2], silu_fast(g0[3]) * u0[3]);
                w.z = cvt_pk_bf16(silu_fast(g1[0]) * u1[0], silu_fast(g1[1]) * u1[1]); w.w = cvt_pk_bf16(silu_fast(g1[2]) * u1[2], silu_fast(g1[3]) * u1[3]);
                *(u32x4*)rowp = w;
            }
    }
};
struct EpiF32 {
    static constexpr bool PERM = false, AFTER_DRAIN = false;
    float* O; int ldc;
    __device__ __forceinline__ void operator()(const f32x4 (&acc)[2][2][4][2], const Unit& u, int wr, int wc, int fr, int fq) const {
        const int row0 = u.pm * BM + wr * 64 + fr, col0 = u.pn * BM + wc * 32 + 4 * fq;
#pragma unroll
        for (int ai = 0; ai < 2; ++ai)
#pragma unroll
            for (int m = 0; m < 4; ++m) {
                float* rowp = O + (size_t)(row0 + ai * HALF + m * 16) * ldc + col0;
#pragma unroll
                for (int bj = 0; bj < 2; ++bj)
#pragma unroll
                    for (int n = 0; n < 2; ++n) *(f32x4*)(rowp + bj * HALF + n * 16) = acc[ai][bj][m][n];
            }
    }
};
template <class Epi, class Sched, bool ALIGN_EPI = false, bool SP2 = false>
__device__ __forceinline__ void gemm_phase(PG8_LAS unsigned char* lds, const Gemm g, const Sched& S, const Epi& E) {
    const int tid = threadIdx.x, wid = __builtin_amdgcn_readfirstlane(tid >> 6), lane = tid & 63, wr = wid >> 2, wc = wid & 3, fr = lane & 15, fq = lane >> 4;
    const int K = g.K, nt = K / BK;
    unsigned voffA[2], voffB[2];
#pragma unroll
    for (int i = 0; i < 2; ++i) { int R, C; stage_rc(tid * 16 + i * 8192, R, C); const int Rb = Epi::PERM ? ((R & ~31) + perm32(R & 31)) : R;
        voffA[i] = (unsigned)(R * K + C) * 2u; voffB[i] = (unsigned)(Rb * K + C) * 2u; }
    const size_t kstep = (size_t)(BK * 2);
    const size_t hstep = (size_t)HALF * K * 2;
    const size_t tstep = 2 * hstep;
    const unsigned ldsw = (unsigned)wid * 1024u;
    const int aoff = lds_byte(wr * 64 + fr, fq * 8), boff = lds_byte(wc * 32 + fr, fq * 8);
#define PG8_SA(b, h) (((b) * 2 + (h)) * HTB)
#define PG8_SB(b, h) ((4 + (b) * 2 + (h)) * HTB)
#define PG8_STAGE(bufoff, gbase, voff) do { _Pragma("unroll") for (int _i = 0; _i < 2; ++_i) \
        __builtin_amdgcn_global_load_lds((const unsigned*)((const char*)(gbase) + (voff)[_i]), (PG8_LAS unsigned*)(lds + (bufoff) + ldsw + _i * 8192), 16, 0, 0); } while (0)
#define PG8_LDA(dst, b, h) do { _Pragma("unroll") for (int m = 0; m < 4; ++m) _Pragma("unroll") for (int k = 0; k < 2; ++k) dst[m][k] = *(const PG8_LAS bf16x8*)(lds + PG8_SA(b, h) + aoff + m * 2048 + k * 1024); } while (0)
#define PG8_LDB(dst, b, h) do { _Pragma("unroll") for (int n = 0; n < 2; ++n) _Pragma("unroll") for (int k = 0; k < 2; ++k) dst[n][k] = *(const PG8_LAS bf16x8*)(lds + PG8_SB(b, h) + boff + n * 2048 + k * 1024); } while (0)
#define PG8_MMA(ai, bj, At, Bt) do { __builtin_amdgcn_s_setprio(1); _Pragma("unroll") for (int m = 0; m < 4; ++m) _Pragma("unroll") for (int n = 0; n < 2; ++n) _Pragma("unroll") for (int k = 0; k < 2; ++k) \
        acc[ai][bj][m][n] = __builtin_amdgcn_mfma_f32_16x16x32_bf16(Bt[n][k], At[m][k], acc[ai][bj][m][n], 0, 0, 0); __builtin_amdgcn_s_setprio(0); } while (0)
#define PG8_WAIT_V(n) asm volatile("s_waitcnt vmcnt(" #n ")" ::: "memory")
#define PG8_WAIT_L(n) asm volatile("s_waitcnt lgkmcnt(" #n ")" ::: "memory")
#define PG8_BAR __builtin_amdgcn_s_barrier()
#define PG8_SCHED __builtin_amdgcn_sched_barrier(0)
    Unit cur, nxt; int ui = 0;
    if (!S.next(0, cur)) return;
    f32x4 acc[2][2][4][2];
#pragma unroll
    for (int a = 0; a < 2; ++a)
#pragma unroll
        for (int b = 0; b < 2; ++b)
#pragma unroll
            for (int m = 0; m < 4; ++m)
#pragma unroll
                for (int n = 0; n < 2; ++n) acc[a][b][m][n] = (f32x4){0.f, 0.f, 0.f, 0.f};
    bf16x8 At[4][2], B0[2][2], B1[2][2];
    const char* cA = (const char*)g.A + (size_t)cur.pm * tstep; const char* cB = (const char*)g.Bt + (size_t)cur.pn * tstep;
    S.a_ready(cur);
    if constexpr (SP2) {
        PG8_STAGE(PG8_SB(0, 0), cB, voffB); PG8_STAGE(PG8_SB(0, 1), cB + hstep, voffB); PG8_STAGE(PG8_SA(0, 0), cA, voffA); PG8_STAGE(PG8_SA(0, 1), cA + hstep, voffA);
        if (wr == 1) PG8_BAR;
        PG8_WAIT_V(2); PG8_BAR;
        PG8_STAGE(PG8_SB(1, 0), cB + kstep, voffB); PG8_STAGE(PG8_SA(1, 0), cA + kstep, voffA); PG8_STAGE(PG8_SB(1, 1), cB + hstep + kstep, voffB);
        PG8_WAIT_V(6); PG8_BAR;
    } else {
        PG8_STAGE(PG8_SB(0, 0), cB, voffB); PG8_STAGE(PG8_SA(0, 0), cA, voffA); PG8_STAGE(PG8_SB(0, 1), cB + hstep, voffB); PG8_STAGE(PG8_SA(0, 1), cA + hstep, voffA);
        if (wr == 1) PG8_BAR;
        PG8_WAIT_V(4); PG8_BAR;
        PG8_STAGE(PG8_SB(1, 0), cB + kstep, voffB); PG8_STAGE(PG8_SA(1, 0), cA + kstep, voffA); PG8_STAGE(PG8_SB(1, 1), cB + hstep + kstep, voffB);
        PG8_WAIT_V(6); PG8_BAR;
    }
    for (;;) {
        const bool has_next = S.next(ui + 1, nxt);
        const char* nA = has_next ? (const char*)g.A + (size_t)nxt.pm * tstep : cA; const char* nB = has_next ? (const char*)g.Bt + (size_t)nxt.pn * tstep : cB;
        for (int t = 0; t < nt; t += 2) {
            const bool last = (t == nt - 2);
            const char* a1 = cA + (size_t)(t + 1) * kstep;
            const char* a2 = last ? nA : cA + (size_t)(t + 2) * kstep; const char* b2 = last ? nB : cB + (size_t)(t + 2) * kstep;
            const char* a3 = a2 + kstep; const char* b3 = b2 + kstep;
            if (last && has_next) S.a_ready(nxt);
            if constexpr (SP2) {
            PG8_LDB(B0, 0, 0); PG8_LDB(B1, 0, 1); PG8_SCHED; PG8_LDA(At, 0, 0); PG8_STAGE(PG8_SA(1, 1), a1 + hstep, voffA);
            PG8_WAIT_V(8); PG8_WAIT_L(0); PG8_BAR; PG8_MMA(0, 0, At, B0); PG8_MMA(0, 1, At, B1); PG8_BAR; PG8_SCHED;
            PG8_LDA(At, 0, 1); PG8_STAGE(PG8_SB(0, 0), b2, voffB); PG8_STAGE(PG8_SB(0, 1), b2 + hstep, voffB); PG8_STAGE(PG8_SA(0, 0), a2, voffA);
            PG8_WAIT_V(8); PG8_WAIT_L(0); PG8_BAR; PG8_MMA(1, 0, At, B0); PG8_MMA(1, 1, At, B1); PG8_BAR; PG8_SCHED;
            PG8_LDB(B0, 1, 0); PG8_LDB(B1, 1, 1); PG8_SCHED; PG8_LDA(At, 1, 0); PG8_STAGE(PG8_SA(0, 1), a2 + hstep, voffA);
            PG8_WAIT_V(8); PG8_WAIT_L(0); PG8_BAR; PG8_MMA(0, 0, At, B0); PG8_MMA(0, 1, At, B1); PG8_BAR; PG8_SCHED;
            PG8_LDA(At, 1, 1); PG8_STAGE(PG8_SB(1, 0), b3, voffB); PG8_STAGE(PG8_SB(1, 1), b3 + hstep, voffB); PG8_STAGE(PG8_SA(1, 0), a3, voffA);
            PG8_WAIT_V(8); PG8_WAIT_L(0); PG8_BAR; PG8_MMA(1, 0, At, B0); PG8_MMA(1, 1, At, B1); PG8_BAR; PG8_SCHED;
            } else {
            PG8_LDB(B0, 0, 0); PG8_SCHED; PG8_LDA(At, 0, 0); PG8_STAGE(PG8_SA(1, 1), a1 + hstep, voffA);
            PG8_WAIT_L(8); PG8_BAR; PG8_WAIT_L(0); PG8_MMA(0, 0, At, B0); PG8_BAR; PG8_SCHED;
            PG8_LDB(B1, 0, 1); PG8_STAGE(PG8_SB(0, 0), b2, voffB);
            PG8_BAR; PG8_WAIT_L(0); PG8_MMA(0, 1, At, B1); PG8_BAR;
            PG8_LDA(At, 0, 1); PG8_STAGE(PG8_SA(0, 0), a2, voffA);
            PG8_BAR; PG8_WAIT_L(0); PG8_MMA(1, 0, At, B0); PG8_BAR; PG8_SCHED;
            PG8_STAGE(PG8_SB(0, 1), b2 + hstep, voffB);
            PG8_WAIT_V(6); PG8_BAR; PG8_MMA(1, 1, At, B1); PG8_BAR;
            PG8_LDB(B0, 1, 0); PG8_SCHED; PG8_LDA(At, 1, 0); PG8_STAGE(PG8_SA(0, 1), a2 + hstep, voffA);
            PG8_WAIT_L(8); PG8_BAR; PG8_WAIT_L(0); PG8_MMA(0, 0, At, B0); PG8_BAR; PG8_SCHED;
            PG8_LDB(B1, 1, 1); PG8_STAGE(PG8_SB(1, 0), b3, voffB);
            PG8_BAR; PG8_WAIT_L(0); PG8_MMA(0, 1, At, B1); PG8_BAR;
            PG8_LDA(At, 1, 1); PG8_STAGE(PG8_SA(1, 0), a3, voffA);
            PG8_BAR; PG8_WAIT_L(0); PG8_MMA(1, 0, At, B0); PG8_BAR; PG8_SCHED;
            PG8_STAGE(PG8_SB(1, 1), b3 + hstep, voffB);
            PG8_WAIT_V(6); PG8_BAR; PG8_MMA(1, 1, At, B1); PG8_BAR;
            }
        }
        if constexpr (ALIGN_EPI) { if (wr == 0) PG8_BAR; }
        if constexpr (!Epi::AFTER_DRAIN) { E(acc, cur, wr, wc, fr, fq); S.done(cur); }
        if (!has_next) break;
#pragma unroll
        for (int a = 0; a < 2; ++a)
#pragma unroll
            for (int b = 0; b < 2; ++b)
#pragma unroll
                for (int m = 0; m < 4; ++m)
#pragma unroll
                    for (int n = 0; n < 2; ++n) acc[a][b][m][n] = (f32x4){0.f, 0.f, 0.f, 0.f};
        cur = nxt; cA = nA; cB = nB; ++ui;
        if constexpr (ALIGN_EPI) { if (wr == 1) PG8_BAR; }
    }
    PG8_WAIT_V(0);
    if constexpr (!ALIGN_EPI) { if (wr == 0) PG8_BAR; }
    PG8_BAR;
    if constexpr (Epi::AFTER_DRAIN) { E.fused(acc, cur, wr, wc, fr, fq, lds, wid, lane); S.done(cur); }
#undef PG8_SA
#undef PG8_SB
#undef PG8_STAGE
#undef PG8_LDA
#undef PG8_LDB
#undef PG8_MMA
#undef PG8_WAIT_V
#undef PG8_WAIT_L
#undef PG8_BAR
#undef PG8_SCHED
}
}
#define GAS __attribute__((address_space(1)))
#define LAS __attribute__((address_space(3)))
typedef unsigned short bf16;
typedef unsigned v4u __attribute__((ext_vector_type(4)));
typedef float f32x4 __attribute__((ext_vector_type(4)));
typedef short bf16x8 __attribute__((ext_vector_type(8)));
typedef GAS unsigned gu32;
typedef GAS unsigned long long gu64;
#define RLX_AGENT __ATOMIC_RELAXED, __HIP_MEMORY_SCOPE_AGENT
#define LDS_WAIT() asm volatile("s_waitcnt lgkmcnt(0)" ::: "memory")
#define VM_WAIT() asm volatile("s_waitcnt vmcnt(0)" ::: "memory")
__device__ __forceinline__ unsigned long long rt() { return __builtin_amdgcn_s_memrealtime(); }
__device__ __forceinline__ unsigned f2bf(float f) { unsigned u = __builtin_bit_cast(unsigned, f); return (u + 0x7fffu + ((u >> 16) & 1u)) >> 16; }
__device__ __forceinline__ unsigned pk2(float lo, float hi) { return f2bf(lo) | (f2bf(hi) << 16); }
#define XB_TMO      128
#define XB_XCNT(j)  (256  + 64 * (j))
#define XB_XSUB(j)  (1280 + 64 * (j))
#define XB_XGEN(j)  (2304 + 64 * (j))
#define XB_TOP      3328
#define XB_TOPGEN   3392
#define XCD_BAR_WORDS 3456
#define XB_SPIN_CAP (1u << 18)

__device__ __forceinline__ unsigned xb_ld(unsigned* p)              { return __hip_atomic_load(p, __ATOMIC_RELAXED, __HIP_MEMORY_SCOPE_AGENT); }
__device__ __forceinline__ unsigned xb_add(unsigned* p, unsigned v) { return __hip_atomic_fetch_add(p, v, __ATOMIC_RELAXED, __HIP_MEMORY_SCOPE_AGENT); }
__device__ __forceinline__ unsigned xb_xcc_id() { return (unsigned)__builtin_amdgcn_s_getreg((3 << 11) | 20) & 0xFu; }
#define XB_SPIN(cond, bar) do { unsigned _sp = 0; while (cond) { __builtin_amdgcn_s_sleep(1); \
    if ((++_sp & 255u) == 0u) { if (xb_ld(&(bar)[XB_TMO])) break; if (_sp > XB_SPIN_CAP) { atomicAdd(&(bar)[XB_TMO], 1u); break; } } } } while (0)

struct XcdBarrier {
    unsigned* bar; unsigned x;
    volatile LAS unsigned* st;
};

__device__ __forceinline__ XcdBarrier xcd_barrier_post(unsigned* bar, volatile LAS unsigned* st) {
    XcdBarrier b; b.bar = bar; b.x = xb_xcc_id(); b.st = st;
    if (threadIdx.x == 0) (void)xb_add(&bar[XB_XCNT(b.x)], 1u);
    return b;
}
__device__ __forceinline__ void xcd_barrier_complete(unsigned* bar, unsigned x, unsigned& nloc, unsigned& nx) {
    const unsigned G = gridDim.x * gridDim.y * gridDim.z;
    unsigned sum, cnt, mine, sp = 0u;
    for (;;) {
        sum = 0u; cnt = 0u; mine = 0u;
#pragma unroll
        for (unsigned j = 0; j < 16; ++j) { const unsigned c = xb_ld(&bar[XB_XCNT(j)]); sum += c; cnt += (c > 0u) ? 1u : 0u; mine = (j == x) ? c : mine; }
        if (sum == G) break;
        __builtin_amdgcn_s_sleep(1);
        if ((++sp & 255u) == 0u) { if (xb_ld(&bar[XB_TMO])) break; if (sp > XB_SPIN_CAP) { atomicAdd(&bar[XB_TMO], 1u); break; } }
    }
    nloc = mine > 0u ? mine : 1u; nx = cnt > 0u ? cnt : 1u;
}

__device__ __forceinline__ void xcd_barrier(const XcdBarrier& b) {
    asm volatile("s_waitcnt vmcnt(0)" ::: "memory");
    __syncthreads();
    if (threadIdx.x == 0) {
        unsigned* bar = b.bar;
        __builtin_amdgcn_s_waitcnt(0);
        unsigned nloc = b.st[0], nx = b.st[1];
        if (nloc == 0u) { xcd_barrier_complete(bar, b.x, nloc, nx); b.st[0] = nloc; b.st[1] = nx; }
        const unsigned old = xb_add(&bar[XB_XSUB(b.x)], 1u);
        const unsigned gen = old / nloc;
        if (old + 1u == (gen + 1u) * nloc) {
            __builtin_amdgcn_fence(__ATOMIC_RELEASE, "agent");
            asm volatile("s_waitcnt vmcnt(0)" ::: "memory");
            const unsigned og = xb_add(&bar[XB_TOP], 1u);
            const unsigned tg = og / nx;
            if (og + 1u == (tg + 1u) * nx) xb_add(&bar[XB_TOPGEN], 1u);
            else XB_SPIN(xb_ld(&bar[XB_TOPGEN]) == tg, bar);
            __builtin_amdgcn_fence(__ATOMIC_ACQUIRE, "agent");
            xb_add(&bar[XB_XGEN(b.x)], 1u);
            asm volatile("s_waitcnt vmcnt(0)" ::: "memory");
        } else {
            XB_SPIN(xb_ld(&bar[XB_XGEN(b.x)]) == gen, bar);
            __builtin_amdgcn_fence(__ATOMIC_ACQUIRE, "agent");
            asm volatile("s_waitcnt vmcnt(0)" ::: "memory");
        }
    }
    __syncthreads();
}
constexpr int NWAVES = 8, NTHR = 512;
constexpr int D = 1024, SEQ = 16384, DBATCH = 128, MP = SEQ, MS = 512, M = MP + MS;
constexpr int DFF = 2816, INW = 3072, PAST = 8192, WB = 2048, KEEP = 2048, NH = 8;
constexpr float EPS = 1e-6f;
constexpr int C_QA = 0, C_KA = 512, C_VA = 1024, C_QR = 1536, C_KR = 1792, C_VR = 2048, C_GR = 2560;
constexpr size_t O_Y = 0, O_KP = (size_t)M * D, O_VP = O_KP + (size_t)KEEP * 512, O_SP = O_VP + (size_t)KEEP * 512,
                 O_KS = O_SP + 32768, O_VS = O_KS + (size_t)MS * 512, O_SS = O_VS + (size_t)MS * 512, O_END = O_SS + (size_t)DBATCH * 32768;
constexpr size_t MiB = 1u << 20;
constexpr size_t WS_CTL = 0, CTL_ZERO_BYTES = 1 * MiB;
constexpr size_t WS_W1GU = 1 * MiB, WS_W1D = 12 * MiB, WS_WIN = 18 * MiB, WS_WOUT = 24 * MiB, WS_W2GU = 26 * MiB, WS_W2D = 37 * MiB, WS_TAB = 43 * MiB;
constexpr size_t WS_XN = 48 * MiB, WS_H = 81 * MiB, WS_Y = 172 * MiB, WS_HRES = 238 * MiB, WS_QKV = 304 * MiB, WS_MIX = 502 * MiB, WS_UPD = 535 * MiB, WS_SPREV = 551 * MiB, WS_QKVB = 567 * MiB, WS_OPART = 667 * MiB, WS_ML = 716 * MiB, WS_SPART = 720 * MiB, WS_SML = 736 * MiB, WS_END = 737 * MiB;
constexpr int CW_BAR = 4096;
constexpr int RING_BYTES = 131072, LDSCTL_OFF = RING_BYTES, MISC_OFF = LDSCTL_OFF + 320, LDS_BYTES = 147456;

__constant__ float INVF[40] = {
    1.f, 0.193922743f, 0.0376060307f, 0.00729266461f, 0.00141421356f, 0.000274248188f, 5.3182961e-05f, 1.03133862e-05f,
    1.f, 0.749894261f, 0.562341332f, 0.421696514f, 0.316227764f, 0.237137377f, 0.177827939f, 0.133352131f, 0.100000001f, 0.0749894157f,
    0.0562341325f, 0.0421696529f, 0.0316227749f, 0.0237137377f, 0.0177827943f, 0.0133352149f, 0.00999999978f, 0.00749894185f,
    0.00562341325f, 0.00421696482f, 0.00316227763f, 0.00237137359f, 0.00177827943f, 0.00133352145f, 0.00100000005f, 0.000749894243f,
    0.000562341302f, 0.000421696517f, 0.000316227757f, 0.00023713737f, 0.00017782794f, 0.00013335215f};
__device__ __forceinline__ float log_g(int h) { return h == 0 ? -0.0317486983145803f : h == 1 ? -0.015748356968139168f : h == 2 ? -0.007843177461025893f : -0.003913899321136329f; }
__device__ __forceinline__ float wave_sum(float v) {
#pragma unroll
    for (int o = 32; o >= 1; o >>= 1) v += __shfl_xor(v, o);
    return v;
}
__device__ __forceinline__ float wave_max(float v) {
#pragma unroll
    for (int o = 32; o >= 1; o >>= 1) v = fmaxf(v, __shfl_xor(v, o));
    return v;
}
__device__ __forceinline__ float silu_f(float x) { return x / (1.f + expf(-x)); }

__device__ __forceinline__ void tr_item(const float* W, int K, int N, bf16* WT, int mode, LAS float* scr, int item, int lane) {
    const int nblk = N / 32, kb = item / nblk, nb = item % nblk, k0 = 64 * kb, n0 = 32 * nb;
    const int rbase = mode == 0 ? n0 : (256 * (n0 >> 7) + (n0 & 127) + (mode == 2 ? 128 : 0));
#pragma unroll 8
    for (int i = 0; i < 32; ++i) { const int kk = 2 * i + (lane >> 5); scr[kk * 33 + (lane & 31)] = W[(size_t)(k0 + kk) * N + n0 + (lane & 31)]; }
    LDS_WAIT(); asm volatile("" ::: "memory");
    const int c = lane & 7;
#pragma unroll
    for (int j = 0; j < 4; ++j) { const int n = (lane >> 3) + 8 * j; const LAS float* s = scr + (8 * c) * 33 + n;
        v4u o; o.x = pk2(s[0 * 33], s[1 * 33]); o.y = pk2(s[2 * 33], s[3 * 33]); o.z = pk2(s[4 * 33], s[5 * 33]); o.w = pk2(s[6 * 33], s[7 * 33]);
        *(GAS v4u*)(WT + (size_t)(rbase + n) * K + k0 + 8 * c) = o; }
    LDS_WAIT(); asm volatile("" ::: "memory");
}
struct Ptrs {
    const float *xp, *xs, *ck, *cv, *st, *g1a, *g1b, *w1g, *w1u, *w1d, *gma, *gmb, *win, *gnw, *wout, *g2a, *g2b, *w2g, *w2u, *w2d;
    float* out;
    bf16 *W1GU, *W1D, *WIN, *WOUT, *W2GU, *W2D, *XN, *H, *MIX;
    float2* TAB; float *Y, *HRES, *QKV, *UPD; bf16 *SPT, *QKVb, *OPART; float2 *ML, *SML; float* SPART;
};
__device__ __forceinline__ void p0_prologue(const Ptrs& P, LAS unsigned char* lds, int gw, int NGW, int wave, int lane, int gtid, int NGT) {
    LAS float* scr = (LAS float*)(lds + wave * 16384);
    constexpr int I_GU = 16 * 88, I_D = 44 * 32, I_IN = 16 * 96, I_OUT = 16 * 32;
    constexpr int NITEMS = 6 * I_GU + I_IN + I_OUT;
    static_assert(I_D == I_GU, "items");
    for (int it = gw; it < NITEMS; it += NGW) {
        int r = it;
        if (r < I_GU) { tr_item(P.w1g, D, DFF, P.W1GU, 1, scr, r, lane); continue; } r -= I_GU;
        if (r < I_GU) { tr_item(P.w1u, D, DFF, P.W1GU, 2, scr, r, lane); continue; } r -= I_GU;
        if (r < I_D) { tr_item(P.w1d, DFF, D, P.W1D, 0, scr, r, lane); continue; } r -= I_D;
        if (r < I_GU) { tr_item(P.w2g, D, DFF, P.W2GU, 1, scr, r, lane); continue; } r -= I_GU;
        if (r < I_GU) { tr_item(P.w2u, D, DFF, P.W2GU, 2, scr, r, lane); continue; } r -= I_GU;
        if (r < I_D) { tr_item(P.w2d, DFF, D, P.W2D, 0, scr, r, lane); continue; } r -= I_D;
        if (r < I_IN) { tr_item(P.win, D, INW, P.WIN, 0, scr, r, lane); continue; } r -= I_IN;
        tr_item(P.wout, D, D, P.WOUT, 0, scr, r, lane);
    }
    for (int idx = gtid; idx < SEQ * 40; idx += NGT) {
        const int pos = idx / 40, f = idx % 40;
        const float ang = (float)pos * INVF[f];
        const double rev = (double)ang * 0.15915494309189535;
        const float fr = (float)(rev - rint(rev));
        P.TAB[idx] = make_float2(__builtin_amdgcn_cosf(fr), __builtin_amdgcn_sinf(fr));
    }
    for (int r = gw; r < M; r += NGW) {
        const float4* x = (const float4*)(r < MP ? P.xp + (size_t)r * D : P.xs + (size_t)(r - MP) * D);
        float4 v[4]; float ss = 0.f;
#pragma unroll
        for (int j = 0; j < 4; ++j) { v[j] = x[lane + 64 * j]; ss += v[j].x * v[j].x + v[j].y * v[j].y + v[j].z * v[j].z + v[j].w * v[j].w; }
        const float rstd = 1.f / sqrtf(wave_sum(ss) * (1.f / D) + EPS);
        uint2* o = (uint2*)(P.XN + (size_t)r * D);
#pragma unroll
        for (int j = 0; j < 4; ++j) { const float4 gg = ((const float4*)P.g1a)[lane + 64 * j];
            o[lane + 64 * j] = make_uint2(pk2(v[j].x * rstd * gg.x, v[j].y * rstd * gg.y), pk2(v[j].z * rstd * gg.z, v[j].w * rstd * gg.w)); }
    }
}
__device__ __forceinline__ void norm_res_phase(const float* resA, const float* resB, const float* Y, const float* gpost, float scale, float* hout, const float* gnext, bf16* XN, int gw, int NGW, int lane) {
    for (int r = gw; r < M; r += NGW) {
        const float4* x = (const float4*)(r < MP ? resA + (size_t)r * D : resB + (size_t)(r - MP) * D);
        const float4* y = (const float4*)(Y + (size_t)r * D);
        float4 v[4], hv[4]; float ss = 0.f;
#pragma unroll
        for (int j = 0; j < 4; ++j) { v[j] = y[lane + 64 * j]; hv[j] = x[lane + 64 * j]; ss += v[j].x * v[j].x + v[j].y * v[j].y + v[j].z * v[j].z + v[j].w * v[j].w; }
        const float rstd = scale / sqrtf(wave_sum(ss) * (1.f / D) + EPS);
        float s2 = 0.f;
#pragma unroll
        for (int j = 0; j < 4; ++j) { const float4 gg = ((const float4*)gpost)[lane + 64 * j];
            hv[j].x += v[j].x * rstd * gg.x; hv[j].y += v[j].y * rstd * gg.y; hv[j].z += v[j].z * rstd * gg.z; hv[j].w += v[j].w * rstd * gg.w;
            s2 += hv[j].x * hv[j].x + hv[j].y * hv[j].y + hv[j].z * hv[j].z + hv[j].w * hv[j].w; }
        float4* ho = (float4*)(hout + (size_t)r * D);
#pragma unroll
        for (int j = 0; j < 4; ++j) ho[lane + 64 * j] = hv[j];
        if (gnext) {
            const float r2 = 1.f / sqrtf(wave_sum(s2) * (1.f / D) + EPS);
            uint2* o = (uint2*)(XN + (size_t)r * D);
#pragma unroll
            for (int j = 0; j < 4; ++j) { const float4 gg = ((const float4*)gnext)[lane + 64 * j];
                o[lane + 64 * j] = make_uint2(pk2(hv[j].x * r2 * gg.x, hv[j].y * r2 * gg.y), pk2(hv[j].z * r2 * gg.z, hv[j].w * r2 * gg.w)); }
        }
    }
}
typedef float f32x16 __attribute__((ext_vector_type(16)));
typedef short s16x4 __attribute__((ext_vector_type(4)));
typedef float f32x2_t __attribute__((ext_vector_type(2)));
typedef __bf16 bf16x2_t __attribute__((ext_vector_type(2)));
__device__ __forceinline__ unsigned cvtpk(float lo, float hi) { f32x2_t v = {lo, hi}; bf16x2_t b = __builtin_convertvector(v, bf16x2_t); return __builtin_bit_cast(unsigned, b); }
__device__ __forceinline__ s16x4 vtr(const LAS unsigned char* p) { return __builtin_bit_cast(s16x4, __builtin_amdgcn_ds_read_tr16_b64_v4i16((LAS s16x4*)p)); }
#define MFMA32(a, b, c) __builtin_amdgcn_mfma_f32_32x32x16_bf16((a), (b), (c), 0, 0, 0)
__device__ __forceinline__ int crow(int reg, int hh) { return (reg & 3) + 8 * (reg >> 2) + 4 * hh; }
__device__ __forceinline__ float bf_lo(unsigned u) { return __builtin_bit_cast(float, u << 16); }
__device__ __forceinline__ float bf_hi(unsigned u) { return __builtin_bit_cast(float, u & 0xffff0000u); }
constexpr float QSCALE = 0.125f * 1.4426950408889634f;

__device__ __forceinline__ void rope_phase(float* QKV, bf16* QKVb, const float2* tab, float* out, int gw, int NGW, int lane) {
    for (int r = gw; r < M; r += NGW) {
        const int pos = r < MP ? r : PAST + ((r - MP) & 3);
        float* row = QKV + (size_t)r * INW;
        bf16* rowb = QKVb + (size_t)r * INW;
        float *ko = nullptr, *vo = nullptr;
        if (r >= MP) { ko = out + O_KS + (size_t)(r - MP) * 512; vo = out + O_VS + (size_t)(r - MP) * 512; }
        else if (r >= MP - KEEP) { ko = out + O_KP + (size_t)(r - (MP - KEEP)) * 512; vo = out + O_VP + (size_t)(r - (MP - KEEP)) * 512; }
        {
            const int s = lane >> 5, hd = (lane >> 2) & 7, qd = lane & 3, base = s * 512 + hd * 64 + qd * 16;
            float v[16];
#pragma unroll
            for (int c = 0; c < 4; ++c) { const float4 t = *(const float4*)(row + base + 4 * c); v[4 * c] = t.x; v[4 * c + 1] = t.y; v[4 * c + 2] = t.z; v[4 * c + 3] = t.w; }
            if (qd == 0) {
#pragma unroll
                for (int e = 0; e < 8; ++e) { const float2 cs = tab[pos * 40 + e]; const float x1 = v[e], x2 = v[8 + e]; v[e] = x1 * cs.x - x2 * cs.y; v[8 + e] = x2 * cs.x + x1 * cs.y; }
#pragma unroll
                for (int c = 0; c < 4; ++c) *(float4*)(row + base + 4 * c) = make_float4(v[4 * c], v[4 * c + 1], v[4 * c + 2], v[4 * c + 3]);
            }
            if (s == 1 && ko) {
#pragma unroll
                for (int c = 0; c < 4; ++c) *(float4*)(ko + hd * 64 + qd * 16 + 4 * c) = make_float4(v[4 * c], v[4 * c + 1], v[4 * c + 2], v[4 * c + 3]);
            }
            const float sc = s == 0 ? QSCALE : 1.f;
            v4u w0, w1;
            w0.x = cvtpk(v[0] * sc, v[1] * sc); w0.y = cvtpk(v[2] * sc, v[3] * sc); w0.z = cvtpk(v[4] * sc, v[5] * sc); w0.w = cvtpk(v[6] * sc, v[7] * sc);
            w1.x = cvtpk(v[8] * sc, v[9] * sc); w1.y = cvtpk(v[10] * sc, v[11] * sc); w1.z = cvtpk(v[12] * sc, v[13] * sc); w1.w = cvtpk(v[14] * sc, v[15] * sc);
            *(v4u*)(rowb + base) = w0; *(v4u*)(rowb + base + 8) = w1;
        }
#pragma unroll
        for (int t = 0; t < 3; ++t) {
            const int base = (t == 0 ? C_VA : t == 1 ? C_VR : C_GR) + 8 * lane;
            const float4 a = *(const float4*)(row + base), b = *(const float4*)(row + base + 4);
            v4u w; w.x = cvtpk(a.x, a.y); w.y = cvtpk(a.z, a.w); w.z = cvtpk(b.x, b.y); w.w = cvtpk(b.z, b.w);
            *(v4u*)(rowb + base) = w;
            if (t == 0 && vo) { *(float4*)(vo + 8 * lane) = a; *(float4*)(vo + 8 * lane + 4) = b; }
        }
        {
            const int s = lane >> 5, h = (lane >> 3) & 3, ig = lane & 7, base = C_QR + s * 256 + h * 64;
            const float4 a = *(const float4*)(row + base + 4 * ig), b = *(const float4*)(row + base + 32 + 4 * ig);
            const float sc = s ? 0.125f : 1.f;
            const float2 c0 = tab[pos * 40 + 8 + 4 * ig], c1 = tab[pos * 40 + 9 + 4 * ig], c2 = tab[pos * 40 + 10 + 4 * ig], c3 = tab[pos * 40 + 11 + 4 * ig];
            const float4 y1 = make_float4((a.x * c0.x - b.x * c0.y) * sc, (a.y * c1.x - b.y * c1.y) * sc, (a.z * c2.x - b.z * c2.y) * sc, (a.w * c3.x - b.w * c3.y) * sc);
            const float4 y2 = make_float4((b.x * c0.x + a.x * c0.y) * sc, (b.y * c1.x + a.y * c1.y) * sc, (b.z * c2.x + a.z * c2.y) * sc, (b.w * c3.x + a.w * c3.y) * sc);
            *(float4*)(row + base + 4 * ig) = y1; *(float4*)(row + base + 32 + 4 * ig) = y2;
            *(uint2*)(rowb + base + 4 * ig) = make_uint2(cvtpk(y1.x, y1.y), cvtpk(y1.z, y1.w));
            *(uint2*)(rowb + base + 32 + 4 * ig) = make_uint2(cvtpk(y2.x, y2.y), cvtpk(y2.z, y2.w));
        }
    }
}

__device__ __forceinline__ void attn_mfma_phase(LAS unsigned char* lds, const bf16* QKVb, bf16* OPART, float2* ML, int gw, int NGW, int wave, int lane) {
    LAS unsigned char* vt = lds + wave * 6144;
    const int i = lane & 31, hh = lane >> 5, i16 = lane & 15, tq = i16 >> 2, tp = i16 & 3, blk = (lane >> 4) & 1;
    constexpr int NITEM = 3 * 4096;
    const int per = (NITEM + NGW - 1) / NGW;
    const int i_beg = gw * per, i_end = (i_beg + per < NITEM) ? i_beg + per : NITEM;
    for (int idx = i_beg; idx < i_end; ++idx) {
        const int b = idx >> 12, rem = idx & 4095, h = rem >> 9, within = rem & 511;
        const int dsh = 2 * b, d = 1 << dsh, r = within >> (9 - dsh), qt = within & ((512 >> dsh) - 1), l0 = qt * 32;
        const int tok_q = (l0 + i) * d + r;
        const bf16* qp = QKVb + (size_t)tok_q * INW + C_QA + h * 64 + 8 * hh;
        bf16x8 qf[4];
#pragma unroll
        for (int ks = 0; ks < 4; ++ks) qf[ks] = *(const bf16x8*)(qp + 16 * ks);
        f32x16 o0, o1;
#pragma unroll
        for (int e = 0; e < 16; ++e) { o0[e] = 0.f; o1[e] = 0.f; }
        float m = -1e30f, l = 0.f;
        const int kt0 = l0 >= 128 ? 0 : ((128 - l0) >> 5);
        for (int kt = kt0; kt < 5; ++kt) {
            const int lk0 = l0 - 128 + 32 * kt;
            const bf16* kp = QKVb + (size_t)((lk0 + i) * d + r) * INW + C_KA + h * 64 + 8 * hh;
            bf16x8 kf[4];
#pragma unroll
            for (int ks = 0; ks < 4; ++ks) kf[ks] = *(const bf16x8*)(kp + 16 * ks);
            v4u vreg[4];
#pragma unroll
            for (int c = 0; c < 4; ++c) { const int rowk = (lane >> 3) + 8 * c;
                vreg[c] = *(const v4u*)(QKVb + (size_t)((lk0 + rowk) * d + r) * INW + C_VA + h * 64 + 8 * (lane & 7)); }
            f32x16 s;
#pragma unroll
            for (int e = 0; e < 16; ++e) s[e] = 0.f;
#pragma unroll
            for (int ks = 0; ks < 4; ++ks) s = MFMA32(kf[ks], qf[ks], s);
#pragma unroll
            for (int c = 0; c < 4; ++c) { const int rowk = (lane >> 3) + 8 * c; *(LAS v4u*)(vt + rowk * 192 + 16 * (lane & 7)) = vreg[c]; }
            float tm = -1e30f;
#pragma unroll
            for (int e = 0; e < 16; ++e) { const int j = crow(e, hh); const bool bad = (kt == 0 && j < i) || (kt == 4 && j > i); s[e] = bad ? -1e30f : s[e]; tm = fmaxf(tm, s[e]); }
            tm = fmaxf(tm, __shfl_xor(tm, 32));
            const float mn = fmaxf(m, tm), scl = __builtin_amdgcn_exp2f(m - mn);
            m = mn; l *= scl;
#pragma unroll
            for (int e = 0; e < 16; ++e) { o0[e] *= scl; o1[e] *= scl; }
            float psum = 0.f;
#pragma unroll
            for (int e = 0; e < 16; ++e) { s[e] = __builtin_amdgcn_exp2f(s[e] - mn); psum += s[e]; }
            l += psum;
            v4u pw0, pw1;
            pw0.x = cvtpk(s[0], s[1]); pw0.y = cvtpk(s[2], s[3]); pw0.z = cvtpk(s[4], s[5]); pw0.w = cvtpk(s[6], s[7]);
            pw1.x = cvtpk(s[8], s[9]); pw1.y = cvtpk(s[10], s[11]); pw1.z = cvtpk(s[12], s[13]); pw1.w = cvtpk(s[14], s[15]);
            const bf16x8 pf0 = __builtin_bit_cast(bf16x8, pw0), pf1 = __builtin_bit_cast(bf16x8, pw1);
            asm volatile("" ::: "memory");
#pragma unroll
            for (int st = 0; st < 2; ++st) {
                const LAS unsigned char* a0 = vt + (16 * st + 4 * hh + tq) * 192 + (16 * blk + 4 * tp) * 2;
                const s16x4 lo0 = vtr(a0), hi0 = vtr(a0 + 8 * 192), lo1 = vtr(a0 + 64), hi1 = vtr(a0 + 8 * 192 + 64);
                const bf16x8 v0 = __builtin_shufflevector(lo0, hi0, 0, 1, 2, 3, 4, 5, 6, 7), v1 = __builtin_shufflevector(lo1, hi1, 0, 1, 2, 3, 4, 5, 6, 7);
                o0 = MFMA32(v0, st == 0 ? pf0 : pf1, o0);
                o1 = MFMA32(v1, st == 0 ? pf0 : pf1, o1);
            }
            asm volatile("" ::: "memory");
        }
        const float lt = l + __shfl_xor(l, 32), inv = 1.f / lt;
        bf16* op = OPART + ((size_t)b * MP + tok_q) * 512 + h * 64 + 4 * hh;
#pragma unroll
        for (int g = 0; g < 4; ++g) {
            *(uint2*)(op + 8 * g) = make_uint2(cvtpk(o0[4 * g] * inv, o0[4 * g + 1] * inv), cvtpk(o0[4 * g + 2] * inv, o0[4 * g + 3] * inv));
            *(uint2*)(op + 32 + 8 * g) = make_uint2(cvtpk(o1[4 * g] * inv, o1[4 * g + 1] * inv), cvtpk(o1[4 * g + 2] * inv, o1[4 * g + 3] * inv));
        }
        if (hh == 0) ML[((size_t)b * MP + tok_q) * 8 + h] = make_float2(m, lt);
    }
}
__device__ __forceinline__ void attn_combine_phase(const bf16* OPART, const float2* ML, bf16* MIX, int gtid, int NGT) {
    for (int idx = gtid; idx < MP * 64; idx += NGT) {
        const int tok = idx >> 6, h = (idx >> 3) & 7, c = idx & 7;
        const float2 a0 = ML[((size_t)0 * MP + tok) * 8 + h], a1 = ML[((size_t)1 * MP + tok) * 8 + h], a2 = ML[((size_t)2 * MP + tok) * 8 + h];
        const float mx = fmaxf(a0.x, fmaxf(a1.x, a2.x));
        float w0 = a0.y * __builtin_amdgcn_exp2f(a0.x - mx), w1 = a1.y * __builtin_amdgcn_exp2f(a1.x - mx), w2 = a2.y * __builtin_amdgcn_exp2f(a2.x - mx);
        const float iw = 1.f / (w0 + w1 + w2); w0 *= iw; w1 *= iw; w2 *= iw;
        const v4u x0 = *(const v4u*)(OPART + ((size_t)0 * MP + tok) * 512 + h * 64 + 8 * c);
        const v4u x1 = *(const v4u*)(OPART + ((size_t)1 * MP + tok) * 512 + h * 64 + 8 * c);
        const v4u x2 = *(const v4u*)(OPART + ((size_t)2 * MP + tok) * 512 + h * 64 + 8 * c);
        v4u o;
        o.x = cvtpk(w0 * bf_lo(x0.x) + w1 * bf_lo(x1.x) + w2 * bf_lo(x2.x), w0 * bf_hi(x0.x) + w1 * bf_hi(x1.x) + w2 * bf_hi(x2.x));
        o.y = cvtpk(w0 * bf_lo(x0.y) + w1 * bf_lo(x1.y) + w2 * bf_lo(x2.y), w0 * bf_hi(x0.y) + w1 * bf_hi(x1.y) + w2 * bf_hi(x2.y));
        o.z = cvtpk(w0 * bf_lo(x0.z) + w1 * bf_lo(x1.z) + w2 * bf_lo(x2.z), w0 * bf_hi(x0.z) + w1 * bf_hi(x1.z) + w2 * bf_hi(x2.z));
        o.w = cvtpk(w0 * bf_lo(x0.w) + w1 * bf_lo(x1.w) + w2 * bf_lo(x2.w), w0 * bf_hi(x0.w) + w1 * bf_hi(x1.w) + w2 * bf_hi(x2.w));
        *(v4u*)(MIX + (size_t)tok * D + h * 64 + 8 * c) = o;
    }
}
__device__ __forceinline__ void ret_out_mfma_phase(LAS unsigned char* lds, const bf16* QKVb, const bf16* SPT, const float* gnw, bf16* MIX, int tid, int wave, int lane) {
    constexpr int RSV = 272;
    const int grp = wave >> 2, itile = wave & 3;
    LAS unsigned char* vb = lds + grp * (128 * RSV);
    const int i = lane & 31, hh = lane >> 5, i16 = lane & 15, tq = i16 >> 2, tp = i16 & 3, blk = (lane >> 4) & 1;
    for (int it = blockIdx.x; it < 256; it += gridDim.x) {
        const int item = it * 2 + grp, n = item >> 2, h = item & 3;
        const float lg2 = log_g(h) * 1.4426950408889634f;
        {
            const int t4 = tid & 255;
#pragma unroll
            for (int c = 0; c < 8; ++c) { const int e = t4 + 256 * c, rowk = e >> 4, ch = e & 15;
                *(LAS v4u*)(vb + rowk * RSV + 16 * ch) = *(const v4u*)(QKVb + (size_t)(n * 128 + rowk) * INW + C_VR + h * 128 + 8 * ch); }
        }
        __syncthreads();
        const int row_i = n * 128 + 32 * itile + i;
        bf16x8 qf[4];
#pragma unroll
        for (int ks = 0; ks < 4; ++ks) qf[ks] = *(const bf16x8*)(QKVb + (size_t)row_i * INW + C_QR + h * 64 + 16 * ks + 8 * hh);
        f32x16 acc[4];
#pragma unroll
        for (int dt = 0; dt < 4; ++dt) {
#pragma unroll
            for (int e = 0; e < 16; ++e) acc[dt][e] = 0.f;
#pragma unroll
            for (int ks = 0; ks < 4; ++ks) { const bf16x8 a = *(const bf16x8*)(SPT + ((size_t)(n * 4 + h) * 128 + 32 * dt + i) * 64 + 16 * ks + 8 * hh); acc[dt] = MFMA32(a, qf[ks], acc[dt]); }
        }
        const float wh = __builtin_amdgcn_exp2f((float)(32 * itile + i + 1) * lg2);
#pragma unroll
        for (int dt = 0; dt < 4; ++dt)
#pragma unroll
            for (int e = 0; e < 16; ++e) acc[dt][e] *= wh;
        for (int jt = 0; jt <= itile; ++jt) {
            bf16x8 kf[4];
#pragma unroll
            for (int ks = 0; ks < 4; ++ks) kf[ks] = *(const bf16x8*)(QKVb + (size_t)(n * 128 + 32 * jt + i) * INW + C_KR + h * 64 + 16 * ks + 8 * hh);
            f32x16 s;
#pragma unroll
            for (int e = 0; e < 16; ++e) s[e] = 0.f;
#pragma unroll
            for (int ks = 0; ks < 4; ++ks) s = MFMA32(kf[ks], qf[ks], s);
#pragma unroll
            for (int e = 0; e < 16; ++e) { const int dl = 32 * (itile - jt) + i - crow(e, hh); s[e] = dl >= 0 ? s[e] * __builtin_amdgcn_exp2f((float)dl * lg2) : 0.f; }
            v4u pw0, pw1;
            pw0.x = cvtpk(s[0], s[1]); pw0.y = cvtpk(s[2], s[3]); pw0.z = cvtpk(s[4], s[5]); pw0.w = cvtpk(s[6], s[7]);
            pw1.x = cvtpk(s[8], s[9]); pw1.y = cvtpk(s[10], s[11]); pw1.z = cvtpk(s[12], s[13]); pw1.w = cvtpk(s[14], s[15]);
            const bf16x8 pf0 = __builtin_bit_cast(bf16x8, pw0), pf1 = __builtin_bit_cast(bf16x8, pw1);
#pragma unroll
            for (int st = 0; st < 2; ++st) {
                const LAS unsigned char* a0 = vb + (32 * jt + 16 * st + 4 * hh + tq) * RSV + (16 * blk + 4 * tp) * 2;
#pragma unroll
                for (int dt = 0; dt < 4; ++dt) {
                    const s16x4 lo = vtr(a0 + 64 * dt), hi = vtr(a0 + 8 * RSV + 64 * dt);
                    const bf16x8 vf = __builtin_shufflevector(lo, hi, 0, 1, 2, 3, 4, 5, 6, 7);
                    acc[dt] = MFMA32(vf, st == 0 ? pf0 : pf1, acc[dt]);
                }
            }
        }
        float s1 = 0.f;
#pragma unroll
        for (int dt = 0; dt < 4; ++dt)
#pragma unroll
            for (int e = 0; e < 16; ++e) s1 += acc[dt][e];
        s1 += __shfl_xor(s1, 32);
        const float mu = s1 * (1.f / 128.f);
        float s2 = 0.f;
#pragma unroll
        for (int dt = 0; dt < 4; ++dt)
#pragma unroll
            for (int e = 0; e < 16; ++e) { const float dd = acc[dt][e] - mu; s2 += dd * dd; }
        s2 += __shfl_xor(s2, 32);
        const float rstd = 1.f / sqrtf(s2 * (1.f / 128.f) + EPS);
#pragma unroll
        for (int dt = 0; dt < 4; ++dt)
#pragma unroll
            for (int g = 0; g < 4; ++g) {
                const int dv0 = 32 * dt + 8 * g + 4 * hh;
                const uint2 gr = *(const uint2*)(QKVb + (size_t)row_i * INW + C_GR + h * 128 + dv0);
                const float4 gw4 = *(const float4*)(gnw + h * 128 + dv0);
                const float y0 = (acc[dt][4 * g] - mu) * rstd * gw4.x * silu_f(bf_lo(gr.x)), y1 = (acc[dt][4 * g + 1] - mu) * rstd * gw4.y * silu_f(bf_hi(gr.x));
                const float y2 = (acc[dt][4 * g + 2] - mu) * rstd * gw4.z * silu_f(bf_lo(gr.y)), y3 = (acc[dt][4 * g + 3] - mu) * rstd * gw4.w * silu_f(bf_hi(gr.y));
                *(uint2*)(MIX + (size_t)row_i * D + 512 + h * 128 + dv0) = make_uint2(cvtpk(y0, y1), cvtpk(y2, y3));
            }
        __syncthreads();
    }
}
template <int CTRL> __device__ __forceinline__ float dppf(float x) { return __builtin_bit_cast(float, __builtin_amdgcn_mov_dpp(__builtin_bit_cast(int, x), CTRL, 0xf, 0xf, true)); }
__device__ __forceinline__ float row16_sum(float v) { v += dppf<0xB1>(v); v += dppf<0x4E>(v); v += dppf<0x141>(v); v += dppf<0x128>(v); return v; }
constexpr int SA_CH = 15, SA_KPC = 60;
__device__ __forceinline__ void sa_rows(int kk, int b, const float* ck, const float* cv, const float* out, const float*& kr, const float*& vr, int& e) {
    e = kk < 516 ? kk : 528 + 16 * ((kk - 516) >> 2) + ((kk - 516) & 3);
    const int idx = 2051 - e;
    if (idx >= WB) { kr = out + O_KS + (size_t)(b * 4 + idx - WB) * 512; vr = out + O_VS + (size_t)(b * 4 + idx - WB) * 512; }
    else { kr = ck + ((size_t)b * WB + idx) * 512; vr = cv + ((size_t)b * WB + idx) * 512; }
}
__device__ __forceinline__ void attn_sample_phase(const float* QKV, const float* ck, const float* cv, const float* out, float* SPART, float2* SML, int gw, int NGW, int lane) {
    const int l16 = lane & 15, hq = lane >> 4;
    for (int item = gw; item < DBATCH * SA_CH; item += NGW) {
        const int b = item / SA_CH, c = item % SA_CH;
        f32x4 q[4][2], o[4][2]; float m[4][2], l[4][2];
#pragma unroll
        for (int i = 0; i < 4; ++i)
#pragma unroll
            for (int u = 0; u < 2; ++u) {
                q[i][u] = *(const f32x4*)(QKV + (size_t)(MP + b * 4 + i) * INW + C_QA + (4 * u + hq) * 64 + 4 * l16) * QSCALE;
                o[i][u] = (f32x4){0.f, 0.f, 0.f, 0.f}; m[i][u] = -1e30f; l[i][u] = 0.f;
            }
        for (int g = 0; g < SA_KPC / 4; ++g) {
            f32x4 kx[4][2], vx[4][2]; int ee[4];
#pragma unroll
            for (int t = 0; t < 4; ++t) {
                const float *kr, *vr; sa_rows(c * SA_KPC + g * 4 + t, b, ck, cv, out, kr, vr, ee[t]);
                kx[t][0] = *(const f32x4*)(kr + 4 * lane); kx[t][1] = *(const f32x4*)(kr + 256 + 4 * lane);
                vx[t][0] = *(const f32x4*)(vr + 4 * lane); vx[t][1] = *(const f32x4*)(vr + 256 + 4 * lane);
            }
#pragma unroll
            for (int t = 0; t < 4; ++t)
#pragma unroll
                for (int i = 0; i < 4; ++i) {
                    const int dl = ee[t] - 3 + i;
                    const int mult = dl >= 0 ? (int)(dl <= 128) + (int)(((dl & 3) == 0) && dl <= 512) + (int)(((dl & 15) == 0) && dl <= 2048) : 0;
                    if (mult) {
                        const float fm = (float)mult;
#pragma unroll
                        for (int u = 0; u < 2; ++u) {
                            const f32x4 pr = q[i][u] * kx[t][u];
                            const float s = row16_sum((pr[0] + pr[1]) + (pr[2] + pr[3]));
                            const float mn = fmaxf(m[i][u], s), scl = __builtin_amdgcn_exp2f(m[i][u] - mn), p = fm * __builtin_amdgcn_exp2f(s - mn);
                            m[i][u] = mn; l[i][u] = l[i][u] * scl + p; o[i][u] = o[i][u] * scl + vx[t][u] * p;
                        }
                    }
                }
        }
#pragma unroll
        for (int i = 0; i < 4; ++i)
#pragma unroll
            for (int u = 0; u < 2; ++u) {
                const size_t base = ((size_t)(b * SA_CH + c) * 4 + i) * 8 + 4 * u + hq;
                *(f32x4*)(SPART + base * 64 + 4 * l16) = o[i][u];
                if (l16 == 0) SML[base] = make_float2(m[i][u], l[i][u]);
            }
    }
}
__device__ __forceinline__ void attn_sample_merge_phase(const float* SPART, const float2* SML, bf16* MIX, int gw, int NGW, int lane) {
    for (int item = gw; item < DBATCH * 32; item += NGW) {
        const int b = item >> 5, i = (item >> 3) & 3, h = item & 7;
        float2 ml[SA_CH]; float mx = -1e30f;
#pragma unroll
        for (int c = 0; c < SA_CH; ++c) { ml[c] = SML[((size_t)(b * SA_CH + c) * 4 + i) * 8 + h]; mx = fmaxf(mx, ml[c].x); }
        float acc = 0.f, L = 0.f;
#pragma unroll
        for (int c = 0; c < SA_CH; ++c) { const float w = __builtin_amdgcn_exp2f(ml[c].x - mx); L += w * ml[c].y; acc += w * SPART[(((size_t)(b * SA_CH + c) * 4 + i) * 8 + h) * 64 + lane]; }
        MIX[(size_t)(MP + b * 4 + i) * D + h * 64 + lane] = (bf16)f2bf(acc / L);
    }
}
__device__ __forceinline__ void ret_upd_phase(LAS unsigned char* lds, const float* QKV, float* UPD, int tid) {
    LAS float* kc = (LAS float*)lds;
    for (int it = blockIdx.x; it < 512; it += gridDim.x) {
        const int n = it >> 2, h = it & 3;
        const float lg = log_g(h);
        for (int e = tid; e < 128 * 64; e += NTHR) { const int j = e >> 6, dk = e & 63;
            kc[e] = QKV[(size_t)(n * 128 + j) * INW + C_KR + h * 64 + dk] * expf((float)(127 - j) * lg); }
        __syncthreads();
        const int dv = tid & 127, qt = tid >> 7;
        float acc[16];
#pragma unroll
        for (int i = 0; i < 16; ++i) acc[i] = 0.f;
        for (int j = 0; j < 128; ++j) {
            const float vj = QKV[(size_t)(n * 128 + j) * INW + C_VR + h * 128 + dv];
#pragma unroll
            for (int i = 0; i < 16; ++i) acc[i] += kc[j * 64 + qt * 16 + i] * vj;
        }
#pragma unroll
        for (int i = 0; i < 16; i += 4) *(float4*)(UPD + ((size_t)(n * 4 + h) * 128 + dv) * 64 + qt * 16 + i) = make_float4(acc[i], acc[i + 1], acc[i + 2], acc[i + 3]);
        __syncthreads();
    }
}
__device__ __forceinline__ void ret_scan_phase(const float* UPDT, bf16* SPT, float* out, int tid) {
    const int e = blockIdx.x * NTHR + tid;
    if (e < 32768) {
        const int h = e >> 13, dv = (e >> 6) & 127, dk = e & 63;
        const float G = expf(128.f * log_g(h));
        float S = 0.f;
        for (int n = 0; n < 128; ++n) { SPT[(size_t)n * 32768 + e] = (bf16)f2bf(S); S = G * S + UPDT[(size_t)n * 32768 + e]; }
        out[O_SP + h * 8192 + dk * 128 + dv] = S;
    }
}
__device__ __forceinline__ void ret_sample_phase(LAS unsigned char* lds, const float* QKV, const float* state, const float* gnw, bf16* MIX, float* out, int tid) {
    const int grp = tid >> 7, t = tid & 127, dv = t;
    LAS float* qs = (LAS float*)(lds + grp * 4096);
    LAS float* ks = qs + 256;
    LAS float* red = ks + 256;
    for (int it = blockIdx.x; it < 128; it += gridDim.x) {
        const int sub = it * 4 + grp, b = sub >> 2, h = sub & 3;
        const float g = 1.f - exp2f(-5.f - (float)h);
        const float g2 = g * g, g3 = g2 * g, g4 = g2 * g2;
        const int row0 = MP + b * 4;
        for (int e = t; e < 256; e += 128) { const int i = e >> 6, dk = e & 63;
            qs[e] = QKV[(size_t)(row0 + i) * INW + C_QR + h * 64 + dk]; ks[e] = QKV[(size_t)(row0 + i) * INW + C_KR + h * 64 + dk]; }
        __syncthreads();
        float v[4];
#pragma unroll
        for (int i = 0; i < 4; ++i) v[i] = QKV[(size_t)(row0 + i) * INW + C_VR + h * 128 + dv];
        const float* s0p = state + (size_t)(b * 4 + h) * 64 * 128 + dv;
        float* snp = out + O_SS + (size_t)(b * 4 + h) * 64 * 128 + dv;
        float c0 = 0.f, c1 = 0.f, c2 = 0.f, c3 = 0.f;
        for (int dk = 0; dk < 64; ++dk) {
            const float s0 = s0p[dk * 128];
            c0 += qs[dk] * s0; c1 += qs[64 + dk] * s0; c2 += qs[128 + dk] * s0; c3 += qs[192 + dk] * s0;
            snp[dk * 128] = g4 * s0 + g3 * ks[dk] * v[0] + g2 * ks[64 + dk] * v[1] + g * ks[128 + dk] * v[2] + ks[192 + dk] * v[3];
        }
        float d00 = 0.f, d10 = 0.f, d11 = 0.f, d20 = 0.f, d21 = 0.f, d22 = 0.f, d30 = 0.f, d31 = 0.f, d32 = 0.f, d33 = 0.f;
        for (int dk = 0; dk < 64; ++dk) {
            const float q0 = qs[dk], q1 = qs[64 + dk], q2 = qs[128 + dk], q3 = qs[192 + dk];
            const float k0 = ks[dk], k1 = ks[64 + dk], k2 = ks[128 + dk], k3 = ks[192 + dk];
            d00 += q0 * k0; d10 += q1 * k0; d11 += q1 * k1; d20 += q2 * k0; d21 += q2 * k1; d22 += q2 * k2;
            d30 += q3 * k0; d31 += q3 * k1; d32 += q3 * k2; d33 += q3 * k3;
        }
        float o[4];
        o[0] = g * c0 + d00 * v[0];
        o[1] = g2 * c1 + g * d10 * v[0] + d11 * v[1];
        o[2] = g3 * c2 + g2 * d20 * v[0] + g * d21 * v[1] + d22 * v[2];
        o[3] = g4 * c3 + g3 * d30 * v[0] + g2 * d31 * v[1] + g * d32 * v[2] + d33 * v[3];
#pragma unroll
        for (int i = 0; i < 4; ++i) { const float s1 = wave_sum(o[i]); if ((t & 63) == 0) red[i * 2 + (t >> 6)] = s1; }
        __syncthreads();
        float dl[4];
#pragma unroll
        for (int i = 0; i < 4; ++i) { const float mu = (red[i * 2] + red[i * 2 + 1]) * (1.f / 128.f); dl[i] = o[i] - mu; }
#pragma unroll
        for (int i = 0; i < 4; ++i) { const float s2 = wave_sum(dl[i] * dl[i]); if ((t & 63) == 0) red[8 + i * 2 + (t >> 6)] = s2; }
        __syncthreads();
#pragma unroll
        for (int i = 0; i < 4; ++i) {
            const float var = (red[8 + i * 2] + red[8 + i * 2 + 1]) * (1.f / 128.f);
            const float y = dl[i] / sqrtf(var + EPS) * gnw[h * 128 + dv];
            const float gg = QKV[(size_t)(row0 + i) * INW + C_GR + h * 128 + dv];
            MIX[(size_t)(row0 + i) * D + 512 + h * 128 + dv] = (bf16)f2bf(silu_f(gg) * y);
        }
        __syncthreads();
    }
}

struct Args { const float* in[20]; float* out; unsigned char* ws; };
__global__ void __launch_bounds__(NTHR, 2) mk_fwd(Args a) {
    extern __shared__ __attribute__((aligned(16))) unsigned char lds_raw[];
    LAS unsigned char* lds = (LAS unsigned char*)lds_raw;
    volatile LAS unsigned* MISC = (volatile LAS unsigned*)(lds + MISC_OFF);
    const int tid = threadIdx.x, lane = tid & 63, wave = __builtin_amdgcn_readfirstlane(tid >> 6);
    const int G = gridDim.x;
    const int gw = blockIdx.x * NWAVES + wave, NGW = G * NWAVES, gtid = blockIdx.x * NTHR + tid, NGT = G * NTHR;
    unsigned char* ws = a.ws;
    Ptrs P;
    P.xp = a.in[0]; P.xs = a.in[1]; P.ck = a.in[2]; P.cv = a.in[3]; P.st = a.in[4]; P.g1a = a.in[5]; P.g1b = a.in[6]; P.w1g = a.in[7]; P.w1u = a.in[8]; P.w1d = a.in[9];
    P.gma = a.in[10]; P.gmb = a.in[11]; P.win = a.in[12]; P.gnw = a.in[13]; P.wout = a.in[14]; P.g2a = a.in[15]; P.g2b = a.in[16]; P.w2g = a.in[17]; P.w2u = a.in[18]; P.w2d = a.in[19];
    P.out = a.out;
    P.W1GU = (bf16*)(ws + WS_W1GU); P.W1D = (bf16*)(ws + WS_W1D); P.WIN = (bf16*)(ws + WS_WIN); P.WOUT = (bf16*)(ws + WS_WOUT); P.W2GU = (bf16*)(ws + WS_W2GU); P.W2D = (bf16*)(ws + WS_W2D);
    P.XN = (bf16*)(ws + WS_XN); P.H = (bf16*)(ws + WS_H); P.MIX = (bf16*)(ws + WS_MIX);
    P.TAB = (float2*)(ws + WS_TAB); P.Y = (float*)(ws + WS_Y); P.HRES = (float*)(ws + WS_HRES); P.QKV = (float*)(ws + WS_QKV); P.UPD = (float*)(ws + WS_UPD); P.SPT = (bf16*)(ws + WS_SPREV); P.QKVb = (bf16*)(ws + WS_QKVB); P.OPART = (bf16*)(ws + WS_OPART); P.ML = (float2*)(ws + WS_ML); P.SPART = (float*)(ws + WS_SPART); P.SML = (float2*)(ws + WS_SML);
    for (int u = tid; u < (LDS_BYTES - LDSCTL_OFF) / 4; u += NTHR) ((LAS unsigned*)(lds + LDSCTL_OFF))[u] = 0u;
    __syncthreads();
    XcdBarrier bar = xcd_barrier_post((unsigned*)(ws + WS_CTL) + CW_BAR, MISC + 8);

    p0_prologue(P, lds, gw, NGW, wave, lane, gtid, NGT);
    xcd_barrier(bar);
    { pg8::Gemm g{P.XN, P.W1GU, M, 2 * DFF, D}; pg8::StaticOrder S; S.init(M, 2 * DFF, G, (int)blockIdx.x); pg8::EpiSwiglu E{P.H, DFF};
      pg8::gemm_phase<pg8::EpiSwiglu, pg8::StaticOrder, true, true>(lds, g, S, E); }
    xcd_barrier(bar);
    { pg8::Gemm g{P.H, P.W1D, M, D, DFF}; pg8::StaticOrder S; S.init(M, D, G, (int)blockIdx.x); pg8::EpiF32 E{P.Y, D};
      pg8::gemm_phase<pg8::EpiF32, pg8::StaticOrder, true, true>(lds, g, S, E); }
    xcd_barrier(bar);
    norm_res_phase(P.xp, P.xs, P.Y, P.g1b, 0.5f, P.HRES, P.gma, P.XN, gw, NGW, lane);
    xcd_barrier(bar);
    { pg8::Gemm g{P.XN, P.WIN, M, INW, D}; pg8::StaticOrder S; S.init(M, INW, G, (int)blockIdx.x); pg8::EpiF32 E{P.QKV, INW};
      pg8::gemm_phase<pg8::EpiF32, pg8::StaticOrder, true, true>(lds, g, S, E); }
    xcd_barrier(bar);
    rope_phase(P.QKV, P.QKVb, P.TAB, P.out, gw, NGW, lane);
    xcd_barrier(bar);
    ret_upd_phase(lds, P.QKV, P.UPD, tid);
    ret_sample_phase(lds, P.QKV, P.st, P.gnw, P.MIX, P.out, tid);
    attn_sample_phase(P.QKV, P.ck, P.cv, P.out, P.SPART, P.SML, gw, NGW, lane);
    attn_mfma_phase(lds, P.QKVb, P.OPART, P.ML, gw, NGW, wave, lane);
    xcd_barrier(bar);
    ret_scan_phase(P.UPD, P.SPT, P.out, tid);
    attn_combine_phase(P.OPART, P.ML, P.MIX, gtid, NGT);
    attn_sample_merge_phase(P.SPART, P.SML, P.MIX, gw, NGW, lane);
    xcd_barrier(bar);
    ret_out_mfma_phase(lds, P.QKVb, P.SPT, P.gnw, P.MIX, tid, wave, lane);
    xcd_barrier(bar);
    { pg8::Gemm g{P.MIX, P.WOUT, M, D, D}; pg8::StaticOrder S; S.init(M, D, G, (int)blockIdx.x); pg8::EpiF32 E{P.Y, D};
      pg8::gemm_phase<pg8::EpiF32, pg8::StaticOrder, true, true>(lds, g, S, E); }
    xcd_barrier(bar);
    norm_res_phase(P.HRES, P.HRES + (size_t)MP * D, P.Y, P.gmb, 1.0f, P.HRES, P.g2a, P.XN, gw, NGW, lane);
    xcd_barrier(bar);
    { pg8::Gemm g{P.XN, P.W2GU, M, 2 * DFF, D}; pg8::StaticOrder S; S.init(M, 2 * DFF, G, (int)blockIdx.x); pg8::EpiSwiglu E{P.H, DFF};
      pg8::gemm_phase<pg8::EpiSwiglu, pg8::StaticOrder, true, true>(lds, g, S, E); }
    xcd_barrier(bar);
    { pg8::Gemm g{P.H, P.W2D, M, D, DFF}; pg8::StaticOrder S; S.init(M, D, G, (int)blockIdx.x); pg8::EpiF32 E{P.Y, D};
      pg8::gemm_phase<pg8::EpiF32, pg8::StaticOrder, true, true>(lds, g, S, E); }
    xcd_barrier(bar);
    norm_res_phase(P.HRES, P.HRES + (size_t)MP * D, P.Y, P.g2b, 0.5f, P.out + O_Y, nullptr, nullptr, gw, NGW, lane);
}

extern "C" void kernel_launch(void* const* d_in, const int* in_sizes, int n_in, void* d_out, int out_size, void* d_ws, size_t ws_size, hipStream_t stream) {
    static int grid = 0;
    if (grid == 0) {
        if (n_in != 20 || (size_t)out_size != O_END || ws_size < WS_END) { fprintf(stderr, "kernel_launch: unexpected sizes (n_in %d out %d ws %zu)\n", n_in, out_size, ws_size); grid = -1; return; }
        int dev = 0, cus = 0;
        if (hipGetDevice(&dev) != hipSuccess || hipDeviceGetAttribute(&cus, hipDeviceAttributeMultiprocessorCount, dev) != hipSuccess) { grid = -1; return; }
        if (hipFuncSetAttribute((const void*)mk_fwd, hipFuncAttributeMaxDynamicSharedMemorySize, LDS_BYTES) != hipSuccess) { fprintf(stderr, "kernel_launch: hipFuncSetAttribute failed\n"); grid = -1; return; }
        int per_cu = 0;
        if (hipOccupancyMaxActiveBlocksPerMultiprocessor(&per_cu, (const void*)mk_fwd, NTHR, LDS_BYTES) != hipSuccess || per_cu < 1) fprintf(stderr, "kernel_launch: occupancy query says %d\n", per_cu);
        (void)hipGetLastError();
        grid = cus;
    }
    if (grid < 0) return;
    (void)hipMemsetAsync((char*)d_ws + WS_CTL, 0, CTL_ZERO_BYTES, stream);
    Args a{};
    for (int i = 0; i < 20; ++i) a.in[i] = (const float*)d_in[i];
    a.out = (float*)d_out; a.ws = (unsigned char*)d_ws;
    hipLaunchKernelGGL(mk_fwd, dim3(grid), dim3(NTHR), LDS_BYTES, stream, a);
}
```

```cpp
#include <hip/hip_runtime.h>
#include <cstdio>
#include <cstdint>
namespace pg8 {
#define PG8_LAS __attribute__((address_space(3)))
typedef unsigned short bf16_t;
typedef short bf16x8 __attribute__((ext_vector_type(8)));
typedef float f32x4 __attribute__((ext_vector_type(4)));
typedef unsigned u32x4 __attribute__((ext_vector_type(4)));
constexpr int BM = 256, BK = 64, HALF = 128, HTB = HALF * BK * 2  , STAGE_BYTES = 8 * HTB, NXCD = 8, WGM = 8;

__host__ __device__ __forceinline__ int lds_byte(int r, int c) { const int st = (r >> 4) * 2 + (c >> 5), rr = r & 15, cc = c & 31, ob = rr * 64 + cc * 2; return st * 1024 + (ob ^ (((ob >> 9) & 1) << 5)); }
__host__ __device__ __forceinline__ void stage_rc(int b, int& R, int& C) { const int st = b / 1024, sb = b % 1024, swz = sb ^ (((sb >> 9) & 1) << 5); R = (st >> 1) * 16 + swz / 64; C = (st & 1) * 32 + (swz % 64) / 2; }
__host__ __device__ __forceinline__ int perm32(int rho) { const int n = rho >> 4, i = rho & 15; return 8 * (i >> 2) + 4 * n + (i & 3); }

struct Unit { int pm, pn; };
struct Gemm { const bf16_t* A; const bf16_t* Bt; int M, N, K; };

struct StaticOrder {
    int nM, nN, nwg, G, c;
    __host__ __device__ void init(int M, int N, int G_, int c_) { nM = M / BM; nN = N / BM; nwg = nM * nN; G = G_; c = c_; }
    __host__ __device__ bool next(int i, Unit& u) const {
        const long L = (long)i * G + c; if (L >= nwg) return false;
        int wgid = (int)L; { const int q = nwg / NXCD, r = nwg % NXCD, xcd = wgid % NXCD, off = wgid / NXCD; wgid = (xcd < r ? xcd * (q + 1) : r * (q + 1) + (xcd - r) * q) + off; }
        const int nig = WGM * nN, gid = wgid / nig, fm = gid * WGM, gsz = (nM - fm) < WGM ? (nM - fm) : WGM;
        u.pm = fm + ((wgid % nig) % gsz); u.pn = (wgid % nig) / gsz; return true;
    }
    __device__ __forceinline__ void a_ready(const Unit&) const {}
    __device__ __forceinline__ void done(const Unit&) const {}
};

__device__ __forceinline__ unsigned cvt_pk_bf16(float lo, float hi) { unsigned r; asm volatile("v_cvt_pk_bf16_f32 %0, %1, %2" : "=v"(r) : "v"(lo), "v"(hi)); return r; }
typedef float f32x2 __attribute__((ext_vector_type(2)));
__device__ __forceinline__ float silu_fast(float x) { return x * __builtin_amdgcn_rcpf(1.0f + __builtin_amdgcn_exp2f(-1.4426950408889634f * x)); }
struct EpiSwiglu {
    static constexpr bool PERM = true, AFTER_DRAIN = false;
    bf16_t* O; int ldc;
    __device__ __forceinline__ void operator()(const f32x4 (&acc)[2][2][4][2], const Unit& u, int wr, int wc, int fr, int fq) const {
        const int row0 = u.pm * BM + wr * 64 + fr, col0 = u.pn * HALF + wc * 32 + 8 * fq;
#pragma unroll
        for (int ai = 0; ai < 2; ++ai)
#pragma unroll
            for (int m = 0; m < 4; ++m) {
                bf16_t* rowp = O + (size_t)(row0 + ai * HALF + m * 16) * ldc + col0;
                const f32x4 g0 = acc[ai][0][m][0], g1 = acc[ai][0][m][1], u0 = acc[ai][1][m][0], u1 = acc[ai][1][m][1];
                u32x4 w;
                w.x = cvt_pk_bf16(silu_fast(g0[0]) * u0[0], silu_fast(g0[1]) * u0[1]); w.y = cvt_pk_bf16(silu_fast(g0[2]) * u0[2], silu_fast(g0[3]) * u0[3]);
                w.z = cvt_pk_bf16(silu_fast(g1[0]) * u1[0], silu_fast(g1[1]) * u1[1]); w.w = cvt_pk_bf16(silu_fast(g1[2]) * u1[2], silu_fast(g1[3]) * u1[3]);
                *(u32x4*)rowp = w;
            }
    }
};
struct EpiF32 {
    static constexpr bool PERM = false, AFTER_DRAIN = false;
    float* O; int ldc;
    __device__ __forceinline__ void operator()(const f32x4 (&acc)[2][2][4][2], const Unit& u, int wr, int wc, int fr, int fq) const {
        const int row0 = u.pm * BM + wr * 64 + fr, col0 = u.pn * BM + wc * 32 + 4 * fq;
#pragma unroll
        for (int ai = 0; ai < 2; ++ai)
#pragma unroll
            for (int m = 0; m < 4; ++m) {
                float* rowp = O + (size_t)(row0 + ai * HALF + m * 16) * ldc + col0;
#pragma unroll
                for (int bj = 0; bj < 2; ++bj)
#pragma unroll
                    for (int n = 0; n < 2; ++n) *(f32x4*)(rowp + bj * HALF + n * 16) = acc[ai][bj][m][n];
            }
    }
};
template <class Epi, class Sched, bool ALIGN_EPI = false, bool SP2 = false>
__device__ __forceinline__ void gemm_phase(PG8_LAS unsigned char* lds, const Gemm g, const Sched& S, const Epi& E) {
    const int tid = threadIdx.x, wid = __builtin_amdgcn_readfirstlane(tid >> 6), lane = tid & 63, wr = wid >> 2, wc = wid & 3, fr = lane & 15, fq = lane >> 4;
    const int K = g.K, nt = K / BK;
    unsigned voffA[2], voffB[2];
#pragma unroll
    for (int i = 0; i < 2; ++i) { int R, C; stage_rc(tid * 16 + i * 8192, R, C); const int Rb = Epi::PERM ? ((R & ~31) + perm32(R & 31)) : R;
        voffA[i] = (unsigned)(R * K + C) * 2u; voffB[i] = (unsigned)(Rb * K + C) * 2u; }
    const size_t kstep = (size_t)(BK * 2);
    const size_t hstep = (size_t)HALF * K * 2;
    const size_t tstep = 2 * hstep;
    const unsigned ldsw = (unsigned)wid * 1024u;
    const int aoff = lds_byte(wr * 64 + fr, fq * 8), boff = lds_byte(wc * 32 + fr, fq * 8);
#define PG8_SA(b, h) (((b) * 2 + (h)) * HTB)
#define PG8_SB(b, h) ((4 + (b) * 2 + (h)) * HTB)
#define PG8_STAGE(bufoff, gbase, voff) do { _Pragma("unroll") for (int _i = 0; _i < 2; ++_i) \
        __builtin_amdgcn_global_load_lds((const unsigned*)((const char*)(gbase) + (voff)[_i]), (PG8_LAS unsigned*)(lds + (bufoff) + ldsw + _i * 8192), 16, 0, 0); } while (0)
#define PG8_LDA(dst, b, h) do { _Pragma("unroll") for (int m = 0; m < 4; ++m) _Pragma("unroll") for (int k = 0; k < 2; ++k) dst[m][k] = *(const PG8_LAS bf16x8*)(lds + PG8_SA(b, h) + aoff + m * 2048 + k * 1024); } while (0)
#define PG8_LDB(dst, b, h) do { _Pragma("unroll") for (int n = 0; n < 2; ++n) _Pragma("unroll") for (int k = 0; k < 2; ++k) dst[n][k] = *(const PG8_LAS bf16x8*)(lds + PG8_SB(b, h) + boff + n * 2048 + k * 1024); } while (0)
#define PG8_MMA(ai, bj, At, Bt) do { __builtin_amdgcn_s_setprio(1); _Pragma("unroll") for (int m = 0; m < 4; ++m) _Pragma("unroll") for (int n = 0; n < 2; ++n) _Pragma("unroll") for (int k = 0; k < 2; ++k) \
        acc[ai][bj][m][n] = __builtin_amdgcn_mfma_f32_16x16x32_bf16(Bt[n][k], At[m][k], acc[ai][bj][m][n], 0, 0, 0); __builtin_amdgcn_s_setprio(0); } while (0)
#define PG8_WAIT_V(n) asm volatile("s_waitcnt vmcnt(" #n ")" ::: "memory")
#define PG8_WAIT_L(n) asm volatile("s_waitcnt lgkmcnt(" #n ")" ::: "memory")
#define PG8_BAR __builtin_amdgcn_s_barrier()
#define PG8_SCHED __builtin_amdgcn_sched_barrier(0)
    Unit cur, nxt; int ui = 0;
    if (!S.next(0, cur)) return;
    f32x4 acc[2][2][4][2];
#pragma unroll
    for (int a = 0; a < 2; ++a)
#pragma unroll
        for (int b = 0; b < 2; ++b)
#pragma unroll
            for (int m = 0; m < 4; ++m)
#pragma unroll
                for (int n = 0; n < 2; ++n) acc[a][b][m][n] = (f32x4){0.f, 0.f, 0.f, 0.f};
    bf16x8 At[4][2], B0[2][2], B1[2][2];
    const char* cA = (const char*)g.A + (size_t)cur.pm * tstep; const char* cB = (const char*)g.Bt + (size_t)cur.pn * tstep;
    S.a_ready(cur);
    if constexpr (SP2) {
        PG8_STAGE(PG8_SB(0, 0), cB, voffB); PG8_STAGE(PG8_SB(0, 1), cB + hstep, voffB); PG8_STAGE(PG8_SA(0, 0), cA, voffA); PG8_STAGE(PG8_SA(0, 1), cA + hstep, voffA);
        if (wr == 1) PG8_BAR;
        PG8_WAIT_V(2); PG8_BAR;
        PG8_STAGE(PG8_SB(1, 0), cB + kstep, voffB); PG8_STAGE(PG8_SA(1, 0), cA + kstep, voffA); PG8_STAGE(PG8_SB(1, 1), cB + hstep + kstep, voffB);
        PG8_WAIT_V(6); PG8_BAR;
    } else {
        PG8_STAGE(PG8_SB(0, 0), cB, voffB); PG8_STAGE(PG8_SA(0, 0), cA, voffA); PG8_STAGE(PG8_SB(0, 1), cB + hstep, voffB); PG8_STAGE(PG8_SA(0, 1), cA + hstep, voffA);
        if (wr == 1) PG8_BAR;
        PG8_WAIT_V(4); PG8_BAR;
        PG8_STAGE(PG8_SB(1, 0), cB + kstep, voffB); PG8_STAGE(PG8_SA(1, 0), cA + kstep, voffA); PG8_STAGE(PG8_SB(1, 1), cB + hstep + kstep, voffB);
        PG8_WAIT_V(6); PG8_BAR;
    }
    for (;;) {
        const bool has_next = S.next(ui + 1, nxt);
        const char* nA = has_next ? (const char*)g.A + (size_t)nxt.pm * tstep : cA; const char* nB = has_next ? (const char*)g.Bt + (size_t)nxt.pn * tstep : cB;
        for (int t = 0; t < nt; t += 2) {
            const bool last = (t == nt - 2);
            const char* a1 = cA + (size_t)(t + 1) * kstep;
            const char* a2 = last ? nA : cA + (size_t)(t + 2) * kstep; const char* b2 = last ? nB : cB + (size_t)(t + 2) * kstep;
            const char* a3 = a2 + kstep; const char* b3 = b2 + kstep;
            if (last && has_next) S.a_ready(nxt);
            if constexpr (SP2) {
            PG8_LDB(B0, 0, 0); PG8_LDB(B1, 0, 1); PG8_SCHED; PG8_LDA(At, 0, 0); PG8_STAGE(PG8_SA(1, 1), a1 + hstep, voffA);
            PG8_WAIT_V(8); PG8_WAIT_L(0); PG8_BAR; PG8_MMA(0, 0, At, B0); PG8_MMA(0, 1, At, B1); PG8_BAR; PG8_SCHED;
            PG8_LDA(At, 0, 1); PG8_STAGE(PG8_SB(0, 0), b2, voffB); PG8_STAGE(PG8_SB(0, 1), b2 + hstep, voffB); PG8_STAGE(PG8_SA(0, 0), a2, voffA);
            PG8_WAIT_V(8); PG8_WAIT_L(0); PG8_BAR; PG8_MMA(1, 0, At, B0); PG8_MMA(1, 1, At, B1); PG8_BAR; PG8_SCHED;
            PG8_LDB(B0, 1, 0); PG8_LDB(B1, 1, 1); PG8_SCHED; PG8_LDA(At, 1, 0); PG8_STAGE(PG8_SA(0, 1), a2 + hstep, voffA);
            PG8_WAIT_V(8); PG8_WAIT_L(0); PG8_BAR; PG8_MMA(0, 0, At, B0); PG8_MMA(0, 1, At, B1); PG8_BAR; PG8_SCHED;
            PG8_LDA(At, 1, 1); PG8_STAGE(PG8_SB(1, 0), b3, voffB); PG8_STAGE(PG8_SB(1, 1), b3 + hstep, voffB); PG8_STAGE(PG8_SA(1, 0), a3, voffA);
            PG8_WAIT_V(8); PG8_WAIT_L(0); PG8_BAR; PG8_MMA(1, 0, At, B0); PG8_MMA(1, 1, At, B1); PG8_BAR; PG8_SCHED;
            } else {
            PG8_LDB(B0, 0, 0); PG8_SCHED; PG8_LDA(At, 0, 0); PG8_STAGE(PG8_SA(1, 1), a1 + hstep, voffA);
            PG8_WAIT_L(8); PG8_BAR; PG8_WAIT_L(0); PG8_MMA(0, 0, At, B0); PG8_BAR; PG8_SCHED;
            PG8_LDB(B1, 0, 1); PG8_STAGE(PG8_SB(0, 0), b2, voffB);
            PG8_BAR; PG8_WAIT_L(0); PG8_MMA(0, 1, At, B1); PG8_BAR;
            PG8_LDA(At, 0, 1); PG8_STAGE(PG8_SA(0, 0), a2, voffA);
            PG8_BAR; PG8_WAIT_L(0); PG8_MMA(1, 0, At, B0); PG8_BAR; PG8_SCHED;
            PG8_STAGE(PG8_SB(0, 1), b2 + hstep, voffB);
            PG8_WAIT_V(6); PG8_BAR; PG8_MMA(1, 1, At, B1); PG8_BAR;
            PG8_LDB(B0, 1, 0); PG8_SCHED; PG8_LDA(At, 1, 0); PG8_STAGE(PG8_SA(0, 1), a2 + hstep, voffA);
            PG8_WAIT_L(8); PG8_BAR; PG8_WAIT_L(0); PG8_MMA(0, 0, At, B0); PG8_BAR; PG8_SCHED;
            PG8_LDB(B1, 1, 1); PG8_STAGE(PG8_SB(1, 0), b3, voffB);
            PG8_BAR; PG8_WAIT_L(0); PG8_MMA(0, 1, At, B1); PG8_BAR;
            PG8_LDA(At, 1, 1); PG8_STAGE(PG8_SA(1, 0), a3, voffA);
            PG8_BAR; PG8_WAIT_L(0); PG8_MMA(1, 0, At, B0); PG8_BAR; PG8_SCHED;
            PG8_STAGE(PG8_SB(1, 1), b3 + hstep, voffB);
            PG8_WAIT_V(6); PG8_BAR; PG8_MMA(1, 1, At, B1); PG8_BAR;
            }
        }
        if constexpr (ALIGN_EPI) { if (wr == 0) PG8_BAR; }
        if constexpr (!Epi::AFTER_DRAIN) { E(acc, cur, wr, wc, fr, fq); S.done(cur); }
        if (!has_next) break;
#pragma unroll
        for (int a = 0; a < 2; ++a)
#pragma unroll
            for (int b = 0; b < 2; ++b)
#pragma unroll
                for (int m = 0; m < 4; ++m)
#pragma unroll
                    for (int n = 0; n < 2; ++n) acc[a][b][m][n] = (f32x4){0.f, 0.f, 0.f, 0.f};
        cur = nxt; cA = nA; cB = nB; ++ui;
        if constexpr (ALIGN_EPI) { if (wr == 1) PG8_BAR; }
    }
    PG8_WAIT_V(0);
    if constexpr (!ALIGN_EPI) { if (wr == 0) PG8_BAR; }
    PG8_BAR;
    if constexpr (Epi::AFTER_DRAIN) { E.fused(acc, cur, wr, wc, fr, fq, lds, wid, lane); S.done(cur); }
#undef PG8_SA
#undef PG8_SB
#undef PG8_STAGE
#undef PG8_LDA
#undef PG8_LDB
#undef PG8_MMA
#undef PG8_WAIT_V
#undef PG8_WAIT_L
#undef PG8_BAR
#undef PG8_SCHED
}
}
#define GAS __attribute__((address_space(1)))
#define LAS __attribute__((address_space(3)))
typedef unsigned short bf16;
typedef unsigned v4u __attribute__((ext_vector_type(4)));
typedef float f32x4 __attribute__((ext_vector_type(4)));
typedef short bf16x8 __attribute__((ext_vector_type(8)));
typedef GAS unsigned gu32;
typedef GAS unsigned long long gu64;
#define RLX_AGENT __ATOMIC_RELAXED, __HIP_MEMORY_SCOPE_AGENT
#define LDS_WAIT() asm volatile("s_waitcnt lgkmcnt(0)" ::: "memory")
#define VM_WAIT() asm volatile("s_waitcnt vmcnt(0)" ::: "memory")
__device__ __forceinline__ unsigned long long rt() { return __builtin_amdgcn_s_memrealtime(); }
__device__ __forceinline__ unsigned f2bf(float f) { unsigned u = __builtin_bit_cast(unsigned, f); return (u + 0x7fffu + ((u >> 16) & 1u)) >> 16; }
__device__ __forceinline__ unsigned pk2(float lo, float hi) { return f2bf(lo) | (f2bf(hi) << 16); }
#define XB_TMO      128
#define XB_XCNT(j)  (256  + 64 * (j))
#define XB_XSUB(j)  (1280 + 64 * (j))
#define XB_XGEN(j)  (2304 + 64 * (j))
#define XB_TOP      3328
#define XB_TOPGEN   3392
#define XCD_BAR_WORDS 3456
#define XB_SPIN_CAP (1u << 18)

__device__ __forceinline__ unsigned xb_ld(unsigned* p)              { return __hip_atomic_load(p, __ATOMIC_RELAXED, __HIP_MEMORY_SCOPE_AGENT); }
__device__ __forceinline__ unsigned xb_add(unsigned* p, unsigned v) { return __hip_atomic_fetch_add(p, v, __ATOMIC_RELAXED, __HIP_MEMORY_SCOPE_AGENT); }
__device__ __forceinline__ unsigned xb_xcc_id() { return (unsigned)__builtin_amdgcn_s_getreg((3 << 11) | 20) & 0xFu; }
#define XB_SPIN(cond, bar) do { unsigned _sp = 0; while (cond) { __builtin_amdgcn_s_sleep(1); \
    if ((++_sp & 255u) == 0u) { if (xb_ld(&(bar)[XB_TMO])) break; if (_sp > XB_SPIN_CAP) { atomicAdd(&(bar)[XB_TMO], 1u); break; } } } } while (0)

struct XcdBarrier {
    unsigned* bar; unsigned x;
    volatile LAS unsigned* st;
};

__device__ __forceinline__ XcdBarrier xcd_barrier_post(unsigned* bar, volatile LAS unsigned* st) {
    XcdBarrier b; b.bar = bar; b.x = xb_xcc_id(); b.st = st;
    if (threadIdx.x == 0) (void)xb_add(&bar[XB_XCNT(b.x)], 1u);
    return b;
}
__device__ __forceinline__ void xcd_barrier_complete(unsigned* bar, unsigned x, unsigned& nloc, unsigned& nx) {
    const unsigned G = gridDim.x * gridDim.y * gridDim.z;
    unsigned sum, cnt, mine, sp = 0u;
    for (;;) {
        sum = 0u; cnt = 0u; mine = 0u;
#pragma unroll
        for (unsigned j = 0; j < 16; ++j) { const unsigned c = xb_ld(&bar[XB_XCNT(j)]); sum += c; cnt += (c > 0u) ? 1u : 0u; mine = (j == x) ? c : mine; }
        if (sum == G) break;
        __builtin_amdgcn_s_sleep(1);
        if ((++sp & 255u) == 0u) { if (xb_ld(&bar[XB_TMO])) break; if (sp > XB_SPIN_CAP) { atomicAdd(&bar[XB_TMO], 1u); break; } }
    }
    nloc = mine > 0u ? mine : 1u; nx = cnt > 0u ? cnt : 1u;
}

__device__ __forceinline__ void xcd_barrier(const XcdBarrier& b) {
    asm volatile("s_waitcnt vmcnt(0)" ::: "memory");
    __syncthreads();
    if (threadIdx.x == 0) {
        unsigned* bar = b.bar;
        __builtin_amdgcn_s_waitcnt(0);
        unsigned nloc = b.st[0], nx = b.st[1];
        if (nloc == 0u) { xcd_barrier_complete(bar, b.x, nloc, nx); b.st[0] = nloc; b.st[1] = nx; }
        const unsigned old = xb_add(&bar[XB_XSUB(b.x)], 1u);
        const unsigned gen = old / nloc;
        if (old + 1u == (gen + 1u) * nloc) {
            __builtin_amdgcn_fence(__ATOMIC_RELEASE, "agent");
            asm volatile("s_waitcnt vmcnt(0)" ::: "memory");
            const unsigned og = xb_add(&bar[XB_TOP], 1u);
            const unsigned tg = og / nx;
            if (og + 1u == (tg + 1u) * nx) xb_add(&bar[XB_TOPGEN], 1u);
            else XB_SPIN(xb_ld(&bar[XB_TOPGEN]) == tg, bar);
            __builtin_amdgcn_fence(__ATOMIC_ACQUIRE, "agent");
            xb_add(&bar[XB_XGEN(b.x)], 1u);
            asm volatile("s_waitcnt vmcnt(0)" ::: "memory");
        } else {
            XB_SPIN(xb_ld(&bar[XB_XGEN(b.x)]) == gen, bar);
            __builtin_amdgcn_fence(__ATOMIC_ACQUIRE, "agent");
            asm volatile("s_waitcnt vmcnt(0)" ::: "memory");
        }
    }
    __syncthreads();
}
constexpr int NWAVES = 8, NTHR = 512;
constexpr int D = 1024, SEQ = 16384, DBATCH = 128, MP = SEQ, MS = 512, M = MP + MS;
constexpr int DFF = 2816, INW = 3072, PAST = 8192, WB = 2048, KEEP = 2048, NH = 8;
constexpr float EPS = 1e-6f;
constexpr int C_QA = 0, C_KA = 512, C_VA = 1024, C_QR = 1536, C_KR = 1792, C_VR = 2048, C_GR = 2560;
constexpr size_t O_Y = 0, O_KP = (size_t)M * D, O_VP = O_KP + (size_t)KEEP * 512, O_SP = O_VP + (size_t)KEEP * 512,
                 O_KS = O_SP + 32768, O_VS = O_KS + (size_t)MS * 512, O_SS = O_VS + (size_t)MS * 512, O_END = O_SS + (size_t)DBATCH * 32768;
constexpr size_t MiB = 1u << 20;
constexpr size_t WS_CTL = 0, CTL_ZERO_BYTES = 1 * MiB;
constexpr size_t WS_W1GU = 1 * MiB, WS_W1D = 12 * MiB, WS_WIN = 18 * MiB, WS_WOUT = 24 * MiB, WS_W2GU = 26 * MiB, WS_W2D = 37 * MiB, WS_TAB = 43 * MiB;
constexpr size_t WS_XN = 48 * MiB, WS_H = 81 * MiB, WS_Y = 172 * MiB, WS_HRES = 238 * MiB, WS_QKV = 304 * MiB, WS_MIX = 502 * MiB, WS_UPD = 535 * MiB, WS_SPREV = 551 * MiB, WS_QKVB = 567 * MiB, WS_OPART = 667 * MiB, WS_ML = 716 * MiB, WS_SPART = 720 * MiB, WS_SML = 736 * MiB, WS_END = 737 * MiB;
constexpr int CW_BAR = 4096;
constexpr int RING_BYTES = 131072, LDSCTL_OFF = RING_BYTES, MISC_OFF = LDSCTL_OFF + 320, LDS_BYTES = 147456;

__constant__ float INVF[40] = {
    1.f, 0.193922743f, 0.0376060307f, 0.00729266461f, 0.00141421356f, 0.000274248188f, 5.3182961e-05f, 1.03133862e-05f,
    1.f, 0.749894261f, 0.562341332f, 0.421696514f, 0.316227764f, 0.237137377f, 0.177827939f, 0.133352131f, 0.100000001f, 0.0749894157f,
    0.0562341325f, 0.0421696529f, 0.0316227749f, 0.0237137377f, 0.0177827943f, 0.0133352149f, 0.00999999978f, 0.00749894185f,
    0.00562341325f, 0.00421696482f, 0.00316227763f, 0.00237137359f, 0.00177827943f, 0.00133352145f, 0.00100000005f, 0.000749894243f,
    0.000562341302f, 0.000421696517f, 0.000316227757f, 0.00023713737f, 0.00017782794f, 0.00013335215f};
__device__ __forceinline__ float log_g(int h) { return h == 0 ? -0.0317486983145803f : h == 1 ? -0.015748356968139168f : h == 2 ? -0.007843177461025893f : -0.003913899321136329f; }
__device__ __forceinline__ float wave_sum(float v) {
#pragma unroll
    for (int o = 32; o >= 1; o >>= 1) v += __shfl_xor(v, o);
    return v;
}
__device__ __forceinline__ float wave_max(float v) {
#pragma unroll
    for (int o = 32; o >= 1; o >>= 1) v = fmaxf(v, __shfl_xor(v, o));
    return v;
}
__device__ __forceinline__ float silu_f(float x) { return x / (1.f + expf(-x)); }

__device__ __forceinline__ void tr_item(const float* W, int K, int N, bf16* WT, int mode, LAS float* scr, int item, int lane) {
    const int nblk = N / 32, kb = item / nblk, nb = item % nblk, k0 = 64 * kb, n0 = 32 * nb;
    const int rbase = mode == 0 ? n0 : (256 * (n0 >> 7) + (n0 & 127) + (mode == 2 ? 128 : 0));
#pragma unroll 8
    for (int i = 0; i < 32; ++i) { const int kk = 2 * i + (lane >> 5); scr[kk * 33 + (lane & 31)] = W[(size_t)(k0 + kk) * N + n0 + (lane & 31)]; }
    LDS_WAIT(); asm volatile("" ::: "memory");
    const int c = lane & 7;
#pragma unroll
    for (int j = 0; j < 4; ++j) { const int n = (lane >> 3) + 8 * j; const LAS float* s = scr + (8 * c) * 33 + n;
        v4u o; o.x = pk2(s[0 * 33], s[1 * 33]); o.y = pk2(s[2 * 33], s[3 * 33]); o.z = pk2(s[4 * 33], s[5 * 33]); o.w = pk2(s[6 * 33], s[7 * 33]);
        *(GAS v4u*)(WT + (size_t)(rbase + n) * K + k0 + 8 * c) = o; }
    LDS_WAIT(); asm volatile("" ::: "memory");
}
struct Ptrs {
    const float *xp, *xs, *ck, *cv, *st, *g1a, *g1b, *w1g, *w1u, *w1d, *gma, *gmb, *win, *gnw, *wout, *g2a, *g2b, *w2g, *w2u, *w2d;
    float* out;
    bf16 *W1GU, *W1D, *WIN, *WOUT, *W2GU, *W2D, *XN, *H, *MIX;
    float2* TAB; float *Y, *HRES, *QKV, *UPD; bf16 *SPT, *QKVb, *OPART; float2 *ML, *SML; float* SPART;
};
__device__ __forceinline__ void p0_prologue(const Ptrs& P, LAS unsigned char* lds, int gw, int NGW, int wave, int lane, int gtid, int NGT) {
    LAS float* scr = (LAS float*)(lds + wave * 16384);
    constexpr int I_GU = 16 * 88, I_D = 44 * 32, I_IN = 16 * 96, I_OUT = 16 * 32;
    constexpr int NITEMS = 6 * I_GU + I_IN + I_OUT;
    static_assert(I_D == I_GU, "items");
    for (int it = gw; it < NITEMS; it += NGW) {
        int r = it;
        if (r < I_GU) { tr_item(P.w1g, D, DFF, P.W1GU, 1, scr, r, lane); continue; } r -= I_GU;
        if (r < I_GU) { tr_item(P.w1u, D, DFF, P.W1GU, 2, scr, r, lane); continue; } r -= I_GU;
        if (r < I_D) { tr_item(P.w1d, DFF, D, P.W1D, 0, scr, r, lane); continue; } r -= I_D;
        if (r < I_GU) { tr_item(P.w2g, D, DFF, P.W2GU, 1, scr, r, lane); continue; } r -= I_GU;
        if (r < I_GU) { tr_item(P.w2u, D, DFF, P.W2GU, 2, scr, r, lane); continue; } r -= I_GU;
        if (r < I_D) { tr_item(P.w2d, DFF, D, P.W2D, 0, scr, r, lane); continue; } r -= I_D;
        if (r < I_IN) { tr_item(P.win, D, INW, P.WIN, 0, scr, r, lane); continue; } r -= I_IN;
        tr_item(P.wout, D, D, P.WOUT, 0, scr, r, lane);
    }
    for (int idx = gtid; idx < SEQ * 40; idx += NGT) {
        const int pos = idx / 40, f = idx % 40;
        const float ang = (float)pos * INVF[f];
        const double rev = (double)ang * 0.15915494309189535;
        const float fr = (float)(rev - rint(rev));
        P.TAB[idx] = make_float2(__builtin_amdgcn_cosf(fr), __builtin_amdgcn_sinf(fr));
    }
    for (int r = gw; r < M; r += NGW) {
        const float4* x = (const float4*)(r < MP ? P.xp + (size_t)r * D : P.xs + (size_t)(r - MP) * D);
        float4 v[4]; float ss = 0.f;
#pragma unroll
        for (int j = 0; j < 4; ++j) { v[j] = x[lane + 64 * j]; ss += v[j].x * v[j].x + v[j].y * v[j].y + v[j].z * v[j].z + v[j].w * v[j].w; }
        const float rstd = 1.f / sqrtf(wave_sum(ss) * (1.f / D) + EPS);
        uint2* o = (uint2*)(P.XN + (size_t)r * D);
#pragma unroll
        for (int j = 0; j < 4; ++j) { const float4 gg = ((const float4*)P.g1a)[lane + 64 * j];
            o[lane + 64 * j] = make_uint2(pk2(v[j].x * rstd * gg.x, v[j].y * rstd * gg.y), pk2(v[j].z * rstd * gg.z, v[j].w * rstd * gg.w)); }
    }
}
__device__ __forceinline__ void norm_res_phase(const float* resA, const float* resB, const float* Y, const float* gpost, float scale, float* hout, const float* gnext, bf16* XN, int gw, int NGW, int lane) {
    for (int r = gw; r < M; r += NGW) {
        const float4* x = (const float4*)(r < MP ? resA + (size_t)r * D : resB + (size_t)(r - MP) * D);
        const float4* y = (const float4*)(Y + (size_t)r * D);
        float4 v[4], hv[4]; float ss = 0.f;
#pragma unroll
        for (int j = 0; j < 4; ++j) { v[j] = y[lane + 64 * j]; hv[j] = x[lane + 64 * j]; ss += v[j].x * v[j].x + v[j].y * v[j].y + v[j].z * v[j].z + v[j].w * v[j].w; }
        const float rstd = scale / sqrtf(wave_sum(ss) * (1.f / D) + EPS);
        float s2 = 0.f;
#pragma unroll
        for (int j = 0; j < 4; ++j) { const float4 gg = ((const float4*)gpost)[lane + 64 * j];
            hv[j].x += v[j].x * rstd * gg.x; hv[j].y += v[j].y * rstd * gg.y; hv[j].z += v[j].z * rstd * gg.z; hv[j].w += v[j].w * rstd * gg.w;
            s2 += hv[j].x * hv[j].x + hv[j].y * hv[j].y + hv[j].z * hv[j].z + hv[j].w * hv[j].w; }
        float4* ho = (float4*)(hout + (size_t)r * D);
#pragma unroll
        for (int j = 0; j < 4; ++j) ho[lane + 64 * j] = hv[j];
        if (gnext) {
            const float r2 = 1.f / sqrtf(wave_sum(s2) * (1.f / D) + EPS);
            uint2* o = (uint2*)(XN + (size_t)r * D);
#pragma unroll
            for (int j = 0; j < 4; ++j) { const float4 gg = ((const float4*)gnext)[lane + 64 * j];
                o[lane + 64 * j] = make_uint2(pk2(hv[j].x * r2 * gg.x, hv[j].y * r2 * gg.y), pk2(hv[j].z * r2 * gg.z, hv[j].w * r2 * gg.w)); }
        }
    }
}
typedef float f32x16 __attribute__((ext_vector_type(16)));
typedef short s16x4 __attribute__((ext_vector_type(4)));
typedef float f32x2_t __attribute__((ext_vector_type(2)));
typedef __bf16 bf16x2_t __attribute__((ext_vector_type(2)));
__device__ __forceinline__ unsigned cvtpk(float lo, float hi) { f32x2_t v = {lo, hi}; bf16x2_t b = __builtin_convertvector(v, bf16x2_t); return __builtin_bit_cast(unsigned, b); }
__device__ __forceinline__ s16x4 vtr(const LAS unsigned char* p) { return __builtin_bit_cast(s16x4, __builtin_amdgcn_ds_read_tr16_b64_v4i16((LAS s16x4*)p)); }
#define MFMA32(a, b, c) __builtin_amdgcn_mfma_f32_32x32x16_bf16((a), (b), (c), 0, 0, 0)
__device__ __forceinline__ int crow(int reg, int hh) { return (reg & 3) + 8 * (reg >> 2) + 4 * hh; }
__device__ __forceinline__ float bf_lo(unsigned u) { return __builtin_bit_cast(float, u << 16); }
__device__ __forceinline__ float bf_hi(unsigned u) { return __builtin_bit_cast(float, u & 0xffff0000u); }
constexpr float QSCALE = 0.125f * 1.4426950408889634f;

__device__ __forceinline__ void rope_phase(float* QKV, bf16* QKVb, const float2* tab, float* out, int gw, int NGW, int lane) {
    for (int r = gw; r < M; r += NGW) {
        const int pos = r < MP ? r : PAST + ((r - MP) & 3);
        float* row = QKV + (size_t)r * INW;
        bf16* rowb = QKVb + (size_t)r * INW;
        float *ko = nullptr, *vo = nullptr;
        if (r >= MP) { ko = out + O_KS + (size_t)(r - MP) * 512; vo = out + O_VS + (size_t)(r - MP) * 512; }
        else if (r >= MP - KEEP) { ko = out + O_KP + (size_t)(r - (MP - KEEP)) * 512; vo = out + O_VP + (size_t)(r - (MP - KEEP)) * 512; }
        {
            const int s = lane >> 5, hd = (lane >> 2) & 7, qd = lane & 3, base = s * 512 + hd * 64 + qd * 16;
            float v[16];
#pragma unroll
            for (int c = 0; c < 4; ++c) { const float4 t = *(const float4*)(row + base + 4 * c); v[4 * c] = t.x; v[4 * c + 1] = t.y; v[4 * c + 2] = t.z; v[4 * c + 3] = t.w; }
            if (qd == 0) {
#pragma unroll
                for (int e = 0; e < 8; ++e) { const float2 cs = tab[pos * 40 + e]; const float x1 = v[e], x2 = v[8 + e]; v[e] = x1 * cs.x - x2 * cs.y; v[8 + e] = x2 * cs.x + x1 * cs.y; }
#pragma unroll
                for (int c = 0; c < 4; ++c) *(float4*)(row + base + 4 * c) = make_float4(v[4 * c], v[4 * c + 1], v[4 * c + 2], v[4 * c + 3]);
            }
            if (s == 1 && ko) {
#pragma unroll
                for (int c = 0; c < 4; ++c) *(float4*)(ko + hd * 64 + qd * 16 + 4 * c) = make_float4(v[4 * c], v[4 * c + 1], v[4 * c + 2], v[4 * c + 3]);
            }
            const float sc = s == 0 ? QSCALE : 1.f;
            v4u w0, w1;
            w0.x = cvtpk(v[0] * sc, v[1] * sc); w0.y = cvtpk(v[2] * sc, v[3] * sc); w0.z = cvtpk(v[4] * sc, v[5] * sc); w0.w = cvtpk(v[6] * sc, v[7] * sc);
            w1.x = cvtpk(v[8] * sc, v[9] * sc); w1.y = cvtpk(v[10] * sc, v[11] * sc); w1.z = cvtpk(v[12] * sc, v[13] * sc); w1.w = cvtpk(v[14] * sc, v[15] * sc);
            *(v4u*)(rowb + base) = w0; *(v4u*)(rowb + base + 8) = w1;
        }
#pragma unroll
        for (int t = 0; t < 3; ++t) {
            const int base = (t == 0 ? C_VA : t == 1 ? C_VR : C_GR) + 8 * lane;
            const float4 a = *(const float4*)(row + base), b = *(const float4*)(row + base + 4);
            v4u w; w.x = cvtpk(a.x, a.y); w.y = cvtpk(a.z, a.w); w.z = cvtpk(b.x, b.y); w.w = cvtpk(b.z, b.w);
            *(v4u*)(rowb + base) = w;
            if (t == 0 && vo) { *(float4*)(vo + 8 * lane) = a; *(float4*)(vo + 8 * lane + 4) = b; }
        }
        {
            const int s = lane >> 5, h = (lane >> 3) & 3, ig = lane & 7, base = C_QR + s * 256 + h * 64;
            const float4 a = *(const float4*)(row + base + 4 * ig), b = *(const float4*)(row + base + 32 + 4 * ig);
            const float sc = s ? 0.125f : 1.f;
            const float2 c0 = tab[pos * 40 + 8 + 4 * ig], c1 = tab[pos * 40 + 9 + 4 * ig], c2 = tab[pos * 40 + 10 + 4 * ig], c3 = tab[pos * 40 + 11 + 4 * ig];
            const float4 y1 = make_float4((a.x * c0.x - b.x * c0.y) * sc, (a.y * c1.x - b.y * c1.y) * sc, (a.z * c2.x - b.z * c2.y) * sc, (a.w * c3.x - b.w * c3.y) * sc);
            const float4 y2 = make_float4((b.x * c0.x + a.x * c0.y) * sc, (b.y * c1.x + a.y * c1.y) * sc, (b.z * c2.x + a.z * c2.y) * sc, (b.w * c3.x + a.w * c3.y) * sc);
            *(float4*)(row + base + 4 * ig) = y1; *(float4*)(row + base + 32 + 4 * ig) = y2;
            *(uint2*)(rowb + base + 4 * ig) = make_uint2(cvtpk(y1.x, y1.y), cvtpk(y1.z, y1.w));
            *(uint2*)(rowb + base + 32 + 4 * ig) = make_uint2(cvtpk(y2.x, y2.y), cvtpk(y2.z, y2.w));
        }
    }
}

__device__ __forceinline__ void attn_mfma_phase(LAS unsigned char* lds, const bf16* QKVb, bf16* OPART, float2* ML, int gw, int NGW, int wave, int lane) {
    LAS unsigned char* vt = lds + wave * 6144;
    const int i = lane & 31, hh = lane >> 5, i16 = lane & 15, tq = i16 >> 2, tp = i16 & 3, blk = (lane >> 4) & 1;
    constexpr int NITEM = 3 * 4096;
    const int per = (NITEM + NGW - 1) / NGW;
    const int i_beg = gw * per, i_end = (i_beg + per < NITEM) ? i_beg + per : NITEM;
    for (int idx = i_beg; idx < i_end; ++idx) {
        const int b = idx >> 12, rem = idx & 4095, h = rem >> 9, within = rem & 511;
        const int dsh = 2 * b, d = 1 << dsh, r = within >> (9 - dsh), qt = within & ((512 >> dsh) - 1), l0 = qt * 32;
        const int tok_q = (l0 + i) * d + r;
        const bf16* qp = QKVb + (size_t)tok_q * INW + C_QA + h * 64 + 8 * hh;
        bf16x8 qf[4];
#pragma unroll
        for (int ks = 0; ks < 4; ++ks) qf[ks] = *(const bf16x8*)(qp + 16 * ks);
        f32x16 o0, o1;
#pragma unroll
        for (int e = 0; e < 16; ++e) { o0[e] = 0.f; o1[e] = 0.f; }
        float m = -1e30f, l = 0.f;
        const int kt0 = l0 >= 128 ? 0 : ((128 - l0) >> 5);
        for (int kt = kt0; kt < 5; ++kt) {
            const int lk0 = l0 - 128 + 32 * kt;
            const bf16* kp = QKVb + (size_t)((lk0 + i) * d + r) * INW + C_KA + h * 64 + 8 * hh;
            bf16x8 kf[4];
#pragma unroll
            for (int ks = 0; ks < 4; ++ks) kf[ks] = *(const bf16x8*)(kp + 16 * ks);
            v4u vreg[4];
#pragma unroll
            for (int c = 0; c < 4; ++c) { const int rowk = (lane >> 3) + 8 * c;
                vreg[c] = *(const v4u*)(QKVb + (size_t)((lk0 + rowk) * d + r) * INW + C_VA + h * 64 + 8 * (lane & 7)); }
            f32x16 s;
#pragma unroll
            for (int e = 0; e < 16; ++e) s[e] = 0.f;
#pragma unroll
            for (int ks = 0; ks < 4; ++ks) s = MFMA32(kf[ks], qf[ks], s);
#pragma unroll
            for (int c = 0; c < 4; ++c) { const int rowk = (lane >> 3) + 8 * c; *(LAS v4u*)(vt + rowk * 192 + 16 * (lane & 7)) = vreg[c]; }
            float tm = -1e30f;
#pragma unroll
            for (int e = 0; e < 16; ++e) { const int j = crow(e, hh); const bool bad = (kt == 0 && j < i) || (kt == 4 && j > i); s[e] = bad ? -1e30f : s[e]; tm = fmaxf(tm, s[e]); }
            tm = fmaxf(tm, __shfl_xor(tm, 32));
            const float mn = fmaxf(m, tm), scl = __builtin_amdgcn_exp2f(m - mn);
            m = mn; l *= scl;
#pragma unroll
            for (int e = 0; e < 16; ++e) { o0[e] *= scl; o1[e] *= scl; }
            float psum = 0.f;
#pragma unroll
            for (int e = 0; e < 16; ++e) { s[e] = __builtin_amdgcn_exp2f(s[e] - mn); psum += s[e]; }
            l += psum;
            v4u pw0, pw1;
            pw0.x = cvtpk(s[0], s[1]); pw0.y = cvtpk(s[2], s[3]); pw0.z = cvtpk(s[4], s[5]); pw0.w = cvtpk(s[6], s[7]);
            pw1.x = cvtpk(s[8], s[9]); pw1.y = cvtpk(s[10], s[11]); pw1.z = cvtpk(s[12], s[13]); pw1.w = cvtpk(s[14], s[15]);
            const bf16x8 pf0 = __builtin_bit_cast(bf16x8, pw0), pf1 = __builtin_bit_cast(bf16x8, pw1);
            asm volatile("" ::: "memory");
#pragma unroll
            for (int st = 0; st < 2; ++st) {
                const LAS unsigned char* a0 = vt + (16 * st + 4 * hh + tq) * 192 + (16 * blk + 4 * tp) * 2;
                const s16x4 lo0 = vtr(a0), hi0 = vtr(a0 + 8 * 192), lo1 = vtr(a0 + 64), hi1 = vtr(a0 + 8 * 192 + 64);
                const bf16x8 v0 = __builtin_shufflevector(lo0, hi0, 0, 1, 2, 3, 4, 5, 6, 7), v1 = __builtin_shufflevector(lo1, hi1, 0, 1, 2, 3, 4, 5, 6, 7);
                o0 = MFMA32(v0, st == 0 ? pf0 : pf1, o0);
                o1 = MFMA32(v1, st == 0 ? pf0 : pf1, o1);
            }
            asm volatile("" ::: "memory");
        }
        const float lt = l + __shfl_xor(l, 32), inv = 1.f / lt;
        bf16* op = OPART + ((size_t)b * MP + tok_q) * 512 + h * 64 + 4 * hh;
#pragma unroll
        for (int g = 0; g < 4; ++g) {
            *(uint2*)(op + 8 * g) = make_uint2(cvtpk(o0[4 * g] * inv, o0[4 * g + 1] * inv), cvtpk(o0[4 * g + 2] * inv, o0[4 * g + 3] * inv));
            *(uint2*)(op + 32 + 8 * g) = make_uint2(cvtpk(o1[4 * g] * inv, o1[4 * g + 1] * inv), cvtpk(o1[4 * g + 2] * inv, o1[4 * g + 3] * inv));
        }
        if (hh == 0) ML[((size_t)b * MP + tok_q) * 8 + h] = make_float2(m, lt);
    }
}
__device__ __forceinline__ void attn_combine_phase(const bf16* OPART, const float2* ML, bf16* MIX, int gtid, int NGT) {
    for (int idx = gtid; idx < MP * 64; idx += NGT) {
        const int tok = idx >> 6, h = (idx >> 3) & 7, c = idx & 7;
        const float2 a0 = ML[((size_t)0 * MP + tok) * 8 + h], a1 = ML[((size_t)1 * MP + tok) * 8 + h], a2 = ML[((size_t)2 * MP + tok) * 8 + h];
        const float mx = fmaxf(a0.x, fmaxf(a1.x, a2.x));
        float w0 = a0.y * __builtin_amdgcn_exp2f(a0.x - mx), w1 = a1.y * __builtin_amdgcn_exp2f(a1.x - mx), w2 = a2.y * __builtin_amdgcn_exp2f(a2.x - mx);
        const float iw = 1.f / (w0 + w1 + w2); w0 *= iw; w1 *= iw; w2 *= iw;
        const v4u x0 = *(const v4u*)(OPART + ((size_t)0 * MP + tok) * 512 + h * 64 + 8 * c);
        const v4u x1 = *(const v4u*)(OPART + ((size_t)1 * MP + tok) * 512 + h * 64 + 8 * c);
        const v4u x2 = *(const v4u*)(OPART + ((size_t)2 * MP + tok) * 512 + h * 64 + 8 * c);
        v4u o;
        o.x = cvtpk(w0 * bf_lo(x0.x) + w1 * bf_lo(x1.x) + w2 * bf_lo(x2.x), w0 * bf_hi(x0.x) + w1 * bf_hi(x1.x) + w2 * bf_hi(x2.x));
        o.y = cvtpk(w0 * bf_lo(x0.y) + w1 * bf_lo(x1.y) + w2 * bf_lo(x2.y), w0 * bf_hi(x0.y) + w1 * bf_hi(x1.y) + w2 * bf_hi(x2.y));
        o.z = cvtpk(w0 * bf_lo(x0.z) + w1 * bf_lo(x1.z) + w2 * bf_lo(x2.z), w0 * bf_hi(x0.z) + w1 * bf_hi(x1.z) + w2 * bf_hi(x2.z));
        o.w = cvtpk(w0 * bf_lo(x0.w) + w1 * bf_lo(x1.w) + w2 * bf_lo(x2.w), w0 * bf_hi(x0.w) + w1 * bf_hi(x1.w) + w2 * bf_hi(x2.w));
        *(v4u*)(MIX + (size_t)tok * D + h * 64 + 8 * c) = o;
    }
}
__device__ __forceinline__ void ret_out_mfma_phase(LAS unsigned char* lds, const bf16* QKVb, const bf16* SPT, const float* gnw, bf16* MIX, int tid, int wave, int lane) {
    constexpr int RSV = 272;
    const int grp = wave >> 2, itile = wave & 3;
    LAS unsigned char* vb = lds + grp * (128 * RSV);
    const int i = lane & 31, hh = lane >> 5, i16 = lane & 15, tq = i16 >> 2, tp = i16 & 3, blk = (lane >> 4) & 1;
    for (int it = blockIdx.x; it < 256; it += gridDim.x) {
        const int item = it * 2 + grp, n = item >> 2, h = item & 3;
        const float lg2 = log_g(h) * 1.4426950408889634f;
        {
            const int t4 = tid & 255;
#pragma unroll
            for (int c = 0; c < 8; ++c) { const int e = t4 + 256 * c, rowk = e >> 4, ch = e & 15;
                *(LAS v4u*)(vb + rowk * RSV + 16 * ch) = *(const v4u*)(QKVb + (size_t)(n * 128 + rowk) * INW + C_VR + h * 128 + 8 * ch); }
        }
        __syncthreads();
        const int row_i = n * 128 + 32 * itile + i;
        bf16x8 qf[4];
#pragma unroll
        for (int ks = 0; ks < 4; ++ks) qf[ks] = *(const bf16x8*)(QKVb + (size_t)row_i * INW + C_QR + h * 64 + 16 * ks + 8 * hh);
        f32x16 acc[4];
#pragma unroll
        for (int dt = 0; dt < 4; ++dt) {
#pragma unroll
            for (int e = 0; e < 16; ++e) acc[dt][e] = 0.f;
#pragma unroll
            for (int ks = 0; ks < 4; ++ks) { const bf16x8 a = *(const bf16x8*)(SPT + ((size_t)(n * 4 + h) * 128 + 32 * dt + i) * 64 + 16 * ks + 8 * hh); acc[dt] = MFMA32(a, qf[ks], acc[dt]); }
        }
        const float wh = __builtin_amdgcn_exp2f((float)(32 * itile + i + 1) * lg2);
#pragma unroll
        for (int dt = 0; dt < 4; ++dt)
#pragma unroll
            for (int e = 0; e < 16; ++e) acc[dt][e] *= wh;
        for (int jt = 0; jt <= itile; ++jt) {
            bf16x8 kf[4];
#pragma unroll
            for (int ks = 0; ks < 4; ++ks) kf[ks] = *(const bf16x8*)(QKVb + (size_t)(n * 128 + 32 * jt + i) * INW + C_KR + h * 64 + 16 * ks + 8 * hh);
            f32x16 s;
#pragma unroll
            for (int e = 0; e < 16; ++e) s[e] = 0.f;
#pragma unroll
            for (int ks = 0; ks < 4; ++ks) s = MFMA32(kf[ks], qf[ks], s);
#pragma unroll
            for (int e = 0; e < 16; ++e) { const int dl = 32 * (itile - jt) + i - crow(e, hh); s[e] = dl >= 0 ? s[e] * __builtin_amdgcn_exp2f((float)dl * lg2) : 0.f; }
            v4u pw0, pw1;
            pw0.x = cvtpk(s[0], s[1]); pw0.y = cvtpk(s[2], s[3]); pw0.z = cvtpk(s[4], s[5]); pw0.w = cvtpk(s[6], s[7]);
            pw1.x = cvtpk(s[8], s[9]); pw1.y = cvtpk(s[10], s[11]); pw1.z = cvtpk(s[12], s[13]); pw1.w = cvtpk(s[14], s[15]);
            const bf16x8 pf0 = __builtin_bit_cast(bf16x8, pw0), pf1 = __builtin_bit_cast(bf16x8, pw1);
#pragma unroll
            for (int st = 0; st < 2; ++st) {
                const LAS unsigned char* a0 = vb + (32 * jt + 16 * st + 4 * hh + tq) * RSV + (16 * blk + 4 * tp) * 2;
#pragma unroll
                for (int dt = 0; dt < 4; ++dt) {
                    const s16x4 lo = vtr(a0 + 64 * dt), hi = vtr(a0 + 8 * RSV + 64 * dt);
                    const bf16x8 vf = __builtin_shufflevector(lo, hi, 0, 1, 2, 3, 4, 5, 6, 7);
                    acc[dt] = MFMA32(vf, st == 0 ? pf0 : pf1, acc[dt]);
                }
            }
        }
        float s1 = 0.f;
#pragma unroll
        for (int dt = 0; dt < 4; ++dt)
#pragma unroll
            for (int e = 0; e < 16; ++e) s1 += acc[dt][e];
        s1 += __shfl_xor(s1, 32);
        const float mu = s1 * (1.f / 128.f);
        float s2 = 0.f;
#pragma unroll
        for (int dt = 0; dt < 4; ++dt)
#pragma unroll
            for (int e = 0; e < 16; ++e) { const float dd = acc[dt][e] - mu; s2 += dd * dd; }
        s2 += __shfl_xor(s2, 32);
        const float rstd = 1.f / sqrtf(s2 * (1.f / 128.f) + EPS);
#pragma unroll
        for (int dt = 0; dt < 4; ++dt)
#pragma unroll
            for (int g = 0; g < 4; ++g) {
                const int dv0 = 32 * dt + 8 * g + 4 * hh;
                const uint2 gr = *(const uint2*)(QKVb + (size_t)row_i * INW + C_GR + h * 128 + dv0);
                const float4 gw4 = *(const float4*)(gnw + h * 128 + dv0);
                const float y0 = (acc[dt][4 * g] - mu) * rstd * gw4.x * silu_f(bf_lo(gr.x)), y1 = (acc[dt][4 * g + 1] - mu) * rstd * gw4.y * silu_f(bf_hi(gr.x));
                const float y2 = (acc[dt][4 * g + 2] - mu) * rstd * gw4.z * silu_f(bf_lo(gr.y)), y3 = (acc[dt][4 * g + 3] - mu) * rstd * gw4.w * silu_f(bf_hi(gr.y));
                *(uint2*)(MIX + (size_t)row_i * D + 512 + h * 128 + dv0) = make_uint2(cvtpk(y0, y1), cvtpk(y2, y3));
            }
        __syncthreads();
    }
}
template <int CTRL> __device__ __forceinline__ float dppf(float x) { return __builtin_bit_cast(float, __builtin_amdgcn_mov_dpp(__builtin_bit_cast(int, x), CTRL, 0xf, 0xf, true)); }
__device__ __forceinline__ float row16_sum(float v) { v += dppf<0xB1>(v); v += dppf<0x4E>(v); v += dppf<0x141>(v); v += dppf<0x128>(v); return v; }
constexpr int SA_CH = 15, SA_KPC = 60;
__device__ __forceinline__ void sa_rows(int kk, int b, const float* ck, const float* cv, const float* out, const float*& kr, const float*& vr, int& e) {
    e = kk < 516 ? kk : 528 + 16 * ((kk - 516) >> 2) + ((kk - 516) & 3);
    const int idx = 2051 - e;
    if (idx >= WB) { kr = out + O_KS + (size_t)(b * 4 + idx - WB) * 512; vr = out + O_VS + (size_t)(b * 4 + idx - WB) * 512; }
    else { kr = ck + ((size_t)b * WB + idx) * 512; vr = cv + ((size_t)b * WB + idx) * 512; }
}
__device__ __forceinline__ void attn_sample_phase(const bf16* QKVb, const float* ck, const float* cv, const float* out, float* SPART, float2* SML, int gw, int NGW, int lane) {
    const int l16 = lane & 15, hq = lane >> 4;
    for (int item = gw; item < DBATCH * SA_CH; item += NGW) {
        const int b = item / SA_CH, c = item % SA_CH;
        f32x4 q[4][2], o[4][2]; float m[4][2], l[4][2];
#pragma unroll
        for (int i = 0; i < 4; ++i)
#pragma unroll
            for (int u = 0; u < 2; ++u) {
                { const uint2 qq = *(const uint2*)(QKVb + (size_t)(MP + b * 4 + i) * INW + C_QA + (4 * u + hq) * 64 + 4 * l16); q[i][u] = (f32x4){bf_lo(qq.x), bf_hi(qq.x), bf_lo(qq.y), bf_hi(qq.y)}; }
                o[i][u] = (f32x4){0.f, 0.f, 0.f, 0.f}; m[i][u] = -1e30f; l[i][u] = 0.f;
            }
        for (int g = 0; g < SA_KPC / 4; ++g) {
            f32x4 kx[4][2], vx[4][2]; int ee[4];
#pragma unroll
            for (int t = 0; t < 4; ++t) {
                const float *kr, *vr; sa_rows(c * SA_KPC + g * 4 + t, b, ck, cv, out, kr, vr, ee[t]);
                kx[t][0] = *(const f32x4*)(kr + 4 * lane); kx[t][1] = *(const f32x4*)(kr + 256 + 4 * lane);
                vx[t][0] = *(const f32x4*)(vr + 4 * lane); vx[t][1] = *(const f32x4*)(vr + 256 + 4 * lane);
            }
#pragma unroll
            for (int t = 0; t < 4; ++t)
#pragma unroll
                for (int i = 0; i < 4; ++i) {
                    const int dl = ee[t] - 3 + i;
                    const int mult = dl >= 0 ? (int)(dl <= 128) + (int)(((dl & 3) == 0) && dl <= 512) + (int)(((dl & 15) == 0) && dl <= 2048) : 0;
                    if (mult) {
                        const float fm = (float)mult;
#pragma unroll
                        for (int u = 0; u < 2; ++u) {
                            const f32x4 pr = q[i][u] * kx[t][u];
                            const float s = row16_sum((pr[0] + pr[1]) + (pr[2] + pr[3]));
                            const float mn = fmaxf(m[i][u], s), scl = __builtin_amdgcn_exp2f(m[i][u] - mn), p = fm * __builtin_amdgcn_exp2f(s - mn);
                            m[i][u] = mn; l[i][u] = l[i][u] * scl + p; o[i][u] = o[i][u] * scl + vx[t][u] * p;
                        }
                    }
                }
        }
#pragma unroll
        for (int i = 0; i < 4; ++i)
#pragma unroll
            for (int u = 0; u < 2; ++u) {
                const size_t base = ((size_t)(b * SA_CH + c) * 4 + i) * 8 + 4 * u + hq;
                *(f32x4*)(SPART + base * 64 + 4 * l16) = o[i][u];
                if (l16 == 0) SML[base] = make_float2(m[i][u], l[i][u]);
            }
    }
}
__device__ __forceinline__ void attn_sample_merge_phase(const float* SPART, const float2* SML, bf16* MIX, int gw, int NGW, int lane) {
    for (int item = gw; item < DBATCH * 32; item += NGW) {
        const int b = item >> 5, i = (item >> 3) & 3, h = item & 7;
        float2 ml[SA_CH]; float mx = -1e30f;
#pragma unroll
        for (int c = 0; c < SA_CH; ++c) { ml[c] = SML[((size_t)(b * SA_CH + c) * 4 + i) * 8 + h]; mx = fmaxf(mx, ml[c].x); }
        float acc = 0.f, L = 0.f;
#pragma unroll
        for (int c = 0; c < SA_CH; ++c) { const float w = __builtin_amdgcn_exp2f(ml[c].x - mx); L += w * ml[c].y; acc += w * SPART[(((size_t)(b * SA_CH + c) * 4 + i) * 8 + h) * 64 + lane]; }
        MIX[(size_t)(MP + b * 4 + i) * D + h * 64 + lane] = (bf16)f2bf(acc / L);
    }
}
__device__ __forceinline__ void ret_upd_phase(LAS unsigned char* lds, const bf16* __restrict__ QKVb, float* __restrict__ UPD, int tid) {
    LAS float* kc = (LAS float*)lds;
    LAS float* vc = (LAS float*)(lds + 32768);
    for (int it = blockIdx.x; it < 512; it += gridDim.x) {
        const int n = it >> 2, h = it & 3;
        const float lg = log_g(h);
#pragma unroll
        for (int c = 0; c < 2; ++c) { const int e = tid + NTHR * c, j = e >> 3, ch = e & 7;
            const v4u x = *(const v4u*)(QKVb + (size_t)(n * 128 + j) * INW + C_KR + h * 64 + 8 * ch);
            const float w = expf((float)(127 - j) * lg);
            *(LAS f32x4*)(kc + j * 64 + 8 * ch) = (f32x4){bf_lo(x.x) * w, bf_hi(x.x) * w, bf_lo(x.y) * w, bf_hi(x.y) * w};
            *(LAS f32x4*)(kc + j * 64 + 8 * ch + 4) = (f32x4){bf_lo(x.z) * w, bf_hi(x.z) * w, bf_lo(x.w) * w, bf_hi(x.w) * w}; }
#pragma unroll
        for (int c = 0; c < 4; ++c) { const int e = tid + NTHR * c, j = e >> 4, ch = e & 15;
            const v4u x = *(const v4u*)(QKVb + (size_t)(n * 128 + j) * INW + C_VR + h * 128 + 8 * ch);
            *(LAS f32x4*)(vc + j * 128 + 8 * ch) = (f32x4){bf_lo(x.x), bf_hi(x.x), bf_lo(x.y), bf_hi(x.y)};
            *(LAS f32x4*)(vc + j * 128 + 8 * ch + 4) = (f32x4){bf_lo(x.z), bf_hi(x.z), bf_lo(x.w), bf_hi(x.w)}; }
        __syncthreads();
        const int dv = tid & 127, qt = tid >> 7;
        float acc[16];
#pragma unroll
        for (int i = 0; i < 16; ++i) acc[i] = 0.f;
#pragma unroll 4
        for (int j = 0; j < 128; ++j) {
            const float vj = vc[j * 128 + dv];
#pragma unroll
            for (int i = 0; i < 16; i += 4) { const f32x4 k4 = *(const LAS f32x4*)(kc + j * 64 + qt * 16 + i);
                acc[i] += k4[0] * vj; acc[i + 1] += k4[1] * vj; acc[i + 2] += k4[2] * vj; acc[i + 3] += k4[3] * vj; }
        }
#pragma unroll
        for (int i = 0; i < 16; i += 4) *(float4*)(UPD + ((size_t)(n * 4 + h) * 128 + dv) * 64 + qt * 16 + i) = make_float4(acc[i], acc[i + 1], acc[i + 2], acc[i + 3]);
        __syncthreads();
    }
}
__device__ __forceinline__ void ret_scan_phase(const float* UPDT, bf16* SPT, float* out, int tid) {
    const int e = blockIdx.x * NTHR + tid;
    if (e < 32768) {
        const int h = e >> 13, dv = (e >> 6) & 127, dk = e & 63;
        const float G = expf(128.f * log_g(h));
        float S = 0.f;
        for (int n = 0; n < 128; ++n) { SPT[(size_t)n * 32768 + e] = (bf16)f2bf(S); S = G * S + UPDT[(size_t)n * 32768 + e]; }
        out[O_SP + h * 8192 + dk * 128 + dv] = S;
    }
}
__device__ __forceinline__ void ret_sample_phase(LAS unsigned char* lds, const bf16* __restrict__ QKVb, const float* __restrict__ state, const float* __restrict__ gnw, bf16* __restrict__ MIX, float* __restrict__ out, int tid) {
    const int grp = tid >> 7, t = tid & 127, dv = t;
    LAS float* qs = (LAS float*)(lds + grp * 4096);
    LAS float* ks = qs + 256;
    LAS float* red = ks + 256;
    for (int it = blockIdx.x; it < 128; it += gridDim.x) {
        const int sub = it * 4 + grp, b = sub >> 2, h = sub & 3;
        const float g = 1.f - exp2f(-5.f - (float)h);
        const float g2 = g * g, g3 = g2 * g, g4 = g2 * g2;
        const int row0 = MP + b * 4;
        const float* s0p = state + (size_t)(b * 4 + h) * 64 * 128 + dv;
        float* snp = out + O_SS + (size_t)(b * 4 + h) * 64 * 128 + dv;
        for (int e = t; e < 256; e += 128) { const int i = e >> 6, dk = e & 63;
            qs[e] = bf_lo((unsigned)QKVb[(size_t)(row0 + i) * INW + C_QR + h * 64 + dk]); ks[e] = bf_lo((unsigned)QKVb[(size_t)(row0 + i) * INW + C_KR + h * 64 + dk]); }
        float v[4];
#pragma unroll
        for (int i = 0; i < 4; ++i) v[i] = bf_lo((unsigned)QKVb[(size_t)(row0 + i) * INW + C_VR + h * 128 + dv]);
        __syncthreads();
        float c0 = 0.f, c1 = 0.f, c2 = 0.f, c3 = 0.f;
#pragma unroll 1
        for (int d0 = 0; d0 < 64; d0 += 16) {
            float s0v[16];
#pragma unroll
            for (int dk = 0; dk < 16; ++dk) s0v[dk] = __builtin_nontemporal_load(s0p + (d0 + dk) * 128);
#pragma unroll
            for (int dk = 0; dk < 16; ++dk) {
                const float s0 = s0v[dk]; const int kk = d0 + dk;
                c0 += qs[kk] * s0; c1 += qs[64 + kk] * s0; c2 += qs[128 + kk] * s0; c3 += qs[192 + kk] * s0;
                __builtin_nontemporal_store(g4 * s0 + g3 * ks[kk] * v[0] + g2 * ks[64 + kk] * v[1] + g * ks[128 + kk] * v[2] + ks[192 + kk] * v[3], snp + kk * 128);
            }
        }
        float d00 = 0.f, d10 = 0.f, d11 = 0.f, d20 = 0.f, d21 = 0.f, d22 = 0.f, d30 = 0.f, d31 = 0.f, d32 = 0.f, d33 = 0.f;
        for (int dk = 0; dk < 64; ++dk) {
            const float q0 = qs[dk], q1 = qs[64 + dk], q2 = qs[128 + dk], q3 = qs[192 + dk];
            const float k0 = ks[dk], k1 = ks[64 + dk], k2 = ks[128 + dk], k3 = ks[192 + dk];
            d00 += q0 * k0; d10 += q1 * k0; d11 += q1 * k1; d20 += q2 * k0; d21 += q2 * k1; d22 += q2 * k2;
            d30 += q3 * k0; d31 += q3 * k1; d32 += q3 * k2; d33 += q3 * k3;
        }
        float o[4];
        o[0] = g * c0 + d00 * v[0];
        o[1] = g2 * c1 + g * d10 * v[0] + d11 * v[1];
        o[2] = g3 * c2 + g2 * d20 * v[0] + g * d21 * v[1] + d22 * v[2];
        o[3] = g4 * c3 + g3 * d30 * v[0] + g2 * d31 * v[1] + g * d32 * v[2] + d33 * v[3];
#pragma unroll
        for (int i = 0; i < 4; ++i) { const float s1 = wave_sum(o[i]); if ((t & 63) == 0) red[i * 2 + (t >> 6)] = s1; }
        __syncthreads();
        float dl[4];
#pragma unroll
        for (int i = 0; i < 4; ++i) { const float mu = (red[i * 2] + red[i * 2 + 1]) * (1.f / 128.f); dl[i] = o[i] - mu; }
#pragma unroll
        for (int i = 0; i < 4; ++i) { const float s2 = wave_sum(dl[i] * dl[i]); if ((t & 63) == 0) red[8 + i * 2 + (t >> 6)] = s2; }
        __syncthreads();
#pragma unroll
        for (int i = 0; i < 4; ++i) {
            const float var = (red[8 + i * 2] + red[8 + i * 2 + 1]) * (1.f / 128.f);
            const float y = dl[i] / sqrtf(var + EPS) * gnw[h * 128 + dv];
            const float gg = bf_lo((unsigned)QKVb[(size_t)(row0 + i) * INW + C_GR + h * 128 + dv]);
            MIX[(size_t)(row0 + i) * D + 512 + h * 128 + dv] = (bf16)f2bf(silu_f(gg) * y);
        }
        __syncthreads();
    }
}

struct Args { const float* in[20]; float* out; unsigned char* ws; };
__global__ void __launch_bounds__(NTHR, 2) mk_fwd(Args a) {
    extern __shared__ __attribute__((aligned(16))) unsigned char lds_raw[];
    LAS unsigned char* lds = (LAS unsigned char*)lds_raw;
    volatile LAS unsigned* MISC = (volatile LAS unsigned*)(lds + MISC_OFF);
    const int tid = threadIdx.x, lane = tid & 63, wave = __builtin_amdgcn_readfirstlane(tid >> 6);
    const int G = gridDim.x;
    const int gw = blockIdx.x * NWAVES + wave, NGW = G * NWAVES, gtid = blockIdx.x * NTHR + tid, NGT = G * NTHR;
    unsigned char* ws = a.ws;
    Ptrs P;
    P.xp = a.in[0]; P.xs = a.in[1]; P.ck = a.in[2]; P.cv = a.in[3]; P.st = a.in[4]; P.g1a = a.in[5]; P.g1b = a.in[6]; P.w1g = a.in[7]; P.w1u = a.in[8]; P.w1d = a.in[9];
    P.gma = a.in[10]; P.gmb = a.in[11]; P.win = a.in[12]; P.gnw = a.in[13]; P.wout = a.in[14]; P.g2a = a.in[15]; P.g2b = a.in[16]; P.w2g = a.in[17]; P.w2u = a.in[18]; P.w2d = a.in[19];
    P.out = a.out;
    P.W1GU = (bf16*)(ws + WS_W1GU); P.W1D = (bf16*)(ws + WS_W1D); P.WIN = (bf16*)(ws + WS_WIN); P.WOUT = (bf16*)(ws + WS_WOUT); P.W2GU = (bf16*)(ws + WS_W2GU); P.W2D = (bf16*)(ws + WS_W2D);
    P.XN = (bf16*)(ws + WS_XN); P.H = (bf16*)(ws + WS_H); P.MIX = (bf16*)(ws + WS_MIX);
    P.TAB = (float2*)(ws + WS_TAB); P.Y = (float*)(ws + WS_Y); P.HRES = (float*)(ws + WS_HRES); P.QKV = (float*)(ws + WS_QKV); P.UPD = (float*)(ws + WS_UPD); P.SPT = (bf16*)(ws + WS_SPREV); P.QKVb = (bf16*)(ws + WS_QKVB); P.OPART = (bf16*)(ws + WS_OPART); P.ML = (float2*)(ws + WS_ML); P.SPART = (float*)(ws + WS_SPART); P.SML = (float2*)(ws + WS_SML);
    for (int u = tid; u < (LDS_BYTES - LDSCTL_OFF) / 4; u += NTHR) ((LAS unsigned*)(lds + LDSCTL_OFF))[u] = 0u;
    __syncthreads();
    XcdBarrier bar = xcd_barrier_post((unsigned*)(ws + WS_CTL) + CW_BAR, MISC + 8);

    p0_prologue(P, lds, gw, NGW, wave, lane, gtid, NGT);
    xcd_barrier(bar);
    { pg8::Gemm g{P.XN, P.W1GU, M, 2 * DFF, D}; pg8::StaticOrder S; S.init(M, 2 * DFF, G, (int)blockIdx.x); pg8::EpiSwiglu E{P.H, DFF};
      pg8::gemm_phase<pg8::EpiSwiglu, pg8::StaticOrder, true, true>(lds, g, S, E); }
    xcd_barrier(bar);
    { pg8::Gemm g{P.H, P.W1D, M, D, DFF}; pg8::StaticOrder S; S.init(M, D, G, (int)blockIdx.x); pg8::EpiF32 E{P.Y, D};
      pg8::gemm_phase<pg8::EpiF32, pg8::StaticOrder, true, true>(lds, g, S, E); }
    xcd_barrier(bar);
    norm_res_phase(P.xp, P.xs, P.Y, P.g1b, 0.5f, P.HRES, P.gma, P.XN, gw, NGW, lane);
    xcd_barrier(bar);
    { pg8::Gemm g{P.XN, P.WIN, M, INW, D}; pg8::StaticOrder S; S.init(M, INW, G, (int)blockIdx.x); pg8::EpiF32 E{P.QKV, INW};
      pg8::gemm_phase<pg8::EpiF32, pg8::StaticOrder, true, true>(lds, g, S, E); }
    xcd_barrier(bar);
    rope_phase(P.QKV, P.QKVb, P.TAB, P.out, gw, NGW, lane);
    xcd_barrier(bar);
    ret_upd_phase(lds, P.QKVb, P.UPD, tid);
    ret_sample_phase(lds, P.QKVb, P.st, P.gnw, P.MIX, P.out, tid);
    attn_sample_phase(P.QKVb, P.ck, P.cv, P.out, P.SPART, P.SML, gw, NGW, lane);
    attn_mfma_phase(lds, P.QKVb, P.OPART, P.ML, gw, NGW, wave, lane);
    xcd_barrier(bar);
    ret_scan_phase(P.UPD, P.SPT, P.out, tid);
    attn_combine_phase(P.OPART, P.ML, P.MIX, gtid, NGT);
    attn_sample_merge_phase(P.SPART, P.SML, P.MIX, gw, NGW, lane);
    xcd_barrier(bar);
    ret_out_mfma_phase(lds, P.QKVb, P.SPT, P.gnw, P.MIX, tid, wave, lane);
    xcd_barrier(bar);
    { pg8::Gemm g{P.MIX, P.WOUT, M, D, D}; pg8::StaticOrder S; S.init(M, D, G, (int)blockIdx.x); pg8::EpiF32 E{P.Y, D};
      pg8::gemm_phase<pg8::EpiF32, pg8::StaticOrder, true, true>(lds, g, S, E); }
    xcd_barrier(bar);
    norm_res_phase(P.HRES, P.HRES + (size_t)MP * D, P.Y, P.gmb, 1.0f, P.HRES, P.g2a, P.XN, gw, NGW, lane);
    xcd_barrier(bar);
    { pg8::Gemm g{P.XN, P.W2GU, M, 2 * DFF, D}; pg8::StaticOrder S; S.init(M, 2 * DFF, G, (int)blockIdx.x); pg8::EpiSwiglu E{P.H, DFF};
      pg8::gemm_phase<pg8::EpiSwiglu, pg8::StaticOrder, true, true>(lds, g, S, E); }
    xcd_barrier(bar);
    { pg8::Gemm g{P.H, P.W2D, M, D, DFF}; pg8::StaticOrder S; S.init(M, D, G, (int)blockIdx.x); pg8::EpiF32 E{P.Y, D};
      pg8::gemm_phase<pg8::EpiF32, pg8::StaticOrder, true, true>(lds, g, S, E); }
    xcd_barrier(bar);
    norm_res_phase(P.HRES, P.HRES + (size_t)MP * D, P.Y, P.g2b, 0.5f, P.out + O_Y, nullptr, nullptr, gw, NGW, lane);
}

extern "C" void kernel_launch(void* const* d_in, const int* in_sizes, int n_in, void* d_out, int out_size, void* d_ws, size_t ws_size, hipStream_t stream) {
    static int grid = 0;
    if (grid == 0) {
        if (n_in != 20 || (size_t)out_size != O_END || ws_size < WS_END) { fprintf(stderr, "kernel_launch: unexpected sizes (n_in %d out %d ws %zu)\n", n_in, out_size, ws_size); grid = -1; return; }
        int dev = 0, cus = 0;
        if (hipGetDevice(&dev) != hipSuccess || hipDeviceGetAttribute(&cus, hipDeviceAttributeMultiprocessorCount, dev) != hipSuccess) { grid = -1; return; }
        if (hipFuncSetAttribute((const void*)mk_fwd, hipFuncAttributeMaxDynamicSharedMemorySize, LDS_BYTES) != hipSuccess) { fprintf(stderr, "kernel_launch: hipFuncSetAttribute failed\n"); grid = -1; return; }
        int per_cu = 0;
        if (hipOccupancyMaxActiveBlocksPerMultiprocessor(&per_cu, (const void*)mk_fwd, NTHR, LDS_BYTES) != hipSuccess || per_cu < 1) fprintf(stderr, "kernel_launch: occupancy query says %d\n", per_cu);
        (void)hipGetLastError();
        grid = cus;
    }
    if (grid < 0) return;
    (void)hipMemsetAsync((char*)d_ws + WS_CTL, 0, CTL_ZERO_BYTES, stream);
    Args a{};
    for (int i = 0; i < 20; ++i) a.in[i] = (const float*)d_in[i];
    a.out = (float*)d_out; a.ws = (unsigned char*)d_ws;
    hipLaunchKernelGGL(mk_fwd, dim3(grid), dim3(NTHR), LDS_BYTES, stream, a);
}
```

```cpp
#include <hip/hip_runtime.h>
#include <cstdio>
#include <cstdint>
namespace pg8 {
#define PG8_LAS __attribute__((address_space(3)))
typedef unsigned short bf16_t;
typedef short bf16x8 __attribute__((ext_vector_type(8)));
typedef float f32x4 __attribute__((ext_vector_type(4)));
typedef unsigned u32x4 __attribute__((ext_vector_type(4)));
constexpr int BM = 256, BK = 64, HALF = 128, HTB = HALF * BK * 2  , STAGE_BYTES = 8 * HTB, NXCD = 8, WGM = 8;

__host__ __device__ __forceinline__ int lds_byte(int r, int c) { const int st = (r >> 4) * 2 + (c >> 5), rr = r & 15, cc = c & 31, ob = rr * 64 + cc * 2; return st * 1024 + (ob ^ (((ob >> 9) & 1) << 5)); }
__host__ __device__ __forceinline__ void stage_rc(int b, int& R, int& C) { const int st = b / 1024, sb = b % 1024, swz = sb ^ (((sb >> 9) & 1) << 5); R = (st >> 1) * 16 + swz / 64; C = (st & 1) * 32 + (swz % 64) / 2; }
__host__ __device__ __forceinline__ int perm32(int rho) { const int n = rho >> 4, i = rho & 15; return 8 * (i >> 2) + 4 * n + (i & 3); }

struct Unit { int pm, pn; };
struct Gemm { const bf16_t* A; const bf16_t* Bt; int M, N, K; };

struct StaticOrder {
    int nM, nN, nwg, G, c;
    __host__ __device__ void init(int M, int N, int G_, int c_) { nM = M / BM; nN = N / BM; nwg = nM * nN; G = G_; c = c_; }
    __host__ __device__ bool next(int i, Unit& u) const {
        const long L = (long)i * G + c; if (L >= nwg) return false;
        int wgid = (int)L; { const int q = nwg / NXCD, r = nwg % NXCD, xcd = wgid % NXCD, off = wgid / NXCD; wgid = (xcd < r ? xcd * (q + 1) : r * (q + 1) + (xcd - r) * q) + off; }
        const int nig = WGM * nN, gid = wgid / nig, fm = gid * WGM, gsz = (nM - fm) < WGM ? (nM - fm) : WGM;
        u.pm = fm + ((wgid % nig) % gsz); u.pn = (wgid % nig) / gsz; return true;
    }
    __device__ __forceinline__ void a_ready(const Unit&) const {}
    __device__ __forceinline__ void done(const Unit&) const {}
};

__device__ __forceinline__ unsigned cvt_pk_bf16(float lo, float hi) { unsigned r; asm volatile("v_cvt_pk_bf16_f32 %0, %1, %2" : "=v"(r) : "v"(lo), "v"(hi)); return r; }
typedef float f32x2 __attribute__((ext_vector_type(2)));
typedef unsigned u32x2 __attribute__((ext_vector_type(2)));
struct EpiQKV {
    static constexpr bool PERM = true, AFTER_DRAIN = false;
    bf16_t* QKVb; const float2* tab; float* okp; float* ovp; float qscale; int keep0;
    __device__ __forceinline__ void operator()(const f32x4 (&acc)[2][2][4][2], const Unit& u, int wr, int wc, int fr, int fq) const {
        const int pn = u.pn, g8 = (wc & 1) * 4 + fq;
#pragma unroll
        for (int ai = 0; ai < 2; ++ai)
#pragma unroll
            for (int m = 0; m < 4; ++m) {
                const int row = u.pm * BM + ai * HALF + wr * 64 + m * 16 + fr;
                bf16_t* rb = QKVb + (size_t)row * 3072;
#pragma unroll
                for (int bj = 0; bj < 2; ++bj) {
                    const int hb = pn * BM + bj * HALF + (wc >> 1) * 64;
                    const f32x4 v0 = acc[ai][bj][m][0], v1 = acc[ai][bj][m][1];
                    if (pn < 4 && g8 < 2) {
                        const float2* t = tab + (size_t)row * 40 + 4 * g8;
                        const float2 c0 = t[0], c1 = t[1], c2 = t[2], c3 = t[3];
                        const f32x4 y1 = {v0[0] * c0.x - v1[0] * c0.y, v0[1] * c1.x - v1[1] * c1.y, v0[2] * c2.x - v1[2] * c2.y, v0[3] * c3.x - v1[3] * c3.y};
                        const f32x4 y2 = {v1[0] * c0.x + v0[0] * c0.y, v1[1] * c1.x + v0[1] * c1.y, v1[2] * c2.x + v0[2] * c2.y, v1[3] * c3.x + v0[3] * c3.y};
                        const float sc = pn < 2 ? qscale : 1.f;
                        u32x2 w1, w2; w1.x = cvt_pk_bf16(y1[0] * sc, y1[1] * sc); w1.y = cvt_pk_bf16(y1[2] * sc, y1[3] * sc); w2.x = cvt_pk_bf16(y2[0] * sc, y2[1] * sc); w2.y = cvt_pk_bf16(y2[2] * sc, y2[3] * sc);
                        *(u32x2*)(rb + hb + 4 * g8) = w1; *(u32x2*)(rb + hb + 4 * g8 + 8) = w2;
                        if (pn >= 2 && row >= keep0) { float* o = okp + (size_t)(row - keep0) * 512 + (hb - 512) + 4 * g8; *(f32x4*)o = y1; *(f32x4*)(o + 8) = y2; }
                    } else if (pn == 6 || pn == 7) {
                        const float2* t = tab + (size_t)row * 40 + 8 + 4 * g8;
                        const float2 c0 = t[0], c1 = t[1], c2 = t[2], c3 = t[3];
                        const float sc = pn == 7 ? 0.125f : 1.f;
                        const f32x4 y1 = {(v0[0] * c0.x - v1[0] * c0.y) * sc, (v0[1] * c1.x - v1[1] * c1.y) * sc, (v0[2] * c2.x - v1[2] * c2.y) * sc, (v0[3] * c3.x - v1[3] * c3.y) * sc};
                        const f32x4 y2 = {(v1[0] * c0.x + v0[0] * c0.y) * sc, (v1[1] * c1.x + v0[1] * c1.y) * sc, (v1[2] * c2.x + v0[2] * c2.y) * sc, (v1[3] * c3.x + v0[3] * c3.y) * sc};
                        u32x2 w1, w2; w1.x = cvt_pk_bf16(y1[0], y1[1]); w1.y = cvt_pk_bf16(y1[2], y1[3]); w2.x = cvt_pk_bf16(y2[0], y2[1]); w2.y = cvt_pk_bf16(y2[2], y2[3]);
                        *(u32x2*)(rb + hb + 4 * g8) = w1; *(u32x2*)(rb + hb + 32 + 4 * g8) = w2;
                    } else {
                        const int col = pn * BM + bj * HALF + wc * 32 + 8 * fq;
                        const float sc = pn < 2 ? qscale : 1.f;
                        u32x4 w; w.x = cvt_pk_bf16(v0[0] * sc, v0[1] * sc); w.y = cvt_pk_bf16(v0[2] * sc, v0[3] * sc); w.z = cvt_pk_bf16(v1[0] * sc, v1[1] * sc); w.w = cvt_pk_bf16(v1[2] * sc, v1[3] * sc);
                        *(u32x4*)(rb + col) = w;
                        if (row >= keep0 && pn >= 2 && pn < 6) { float* o = (pn < 4 ? okp + (size_t)(row - keep0) * 512 + (col - 512) : ovp + (size_t)(row - keep0) * 512 + (col - 1024)); *(f32x4*)o = v0; *(f32x4*)(o + 4) = v1; }
                    }
                }
            }
    }
};
__device__ __forceinline__ float silu_fast(float x) { return x * __builtin_amdgcn_rcpf(1.0f + __builtin_amdgcn_exp2f(-1.4426950408889634f * x)); }
struct EpiSwiglu {
    static constexpr bool PERM = true, AFTER_DRAIN = false;
    bf16_t* O; int ldc;
    __device__ __forceinline__ void operator()(const f32x4 (&acc)[2][2][4][2], const Unit& u, int wr, int wc, int fr, int fq) const {
        const int row0 = u.pm * BM + wr * 64 + fr, col0 = u.pn * HALF + wc * 32 + 8 * fq;
#pragma unroll
        for (int ai = 0; ai < 2; ++ai)
#pragma unroll
            for (int m = 0; m < 4; ++m) {
                bf16_t* rowp = O + (size_t)(row0 + ai * HALF + m * 16) * ldc + col0;
                const f32x4 g0 = acc[ai][0][m][0], g1 = acc[ai][0][m][1], u0 = acc[ai][1][m][0], u1 = acc[ai][1][m][1];
                u32x4 w;
                w.x = cvt_pk_bf16(silu_fast(g0[0]) * u0[0], silu_fast(g0[1]) * u0[1]); w.y = cvt_pk_bf16(silu_fast(g0[2]) * u0[2], silu_fast(g0[3]) * u0[3]);
                w.z = cvt_pk_bf16(silu_fast(g1[0]) * u1[0], silu_fast(g1[1]) * u1[1]); w.w = cvt_pk_bf16(silu_fast(g1[2]) * u1[2], silu_fast(g1[3]) * u1[3]);
                *(u32x4*)rowp = w;
            }
    }
};
struct EpiF32 {
    static constexpr bool PERM = false, AFTER_DRAIN = false;
    float* O; int ldc;
    __device__ __forceinline__ void operator()(const f32x4 (&acc)[2][2][4][2], const Unit& u, int wr, int wc, int fr, int fq) const {
        const int row0 = u.pm * BM + wr * 64 + fr, col0 = u.pn * BM + wc * 32 + 4 * fq;
#pragma unroll
        for (int ai = 0; ai < 2; ++ai)
#pragma unroll
            for (int m = 0; m < 4; ++m) {
                float* rowp = O + (size_t)(row0 + ai * HALF + m * 16) * ldc + col0;
#pragma unroll
                for (int bj = 0; bj < 2; ++bj)
#pragma unroll
                    for (int n = 0; n < 2; ++n) *(f32x4*)(rowp + bj * HALF + n * 16) = acc[ai][bj][m][n];
            }
    }
};
template <class Epi, class Sched, bool ALIGN_EPI = false, bool SP2 = false>
__device__ __forceinline__ void gemm_phase(PG8_LAS unsigned char* lds, const Gemm g, const Sched& S, const Epi& E) {
    int tid_ = threadIdx.x; asm volatile("" : "+v"(tid_));
    const int tid = tid_, wid = __builtin_amdgcn_readfirstlane(tid >> 6), lane = tid & 63, wr = wid >> 2, wc = wid & 3, fr = lane & 15, fq = lane >> 4;
    const int K = g.K, nt = K / BK;
    unsigned voffA[2], voffB[2];
#pragma unroll
    for (int i = 0; i < 2; ++i) { int R, C; stage_rc(tid * 16 + i * 8192, R, C); const int Rb = Epi::PERM ? ((R & ~31) + perm32(R & 31)) : R;
        voffA[i] = (unsigned)(R * K + C) * 2u; voffB[i] = (unsigned)(Rb * K + C) * 2u; }
    const size_t kstep = (size_t)(BK * 2);
    const size_t hstep = (size_t)HALF * K * 2;
    const size_t tstep = 2 * hstep;
    const unsigned ldsw = (unsigned)wid * 1024u;
    const int aoff = lds_byte(wr * 64 + fr, fq * 8), boff = lds_byte(wc * 32 + fr, fq * 8);
#define PG8_SA(b, h) (((b) * 2 + (h)) * HTB)
#define PG8_SB(b, h) ((4 + (b) * 2 + (h)) * HTB)
#define PG8_STAGE(bufoff, gbase, voff) do { _Pragma("unroll") for (int _i = 0; _i < 2; ++_i) \
        __builtin_amdgcn_global_load_lds((const unsigned*)((const char*)(gbase) + (voff)[_i]), (PG8_LAS unsigned*)(lds + (bufoff) + ldsw + _i * 8192), 16, 0, 0); } while (0)
#define PG8_LDA(dst, b, h) do { _Pragma("unroll") for (int m = 0; m < 4; ++m) _Pragma("unroll") for (int k = 0; k < 2; ++k) dst[m][k] = *(const PG8_LAS bf16x8*)(lds + PG8_SA(b, h) + aoff + m * 2048 + k * 1024); } while (0)
#define PG8_LDB(dst, b, h) do { _Pragma("unroll") for (int n = 0; n < 2; ++n) _Pragma("unroll") for (int k = 0; k < 2; ++k) dst[n][k] = *(const PG8_LAS bf16x8*)(lds + PG8_SB(b, h) + boff + n * 2048 + k * 1024); } while (0)
#define PG8_MMA(ai, bj, At, Bt) do { __builtin_amdgcn_s_setprio(1); _Pragma("unroll") for (int m = 0; m < 4; ++m) _Pragma("unroll") for (int n = 0; n < 2; ++n) _Pragma("unroll") for (int k = 0; k < 2; ++k) \
        acc[ai][bj][m][n] = __builtin_amdgcn_mfma_f32_16x16x32_bf16(Bt[n][k], At[m][k], acc[ai][bj][m][n], 0, 0, 0); __builtin_amdgcn_s_setprio(0); } while (0)
#define PG8_WAIT_V(n) asm volatile("s_waitcnt vmcnt(" #n ")" ::: "memory")
#define PG8_WAIT_L(n) asm volatile("s_waitcnt lgkmcnt(" #n ")" ::: "memory")
#define PG8_BAR __builtin_amdgcn_s_barrier()
#define PG8_SCHED __builtin_amdgcn_sched_barrier(0)
    Unit cur, nxt; int ui = 0;
    if (!S.next(0, cur)) return;
    f32x4 acc[2][2][4][2];
#pragma unroll
    for (int a = 0; a < 2; ++a)
#pragma unroll
        for (int b = 0; b < 2; ++b)
#pragma unroll
            for (int m = 0; m < 4; ++m)
#pragma unroll
                for (int n = 0; n < 2; ++n) acc[a][b][m][n] = (f32x4){0.f, 0.f, 0.f, 0.f};
    bf16x8 At[4][2], B0[2][2], B1[2][2];
    const char* cA = (const char*)g.A + (size_t)cur.pm * tstep; const char* cB = (const char*)g.Bt + (size_t)cur.pn * tstep;
    S.a_ready(cur);
    if constexpr (SP2) {
        PG8_STAGE(PG8_SB(0, 0), cB, voffB); PG8_STAGE(PG8_SB(0, 1), cB + hstep, voffB); PG8_STAGE(PG8_SA(0, 0), cA, voffA); PG8_STAGE(PG8_SA(0, 1), cA + hstep, voffA);
        if (wr == 1) PG8_BAR;
        PG8_WAIT_V(2); PG8_BAR;
        PG8_STAGE(PG8_SB(1, 0), cB + kstep, voffB); PG8_STAGE(PG8_SA(1, 0), cA + kstep, voffA); PG8_STAGE(PG8_SB(1, 1), cB + hstep + kstep, voffB);
        PG8_WAIT_V(6); PG8_BAR;
    } else {
        PG8_STAGE(PG8_SB(0, 0), cB, voffB); PG8_STAGE(PG8_SA(0, 0), cA, voffA); PG8_STAGE(PG8_SB(0, 1), cB + hstep, voffB); PG8_STAGE(PG8_SA(0, 1), cA + hstep, voffA);
        if (wr == 1) PG8_BAR;
        PG8_WAIT_V(4); PG8_BAR;
        PG8_STAGE(PG8_SB(1, 0), cB + kstep, voffB); PG8_STAGE(PG8_SA(1, 0), cA + kstep, voffA); PG8_STAGE(PG8_SB(1, 1), cB + hstep + kstep, voffB);
        PG8_WAIT_V(6); PG8_BAR;
    }
    for (;;) {
        const bool has_next = S.next(ui + 1, nxt);
        const char* nA = has_next ? (const char*)g.A + (size_t)nxt.pm * tstep : cA; const char* nB = has_next ? (const char*)g.Bt + (size_t)nxt.pn * tstep : cB;
        for (int t = 0; t < nt; t += 2) {
            const bool last = (t == nt - 2);
            const char* a1 = cA + (size_t)(t + 1) * kstep;
            const char* a2 = last ? nA : cA + (size_t)(t + 2) * kstep; const char* b2 = last ? nB : cB + (size_t)(t + 2) * kstep;
            const char* a3 = a2 + kstep; const char* b3 = b2 + kstep;
            if (last && has_next) S.a_ready(nxt);
            if constexpr (SP2) {
            PG8_LDB(B0, 0, 0); PG8_LDB(B1, 0, 1); PG8_SCHED; PG8_LDA(At, 0, 0); PG8_STAGE(PG8_SA(1, 1), a1 + hstep, voffA);
            PG8_WAIT_V(8); PG8_WAIT_L(0); PG8_BAR; PG8_MMA(0, 0, At, B0); PG8_MMA(0, 1, At, B1); PG8_BAR; PG8_SCHED;
            PG8_LDA(At, 0, 1); PG8_STAGE(PG8_SB(0, 0), b2, voffB); PG8_STAGE(PG8_SB(0, 1), b2 + hstep, voffB); PG8_STAGE(PG8_SA(0, 0), a2, voffA);
            PG8_WAIT_V(8); PG8_WAIT_L(0); PG8_BAR; PG8_MMA(1, 0, At, B0); PG8_MMA(1, 1, At, B1); PG8_BAR; PG8_SCHED;
            PG8_LDB(B0, 1, 0); PG8_LDB(B1, 1, 1); PG8_SCHED; PG8_LDA(At, 1, 0); PG8_STAGE(PG8_SA(0, 1), a2 + hstep, voffA);
            PG8_WAIT_V(8); PG8_WAIT_L(0); PG8_BAR; PG8_MMA(0, 0, At, B0); PG8_MMA(0, 1, At, B1); PG8_BAR; PG8_SCHED;
            PG8_LDA(At, 1, 1); PG8_STAGE(PG8_SB(1, 0), b3, voffB); PG8_STAGE(PG8_SB(1, 1), b3 + hstep, voffB); PG8_STAGE(PG8_SA(1, 0), a3, voffA);
            PG8_WAIT_V(8); PG8_WAIT_L(0); PG8_BAR; PG8_MMA(1, 0, At, B0); PG8_MMA(1, 1, At, B1); PG8_BAR; PG8_SCHED;
            } else {
            PG8_LDB(B0, 0, 0); PG8_SCHED; PG8_LDA(At, 0, 0); PG8_STAGE(PG8_SA(1, 1), a1 + hstep, voffA);
            PG8_WAIT_L(8); PG8_BAR; PG8_WAIT_L(0); PG8_MMA(0, 0, At, B0); PG8_BAR; PG8_SCHED;
            PG8_LDB(B1, 0, 1); PG8_STAGE(PG8_SB(0, 0), b2, voffB);
            PG8_BAR; PG8_WAIT_L(0); PG8_MMA(0, 1, At, B1); PG8_BAR;
            PG8_LDA(At, 0, 1); PG8_STAGE(PG8_SA(0, 0), a2, voffA);
            PG8_BAR; PG8_WAIT_L(0); PG8_MMA(1, 0, At, B0); PG8_BAR; PG8_SCHED;
            PG8_STAGE(PG8_SB(0, 1), b2 + hstep, voffB);
            PG8_WAIT_V(6); PG8_BAR; PG8_MMA(1, 1, At, B1); PG8_BAR;
            PG8_LDB(B0, 1, 0); PG8_SCHED; PG8_LDA(At, 1, 0); PG8_STAGE(PG8_SA(0, 1), a2 + hstep, voffA);
            PG8_WAIT_L(8); PG8_BAR; PG8_WAIT_L(0); PG8_MMA(0, 0, At, B0); PG8_BAR; PG8_SCHED;
            PG8_LDB(B1, 1, 1); PG8_STAGE(PG8_SB(1, 0), b3, voffB);
            PG8_BAR; PG8_WAIT_L(0); PG8_MMA(0, 1, At, B1); PG8_BAR;
            PG8_LDA(At, 1, 1); PG8_STAGE(PG8_SA(1, 0), a3, voffA);
            PG8_BAR; PG8_WAIT_L(0); PG8_MMA(1, 0, At, B0); PG8_BAR; PG8_SCHED;
            PG8_STAGE(PG8_SB(1, 1), b3 + hstep, voffB);
            PG8_WAIT_V(6); PG8_BAR; PG8_MMA(1, 1, At, B1); PG8_BAR;
            }
        }
        if constexpr (ALIGN_EPI) { if (wr == 0) PG8_BAR; }
        if constexpr (!Epi::AFTER_DRAIN) { E(acc, cur, wr, wc, fr, fq); S.done(cur); }
        if (!has_next) break;
#pragma unroll
        for (int a = 0; a < 2; ++a)
#pragma unroll
            for (int b = 0; b < 2; ++b)
#pragma unroll
                for (int m = 0; m < 4; ++m)
#pragma unroll
                    for (int n = 0; n < 2; ++n) acc[a][b][m][n] = (f32x4){0.f, 0.f, 0.f, 0.f};
        cur = nxt; cA = nA; cB = nB; ++ui;
        if constexpr (ALIGN_EPI) { if (wr == 1) PG8_BAR; }
    }
    PG8_WAIT_V(0);
    if constexpr (!ALIGN_EPI) { if (wr == 0) PG8_BAR; }
    PG8_BAR;
    if constexpr (Epi::AFTER_DRAIN) { E.fused(acc, cur, wr, wc, fr, fq, lds, wid, lane); S.done(cur); }
#undef PG8_SA
#undef PG8_SB
#undef PG8_STAGE
#undef PG8_LDA
#undef PG8_LDB
#undef PG8_MMA
#undef PG8_WAIT_V
#undef PG8_WAIT_L
#undef PG8_BAR
#undef PG8_SCHED
}
}
#define GAS __attribute__((address_space(1)))
#define LAS __attribute__((address_space(3)))
typedef unsigned short bf16;
typedef unsigned v4u __attribute__((ext_vector_type(4)));
typedef float f32x4 __attribute__((ext_vector_type(4)));
typedef short bf16x8 __attribute__((ext_vector_type(8)));
typedef GAS unsigned gu32;
typedef GAS unsigned long long gu64;
#define RLX_AGENT __ATOMIC_RELAXED, __HIP_MEMORY_SCOPE_AGENT
#define LDS_WAIT() asm volatile("s_waitcnt lgkmcnt(0)" ::: "memory")
#define VM_WAIT() asm volatile("s_waitcnt vmcnt(0)" ::: "memory")
__device__ __forceinline__ unsigned long long rt() { return __builtin_amdgcn_s_memrealtime(); }
__device__ __forceinline__ unsigned f2bf(float f) { unsigned u = __builtin_bit_cast(unsigned, f); return (u + 0x7fffu + ((u >> 16) & 1u)) >> 16; }
__device__ __forceinline__ unsigned pk2(float lo, float hi) { return f2bf(lo) | (f2bf(hi) << 16); }
#define XB_TMO      128
#define XB_XCNT(j)  (256  + 64 * (j))
#define XB_XSUB(j)  (1280 + 64 * (j))
#define XB_XGEN(j)  (2304 + 64 * (j))
#define XB_TOP      3328
#define XB_TOPGEN   3392
#define XCD_BAR_WORDS 3456
#define XB_SPIN_CAP (1u << 18)

__device__ __forceinline__ unsigned xb_ld(unsigned* p)              { return __hip_atomic_load(p, __ATOMIC_RELAXED, __HIP_MEMORY_SCOPE_AGENT); }
__device__ __forceinline__ unsigned xb_add(unsigned* p, unsigned v) { return __hip_atomic_fetch_add(p, v, __ATOMIC_RELAXED, __HIP_MEMORY_SCOPE_AGENT); }
__device__ __forceinline__ unsigned xb_xcc_id() { return (unsigned)__builtin_amdgcn_s_getreg((3 << 11) | 20) & 0xFu; }
#define XB_SPIN(cond, bar) do { unsigned _sp = 0; while (cond) { __builtin_amdgcn_s_sleep(1); \
    if ((++_sp & 255u) == 0u) { if (xb_ld(&(bar)[XB_TMO])) break; if (_sp > XB_SPIN_CAP) { atomicAdd(&(bar)[XB_TMO], 1u); break; } } } } while (0)

struct XcdBarrier {
    unsigned* bar; unsigned x;
    volatile LAS unsigned* st;
};

__device__ __forceinline__ XcdBarrier xcd_barrier_post(unsigned* bar, volatile LAS unsigned* st) {
    XcdBarrier b; b.bar = bar; b.x = xb_xcc_id(); b.st = st;
    if (threadIdx.x == 0) (void)xb_add(&bar[XB_XCNT(b.x)], 1u);
    return b;
}
__device__ __forceinline__ void xcd_barrier_complete(unsigned* bar, unsigned x, unsigned& nloc, unsigned& nx) {
    const unsigned G = gridDim.x * gridDim.y * gridDim.z;
    unsigned sum, cnt, mine, sp = 0u;
    for (;;) {
        sum = 0u; cnt = 0u; mine = 0u;
#pragma unroll
        for (unsigned j = 0; j < 16; ++j) { const unsigned c = xb_ld(&bar[XB_XCNT(j)]); sum += c; cnt += (c > 0u) ? 1u : 0u; mine = (j == x) ? c : mine; }
        if (sum == G) break;
        __builtin_amdgcn_s_sleep(1);
        if ((++sp & 255u) == 0u) { if (xb_ld(&bar[XB_TMO])) break; if (sp > XB_SPIN_CAP) { atomicAdd(&bar[XB_TMO], 1u); break; } }
    }
    nloc = mine > 0u ? mine : 1u; nx = cnt > 0u ? cnt : 1u;
}

__device__ __forceinline__ void xcd_barrier(const XcdBarrier& b) {
    asm volatile("s_waitcnt vmcnt(0)" ::: "memory");
    __syncthreads();
    if (threadIdx.x == 0) {
        unsigned* bar = b.bar;
        __builtin_amdgcn_s_waitcnt(0);
        unsigned nloc = b.st[0], nx = b.st[1];
        if (nloc == 0u) { xcd_barrier_complete(bar, b.x, nloc, nx); b.st[0] = nloc; b.st[1] = nx; }
        const unsigned old = xb_add(&bar[XB_XSUB(b.x)], 1u);
        const unsigned gen = old / nloc;
        if (old + 1u == (gen + 1u) * nloc) {
            __builtin_amdgcn_fence(__ATOMIC_RELEASE, "agent");
            asm volatile("s_waitcnt vmcnt(0)" ::: "memory");
            const unsigned og = xb_add(&bar[XB_TOP], 1u);
            const unsigned tg = og / nx;
            if (og + 1u == (tg + 1u) * nx) xb_add(&bar[XB_TOPGEN], 1u);
            else XB_SPIN(xb_ld(&bar[XB_TOPGEN]) == tg, bar);
            __builtin_amdgcn_fence(__ATOMIC_ACQUIRE, "agent");
            xb_add(&bar[XB_XGEN(b.x)], 1u);
            asm volatile("s_waitcnt vmcnt(0)" ::: "memory");
        } else {
            XB_SPIN(xb_ld(&bar[XB_XGEN(b.x)]) == gen, bar);
            __builtin_amdgcn_fence(__ATOMIC_ACQUIRE, "agent");
            asm volatile("s_waitcnt vmcnt(0)" ::: "memory");
        }
    }
    __syncthreads();
}
constexpr int NWAVES = 8, NTHR = 512;
constexpr int D = 1024, SEQ = 16384, DBATCH = 128, MP = SEQ, MS = 512, M = MP + MS;
constexpr int DFF = 2816, INW = 3072, PAST = 8192, WB = 2048, KEEP = 2048, NH = 8;
constexpr float EPS = 1e-6f;
constexpr int C_QA = 0, C_KA = 512, C_VA = 1024, C_QR = 1536, C_KR = 1792, C_VR = 2048, C_GR = 2560;
constexpr size_t O_Y = 0, O_KP = (size_t)M * D, O_VP = O_KP + (size_t)KEEP * 512, O_SP = O_VP + (size_t)KEEP * 512,
                 O_KS = O_SP + 32768, O_VS = O_KS + (size_t)MS * 512, O_SS = O_VS + (size_t)MS * 512, O_END = O_SS + (size_t)DBATCH * 32768;
constexpr size_t MiB = 1u << 20;
constexpr size_t WS_CTL = 0, CTL_ZERO_BYTES = 1 * MiB;
constexpr size_t WS_W1GU = 1 * MiB, WS_W1D = 12 * MiB, WS_WIN = 18 * MiB, WS_WOUT = 24 * MiB, WS_W2GU = 26 * MiB, WS_W2D = 37 * MiB, WS_TAB = 43 * MiB;
constexpr size_t WS_XN = 48 * MiB, WS_H = 81 * MiB, WS_Y = 172 * MiB, WS_HRES = 238 * MiB, WS_QKV = 304 * MiB, WS_MIX = 502 * MiB, WS_UPD = 535 * MiB, WS_SPREV = 551 * MiB, WS_QKVB = 567 * MiB, WS_OPART = 667 * MiB, WS_ML = 716 * MiB, WS_SPART = 720 * MiB, WS_SML = 736 * MiB, WS_END = 737 * MiB;
constexpr int CW_BAR = 4096;
constexpr int RING_BYTES = 131072, LDSCTL_OFF = RING_BYTES, MISC_OFF = LDSCTL_OFF + 320, LDS_BYTES = 147456;

__constant__ float INVF[40] = {
    1.f, 0.193922743f, 0.0376060307f, 0.00729266461f, 0.00141421356f, 0.000274248188f, 5.3182961e-05f, 1.03133862e-05f,
    1.f, 0.749894261f, 0.562341332f, 0.421696514f, 0.316227764f, 0.237137377f, 0.177827939f, 0.133352131f, 0.100000001f, 0.0749894157f,
    0.0562341325f, 0.0421696529f, 0.0316227749f, 0.0237137377f, 0.0177827943f, 0.0133352149f, 0.00999999978f, 0.00749894185f,
    0.00562341325f, 0.00421696482f, 0.00316227763f, 0.00237137359f, 0.00177827943f, 0.00133352145f, 0.00100000005f, 0.000749894243f,
    0.000562341302f, 0.000421696517f, 0.000316227757f, 0.00023713737f, 0.00017782794f, 0.00013335215f};
__device__ __forceinline__ float log_g(int h) { return h == 0 ? -0.0317486983145803f : h == 1 ? -0.015748356968139168f : h == 2 ? -0.007843177461025893f : -0.003913899321136329f; }
__device__ __forceinline__ float wave_sum(float v) {
#pragma unroll
    for (int o = 32; o >= 1; o >>= 1) v += __shfl_xor(v, o);
    return v;
}
__device__ __forceinline__ float wave_max(float v) {
#pragma unroll
    for (int o = 32; o >= 1; o >>= 1) v = fmaxf(v, __shfl_xor(v, o));
    return v;
}
__device__ __forceinline__ float silu_f(float x) { return x / (1.f + expf(-x)); }

__host__ __device__ __forceinline__ int win_perm(int col) {
    if (col < 1024) { const int dd = col & 63; return dd < 16 ? (col & ~63) + 8 * ((dd >> 2) & 1) + 4 * (dd >> 3) + (dd & 3) : col; }
    if (col >= 1536 && col < 2048) { const int dd = col & 63; return (col & ~63) + 8 * ((dd & 31) >> 2) + 4 * (dd >> 5) + (dd & 3); }
    return col;
}
__device__ __forceinline__ void tr_item(const float* W, int K, int N, bf16* WT, int mode, LAS float* scr, int item, int lane) {
    const int nblk = N / 32, kb = item / nblk, nb = item % nblk, k0 = 64 * kb, n0 = 32 * nb;
    const int rbase = mode == 0 ? n0 : (256 * (n0 >> 7) + (n0 & 127) + (mode == 2 ? 128 : 0));
#pragma unroll 8
    for (int i = 0; i < 32; ++i) { const int kk = 2 * i + (lane >> 5); scr[kk * 33 + (lane & 31)] = W[(size_t)(k0 + kk) * N + n0 + (lane & 31)]; }
    LDS_WAIT(); asm volatile("" ::: "memory");
    const int c = lane & 7;
#pragma unroll
    for (int j = 0; j < 4; ++j) { const int n = (lane >> 3) + 8 * j; const LAS float* s = scr + (8 * c) * 33 + n;
        v4u o; o.x = pk2(s[0 * 33], s[1 * 33]); o.y = pk2(s[2 * 33], s[3 * 33]); o.z = pk2(s[4 * 33], s[5 * 33]); o.w = pk2(s[6 * 33], s[7 * 33]);
        const int orow = mode == 3 ? win_perm(n0 + n) : rbase + n;
        *(GAS v4u*)(WT + (size_t)orow * K + k0 + 8 * c) = o; }
    LDS_WAIT(); asm volatile("" ::: "memory");
}
struct Ptrs {
    const float *xp, *xs, *ck, *cv, *st, *g1a, *g1b, *w1g, *w1u, *w1d, *gma, *gmb, *win, *gnw, *wout, *g2a, *g2b, *w2g, *w2u, *w2d;
    float* out;
    bf16 *W1GU, *W1D, *WIN, *WOUT, *W2GU, *W2D, *XN, *H, *MIX;
    float2* TAB; float *Y, *HRES, *QKV, *UPD; bf16 *SPT, *QKVb, *OPART; float2 *ML, *SML; float* SPART;
};
__device__ __forceinline__ void p0_prologue(const Ptrs& P, LAS unsigned char* lds, int gw, int NGW, int wave, int lane, int gtid, int NGT) {
    LAS float* scr = (LAS float*)(lds + wave * 16384);
    constexpr int I_GU = 16 * 88, I_D = 44 * 32, I_IN = 16 * 96, I_OUT = 16 * 32;
    constexpr int NITEMS = 6 * I_GU + I_IN + I_OUT;
    static_assert(I_D == I_GU, "items");
    for (int it = gw; it < NITEMS; it += NGW) {
        int r = it;
        if (r < I_GU) { tr_item(P.w1g, D, DFF, P.W1GU, 1, scr, r, lane); continue; } r -= I_GU;
        if (r < I_GU) { tr_item(P.w1u, D, DFF, P.W1GU, 2, scr, r, lane); continue; } r -= I_GU;
        if (r < I_D) { tr_item(P.w1d, DFF, D, P.W1D, 0, scr, r, lane); continue; } r -= I_D;
        if (r < I_GU) { tr_item(P.w2g, D, DFF, P.W2GU, 1, scr, r, lane); continue; } r -= I_GU;
        if (r < I_GU) { tr_item(P.w2u, D, DFF, P.W2GU, 2, scr, r, lane); continue; } r -= I_GU;
        if (r < I_D) { tr_item(P.w2d, DFF, D, P.W2D, 0, scr, r, lane); continue; } r -= I_D;
        if (r < I_IN) { tr_item(P.win, D, INW, P.WIN, 3, scr, r, lane); continue; } r -= I_IN;
        tr_item(P.wout, D, D, P.WOUT, 0, scr, r, lane);
    }
    for (int idx = gtid; idx < SEQ * 40; idx += NGT) {
        const int pos = idx / 40, f = idx % 40;
        const float ang = (float)pos * INVF[f];
        const double rev = (double)ang * 0.15915494309189535;
        const float fr = (float)(rev - rint(rev));
        P.TAB[idx] = make_float2(__builtin_amdgcn_cosf(fr), __builtin_amdgcn_sinf(fr));
    }
    for (int r = gw; r < M; r += NGW) {
        const float4* x = (const float4*)(r < MP ? P.xp + (size_t)r * D : P.xs + (size_t)(r - MP) * D);
        float4 v[4]; float ss = 0.f;
#pragma unroll
        for (int j = 0; j < 4; ++j) { v[j] = x[lane + 64 * j]; ss += v[j].x * v[j].x + v[j].y * v[j].y + v[j].z * v[j].z + v[j].w * v[j].w; }
        const float rstd = 1.f / sqrtf(wave_sum(ss) * (1.f / D) + EPS);
        uint2* o = (uint2*)(P.XN + (size_t)r * D);
#pragma unroll
        for (int j = 0; j < 4; ++j) { const float4 gg = ((const float4*)P.g1a)[lane + 64 * j];
            o[lane + 64 * j] = make_uint2(pk2(v[j].x * rstd * gg.x, v[j].y * rstd * gg.y), pk2(v[j].z * rstd * gg.z, v[j].w * rstd * gg.w)); }
    }
}
__device__ __forceinline__ void norm_res_phase(const float* resA, const float* resB, const float* Y, const float* gpost, float scale, float* hout, const float* gnext, bf16* XN, int gw, int NGW, int lane) {
    for (int r = gw; r < M; r += NGW) {
        const float4* x = (const float4*)(r < MP ? resA + (size_t)r * D : resB + (size_t)(r - MP) * D);
        const float4* y = (const float4*)(Y + (size_t)r * D);
        float4 v[4], hv[4]; float ss = 0.f;
#pragma unroll
        for (int j = 0; j < 4; ++j) { v[j] = y[lane + 64 * j]; hv[j] = x[lane + 64 * j]; ss += v[j].x * v[j].x + v[j].y * v[j].y + v[j].z * v[j].z + v[j].w * v[j].w; }
        const float rstd = scale / sqrtf(wave_sum(ss) * (1.f / D) + EPS);
        float s2 = 0.f;
#pragma unroll
        for (int j = 0; j < 4; ++j) { const float4 gg = ((const float4*)gpost)[lane + 64 * j];
            hv[j].x += v[j].x * rstd * gg.x; hv[j].y += v[j].y * rstd * gg.y; hv[j].z += v[j].z * rstd * gg.z; hv[j].w += v[j].w * rstd * gg.w;
            s2 += hv[j].x * hv[j].x + hv[j].y * hv[j].y + hv[j].z * hv[j].z + hv[j].w * hv[j].w; }
        float4* ho = (float4*)(hout + (size_t)r * D);
#pragma unroll
        for (int j = 0; j < 4; ++j) ho[lane + 64 * j] = hv[j];
        if (gnext) {
            const float r2 = 1.f / sqrtf(wave_sum(s2) * (1.f / D) + EPS);
            uint2* o = (uint2*)(XN + (size_t)r * D);
#pragma unroll
            for (int j = 0; j < 4; ++j) { const float4 gg = ((const float4*)gnext)[lane + 64 * j];
                o[lane + 64 * j] = make_uint2(pk2(hv[j].x * r2 * gg.x, hv[j].y * r2 * gg.y), pk2(hv[j].z * r2 * gg.z, hv[j].w * r2 * gg.w)); }
        }
    }
}
typedef float f32x16 __attribute__((ext_vector_type(16)));
typedef short s16x4 __attribute__((ext_vector_type(4)));
typedef float f32x2_t __attribute__((ext_vector_type(2)));
typedef __bf16 bf16x2_t __attribute__((ext_vector_type(2)));
__device__ __forceinline__ unsigned cvtpk(float lo, float hi) { f32x2_t v = {lo, hi}; bf16x2_t b = __builtin_convertvector(v, bf16x2_t); return __builtin_bit_cast(unsigned, b); }
__device__ __forceinline__ s16x4 vtr(const LAS unsigned char* p) { return __builtin_bit_cast(s16x4, __builtin_amdgcn_ds_read_tr16_b64_v4i16((LAS s16x4*)p)); }
#define MFMA32(a, b, c) __builtin_amdgcn_mfma_f32_32x32x16_bf16((a), (b), (c), 0, 0, 0)
__device__ __forceinline__ int crow(int reg, int hh) { return (reg & 3) + 8 * (reg >> 2) + 4 * hh; }
__device__ __forceinline__ float bf_lo(unsigned u) { return __builtin_bit_cast(float, u << 16); }
__device__ __forceinline__ float bf_hi(unsigned u) { return __builtin_bit_cast(float, u & 0xffff0000u); }
constexpr float QSCALE = 0.125f * 1.4426950408889634f;

__device__ __forceinline__ void sk_tile(LAS unsigned char* lds, const bf16* A, int lda, const bf16* Wt, int K, int r0, int c0, int tid, int wave, int lane) {
    const int i = lane & 31, hh = lane >> 5;
    const int ksl = K >> 3, k0 = wave * ksl;
    const bf16* ap = A + (size_t)(r0 + i) * lda + k0 + 8 * hh;
    const bf16* bp0 = Wt + (size_t)(c0 + i) * K + k0 + 8 * hh;
    const bf16* bp1 = bp0 + (size_t)32 * K;
    f32x16 acc0, acc1;
#pragma unroll
    for (int e = 0; e < 16; ++e) { acc0[e] = 0.f; acc1[e] = 0.f; }
#pragma unroll 4
    for (int ks = 0; ks < (ksl >> 4); ++ks) {
        const bf16x8 a = *(const bf16x8*)(ap + 16 * ks), b0 = *(const bf16x8*)(bp0 + 16 * ks), b1 = *(const bf16x8*)(bp1 + 16 * ks);
        acc0 = MFMA32(a, b0, acc0); acc1 = MFMA32(a, b1, acc1);
    }
    LAS float* part = (LAS float*)lds + wave * 2048;
#pragma unroll
    for (int e = 0; e < 16; ++e) { const int row = crow(e, hh); part[row * 64 + i] = acc0[e]; part[row * 64 + 32 + i] = acc1[e]; }
    __syncthreads();
    {
        const LAS f32x4* p4 = (const LAS f32x4*)lds + tid;
        f32x4 s = p4[0];
#pragma unroll
        for (int w = 1; w < 8; ++w) s += p4[w * 512];
        ((LAS f32x4*)(lds + 65536))[tid] = s;
    }
    __syncthreads();
}
__device__ __forceinline__ void sk_gemm_y(LAS unsigned char* lds, const bf16* A, int lda, const bf16* Wt, int K, float* Y, int tid, int wave, int lane) {
    for (int item = blockIdx.x; item < 256; item += gridDim.x) {
        const int rt = item >> 4, ct = item & 15;
        sk_tile(lds, A, lda, Wt, K, MP + 32 * rt, 64 * ct, tid, wave, lane);
        const f32x4 v = ((const LAS f32x4*)(lds + 65536))[tid];
        *(f32x4*)(Y + (size_t)(MP + 32 * rt + (tid >> 4)) * D + 64 * ct + 4 * (tid & 15)) = v;
        __syncthreads();
    }
}
__device__ __forceinline__ void sk_gemm_qkv(LAS unsigned char* lds, const bf16* XN, const bf16* WIN, bf16* QKVb, const float2* tab, float* out, int tid, int wave, int lane) {
    const LAS float* red = (const LAS float*)(lds + 65536);
    for (int item = blockIdx.x; item < 768; item += gridDim.x) {
        const int rt = item / 48, ct = item % 48;
        sk_tile(lds, XN, D, WIN, D, MP + 32 * rt, 64 * ct, tid, wave, lane);
        const int row = tid >> 4, c4 = tid & 15, srow = 32 * rt + row, pos = PAST + (srow & 3), nc0 = 64 * ct;
        float y[4];
#pragma unroll
        for (int k = 0; k < 4; ++k) {
            const int dd = 4 * c4 + k;
            const float x = red[row * 64 + (win_perm(nc0 + dd) - nc0)];
            float r = x;
            if (ct < 16) {
                if (dd < 16) { const float xp = red[row * 64 + (win_perm(nc0 + (dd ^ 8)) - nc0)]; const float2 cs = tab[pos * 40 + (dd & 7)];
                    r = dd < 8 ? x * cs.x - xp * cs.y : x * cs.x + xp * cs.y; }
                if (ct < 8) r *= QSCALE;
            } else if (ct >= 24 && ct < 32) {
                const float xp = red[row * 64 + (win_perm(nc0 + (dd ^ 32)) - nc0)]; const float2 cs = tab[pos * 40 + 8 + (dd & 31)];
                r = dd < 32 ? x * cs.x - xp * cs.y : x * cs.x + xp * cs.y;
                if (ct >= 28) r *= 0.125f;
            }
            y[k] = r;
        }
        *(uint2*)(QKVb + (size_t)(MP + srow) * INW + nc0 + 4 * c4) = make_uint2(cvtpk(y[0], y[1]), cvtpk(y[2], y[3]));
        if (ct >= 8 && ct < 16) *(float4*)(out + O_KS + (size_t)srow * 512 + (nc0 - C_KA) + 4 * c4) = make_float4(y[0], y[1], y[2], y[3]);
        if (ct >= 16 && ct < 24) *(float4*)(out + O_VS + (size_t)srow * 512 + (nc0 - C_VA) + 4 * c4) = make_float4(y[0], y[1], y[2], y[3]);
        __syncthreads();
    }
}
__device__ __forceinline__ void attn_mfma_phase(LAS unsigned char* lds, const bf16* QKVb, bf16* OPART, float2* ML, int gw, int NGW, int wave, int lane) {
    LAS unsigned char* vt = lds + wave * 6144;
    const int i = lane & 31, hh = lane >> 5, i16 = lane & 15, tq = i16 >> 2, tp = i16 & 3, blk = (lane >> 4) & 1;
    constexpr int NITEM = 3 * 4096;
    const int per = (NITEM + NGW - 1) / NGW;
    const int i_beg = gw * per, i_end = (i_beg + per < NITEM) ? i_beg + per : NITEM;
    for (int idx = i_beg; idx < i_end; ++idx) {
        const int b = idx >> 12, rem = idx & 4095, h = rem >> 9, within = rem & 511;
        const int dsh = 2 * b, d = 1 << dsh, r = within >> (9 - dsh), qt = within & ((512 >> dsh) - 1), l0 = qt * 32;
        const int tok_q = (l0 + i) * d + r;
        const bf16* qp = QKVb + (size_t)tok_q * INW + C_QA + h * 64 + 8 * hh;
        bf16x8 qf[4];
#pragma unroll
        for (int ks = 0; ks < 4; ++ks) qf[ks] = *(const bf16x8*)(qp + 16 * ks);
        f32x16 o0, o1;
#pragma unroll
        for (int e = 0; e < 16; ++e) { o0[e] = 0.f; o1[e] = 0.f; }
        float m = -1e30f, l = 0.f;
        const int kt0 = l0 >= 128 ? 0 : ((128 - l0) >> 5);
        for (int kt = kt0; kt < 5; ++kt) {
            const int lk0 = l0 - 128 + 32 * kt;
            const bf16* kp = QKVb + (size_t)((lk0 + i) * d + r) * INW + C_KA + h * 64 + 8 * hh;
            bf16x8 kf[4];
#pragma unroll
            for (int ks = 0; ks < 4; ++ks) kf[ks] = *(const bf16x8*)(kp + 16 * ks);
            v4u vreg[4];
#pragma unroll
            for (int c = 0; c < 4; ++c) { const int rowk = (lane >> 3) + 8 * c;
                vreg[c] = *(const v4u*)(QKVb + (size_t)((lk0 + rowk) * d + r) * INW + C_VA + h * 64 + 8 * (lane & 7)); }
            f32x16 s;
#pragma unroll
            for (int e = 0; e < 16; ++e) s[e] = 0.f;
#pragma unroll
            for (int ks = 0; ks < 4; ++ks) s = MFMA32(kf[ks], qf[ks], s);
#pragma unroll
            for (int c = 0; c < 4; ++c) { const int rowk = (lane >> 3) + 8 * c; *(LAS v4u*)(vt + rowk * 192 + 16 * (lane & 7)) = vreg[c]; }
            float tm = -1e30f;
#pragma unroll
            for (int e = 0; e < 16; ++e) { const int j = crow(e, hh); const bool bad = (kt == 0 && j < i) || (kt == 4 && j > i); s[e] = bad ? -1e30f : s[e]; tm = fmaxf(tm, s[e]); }
            tm = fmaxf(tm, __shfl_xor(tm, 32));
            const float mn = fmaxf(m, tm), scl = __builtin_amdgcn_exp2f(m - mn);
            m = mn; l *= scl;
#pragma unroll
            for (int e = 0; e < 16; ++e) { o0[e] *= scl; o1[e] *= scl; }
            float psum = 0.f;
#pragma unroll
            for (int e = 0; e < 16; ++e) { s[e] = __builtin_amdgcn_exp2f(s[e] - mn); psum += s[e]; }
            l += psum;
            v4u pw0, pw1;
            pw0.x = cvtpk(s[0], s[1]); pw0.y = cvtpk(s[2], s[3]); pw0.z = cvtpk(s[4], s[5]); pw0.w = cvtpk(s[6], s[7]);
            pw1.x = cvtpk(s[8], s[9]); pw1.y = cvtpk(s[10], s[11]); pw1.z = cvtpk(s[12], s[13]); pw1.w = cvtpk(s[14], s[15]);
            const bf16x8 pf0 = __builtin_bit_cast(bf16x8, pw0), pf1 = __builtin_bit_cast(bf16x8, pw1);
            asm volatile("" ::: "memory");
#pragma unroll
            for (int st = 0; st < 2; ++st) {
                const LAS unsigned char* a0 = vt + (16 * st + 4 * hh + tq) * 192 + (16 * blk + 4 * tp) * 2;
                const s16x4 lo0 = vtr(a0), hi0 = vtr(a0 + 8 * 192), lo1 = vtr(a0 + 64), hi1 = vtr(a0 + 8 * 192 + 64);
                const bf16x8 v0 = __builtin_shufflevector(lo0, hi0, 0, 1, 2, 3, 4, 5, 6, 7), v1 = __builtin_shufflevector(lo1, hi1, 0, 1, 2, 3, 4, 5, 6, 7);
                o0 = MFMA32(v0, st == 0 ? pf0 : pf1, o0);
                o1 = MFMA32(v1, st == 0 ? pf0 : pf1, o1);
            }
            asm volatile("" ::: "memory");
        }
        const float lt = l + __shfl_xor(l, 32), inv = 1.f / lt;
        bf16* op = OPART + ((size_t)b * MP + tok_q) * 512 + h * 64 + 4 * hh;
#pragma unroll
        for (int g = 0; g < 4; ++g) {
            *(uint2*)(op + 8 * g) = make_uint2(cvtpk(o0[4 * g] * inv, o0[4 * g + 1] * inv), cvtpk(o0[4 * g + 2] * inv, o0[4 * g + 3] * inv));
            *(uint2*)(op + 32 + 8 * g) = make_uint2(cvtpk(o1[4 * g] * inv, o1[4 * g + 1] * inv), cvtpk(o1[4 * g + 2] * inv, o1[4 * g + 3] * inv));
        }
        if (hh == 0) ML[((size_t)b * MP + tok_q) * 8 + h] = make_float2(m, lt);
    }
}
__device__ __forceinline__ void attn_combine_phase(const bf16* OPART, const float2* ML, bf16* MIX, int gtid, int NGT) {
    for (int idx = gtid; idx < MP * 64; idx += NGT) {
        const int tok = idx >> 6, h = (idx >> 3) & 7, c = idx & 7;
        const float2 a0 = ML[((size_t)0 * MP + tok) * 8 + h], a1 = ML[((size_t)1 * MP + tok) * 8 + h], a2 = ML[((size_t)2 * MP + tok) * 8 + h];
        const float mx = fmaxf(a0.x, fmaxf(a1.x, a2.x));
        float w0 = a0.y * __builtin_amdgcn_exp2f(a0.x - mx), w1 = a1.y * __builtin_amdgcn_exp2f(a1.x - mx), w2 = a2.y * __builtin_amdgcn_exp2f(a2.x - mx);
        const float iw = 1.f / (w0 + w1 + w2); w0 *= iw; w1 *= iw; w2 *= iw;
        const v4u x0 = *(const v4u*)(OPART + ((size_t)0 * MP + tok) * 512 + h * 64 + 8 * c);
        const v4u x1 = *(const v4u*)(OPART + ((size_t)1 * MP + tok) * 512 + h * 64 + 8 * c);
        const v4u x2 = *(const v4u*)(OPART + ((size_t)2 * MP + tok) * 512 + h * 64 + 8 * c);
        v4u o;
        o.x = cvtpk(w0 * bf_lo(x0.x) + w1 * bf_lo(x1.x) + w2 * bf_lo(x2.x), w0 * bf_hi(x0.x) + w1 * bf_hi(x1.x) + w2 * bf_hi(x2.x));
        o.y = cvtpk(w0 * bf_lo(x0.y) + w1 * bf_lo(x1.y) + w2 * bf_lo(x2.y), w0 * bf_hi(x0.y) + w1 * bf_hi(x1.y) + w2 * bf_hi(x2.y));
        o.z = cvtpk(w0 * bf_lo(x0.z) + w1 * bf_lo(x1.z) + w2 * bf_lo(x2.z), w0 * bf_hi(x0.z) + w1 * bf_hi(x1.z) + w2 * bf_hi(x2.z));
        o.w = cvtpk(w0 * bf_lo(x0.w) + w1 * bf_lo(x1.w) + w2 * bf_lo(x2.w), w0 * bf_hi(x0.w) + w1 * bf_hi(x1.w) + w2 * bf_hi(x2.w));
        *(v4u*)(MIX + (size_t)tok * D + h * 64 + 8 * c) = o;
    }
}
__device__ __forceinline__ void ret_out_mfma_phase(LAS unsigned char* lds, const bf16* QKVb, const bf16* SPT, const float* gnw, bf16* MIX, int tid, int wave, int lane) {
    constexpr int RSV = 272;
    const int grp = wave >> 2, itile = wave & 3;
    LAS unsigned char* vb = lds + grp * (128 * RSV);
    const int i = lane & 31, hh = lane >> 5, i16 = lane & 15, tq = i16 >> 2, tp = i16 & 3, blk = (lane >> 4) & 1;
    for (int it = blockIdx.x; it < 256; it += gridDim.x) {
        const int item = it * 2 + grp, n = item >> 2, h = item & 3;
        const float lg2 = log_g(h) * 1.4426950408889634f;
        {
            const int t4 = tid & 255;
#pragma unroll
            for (int c = 0; c < 8; ++c) { const int e = t4 + 256 * c, rowk = e >> 4, ch = e & 15;
                *(LAS v4u*)(vb + rowk * RSV + 16 * ch) = *(const v4u*)(QKVb + (size_t)(n * 128 + rowk) * INW + C_VR + h * 128 + 8 * ch); }
        }
        __syncthreads();
        const int row_i = n * 128 + 32 * itile + i;
        bf16x8 qf[4];
#pragma unroll
        for (int ks = 0; ks < 4; ++ks) qf[ks] = *(const bf16x8*)(QKVb + (size_t)row_i * INW + C_QR + h * 64 + 16 * ks + 8 * hh);
        f32x16 acc[4];
#pragma unroll
        for (int dt = 0; dt < 4; ++dt) {
#pragma unroll
            for (int e = 0; e < 16; ++e) acc[dt][e] = 0.f;
#pragma unroll
            for (int ks = 0; ks < 4; ++ks) { const bf16x8 a = *(const bf16x8*)(SPT + ((size_t)(n * 4 + h) * 128 + 32 * dt + i) * 64 + 16 * ks + 8 * hh); acc[dt] = MFMA32(a, qf[ks], acc[dt]); }
        }
        const float wh = __builtin_amdgcn_exp2f((float)(32 * itile + i + 1) * lg2);
#pragma unroll
        for (int dt = 0; dt < 4; ++dt)
#pragma unroll
            for (int e = 0; e < 16; ++e) acc[dt][e] *= wh;
        for (int jt = 0; jt <= itile; ++jt) {
            bf16x8 kf[4];
#pragma unroll
            for (int ks = 0; ks < 4; ++ks) kf[ks] = *(const bf16x8*)(QKVb + (size_t)(n * 128 + 32 * jt + i) * INW + C_KR + h * 64 + 16 * ks + 8 * hh);
            f32x16 s;
#pragma unroll
            for (int e = 0; e < 16; ++e) s[e] = 0.f;
#pragma unroll
            for (int ks = 0; ks < 4; ++ks) s = MFMA32(kf[ks], qf[ks], s);
#pragma unroll
            for (int e = 0; e < 16; ++e) { const int dl = 32 * (itile - jt) + i - crow(e, hh); s[e] = dl >= 0 ? s[e] * __builtin_amdgcn_exp2f((float)dl * lg2) : 0.f; }
            v4u pw0, pw1;
            pw0.x = cvtpk(s[0], s[1]); pw0.y = cvtpk(s[2], s[3]); pw0.z = cvtpk(s[4], s[5]); pw0.w = cvtpk(s[6], s[7]);
            pw1.x = cvtpk(s[8], s[9]); pw1.y = cvtpk(s[10], s[11]); pw1.z = cvtpk(s[12], s[13]); pw1.w = cvtpk(s[14], s[15]);
            const bf16x8 pf0 = __builtin_bit_cast(bf16x8, pw0), pf1 = __builtin_bit_cast(bf16x8, pw1);
#pragma unroll
            for (int st = 0; st < 2; ++st) {
                const LAS unsigned char* a0 = vb + (32 * jt + 16 * st + 4 * hh + tq) * RSV + (16 * blk + 4 * tp) * 2;
#pragma unroll
                for (int dt = 0; dt < 4; ++dt) {
                    const s16x4 lo = vtr(a0 + 64 * dt), hi = vtr(a0 + 8 * RSV + 64 * dt);
                    const bf16x8 vf = __builtin_shufflevector(lo, hi, 0, 1, 2, 3, 4, 5, 6, 7);
                    acc[dt] = MFMA32(vf, st == 0 ? pf0 : pf1, acc[dt]);
                }
            }
        }
        float s1 = 0.f;
#pragma unroll
        for (int dt = 0; dt < 4; ++dt)
#pragma unroll
            for (int e = 0; e < 16; ++e) s1 += acc[dt][e];
        s1 += __shfl_xor(s1, 32);
        const float mu = s1 * (1.f / 128.f);
        float s2 = 0.f;
#pragma unroll
        for (int dt = 0; dt < 4; ++dt)
#pragma unroll
            for (int e = 0; e < 16; ++e) { const float dd = acc[dt][e] - mu; s2 += dd * dd; }
        s2 += __shfl_xor(s2, 32);
        const float rstd = 1.f / sqrtf(s2 * (1.f / 128.f) + EPS);
#pragma unroll
        for (int dt = 0; dt < 4; ++dt)
#pragma unroll
            for (int g = 0; g < 4; ++g) {
                const int dv0 = 32 * dt + 8 * g + 4 * hh;
                const uint2 gr = *(const uint2*)(QKVb + (size_t)row_i * INW + C_GR + h * 128 + dv0);
                const float4 gw4 = *(const float4*)(gnw + h * 128 + dv0);
                const float y0 = (acc[dt][4 * g] - mu) * rstd * gw4.x * silu_f(bf_lo(gr.x)), y1 = (acc[dt][4 * g + 1] - mu) * rstd * gw4.y * silu_f(bf_hi(gr.x));
                const float y2 = (acc[dt][4 * g + 2] - mu) * rstd * gw4.z * silu_f(bf_lo(gr.y)), y3 = (acc[dt][4 * g + 3] - mu) * rstd * gw4.w * silu_f(bf_hi(gr.y));
                *(uint2*)(MIX + (size_t)row_i * D + 512 + h * 128 + dv0) = make_uint2(cvtpk(y0, y1), cvtpk(y2, y3));
            }
        __syncthreads();
    }
}
template <int CTRL> __device__ __forceinline__ float dppf(float x) { return __builtin_bit_cast(float, __builtin_amdgcn_mov_dpp(__builtin_bit_cast(int, x), CTRL, 0xf, 0xf, true)); }
__device__ __forceinline__ float row16_sum(float v) { v += dppf<0xB1>(v); v += dppf<0x4E>(v); v += dppf<0x141>(v); v += dppf<0x128>(v); return v; }
constexpr int SA_CH = 15, SA_KPC = 60;
__device__ __forceinline__ void sa_rows(int kk, int b, const float* ck, const float* cv, const float* out, const float*& kr, const float*& vr, int& e) {
    e = kk < 516 ? kk : 528 + 16 * ((kk - 516) >> 2) + ((kk - 516) & 3);
    const int idx = 2051 - e;
    if (idx >= WB) { kr = out + O_KS + (size_t)(b * 4 + idx - WB) * 512; vr = out + O_VS + (size_t)(b * 4 + idx - WB) * 512; }
    else { kr = ck + ((size_t)b * WB + idx) * 512; vr = cv + ((size_t)b * WB + idx) * 512; }
}
__device__ __forceinline__ void attn_sample_phase(const bf16* QKVb, const float* ck, const float* cv, const float* out, float* SPART, float2* SML, int gw, int NGW, int lane) {
    const int l16 = lane & 15, hq = lane >> 4;
    for (int item = gw; item < DBATCH * SA_CH; item += NGW) {
        const int b = item / SA_CH, c = item % SA_CH;
        f32x4 q[4][2], o[4][2]; float m[4][2], l[4][2];
#pragma unroll
        for (int i = 0; i < 4; ++i)
#pragma unroll
            for (int u = 0; u < 2; ++u) {
                { const uint2 qq = *(const uint2*)(QKVb + (size_t)(MP + b * 4 + i) * INW + C_QA + (4 * u + hq) * 64 + 4 * l16); q[i][u] = (f32x4){bf_lo(qq.x), bf_hi(qq.x), bf_lo(qq.y), bf_hi(qq.y)}; }
                o[i][u] = (f32x4){0.f, 0.f, 0.f, 0.f}; m[i][u] = -1e30f; l[i][u] = 0.f;
            }
        for (int g = 0; g < SA_KPC / 4; ++g) {
            f32x4 kx[4][2], vx[4][2]; int ee[4];
#pragma unroll
            for (int t = 0; t < 4; ++t) {
                const float *kr, *vr; sa_rows(c * SA_KPC + g * 4 + t, b, ck, cv, out, kr, vr, ee[t]);
                kx[t][0] = *(const f32x4*)(kr + 4 * lane); kx[t][1] = *(const f32x4*)(kr + 256 + 4 * lane);
                vx[t][0] = *(const f32x4*)(vr + 4 * lane); vx[t][1] = *(const f32x4*)(vr + 256 + 4 * lane);
            }
#pragma unroll
            for (int t = 0; t < 4; ++t)
#pragma unroll
                for (int i = 0; i < 4; ++i) {
                    const int dl = ee[t] - 3 + i;
                    const int mult = dl >= 0 ? (int)(dl <= 128) + (int)(((dl & 3) == 0) && dl <= 512) + (int)(((dl & 15) == 0) && dl <= 2048) : 0;
                    if (mult) {
                        const float fm = (float)mult;
#pragma unroll
                        for (int u = 0; u < 2; ++u) {
                            const f32x4 pr = q[i][u] * kx[t][u];
                            const float s = row16_sum((pr[0] + pr[1]) + (pr[2] + pr[3]));
                            const float mn = fmaxf(m[i][u], s), scl = __builtin_amdgcn_exp2f(m[i][u] - mn), p = fm * __builtin_amdgcn_exp2f(s - mn);
                            m[i][u] = mn; l[i][u] = l[i][u] * scl + p; o[i][u] = o[i][u] * scl + vx[t][u] * p;
                        }
                    }
                }
        }
#pragma unroll
        for (int i = 0; i < 4; ++i)
#pragma unroll
            for (int u = 0; u < 2; ++u) {
                const size_t base = ((size_t)(b * SA_CH + c) * 4 + i) * 8 + 4 * u + hq;
                *(f32x4*)(SPART + base * 64 + 4 * l16) = o[i][u];
                if (l16 == 0) SML[base] = make_float2(m[i][u], l[i][u]);
            }
    }
}
__device__ __forceinline__ void attn_sample_merge_phase(const float* SPART, const float2* SML, bf16* MIX, int gw, int NGW, int lane) {
    for (int item = gw; item < DBATCH * 32; item += NGW) {
        const int b = item >> 5, i = (item >> 3) & 3, h = item & 7;
        float2 ml[SA_CH]; float mx = -1e30f;
#pragma unroll
        for (int c = 0; c < SA_CH; ++c) { ml[c] = SML[((size_t)(b * SA_CH + c) * 4 + i) * 8 + h]; mx = fmaxf(mx, ml[c].x); }
        float acc = 0.f, L = 0.f;
#pragma unroll
        for (int c = 0; c < SA_CH; ++c) { const float w = __builtin_amdgcn_exp2f(ml[c].x - mx); L += w * ml[c].y; acc += w * SPART[(((size_t)(b * SA_CH + c) * 4 + i) * 8 + h) * 64 + lane]; }
        MIX[(size_t)(MP + b * 4 + i) * D + h * 64 + lane] = (bf16)f2bf(acc / L);
    }
}
__device__ __forceinline__ void ret_upd_phase(LAS unsigned char* lds, const bf16* __restrict__ QKVb, float* __restrict__ UPD, int tid) {
    LAS float* kc = (LAS float*)lds;
    LAS float* vc = (LAS float*)(lds + 32768);
    for (int it = blockIdx.x; it < 512; it += gridDim.x) {
        const int n = it >> 2, h = it & 3;
        const float lg = log_g(h);
#pragma unroll
        for (int c = 0; c < 2; ++c) { const int e = tid + NTHR * c, j = e >> 3, ch = e & 7;
            const v4u x = *(const v4u*)(QKVb + (size_t)(n * 128 + j) * INW + C_KR + h * 64 + 8 * ch);
            const float w = expf((float)(127 - j) * lg);
            *(LAS f32x4*)(kc + j * 64 + 8 * ch) = (f32x4){bf_lo(x.x) * w, bf_hi(x.x) * w, bf_lo(x.y) * w, bf_hi(x.y) * w};
            *(LAS f32x4*)(kc + j * 64 + 8 * ch + 4) = (f32x4){bf_lo(x.z) * w, bf_hi(x.z) * w, bf_lo(x.w) * w, bf_hi(x.w) * w}; }
#pragma unroll
        for (int c = 0; c < 4; ++c) { const int e = tid + NTHR * c, j = e >> 4, ch = e & 15;
            const v4u x = *(const v4u*)(QKVb + (size_t)(n * 128 + j) * INW + C_VR + h * 128 + 8 * ch);
            *(LAS f32x4*)(vc + j * 128 + 8 * ch) = (f32x4){bf_lo(x.x), bf_hi(x.x), bf_lo(x.y), bf_hi(x.y)};
            *(LAS f32x4*)(vc + j * 128 + 8 * ch + 4) = (f32x4){bf_lo(x.z), bf_hi(x.z), bf_lo(x.w), bf_hi(x.w)}; }
        __syncthreads();
        const int dv = tid & 127, qt = tid >> 7;
        float acc[16];
#pragma unroll
        for (int i = 0; i < 16; ++i) acc[i] = 0.f;
#pragma unroll 4
        for (int j = 0; j < 128; ++j) {
            const float vj = vc[j * 128 + dv];
#pragma unroll
            for (int i = 0; i < 16; i += 4) { const f32x4 k4 = *(const LAS f32x4*)(kc + j * 64 + qt * 16 + i);
                acc[i] += k4[0] * vj; acc[i + 1] += k4[1] * vj; acc[i + 2] += k4[2] * vj; acc[i + 3] += k4[3] * vj; }
        }
#pragma unroll
        for (int i = 0; i < 16; i += 4) *(float4*)(UPD + ((size_t)(n * 4 + h) * 128 + dv) * 64 + qt * 16 + i) = make_float4(acc[i], acc[i + 1], acc[i + 2], acc[i + 3]);
        __syncthreads();
    }
}
__device__ __forceinline__ void ret_scan_phase(const float* UPDT, bf16* SPT, float* out, int tid) {
    const int e = blockIdx.x * NTHR + tid;
    if (e < 32768) {
        const int h = e >> 13, dv = (e >> 6) & 127, dk = e & 63;
        const float G = expf(128.f * log_g(h));
        float S = 0.f;
        for (int n = 0; n < 128; ++n) { SPT[(size_t)n * 32768 + e] = (bf16)f2bf(S); S = G * S + UPDT[(size_t)n * 32768 + e]; }
        out[O_SP + h * 8192 + dk * 128 + dv] = S;
    }
}
__device__ __forceinline__ void ret_sample_phase(LAS unsigned char* lds, const bf16* __restrict__ QKVb, const float* __restrict__ state, const float* __restrict__ gnw, bf16* __restrict__ MIX, float* __restrict__ out, int tid) {
    const int grp = tid >> 7, t = tid & 127, dv = t;
    LAS float* qs = (LAS float*)(lds + grp * 4096);
    LAS float* ks = qs + 256;
    LAS float* red = ks + 256;
    for (int it = blockIdx.x; it < 128; it += gridDim.x) {
        const int sub = it * 4 + grp, b = sub >> 2, h = sub & 3;
        const float g = 1.f - exp2f(-5.f - (float)h);
        const float g2 = g * g, g3 = g2 * g, g4 = g2 * g2;
        const int row0 = MP + b * 4;
        const float* s0p = state + (size_t)(b * 4 + h) * 64 * 128 + dv;
        float* snp = out + O_SS + (size_t)(b * 4 + h) * 64 * 128 + dv;
        for (int e = t; e < 256; e += 128) { const int i = e >> 6, dk = e & 63;
            qs[e] = bf_lo((unsigned)QKVb[(size_t)(row0 + i) * INW + C_QR + h * 64 + dk]); ks[e] = bf_lo((unsigned)QKVb[(size_t)(row0 + i) * INW + C_KR + h * 64 + dk]); }
        float v[4];
#pragma unroll
        for (int i = 0; i < 4; ++i) v[i] = bf_lo((unsigned)QKVb[(size_t)(row0 + i) * INW + C_VR + h * 128 + dv]);
        __syncthreads();
        float c0 = 0.f, c1 = 0.f, c2 = 0.f, c3 = 0.f;
#pragma unroll 1
        for (int d0 = 0; d0 < 64; d0 += 16) {
            float s0v[16];
#pragma unroll
            for (int dk = 0; dk < 16; ++dk) s0v[dk] = __builtin_nontemporal_load(s0p + (d0 + dk) * 128);
#pragma unroll
            for (int dk = 0; dk < 16; ++dk) {
                const float s0 = s0v[dk]; const int kk = d0 + dk;
                c0 += qs[kk] * s0; c1 += qs[64 + kk] * s0; c2 += qs[128 + kk] * s0; c3 += qs[192 + kk] * s0;
                __builtin_nontemporal_store(g4 * s0 + g3 * ks[kk] * v[0] + g2 * ks[64 + kk] * v[1] + g * ks[128 + kk] * v[2] + ks[192 + kk] * v[3], snp + kk * 128);
            }
        }
        float d00 = 0.f, d10 = 0.f, d11 = 0.f, d20 = 0.f, d21 = 0.f, d22 = 0.f, d30 = 0.f, d31 = 0.f, d32 = 0.f, d33 = 0.f;
        for (int dk = 0; dk < 64; ++dk) {
            const float q0 = qs[dk], q1 = qs[64 + dk], q2 = qs[128 + dk], q3 = qs[192 + dk];
            const float k0 = ks[dk], k1 = ks[64 + dk], k2 = ks[128 + dk], k3 = ks[192 + dk];
            d00 += q0 * k0; d10 += q1 * k0; d11 += q1 * k1; d20 += q2 * k0; d21 += q2 * k1; d22 += q2 * k2;
            d30 += q3 * k0; d31 += q3 * k1; d32 += q3 * k2; d33 += q3 * k3;
        }
        float o[4];
        o[0] = g * c0 + d00 * v[0];
        o[1] = g2 * c1 + g * d10 * v[0] + d11 * v[1];
        o[2] = g3 * c2 + g2 * d20 * v[0] + g * d21 * v[1] + d22 * v[2];
        o[3] = g4 * c3 + g3 * d30 * v[0] + g2 * d31 * v[1] + g * d32 * v[2] + d33 * v[3];
#pragma unroll
        for (int i = 0; i < 4; ++i) { const float s1 = wave_sum(o[i]); if ((t & 63) == 0) red[i * 2 + (t >> 6)] = s1; }
        __syncthreads();
        float dl[4];
#pragma unroll
        for (int i = 0; i < 4; ++i) { const float mu = (red[i * 2] + red[i * 2 + 1]) * (1.f / 128.f); dl[i] = o[i] - mu; }
#pragma unroll
        for (int i = 0; i < 4; ++i) { const float s2 = wave_sum(dl[i] * dl[i]); if ((t & 63) == 0) red[8 + i * 2 + (t >> 6)] = s2; }
        __syncthreads();
#pragma unroll
        for (int i = 0; i < 4; ++i) {
            const float var = (red[8 + i * 2] + red[8 + i * 2 + 1]) * (1.f / 128.f);
            const float y = dl[i] / sqrtf(var + EPS) * gnw[h * 128 + dv];
            const float gg = bf_lo((unsigned)QKVb[(size_t)(row0 + i) * INW + C_GR + h * 128 + dv]);
            MIX[(size_t)(row0 + i) * D + 512 + h * 128 + dv] = (bf16)f2bf(silu_f(gg) * y);
        }
        __syncthreads();
    }
}

struct Args { const float* in[20]; float* out; unsigned char* ws; };
__global__ void __launch_bounds__(NTHR, 2) mk_fwd(Args a) {
    extern __shared__ __attribute__((aligned(16))) unsigned char lds_raw[];
    LAS unsigned char* lds = (LAS unsigned char*)lds_raw;
    volatile LAS unsigned* MISC = (volatile LAS unsigned*)(lds + MISC_OFF);
    const int tid = threadIdx.x, lane = tid & 63, wave = __builtin_amdgcn_readfirstlane(tid >> 6);
    const int G = gridDim.x;
    const int gw = blockIdx.x * NWAVES + wave, NGW = G * NWAVES, gtid = blockIdx.x * NTHR + tid, NGT = G * NTHR;
    unsigned char* ws = a.ws;
    Ptrs P;
    P.xp = a.in[0]; P.xs = a.in[1]; P.ck = a.in[2]; P.cv = a.in[3]; P.st = a.in[4]; P.g1a = a.in[5]; P.g1b = a.in[6]; P.w1g = a.in[7]; P.w1u = a.in[8]; P.w1d = a.in[9];
    P.gma = a.in[10]; P.gmb = a.in[11]; P.win = a.in[12]; P.gnw = a.in[13]; P.wout = a.in[14]; P.g2a = a.in[15]; P.g2b = a.in[16]; P.w2g = a.in[17]; P.w2u = a.in[18]; P.w2d = a.in[19];
    P.out = a.out;
    P.W1GU = (bf16*)(ws + WS_W1GU); P.W1D = (bf16*)(ws + WS_W1D); P.WIN = (bf16*)(ws + WS_WIN); P.WOUT = (bf16*)(ws + WS_WOUT); P.W2GU = (bf16*)(ws + WS_W2GU); P.W2D = (bf16*)(ws + WS_W2D);
    P.XN = (bf16*)(ws + WS_XN); P.H = (bf16*)(ws + WS_H); P.MIX = (bf16*)(ws + WS_MIX);
    P.TAB = (float2*)(ws + WS_TAB); P.Y = (float*)(ws + WS_Y); P.HRES = (float*)(ws + WS_HRES); P.QKV = (float*)(ws + WS_QKV); P.UPD = (float*)(ws + WS_UPD); P.SPT = (bf16*)(ws + WS_SPREV); P.QKVb = (bf16*)(ws + WS_QKVB); P.OPART = (bf16*)(ws + WS_OPART); P.ML = (float2*)(ws + WS_ML); P.SPART = (float*)(ws + WS_SPART); P.SML = (float2*)(ws + WS_SML);
    for (int u = tid; u < (LDS_BYTES - LDSCTL_OFF) / 4; u += NTHR) ((LAS unsigned*)(lds + LDSCTL_OFF))[u] = 0u;
    __syncthreads();
    XcdBarrier bar = xcd_barrier_post((unsigned*)(ws + WS_CTL) + CW_BAR, MISC + 8);

    p0_prologue(P, lds, gw, NGW, wave, lane, gtid, NGT);
    xcd_barrier(bar);
    { pg8::Gemm g{P.XN, P.W1GU, M, 2 * DFF, D}; pg8::StaticOrder S; S.init(M, 2 * DFF, G, (int)blockIdx.x); pg8::EpiSwiglu E{P.H, DFF};
      pg8::gemm_phase<pg8::EpiSwiglu, pg8::StaticOrder, true, true>(lds, g, S, E); }
    xcd_barrier(bar);
    { pg8::Gemm g{P.H, P.W1D, MP, D, DFF}; pg8::StaticOrder S; S.init(MP, D, G, (int)blockIdx.x); pg8::EpiF32 E{P.Y, D};
      pg8::gemm_phase<pg8::EpiF32, pg8::StaticOrder, true, true>(lds, g, S, E); }
    sk_gemm_y(lds, P.H, DFF, P.W1D, DFF, P.Y, tid, wave, lane);
    xcd_barrier(bar);
    norm_res_phase(P.xp, P.xs, P.Y, P.g1b, 0.5f, P.HRES, P.gma, P.XN, gw, NGW, lane);
    xcd_barrier(bar);
    { pg8::Gemm g{P.XN, P.WIN, MP, INW, D}; pg8::StaticOrder S; S.init(MP, INW, G, (int)blockIdx.x);
      pg8::EpiQKV E{P.QKVb, P.TAB, P.out + O_KP, P.out + O_VP, QSCALE, MP - KEEP};
      pg8::gemm_phase<pg8::EpiQKV, pg8::StaticOrder, true, true>(lds, g, S, E); }
    sk_gemm_qkv(lds, P.XN, P.WIN, P.QKVb, P.TAB, P.out, tid, wave, lane);
    xcd_barrier(bar);
    ret_upd_phase(lds, P.QKVb, P.UPD, tid);
    ret_sample_phase(lds, P.QKVb, P.st, P.gnw, P.MIX, P.out, tid);
    attn_sample_phase(P.QKVb, P.ck, P.cv, P.out, P.SPART, P.SML, gw, NGW, lane);
    attn_mfma_phase(lds, P.QKVb, P.OPART, P.ML, gw, NGW, wave, lane);
    xcd_barrier(bar);
    ret_scan_phase(P.UPD, P.SPT, P.out, tid);
    attn_combine_phase(P.OPART, P.ML, P.MIX, gtid, NGT);
    attn_sample_merge_phase(P.SPART, P.SML, P.MIX, gw, NGW, lane);
    xcd_barrier(bar);
    ret_out_mfma_phase(lds, P.QKVb, P.SPT, P.gnw, P.MIX, tid, wave, lane);
    xcd_barrier(bar);
    { pg8::Gemm g{P.MIX, P.WOUT, MP, D, D}; pg8::StaticOrder S; S.init(MP, D, G, (int)blockIdx.x); pg8::EpiF32 E{P.Y, D};
      pg8::gemm_phase<pg8::EpiF32, pg8::StaticOrder, true, true>(lds, g, S, E); }
    sk_gemm_y(lds, P.MIX, D, P.WOUT, D, P.Y, tid, wave, lane);
    xcd_barrier(bar);
    norm_res_phase(P.HRES, P.HRES + (size_t)MP * D, P.Y, P.gmb, 1.0f, P.HRES, P.g2a, P.XN, gw, NGW, lane);
    xcd_barrier(bar);
    { pg8::Gemm g{P.XN, P.W2GU, M, 2 * DFF, D}; pg8::StaticOrder S; S.init(M, 2 * DFF, G, (int)blockIdx.x); pg8::EpiSwiglu E{P.H, DFF};
      pg8::gemm_phase<pg8::EpiSwiglu, pg8::StaticOrder, true, true>(lds, g, S, E); }
    xcd_barrier(bar);
    { pg8::Gemm g{P.H, P.W2D, MP, D, DFF}; pg8::StaticOrder S; S.init(MP, D, G, (int)blockIdx.x); pg8::EpiF32 E{P.Y, D};
      pg8::gemm_phase<pg8::EpiF32, pg8::StaticOrder, true, true>(lds, g, S, E); }
    sk_gemm_y(lds, P.H, DFF, P.W2D, DFF, P.Y, tid, wave, lane);
    xcd_barrier(bar);
    norm_res_phase(P.HRES, P.HRES + (size_t)MP * D, P.Y, P.g2b, 0.5f, P.out + O_Y, nullptr, nullptr, gw, NGW, lane);
}

extern "C" void kernel_launch(void* const* d_in, const int* in_sizes, int n_in, void* d_out, int out_size, void* d_ws, size_t ws_size, hipStream_t stream) {
    static int grid = 0;
    if (grid == 0) {
        if (n_in != 20 || (size_t)out_size != O_END || ws_size < WS_END) { fprintf(stderr, "kernel_launch: unexpected sizes (n_in %d out %d ws %zu)\n", n_in, out_size, ws_size); grid = -1; return; }
        int dev = 0, cus = 0;
        if (hipGetDevice(&dev) != hipSuccess || hipDeviceGetAttribute(&cus, hipDeviceAttributeMultiprocessorCount, dev) != hipSuccess) { grid = -1; return; }
        if (hipFuncSetAttribute((const void*)mk_fwd, hipFuncAttributeMaxDynamicSharedMemorySize, LDS_BYTES) != hipSuccess) { fprintf(stderr, "kernel_launch: hipFuncSetAttribute failed\n"); grid = -1; return; }
        int per_cu = 0;
        if (hipOccupancyMaxActiveBlocksPerMultiprocessor(&per_cu, (const void*)mk_fwd, NTHR, LDS_BYTES) != hipSuccess || per_cu < 1) fprintf(stderr, "kernel_launch: occupancy query says %d\n", per_cu);
        (void)hipGetLastError();
        grid = cus;
    }
    if (grid < 0) return;
    (void)hipMemsetAsync((char*)d_ws + WS_CTL, 0, CTL_ZERO_BYTES, stream);
    Args a{};
    for (int i = 0; i < 20; ++i) a.in[i] = (const float*)d_in[i];
    a.out = (float*)d_out; a.ws = (unsigned char*)d_ws;
    hipLaunchKernelGGL(mk_fwd, dim3(grid), dim3(NTHR), LDS_BYTES, stream, a);
}
```

```cpp
#include <hip/hip_runtime.h>
#include <cstdio>
#include <cstdint>
namespace pg8 {
#define PG8_LAS __attribute__((address_space(3)))
typedef unsigned short bf16_t;
typedef short bf16x8 __attribute__((ext_vector_type(8)));
typedef float f32x4 __attribute__((ext_vector_type(4)));
typedef unsigned u32x4 __attribute__((ext_vector_type(4)));
constexpr int BM = 256, BK = 64, HALF = 128, HTB = HALF * BK * 2  , STAGE_BYTES = 8 * HTB, NXCD = 8, WGM = 8;

__host__ __device__ __forceinline__ int lds_byte(int r, int c) { const int st = (r >> 4) * 2 + (c >> 5), rr = r & 15, cc = c & 31, ob = rr * 64 + cc * 2; return st * 1024 + (ob ^ (((ob >> 9) & 1) << 5)); }
__host__ __device__ __forceinline__ void stage_rc(int b, int& R, int& C) { const int st = b / 1024, sb = b % 1024, swz = sb ^ (((sb >> 9) & 1) << 5); R = (st >> 1) * 16 + swz / 64; C = (st & 1) * 32 + (swz % 64) / 2; }
__host__ __device__ __forceinline__ int perm32(int rho) { const int n = rho >> 4, i = rho & 15; return 8 * (i >> 2) + 4 * n + (i & 3); }

struct Unit { int pm, pn; };
struct Gemm { const bf16_t* A; const bf16_t* Bt; int M, N, K; };

struct StaticOrder {
    int nM, nN, nwg, G, c;
    __host__ __device__ void init(int M, int N, int G_, int c_) { nM = M / BM; nN = N / BM; nwg = nM * nN; G = G_; c = c_; }
    __host__ __device__ bool next(int i, Unit& u) const {
        const long L = (long)i * G + c; if (L >= nwg) return false;
        int wgid = (int)L; { const int q = nwg / NXCD, r = nwg % NXCD, xcd = wgid % NXCD, off = wgid / NXCD; wgid = (xcd < r ? xcd * (q + 1) : r * (q + 1) + (xcd - r) * q) + off; }
        const int nig = WGM * nN, gid = wgid / nig, fm = gid * WGM, gsz = (nM - fm) < WGM ? (nM - fm) : WGM;
        u.pm = fm + ((wgid % nig) % gsz); u.pn = (wgid % nig) / gsz; return true;
    }
    __device__ __forceinline__ void a_ready(const Unit&) const {}
    __device__ __forceinline__ void done(const Unit&) const {}
};

__device__ __forceinline__ unsigned cvt_pk_bf16(float lo, float hi) { unsigned r; asm volatile("v_cvt_pk_bf16_f32 %0, %1, %2" : "=v"(r) : "v"(lo), "v"(hi)); return r; }
typedef float f32x2 __attribute__((ext_vector_type(2)));
typedef unsigned u32x2 __attribute__((ext_vector_type(2)));
struct EpiQKV {
    static constexpr bool PERM = true, AFTER_DRAIN = false;
    bf16_t* QKVb; const float2* tab; float* okp; float* ovp; float qscale; int keep0;
    __device__ __forceinline__ void operator()(const f32x4 (&acc)[2][2][4][2], const Unit& u, int wr, int wc, int fr, int fq) const {
        const int pn = u.pn, g8 = (wc & 1) * 4 + fq;
#pragma unroll
        for (int ai = 0; ai < 2; ++ai)
#pragma unroll
            for (int m = 0; m < 4; ++m) {
                const int row = u.pm * BM + ai * HALF + wr * 64 + m * 16 + fr;
                bf16_t* rb = QKVb + (size_t)row * 3072;
#pragma unroll
                for (int bj = 0; bj < 2; ++bj) {
                    const int hb = pn * BM + bj * HALF + (wc >> 1) * 64;
                    const f32x4 v0 = acc[ai][bj][m][0], v1 = acc[ai][bj][m][1];
                    if (pn < 4 && g8 < 2) {
                        const float2* t = tab + (size_t)row * 40 + 4 * g8;
                        const float2 c0 = t[0], c1 = t[1], c2 = t[2], c3 = t[3];
                        const f32x4 y1 = {v0[0] * c0.x - v1[0] * c0.y, v0[1] * c1.x - v1[1] * c1.y, v0[2] * c2.x - v1[2] * c2.y, v0[3] * c3.x - v1[3] * c3.y};
                        const f32x4 y2 = {v1[0] * c0.x + v0[0] * c0.y, v1[1] * c1.x + v0[1] * c1.y, v1[2] * c2.x + v0[2] * c2.y, v1[3] * c3.x + v0[3] * c3.y};
                        const float sc = pn < 2 ? qscale : 1.f;
                        u32x2 w1, w2; w1.x = cvt_pk_bf16(y1[0] * sc, y1[1] * sc); w1.y = cvt_pk_bf16(y1[2] * sc, y1[3] * sc); w2.x = cvt_pk_bf16(y2[0] * sc, y2[1] * sc); w2.y = cvt_pk_bf16(y2[2] * sc, y2[3] * sc);
                        *(u32x2*)(rb + hb + 4 * g8) = w1; *(u32x2*)(rb + hb + 4 * g8 + 8) = w2;
                        if (pn >= 2 && row >= keep0) { float* o = okp + (size_t)(row - keep0) * 512 + (hb - 512) + 4 * g8; *(f32x4*)o = y1; *(f32x4*)(o + 8) = y2; }
                    } else if (pn == 6 || pn == 7) {
                        const float2* t = tab + (size_t)row * 40 + 8 + 4 * g8;
                        const float2 c0 = t[0], c1 = t[1], c2 = t[2], c3 = t[3];
                        const float sc = pn == 7 ? 0.125f : 1.f;
                        const f32x4 y1 = {(v0[0] * c0.x - v1[0] * c0.y) * sc, (v0[1] * c1.x - v1[1] * c1.y) * sc, (v0[2] * c2.x - v1[2] * c2.y) * sc, (v0[3] * c3.x - v1[3] * c3.y) * sc};
                        const f32x4 y2 = {(v1[0] * c0.x + v0[0] * c0.y) * sc, (v1[1] * c1.x + v0[1] * c1.y) * sc, (v1[2] * c2.x + v0[2] * c2.y) * sc, (v1[3] * c3.x + v0[3] * c3.y) * sc};
                        u32x2 w1, w2; w1.x = cvt_pk_bf16(y1[0], y1[1]); w1.y = cvt_pk_bf16(y1[2], y1[3]); w2.x = cvt_pk_bf16(y2[0], y2[1]); w2.y = cvt_pk_bf16(y2[2], y2[3]);
                        *(u32x2*)(rb + hb + 4 * g8) = w1; *(u32x2*)(rb + hb + 32 + 4 * g8) = w2;
                    } else {
                        const int col = pn * BM + bj * HALF + wc * 32 + 8 * fq;
                        const float sc = pn < 2 ? qscale : 1.f;
                        u32x4 w; w.x = cvt_pk_bf16(v0[0] * sc, v0[1] * sc); w.y = cvt_pk_bf16(v0[2] * sc, v0[3] * sc); w.z = cvt_pk_bf16(v1[0] * sc, v1[1] * sc); w.w = cvt_pk_bf16(v1[2] * sc, v1[3] * sc);
                        *(u32x4*)(rb + col) = w;
                        if (row >= keep0 && pn >= 2 && pn < 6) { float* o = (pn < 4 ? okp + (size_t)(row - keep0) * 512 + (col - 512) : ovp + (size_t)(row - keep0) * 512 + (col - 1024)); *(f32x4*)o = v0; *(f32x4*)(o + 4) = v1; }
                    }
                }
            }
    }
};
__device__ __forceinline__ float silu_fast(float x) { return x * __builtin_amdgcn_rcpf(1.0f + __builtin_amdgcn_exp2f(-1.4426950408889634f * x)); }
struct EpiSwiglu {
    static constexpr bool PERM = true, AFTER_DRAIN = false;
    bf16_t* O; int ldc;
    __device__ __forceinline__ void operator()(const f32x4 (&acc)[2][2][4][2], const Unit& u, int wr, int wc, int fr, int fq) const {
        const int row0 = u.pm * BM + wr * 64 + fr, col0 = u.pn * HALF + wc * 32 + 8 * fq;
#pragma unroll
        for (int ai = 0; ai < 2; ++ai)
#pragma unroll
            for (int m = 0; m < 4; ++m) {
                bf16_t* rowp = O + (size_t)(row0 + ai * HALF + m * 16) * ldc + col0;
                const f32x4 g0 = acc[ai][0][m][0], g1 = acc[ai][0][m][1], u0 = acc[ai][1][m][0], u1 = acc[ai][1][m][1];
                u32x4 w;
                w.x = cvt_pk_bf16(silu_fast(g0[0]) * u0[0], silu_fast(g0[1]) * u0[1]); w.y = cvt_pk_bf16(silu_fast(g0[2]) * u0[2], silu_fast(g0[3]) * u0[3]);
                w.z = cvt_pk_bf16(silu_fast(g1[0]) * u1[0], silu_fast(g1[1]) * u1[1]); w.w = cvt_pk_bf16(silu_fast(g1[2]) * u1[2], silu_fast(g1[3]) * u1[3]);
                *(u32x4*)rowp = w;
            }
    }
};
struct EpiF32 {
    static constexpr bool PERM = false, AFTER_DRAIN = false;
    float* O; int ldc;
    __device__ __forceinline__ void operator()(const f32x4 (&acc)[2][2][4][2], const Unit& u, int wr, int wc, int fr, int fq) const {
        const int row0 = u.pm * BM + wr * 64 + fr, col0 = u.pn * BM + wc * 32 + 4 * fq;
#pragma unroll
        for (int ai = 0; ai < 2; ++ai)
#pragma unroll
            for (int m = 0; m < 4; ++m) {
                float* rowp = O + (size_t)(row0 + ai * HALF + m * 16) * ldc + col0;
#pragma unroll
                for (int bj = 0; bj < 2; ++bj)
#pragma unroll
                    for (int n = 0; n < 2; ++n) *(f32x4*)(rowp + bj * HALF + n * 16) = acc[ai][bj][m][n];
            }
    }
};
template <class Epi, class Sched, bool ALIGN_EPI = false, bool SP2 = false>
__device__ __forceinline__ void gemm_phase(PG8_LAS unsigned char* lds, const Gemm g, const Sched& S, const Epi& E) {
    int tid_ = threadIdx.x; asm volatile("" : "+v"(tid_));
    const int tid = tid_, wid = __builtin_amdgcn_readfirstlane(tid >> 6), lane = tid & 63, wr = wid >> 2, wc = wid & 3, fr = lane & 15, fq = lane >> 4;
    const int K = g.K, nt = K / BK;
    unsigned voffA[2], voffB[2];
#pragma unroll
    for (int i = 0; i < 2; ++i) { int R, C; stage_rc(tid * 16 + i * 8192, R, C); const int Rb = Epi::PERM ? ((R & ~31) + perm32(R & 31)) : R;
        voffA[i] = (unsigned)(R * K + C) * 2u; voffB[i] = (unsigned)(Rb * K + C) * 2u; }
    const size_t kstep = (size_t)(BK * 2);
    const size_t hstep = (size_t)HALF * K * 2;
    const size_t tstep = 2 * hstep;
    const unsigned ldsw = (unsigned)wid * 1024u;
    const int aoff = lds_byte(wr * 64 + fr, fq * 8), boff = lds_byte(wc * 32 + fr, fq * 8);
#define PG8_SA(b, h) (((b) * 2 + (h)) * HTB)
#define PG8_SB(b, h) ((4 + (b) * 2 + (h)) * HTB)
#define PG8_STAGE(bufoff, gbase, voff) do { _Pragma("unroll") for (int _i = 0; _i < 2; ++_i) \
        __builtin_amdgcn_global_load_lds((const unsigned*)((const char*)(gbase) + (voff)[_i]), (PG8_LAS unsigned*)(lds + (bufoff) + ldsw + _i * 8192), 16, 0, 0); } while (0)
#define PG8_LDA(dst, b, h) do { _Pragma("unroll") for (int m = 0; m < 4; ++m) _Pragma("unroll") for (int k = 0; k < 2; ++k) dst[m][k] = *(const PG8_LAS bf16x8*)(lds + PG8_SA(b, h) + aoff + m * 2048 + k * 1024); } while (0)
#define PG8_LDB(dst, b, h) do { _Pragma("unroll") for (int n = 0; n < 2; ++n) _Pragma("unroll") for (int k = 0; k < 2; ++k) dst[n][k] = *(const PG8_LAS bf16x8*)(lds + PG8_SB(b, h) + boff + n * 2048 + k * 1024); } while (0)
#define PG8_MMA(ai, bj, At, Bt) do { __builtin_amdgcn_s_setprio(1); _Pragma("unroll") for (int m = 0; m < 4; ++m) _Pragma("unroll") for (int n = 0; n < 2; ++n) _Pragma("unroll") for (int k = 0; k < 2; ++k) \
        acc[ai][bj][m][n] = __builtin_amdgcn_mfma_f32_16x16x32_bf16(Bt[n][k], At[m][k], acc[ai][bj][m][n], 0, 0, 0); __builtin_amdgcn_s_setprio(0); } while (0)
#define PG8_WAIT_V(n) asm volatile("s_waitcnt vmcnt(" #n ")" ::: "memory")
#define PG8_WAIT_L(n) asm volatile("s_waitcnt lgkmcnt(" #n ")" ::: "memory")
#define PG8_BAR __builtin_amdgcn_s_barrier()
#define PG8_SCHED __builtin_amdgcn_sched_barrier(0)
    Unit cur, nxt; int ui = 0;
    if (!S.next(0, cur)) return;
    f32x4 acc[2][2][4][2];
#pragma unroll
    for (int a = 0; a < 2; ++a)
#pragma unroll
        for (int b = 0; b < 2; ++b)
#pragma unroll
            for (int m = 0; m < 4; ++m)
#pragma unroll
                for (int n = 0; n < 2; ++n) acc[a][b][m][n] = (f32x4){0.f, 0.f, 0.f, 0.f};
    bf16x8 At[4][2], B0[2][2], B1[2][2];
    const char* cA = (const char*)g.A + (size_t)cur.pm * tstep; const char* cB = (const char*)g.Bt + (size_t)cur.pn * tstep;
    S.a_ready(cur);
    if constexpr (SP2) {
        PG8_STAGE(PG8_SB(0, 0), cB, voffB); PG8_STAGE(PG8_SB(0, 1), cB + hstep, voffB); PG8_STAGE(PG8_SA(0, 0), cA, voffA); PG8_STAGE(PG8_SA(0, 1), cA + hstep, voffA);
        if (wr == 1) PG8_BAR;
        PG8_WAIT_V(2); PG8_BAR;
        PG8_STAGE(PG8_SB(1, 0), cB + kstep, voffB); PG8_STAGE(PG8_SA(1, 0), cA + kstep, voffA); PG8_STAGE(PG8_SB(1, 1), cB + hstep + kstep, voffB);
        PG8_WAIT_V(6); PG8_BAR;
    } else {
        PG8_STAGE(PG8_SB(0, 0), cB, voffB); PG8_STAGE(PG8_SA(0, 0), cA, voffA); PG8_STAGE(PG8_SB(0, 1), cB + hstep, voffB); PG8_STAGE(PG8_SA(0, 1), cA + hstep, voffA);
        if (wr == 1) PG8_BAR;
        PG8_WAIT_V(4); PG8_BAR;
        PG8_STAGE(PG8_SB(1, 0), cB + kstep, voffB); PG8_STAGE(PG8_SA(1, 0), cA + kstep, voffA); PG8_STAGE(PG8_SB(1, 1), cB + hstep + kstep, voffB);
        PG8_WAIT_V(6); PG8_BAR;
    }
    for (;;) {
        const bool has_next = S.next(ui + 1, nxt);
        const char* nA = has_next ? (const char*)g.A + (size_t)nxt.pm * tstep : cA; const char* nB = has_next ? (const char*)g.Bt + (size_t)nxt.pn * tstep : cB;
        for (int t = 0; t < nt; t += 2) {
            const bool last = (t == nt - 2);
            const char* a1 = cA + (size_t)(t + 1) * kstep;
            const char* a2 = last ? nA : cA + (size_t)(t + 2) * kstep; const char* b2 = last ? nB : cB + (size_t)(t + 2) * kstep;
            const char* a3 = a2 + kstep; const char* b3 = b2 + kstep;
            if (last && has_next) S.a_ready(nxt);
            if constexpr (SP2) {
            PG8_LDB(B0, 0, 0); PG8_LDB(B1, 0, 1); PG8_SCHED; PG8_LDA(At, 0, 0); PG8_STAGE(PG8_SA(1, 1), a1 + hstep, voffA);
            PG8_WAIT_V(8); PG8_WAIT_L(0); PG8_BAR; PG8_MMA(0, 0, At, B0); PG8_MMA(0, 1, At, B1); PG8_BAR; PG8_SCHED;
            PG8_LDA(At, 0, 1); PG8_STAGE(PG8_SB(0, 0), b2, voffB); PG8_STAGE(PG8_SB(0, 1), b2 + hstep, voffB); PG8_STAGE(PG8_SA(0, 0), a2, voffA);
            PG8_WAIT_V(8); PG8_WAIT_L(0); PG8_BAR; PG8_MMA(1, 0, At, B0); PG8_MMA(1, 1, At, B1); PG8_BAR; PG8_SCHED;
            PG8_LDB(B0, 1, 0); PG8_LDB(B1, 1, 1); PG8_SCHED; PG8_LDA(At, 1, 0); PG8_STAGE(PG8_SA(0, 1), a2 + hstep, voffA);
            PG8_WAIT_V(8); PG8_WAIT_L(0); PG8_BAR; PG8_MMA(0, 0, At, B0); PG8_MMA(0, 1, At, B1); PG8_BAR; PG8_SCHED;
            PG8_LDA(At, 1, 1); PG8_STAGE(PG8_SB(1, 0), b3, voffB); PG8_STAGE(PG8_SB(1, 1), b3 + hstep, voffB); PG8_STAGE(PG8_SA(1, 0), a3, voffA);
            PG8_WAIT_V(8); PG8_WAIT_L(0); PG8_BAR; PG8_MMA(1, 0, At, B0); PG8_MMA(1, 1, At, B1); PG8_BAR; PG8_SCHED;
            } else {
            PG8_LDB(B0, 0, 0); PG8_SCHED; PG8_LDA(At, 0, 0); PG8_STAGE(PG8_SA(1, 1), a1 + hstep, voffA);
            PG8_WAIT_L(8); PG8_BAR; PG8_WAIT_L(0); PG8_MMA(0, 0, At, B0); PG8_BAR; PG8_SCHED;
            PG8_LDB(B1, 0, 1); PG8_STAGE(PG8_SB(0, 0), b2, voffB);
            PG8_BAR; PG8_WAIT_L(0); PG8_MMA(0, 1, At, B1); PG8_BAR;
            PG8_LDA(At, 0, 1); PG8_STAGE(PG8_SA(0, 0), a2, voffA);
            PG8_BAR; PG8_WAIT_L(0); PG8_MMA(1, 0, At, B0); PG8_BAR; PG8_SCHED;
            PG8_STAGE(PG8_SB(0, 1), b2 + hstep, voffB);
            PG8_WAIT_V(6); PG8_BAR; PG8_MMA(1, 1, At, B1); PG8_BAR;
            PG8_LDB(B0, 1, 0); PG8_SCHED; PG8_LDA(At, 1, 0); PG8_STAGE(PG8_SA(0, 1), a2 + hstep, voffA);
            PG8_WAIT_L(8); PG8_BAR; PG8_WAIT_L(0); PG8_MMA(0, 0, At, B0); PG8_BAR; PG8_SCHED;
            PG8_LDB(B1, 1, 1); PG8_STAGE(PG8_SB(1, 0), b3, voffB);
            PG8_BAR; PG8_WAIT_L(0); PG8_MMA(0, 1, At, B1); PG8_BAR;
            PG8_LDA(At, 1, 1); PG8_STAGE(PG8_SA(1, 0), a3, voffA);
            PG8_BAR; PG8_WAIT_L(0); PG8_MMA(1, 0, At, B0); PG8_BAR; PG8_SCHED;
            PG8_STAGE(PG8_SB(1, 1), b3 + hstep, voffB);
            PG8_WAIT_V(6); PG8_BAR; PG8_MMA(1, 1, At, B1); PG8_BAR;
            }
        }
        if constexpr (ALIGN_EPI) { if (wr == 0) PG8_BAR; }
        if constexpr (!Epi::AFTER_DRAIN) { E(acc, cur, wr, wc, fr, fq); S.done(cur); }
        if (!has_next) break;
#pragma unroll
        for (int a = 0; a < 2; ++a)
#pragma unroll
            for (int b = 0; b < 2; ++b)
#pragma unroll
                for (int m = 0; m < 4; ++m)
#pragma unroll
                    for (int n = 0; n < 2; ++n) acc[a][b][m][n] = (f32x4){0.f, 0.f, 0.f, 0.f};
        cur = nxt; cA = nA; cB = nB; ++ui;
        if constexpr (ALIGN_EPI) { if (wr == 1) PG8_BAR; }
    }
    PG8_WAIT_V(0);
    if constexpr (!ALIGN_EPI) { if (wr == 0) PG8_BAR; }
    PG8_BAR;
    if constexpr (Epi::AFTER_DRAIN) { E.fused(acc, cur, wr, wc, fr, fq, lds, wid, lane); S.done(cur); }
#undef PG8_SA
#undef PG8_SB
#undef PG8_STAGE
#undef PG8_LDA
#undef PG8_LDB
#undef PG8_MMA
#undef PG8_WAIT_V
#undef PG8_WAIT_L
#undef PG8_BAR
#undef PG8_SCHED
}
}
#define GAS __attribute__((address_space(1)))
#define LAS __attribute__((address_space(3)))
typedef unsigned short bf16;
typedef unsigned v4u __attribute__((ext_vector_type(4)));
typedef float f32x4 __attribute__((ext_vector_type(4)));
typedef short bf16x8 __attribute__((ext_vector_type(8)));
typedef GAS unsigned gu32;
typedef GAS unsigned long long gu64;
#define RLX_AGENT __ATOMIC_RELAXED, __HIP_MEMORY_SCOPE_AGENT
#define LDS_WAIT() asm volatile("s_waitcnt lgkmcnt(0)" ::: "memory")
#define VM_WAIT() asm volatile("s_waitcnt vmcnt(0)" ::: "memory")
__device__ __forceinline__ unsigned long long rt() { return __builtin_amdgcn_s_memrealtime(); }
__device__ __forceinline__ unsigned f2bf(float f) { unsigned u = __builtin_bit_cast(unsigned, f); return (u + 0x7fffu + ((u >> 16) & 1u)) >> 16; }
__device__ __forceinline__ unsigned pk2(float lo, float hi) { return f2bf(lo) | (f2bf(hi) << 16); }
#define XB_TMO      128
#define XB_XCNT(j)  (256  + 64 * (j))
#define XB_XSUB(j)  (1280 + 64 * (j))
#define XB_XGEN(j)  (2304 + 64 * (j))
#define XB_TOP      3328
#define XB_TOPGEN   3392
#define XCD_BAR_WORDS 3456
#define XB_SPIN_CAP (1u << 18)

__device__ __forceinline__ unsigned xb_ld(unsigned* p)              { return __hip_atomic_load(p, __ATOMIC_RELAXED, __HIP_MEMORY_SCOPE_AGENT); }
__device__ __forceinline__ unsigned xb_add(unsigned* p, unsigned v) { return __hip_atomic_fetch_add(p, v, __ATOMIC_RELAXED, __HIP_MEMORY_SCOPE_AGENT); }
__device__ __forceinline__ unsigned xb_xcc_id() { return (unsigned)__builtin_amdgcn_s_getreg((3 << 11) | 20) & 0xFu; }
#define XB_SPIN(cond, bar) do { unsigned _sp = 0; while (cond) { __builtin_amdgcn_s_sleep(1); \
    if ((++_sp & 255u) == 0u) { if (xb_ld(&(bar)[XB_TMO])) break; if (_sp > XB_SPIN_CAP) { atomicAdd(&(bar)[XB_TMO], 1u); break; } } } } while (0)

struct XcdBarrier {
    unsigned* bar; unsigned x;
    volatile LAS unsigned* st;
};

__device__ __forceinline__ XcdBarrier xcd_barrier_post(unsigned* bar, volatile LAS unsigned* st) {
    XcdBarrier b; b.bar = bar; b.x = xb_xcc_id(); b.st = st;
    if (threadIdx.x == 0) (void)xb_add(&bar[XB_XCNT(b.x)], 1u);
    return b;
}
__device__ __forceinline__ void xcd_barrier_complete(unsigned* bar, unsigned x, unsigned& nloc, unsigned& nx) {
    const unsigned G = gridDim.x * gridDim.y * gridDim.z;
    unsigned sum, cnt, mine, sp = 0u;
    for (;;) {
        sum = 0u; cnt = 0u; mine = 0u;
#pragma unroll
        for (unsigned j = 0; j < 16; ++j) { const unsigned c = xb_ld(&bar[XB_XCNT(j)]); sum += c; cnt += (c > 0u) ? 1u : 0u; mine = (j == x) ? c : mine; }
        if (sum == G) break;
        __builtin_amdgcn_s_sleep(1);
        if ((++sp & 255u) == 0u) { if (xb_ld(&bar[XB_TMO])) break; if (sp > XB_SPIN_CAP) { atomicAdd(&bar[XB_TMO], 1u); break; } }
    }
    nloc = mine > 0u ? mine : 1u; nx = cnt > 0u ? cnt : 1u;
}

__device__ __forceinline__ void xcd_barrier(const XcdBarrier& b) {
    asm volatile("s_waitcnt vmcnt(0)" ::: "memory");
    __syncthreads();
    if (threadIdx.x == 0) {
        unsigned* bar = b.bar;
        __builtin_amdgcn_s_waitcnt(0);
        unsigned nloc = b.st[0], nx = b.st[1];
        if (nloc == 0u) { xcd_barrier_complete(bar, b.x, nloc, nx); b.st[0] = nloc; b.st[1] = nx; }
        const unsigned old = xb_add(&bar[XB_XSUB(b.x)], 1u);
        const unsigned gen = old / nloc;
        if (old + 1u == (gen + 1u) * nloc) {
            __builtin_amdgcn_fence(__ATOMIC_RELEASE, "agent");
            asm volatile("s_waitcnt vmcnt(0)" ::: "memory");
            const unsigned og = xb_add(&bar[XB_TOP], 1u);
            const unsigned tg = og / nx;
            if (og + 1u == (tg + 1u) * nx) xb_add(&bar[XB_TOPGEN], 1u);
            else XB_SPIN(xb_ld(&bar[XB_TOPGEN]) == tg, bar);
            __builtin_amdgcn_fence(__ATOMIC_ACQUIRE, "agent");
            xb_add(&bar[XB_XGEN(b.x)], 1u);
            asm volatile("s_waitcnt vmcnt(0)" ::: "memory");
        } else {
            XB_SPIN(xb_ld(&bar[XB_XGEN(b.x)]) == gen, bar);
            __builtin_amdgcn_fence(__ATOMIC_ACQUIRE, "agent");
            asm volatile("s_waitcnt vmcnt(0)" ::: "memory");
        }
    }
    __syncthreads();
}
constexpr int NWAVES = 8, NTHR = 512;
constexpr int D = 1024, SEQ = 16384, DBATCH = 128, MP = SEQ, MS = 512, M = MP + MS;
constexpr int DFF = 2816, INW = 3072, PAST = 8192, WB = 2048, KEEP = 2048, NH = 8;
constexpr float EPS = 1e-6f;
constexpr int C_QA = 0, C_KA = 512, C_VA = 1024, C_QR = 1536, C_KR = 1792, C_VR = 2048, C_GR = 2560;
constexpr size_t O_Y = 0, O_KP = (size_t)M * D, O_VP = O_KP + (size_t)KEEP * 512, O_SP = O_VP + (size_t)KEEP * 512,
                 O_KS = O_SP + 32768, O_VS = O_KS + (size_t)MS * 512, O_SS = O_VS + (size_t)MS * 512, O_END = O_SS + (size_t)DBATCH * 32768;
constexpr size_t MiB = 1u << 20;
constexpr size_t WS_CTL = 0, CTL_ZERO_BYTES = 1 * MiB;
constexpr size_t WS_W1GU = 1 * MiB, WS_W1D = 12 * MiB, WS_WIN = 18 * MiB, WS_WOUT = 24 * MiB, WS_W2GU = 26 * MiB, WS_W2D = 37 * MiB, WS_TAB = 43 * MiB;
constexpr size_t WS_XN = 48 * MiB, WS_H = 81 * MiB, WS_Y = 172 * MiB, WS_HRES = 238 * MiB, WS_QKV = 304 * MiB, WS_MIX = 502 * MiB, WS_UPD = 535 * MiB, WS_SPREV = 551 * MiB, WS_QKVB = 567 * MiB, WS_OPART = 667 * MiB, WS_ML = 716 * MiB, WS_SPART = 720 * MiB, WS_SML = 736 * MiB, WS_END = 737 * MiB;
constexpr int CW_BAR = 4096;
constexpr int RING_BYTES = 131072, LDSCTL_OFF = RING_BYTES, MISC_OFF = LDSCTL_OFF + 320, LDS_BYTES = 147456;

__constant__ float INVF[40] = {
    1.f, 0.193922743f, 0.0376060307f, 0.00729266461f, 0.00141421356f, 0.000274248188f, 5.3182961e-05f, 1.03133862e-05f,
    1.f, 0.749894261f, 0.562341332f, 0.421696514f, 0.316227764f, 0.237137377f, 0.177827939f, 0.133352131f, 0.100000001f, 0.0749894157f,
    0.0562341325f, 0.0421696529f, 0.0316227749f, 0.0237137377f, 0.0177827943f, 0.0133352149f, 0.00999999978f, 0.00749894185f,
    0.00562341325f, 0.00421696482f, 0.00316227763f, 0.00237137359f, 0.00177827943f, 0.00133352145f, 0.00100000005f, 0.000749894243f,
    0.000562341302f, 0.000421696517f, 0.000316227757f, 0.00023713737f, 0.00017782794f, 0.00013335215f};
__device__ __forceinline__ float log_g(int h) { return h == 0 ? -0.0317486983145803f : h == 1 ? -0.015748356968139168f : h == 2 ? -0.007843177461025893f : -0.003913899321136329f; }
__device__ __forceinline__ float wave_sum(float v) {
#pragma unroll
    for (int o = 32; o >= 1; o >>= 1) v += __shfl_xor(v, o);
    return v;
}
__device__ __forceinline__ float wave_max(float v) {
#pragma unroll
    for (int o = 32; o >= 1; o >>= 1) v = fmaxf(v, __shfl_xor(v, o));
    return v;
}
__device__ __forceinline__ float silu_f(float x) { return x / (1.f + expf(-x)); }

__host__ __device__ __forceinline__ int win_perm(int col) {
    if (col < 1024) { const int dd = col & 63; return dd < 16 ? (col & ~63) + 8 * ((dd >> 2) & 1) + 4 * (dd >> 3) + (dd & 3) : col; }
    if (col >= 1536 && col < 2048) { const int dd = col & 63; return (col & ~63) + 8 * ((dd & 31) >> 2) + 4 * (dd >> 5) + (dd & 3); }
    return col;
}
__device__ __forceinline__ void tr_item(const float* W, int K, int N, bf16* WT, int mode, LAS float* scr, int item, int lane) {
    const int nblk = N / 32, kb = item / nblk, nb = item % nblk, k0 = 64 * kb, n0 = 32 * nb;
    const int rbase = mode == 0 ? n0 : (256 * (n0 >> 7) + (n0 & 127) + (mode == 2 ? 128 : 0));
    {
        const int row8 = lane >> 3, c4 = lane & 7;
        float4 v[8];
#pragma unroll
        for (int i = 0; i < 8; ++i) v[i] = *(const float4*)(W + (size_t)(k0 + 8 * i + row8) * N + n0 + 4 * c4);
#pragma unroll
        for (int i = 0; i < 8; ++i) { LAS float* d = scr + (8 * i + row8) * 33 + 4 * c4; d[0] = v[i].x; d[1] = v[i].y; d[2] = v[i].z; d[3] = v[i].w; }
    }
    LDS_WAIT(); asm volatile("" ::: "memory");
    const int c = lane & 7;
#pragma unroll
    for (int j = 0; j < 4; ++j) { const int n = (lane >> 3) + 8 * j; const LAS float* s = scr + (8 * c) * 33 + n;
        v4u o; o.x = pk2(s[0 * 33], s[1 * 33]); o.y = pk2(s[2 * 33], s[3 * 33]); o.z = pk2(s[4 * 33], s[5 * 33]); o.w = pk2(s[6 * 33], s[7 * 33]);
        const int orow = mode == 3 ? win_perm(n0 + n) : rbase + n;
        *(GAS v4u*)(WT + (size_t)orow * K + k0 + 8 * c) = o; }
    LDS_WAIT(); asm volatile("" ::: "memory");
}
struct Ptrs {
    const float *xp, *xs, *ck, *cv, *st, *g1a, *g1b, *w1g, *w1u, *w1d, *gma, *gmb, *win, *gnw, *wout, *g2a, *g2b, *w2g, *w2u, *w2d;
    float* out;
    bf16 *W1GU, *W1D, *WIN, *WOUT, *W2GU, *W2D, *XN, *H, *MIX;
    float2* TAB; float *Y, *HRES, *QKV, *UPD; bf16 *SPT, *QKVb, *OPART; float2 *ML, *SML; float* SPART;
};
__device__ __forceinline__ void p0_prologue(const Ptrs& P, LAS unsigned char* lds, int gw, int NGW, int wave, int lane, int gtid, int NGT) {
    LAS float* scr = (LAS float*)(lds + wave * 16384);
    constexpr int I_GU = 16 * 88;
    for (int it = gw; it < 2 * I_GU; it += NGW) {
        if (it < I_GU) tr_item(P.w1g, D, DFF, P.W1GU, 1, scr, it, lane); else tr_item(P.w1u, D, DFF, P.W1GU, 2, scr, it - I_GU, lane);
    }
    for (int idx = gtid; idx < SEQ * 40; idx += NGT) {
        const int pos = idx / 40, f = idx % 40;
        const float ang = (float)pos * INVF[f];
        const double rev = (double)ang * 0.15915494309189535;
        const float fr = (float)(rev - rint(rev));
        P.TAB[idx] = make_float2(__builtin_amdgcn_cosf(fr), __builtin_amdgcn_sinf(fr));
    }
    for (int r = gw; r < M; r += NGW) {
        const float4* x = (const float4*)(r < MP ? P.xp + (size_t)r * D : P.xs + (size_t)(r - MP) * D);
        float4 v[4]; float ss = 0.f;
#pragma unroll
        for (int j = 0; j < 4; ++j) { v[j] = x[lane + 64 * j]; ss += v[j].x * v[j].x + v[j].y * v[j].y + v[j].z * v[j].z + v[j].w * v[j].w; }
        const float rstd = 1.f / sqrtf(wave_sum(ss) * (1.f / D) + EPS);
        uint2* o = (uint2*)(P.XN + (size_t)r * D);
#pragma unroll
        for (int j = 0; j < 4; ++j) { const float4 gg = ((const float4*)P.g1a)[lane + 64 * j];
            o[lane + 64 * j] = make_uint2(pk2(v[j].x * rstd * gg.x, v[j].y * rstd * gg.y), pk2(v[j].z * rstd * gg.z, v[j].w * rstd * gg.w)); }
    }
}
__device__ __forceinline__ void p0_deferred(const Ptrs& P, LAS unsigned char* lds, int gw, int NGW, int wave, int lane) {
    LAS float* scr = (LAS float*)(lds + wave * 16384);
    constexpr int I_GU = 16 * 88, I_D = 44 * 32, I_IN = 16 * 96, I_OUT = 16 * 32;
    constexpr int NITEMS = 2 * I_D + 2 * I_GU + I_IN + I_OUT;
    for (int it = gw; it < NITEMS; it += NGW) {
        int r = it;
        if (r < I_D) { tr_item(P.w1d, DFF, D, P.W1D, 0, scr, r, lane); continue; } r -= I_D;
        if (r < I_IN) { tr_item(P.win, D, INW, P.WIN, 3, scr, r, lane); continue; } r -= I_IN;
        if (r < I_OUT) { tr_item(P.wout, D, D, P.WOUT, 0, scr, r, lane); continue; } r -= I_OUT;
        if (r < I_GU) { tr_item(P.w2g, D, DFF, P.W2GU, 1, scr, r, lane); continue; } r -= I_GU;
        if (r < I_GU) { tr_item(P.w2u, D, DFF, P.W2GU, 2, scr, r, lane); continue; } r -= I_GU;
        tr_item(P.w2d, DFF, D, P.W2D, 0, scr, r, lane);
    }
}
__device__ __forceinline__ void norm_res_phase(const float* resA, const float* resB, const float* Y, const float* gpost, float scale, float* hout, const float* gnext, bf16* XN, int gw, int NGW, int lane) {
    for (int r = gw; r < M; r += NGW) {
        const float4* x = (const float4*)(r < MP ? resA + (size_t)r * D : resB + (size_t)(r - MP) * D);
        const float4* y = (const float4*)(Y + (size_t)r * D);
        float4 v[4], hv[4]; float ss = 0.f;
#pragma unroll
        for (int j = 0; j < 4; ++j) { v[j] = y[lane + 64 * j]; hv[j] = x[lane + 64 * j]; ss += v[j].x * v[j].x + v[j].y * v[j].y + v[j].z * v[j].z + v[j].w * v[j].w; }
        const float rstd = scale / sqrtf(wave_sum(ss) * (1.f / D) + EPS);
        float s2 = 0.f;
#pragma unroll
        for (int j = 0; j < 4; ++j) { const float4 gg = ((const float4*)gpost)[lane + 64 * j];
            hv[j].x += v[j].x * rstd * gg.x; hv[j].y += v[j].y * rstd * gg.y; hv[j].z += v[j].z * rstd * gg.z; hv[j].w += v[j].w * rstd * gg.w;
            s2 += hv[j].x * hv[j].x + hv[j].y * hv[j].y + hv[j].z * hv[j].z + hv[j].w * hv[j].w; }
        float4* ho = (float4*)(hout + (size_t)r * D);
#pragma unroll
        for (int j = 0; j < 4; ++j) ho[lane + 64 * j] = hv[j];
        if (gnext) {
            const float r2 = 1.f / sqrtf(wave_sum(s2) * (1.f / D) + EPS);
            uint2* o = (uint2*)(XN + (size_t)r * D);
#pragma unroll
            for (int j = 0; j < 4; ++j) { const float4 gg = ((const float4*)gnext)[lane + 64 * j];
                o[lane + 64 * j] = make_uint2(pk2(hv[j].x * r2 * gg.x, hv[j].y * r2 * gg.y), pk2(hv[j].z * r2 * gg.z, hv[j].w * r2 * gg.w)); }
        }
    }
}
typedef float f32x16 __attribute__((ext_vector_type(16)));
typedef short s16x4 __attribute__((ext_vector_type(4)));
typedef float f32x2_t __attribute__((ext_vector_type(2)));
typedef __bf16 bf16x2_t __attribute__((ext_vector_type(2)));
__device__ __forceinline__ unsigned cvtpk(float lo, float hi) { f32x2_t v = {lo, hi}; bf16x2_t b = __builtin_convertvector(v, bf16x2_t); return __builtin_bit_cast(unsigned, b); }
__device__ __forceinline__ s16x4 vtr(const LAS unsigned char* p) { return __builtin_bit_cast(s16x4, __builtin_amdgcn_ds_read_tr16_b64_v4i16((LAS s16x4*)p)); }
#define MFMA32(a, b, c) __builtin_amdgcn_mfma_f32_32x32x16_bf16((a), (b), (c), 0, 0, 0)
__device__ __forceinline__ int crow(int reg, int hh) { return (reg & 3) + 8 * (reg >> 2) + 4 * hh; }
__device__ __forceinline__ float bf_lo(unsigned u) { return __builtin_bit_cast(float, u << 16); }
__device__ __forceinline__ float bf_hi(unsigned u) { return __builtin_bit_cast(float, u & 0xffff0000u); }
constexpr float QSCALE = 0.125f * 1.4426950408889634f;

__device__ __forceinline__ void sk_tile(LAS unsigned char* lds, const bf16* A, int lda, const bf16* Wt, int K, int r0, int c0, int tid, int wave, int lane) {
    const int i = lane & 31, hh = lane >> 5;
    const int ksl = K >> 3, k0 = wave * ksl;
    const bf16* ap = A + (size_t)(r0 + i) * lda + k0 + 8 * hh;
    const bf16* bp0 = Wt + (size_t)(c0 + i) * K + k0 + 8 * hh;
    const bf16* bp1 = bp0 + (size_t)32 * K;
    f32x16 acc0, acc1;
#pragma unroll
    for (int e = 0; e < 16; ++e) { acc0[e] = 0.f; acc1[e] = 0.f; }
#pragma unroll 4
    for (int ks = 0; ks < (ksl >> 4); ++ks) {
        const bf16x8 a = *(const bf16x8*)(ap + 16 * ks), b0 = *(const bf16x8*)(bp0 + 16 * ks), b1 = *(const bf16x8*)(bp1 + 16 * ks);
        acc0 = MFMA32(a, b0, acc0); acc1 = MFMA32(a, b1, acc1);
    }
    LAS float* part = (LAS float*)lds + wave * 2048;
#pragma unroll
    for (int e = 0; e < 16; ++e) { const int row = crow(e, hh); part[row * 64 + i] = acc0[e]; part[row * 64 + 32 + i] = acc1[e]; }
    __syncthreads();
    {
        const LAS f32x4* p4 = (const LAS f32x4*)lds + tid;
        f32x4 s = p4[0];
#pragma unroll
        for (int w = 1; w < 8; ++w) s += p4[w * 512];
        ((LAS f32x4*)(lds + 65536))[tid] = s;
    }
    __syncthreads();
}
__device__ __forceinline__ void sk_gemm_y(LAS unsigned char* lds, const bf16* A, int lda, const bf16* Wt, int K, float* Y, int tid, int wave, int lane) {
    for (int item = blockIdx.x; item < 256; item += gridDim.x) {
        const int rt = item >> 4, ct = item & 15;
        sk_tile(lds, A, lda, Wt, K, MP + 32 * rt, 64 * ct, tid, wave, lane);
        const f32x4 v = ((const LAS f32x4*)(lds + 65536))[tid];
        *(f32x4*)(Y + (size_t)(MP + 32 * rt + (tid >> 4)) * D + 64 * ct + 4 * (tid & 15)) = v;
        __syncthreads();
    }
}
__device__ __forceinline__ void sk_gemm_qkv(LAS unsigned char* lds, const bf16* XN, const bf16* WIN, bf16* QKVb, const float2* tab, float* out, int tid, int wave, int lane) {
    const LAS float* red = (const LAS float*)(lds + 65536);
    for (int item = blockIdx.x; item < 768; item += gridDim.x) {
        const int rt = item / 48, ct = item % 48;
        sk_tile(lds, XN, D, WIN, D, MP + 32 * rt, 64 * ct, tid, wave, lane);
        const int row = tid >> 4, c4 = tid & 15, srow = 32 * rt + row, pos = PAST + (srow & 3), nc0 = 64 * ct;
        float y[4];
#pragma unroll
        for (int k = 0; k < 4; ++k) {
            const int dd = 4 * c4 + k;
            const float x = red[row * 64 + (win_perm(nc0 + dd) - nc0)];
            float r = x;
            if (ct < 16) {
                if (dd < 16) { const float xp = red[row * 64 + (win_perm(nc0 + (dd ^ 8)) - nc0)]; const float2 cs = tab[pos * 40 + (dd & 7)];
                    r = dd < 8 ? x * cs.x - xp * cs.y : x * cs.x + xp * cs.y; }
                if (ct < 8) r *= QSCALE;
            } else if (ct >= 24 && ct < 32) {
                const float xp = red[row * 64 + (win_perm(nc0 + (dd ^ 32)) - nc0)]; const float2 cs = tab[pos * 40 + 8 + (dd & 31)];
                r = dd < 32 ? x * cs.x - xp * cs.y : x * cs.x + xp * cs.y;
                if (ct >= 28) r *= 0.125f;
            }
            y[k] = r;
        }
        *(uint2*)(QKVb + (size_t)(MP + srow) * INW + nc0 + 4 * c4) = make_uint2(cvtpk(y[0], y[1]), cvtpk(y[2], y[3]));
        if (ct >= 8 && ct < 16) *(float4*)(out + O_KS + (size_t)srow * 512 + (nc0 - C_KA) + 4 * c4) = make_float4(y[0], y[1], y[2], y[3]);
        if (ct >= 16 && ct < 24) *(float4*)(out + O_VS + (size_t)srow * 512 + (nc0 - C_VA) + 4 * c4) = make_float4(y[0], y[1], y[2], y[3]);
        __syncthreads();
    }
}
__device__ __forceinline__ void attn_mfma_phase(LAS unsigned char* lds, const bf16* QKVb, bf16* OPART, float2* ML, int tid, int wave, int lane) {
    constexpr int RSK = 144, RSV = 192;
    LAS unsigned char* kimg = lds;
    LAS unsigned char* vimg = lds + 384 * RSK;
    const int i = lane & 31, hh = lane >> 5, i16 = lane & 15, tq = i16 >> 2, tp = i16 & 3, blk = (lane >> 4) & 1;
    for (int item = blockIdx.x; item < 1536; item += gridDim.x) {
        const int h = item / 192, w = item % 192;
        int b, r, bk;
        if (w < 64) { b = 0; r = 0; bk = w; } else if (w < 128) { b = 1; r = (w - 64) >> 4; bk = (w - 64) & 15; } else { b = 2; r = (w - 128) >> 2; bk = (w - 128) & 3; }
        const int d = 1 << (2 * b), L0 = bk * 256;
#pragma unroll
        for (int c = 0; c < 6; ++c) {
            const int e = tid + NTHR * c, j = e >> 3, ch = e & 7, l = L0 - 128 + j;
            if (l >= 0) {
                const bf16* src = QKVb + (size_t)(l * d + r) * INW + h * 64 + 8 * ch;
                *(LAS v4u*)(kimg + j * RSK + 16 * ch) = *(const v4u*)(src + C_KA);
                *(LAS v4u*)(vimg + j * RSV + 16 * ch) = *(const v4u*)(src + C_VA);
            }
        }
        const int l0 = L0 + 32 * wave;
        const int tok_q = (l0 + i) * d + r;
        const bf16* qp = QKVb + (size_t)tok_q * INW + C_QA + h * 64 + 8 * hh;
        bf16x8 qf[4];
#pragma unroll
        for (int ks = 0; ks < 4; ++ks) qf[ks] = *(const bf16x8*)(qp + 16 * ks);
        __syncthreads();
        f32x16 o0, o1;
#pragma unroll
        for (int e = 0; e < 16; ++e) { o0[e] = 0.f; o1[e] = 0.f; }
        float m = -1e30f, l = 0.f;
        const int kt0 = l0 >= 128 ? 0 : ((128 - l0) >> 5);
        for (int kt = kt0; kt < 5; ++kt) {
            const int jb = 32 * wave + 32 * kt;
            const LAS unsigned char* kp = kimg + (jb + i) * RSK + 16 * hh;
            f32x16 s;
#pragma unroll
            for (int e = 0; e < 16; ++e) s[e] = 0.f;
#pragma unroll
            for (int ks = 0; ks < 4; ++ks) { const bf16x8 kf = *(const LAS bf16x8*)(kp + 32 * ks); s = MFMA32(kf, qf[ks], s); }
            float tm = -1e30f;
#pragma unroll
            for (int e = 0; e < 16; ++e) { const int j = crow(e, hh); const bool bad = (kt == 0 && j < i) || (kt == 4 && j > i); s[e] = bad ? -1e30f : s[e]; tm = fmaxf(tm, s[e]); }
            tm = fmaxf(tm, __shfl_xor(tm, 32));
            const float mn = fmaxf(m, tm), scl = __builtin_amdgcn_exp2f(m - mn);
            m = mn; l *= scl;
#pragma unroll
            for (int e = 0; e < 16; ++e) { o0[e] *= scl; o1[e] *= scl; }
            float psum = 0.f;
#pragma unroll
            for (int e = 0; e < 16; ++e) { s[e] = __builtin_amdgcn_exp2f(s[e] - mn); psum += s[e]; }
            l += psum;
            v4u pw0, pw1;
            pw0.x = cvtpk(s[0], s[1]); pw0.y = cvtpk(s[2], s[3]); pw0.z = cvtpk(s[4], s[5]); pw0.w = cvtpk(s[6], s[7]);
            pw1.x = cvtpk(s[8], s[9]); pw1.y = cvtpk(s[10], s[11]); pw1.z = cvtpk(s[12], s[13]); pw1.w = cvtpk(s[14], s[15]);
            const bf16x8 pf0 = __builtin_bit_cast(bf16x8, pw0), pf1 = __builtin_bit_cast(bf16x8, pw1);
#pragma unroll
            for (int st = 0; st < 2; ++st) {
                const LAS unsigned char* a0 = vimg + (jb + 16 * st + 4 * hh + tq) * RSV + (16 * blk + 4 * tp) * 2;
                const s16x4 lo0 = vtr(a0), hi0 = vtr(a0 + 8 * RSV), lo1 = vtr(a0 + 64), hi1 = vtr(a0 + 8 * RSV + 64);
                const bf16x8 v0 = __builtin_shufflevector(lo0, hi0, 0, 1, 2, 3, 4, 5, 6, 7), v1 = __builtin_shufflevector(lo1, hi1, 0, 1, 2, 3, 4, 5, 6, 7);
                o0 = MFMA32(v0, st == 0 ? pf0 : pf1, o0);
                o1 = MFMA32(v1, st == 0 ? pf0 : pf1, o1);
            }
        }
        const float lt = l + __shfl_xor(l, 32), inv = 1.f / lt;
        bf16* op = OPART + ((size_t)b * MP + tok_q) * 512 + h * 64 + 4 * hh;
#pragma unroll
        for (int g = 0; g < 4; ++g) {
            *(uint2*)(op + 8 * g) = make_uint2(cvtpk(o0[4 * g] * inv, o0[4 * g + 1] * inv), cvtpk(o0[4 * g + 2] * inv, o0[4 * g + 3] * inv));
            *(uint2*)(op + 32 + 8 * g) = make_uint2(cvtpk(o1[4 * g] * inv, o1[4 * g + 1] * inv), cvtpk(o1[4 * g + 2] * inv, o1[4 * g + 3] * inv));
        }
        if (hh == 0) ML[((size_t)b * MP + tok_q) * 8 + h] = make_float2(m, lt);
        __syncthreads();
    }
}
__device__ __forceinline__ void attn_combine_phase(const bf16* OPART, const float2* ML, bf16* MIX, int gtid, int NGT) {
    for (int idx = gtid; idx < MP * 64; idx += NGT) {
        const int tok = idx >> 6, h = (idx >> 3) & 7, c = idx & 7;
        const float2 a0 = ML[((size_t)0 * MP + tok) * 8 + h], a1 = ML[((size_t)1 * MP + tok) * 8 + h], a2 = ML[((size_t)2 * MP + tok) * 8 + h];
        const float mx = fmaxf(a0.x, fmaxf(a1.x, a2.x));
        float w0 = a0.y * __builtin_amdgcn_exp2f(a0.x - mx), w1 = a1.y * __builtin_amdgcn_exp2f(a1.x - mx), w2 = a2.y * __builtin_amdgcn_exp2f(a2.x - mx);
        const float iw = 1.f / (w0 + w1 + w2); w0 *= iw; w1 *= iw; w2 *= iw;
        const v4u x0 = *(const v4u*)(OPART + ((size_t)0 * MP + tok) * 512 + h * 64 + 8 * c);
        const v4u x1 = *(const v4u*)(OPART + ((size_t)1 * MP + tok) * 512 + h * 64 + 8 * c);
        const v4u x2 = *(const v4u*)(OPART + ((size_t)2 * MP + tok) * 512 + h * 64 + 8 * c);
        v4u o;
        o.x = cvtpk(w0 * bf_lo(x0.x) + w1 * bf_lo(x1.x) + w2 * bf_lo(x2.x), w0 * bf_hi(x0.x) + w1 * bf_hi(x1.x) + w2 * bf_hi(x2.x));
        o.y = cvtpk(w0 * bf_lo(x0.y) + w1 * bf_lo(x1.y) + w2 * bf_lo(x2.y), w0 * bf_hi(x0.y) + w1 * bf_hi(x1.y) + w2 * bf_hi(x2.y));
        o.z = cvtpk(w0 * bf_lo(x0.z) + w1 * bf_lo(x1.z) + w2 * bf_lo(x2.z), w0 * bf_hi(x0.z) + w1 * bf_hi(x1.z) + w2 * bf_hi(x2.z));
        o.w = cvtpk(w0 * bf_lo(x0.w) + w1 * bf_lo(x1.w) + w2 * bf_lo(x2.w), w0 * bf_hi(x0.w) + w1 * bf_hi(x1.w) + w2 * bf_hi(x2.w));
        *(v4u*)(MIX + (size_t)tok * D + h * 64 + 8 * c) = o;
    }
}
__device__ __forceinline__ void ret_out_mfma_phase(LAS unsigned char* lds, const bf16* QKVb, const bf16* SPT, const float* gnw, bf16* MIX, int tid, int wave, int lane) {
    constexpr int RSV = 272;
    const int grp = wave >> 2, itile = wave & 3;
    LAS unsigned char* vb = lds + grp * (128 * RSV);
    const int i = lane & 31, hh = lane >> 5, i16 = lane & 15, tq = i16 >> 2, tp = i16 & 3, blk = (lane >> 4) & 1;
    for (int it = blockIdx.x; it < 256; it += gridDim.x) {
        const int item = it * 2 + grp, n = item >> 2, h = item & 3;
        const float lg2 = log_g(h) * 1.4426950408889634f;
        {
            const int t4 = tid & 255;
#pragma unroll
            for (int c = 0; c < 8; ++c) { const int e = t4 + 256 * c, rowk = e >> 4, ch = e & 15;
                *(LAS v4u*)(vb + rowk * RSV + 16 * ch) = *(const v4u*)(QKVb + (size_t)(n * 128 + rowk) * INW + C_VR + h * 128 + 8 * ch); }
        }
        __syncthreads();
        const int row_i = n * 128 + 32 * itile + i;
        bf16x8 qf[4];
#pragma unroll
        for (int ks = 0; ks < 4; ++ks) qf[ks] = *(const bf16x8*)(QKVb + (size_t)row_i * INW + C_QR + h * 64 + 16 * ks + 8 * hh);
        f32x16 acc[4];
#pragma unroll
        for (int dt = 0; dt < 4; ++dt) {
#pragma unroll
            for (int e = 0; e < 16; ++e) acc[dt][e] = 0.f;
#pragma unroll
            for (int ks = 0; ks < 4; ++ks) { const bf16x8 a = *(const bf16x8*)(SPT + ((size_t)(n * 4 + h) * 128 + 32 * dt + i) * 64 + 16 * ks + 8 * hh); acc[dt] = MFMA32(a, qf[ks], acc[dt]); }
        }
        const float wh = __builtin_amdgcn_exp2f((float)(32 * itile + i + 1) * lg2);
#pragma unroll
        for (int dt = 0; dt < 4; ++dt)
#pragma unroll
            for (int e = 0; e < 16; ++e) acc[dt][e] *= wh;
        for (int jt = 0; jt <= itile; ++jt) {
            bf16x8 kf[4];
#pragma unroll
            for (int ks = 0; ks < 4; ++ks) kf[ks] = *(const bf16x8*)(QKVb + (size_t)(n * 128 + 32 * jt + i) * INW + C_KR + h * 64 + 16 * ks + 8 * hh);
            f32x16 s;
#pragma unroll
            for (int e = 0; e < 16; ++e) s[e] = 0.f;
#pragma unroll
            for (int ks = 0; ks < 4; ++ks) s = MFMA32(kf[ks], qf[ks], s);
#pragma unroll
            for (int e = 0; e < 16; ++e) { const int dl = 32 * (itile - jt) + i - crow(e, hh); s[e] = dl >= 0 ? s[e] * __builtin_amdgcn_exp2f((float)dl * lg2) : 0.f; }
            v4u pw0, pw1;
            pw0.x = cvtpk(s[0], s[1]); pw0.y = cvtpk(s[2], s[3]); pw0.z = cvtpk(s[4], s[5]); pw0.w = cvtpk(s[6], s[7]);
            pw1.x = cvtpk(s[8], s[9]); pw1.y = cvtpk(s[10], s[11]); pw1.z = cvtpk(s[12], s[13]); pw1.w = cvtpk(s[14], s[15]);
            const bf16x8 pf0 = __builtin_bit_cast(bf16x8, pw0), pf1 = __builtin_bit_cast(bf16x8, pw1);
#pragma unroll
            for (int st = 0; st < 2; ++st) {
                const LAS unsigned char* a0 = vb + (32 * jt + 16 * st + 4 * hh + tq) * RSV + (16 * blk + 4 * tp) * 2;
#pragma unroll
                for (int dt = 0; dt < 4; ++dt) {
                    const s16x4 lo = vtr(a0 + 64 * dt), hi = vtr(a0 + 8 * RSV + 64 * dt);
                    const bf16x8 vf = __builtin_shufflevector(lo, hi, 0, 1, 2, 3, 4, 5, 6, 7);
                    acc[dt] = MFMA32(vf, st == 0 ? pf0 : pf1, acc[dt]);
                }
            }
        }
        float s1 = 0.f;
#pragma unroll
        for (int dt = 0; dt < 4; ++dt)
#pragma unroll
            for (int e = 0; e < 16; ++e) s1 += acc[dt][e];
        s1 += __shfl_xor(s1, 32);
        const float mu = s1 * (1.f / 128.f);
        float s2 = 0.f;
#pragma unroll
        for (int dt = 0; dt < 4; ++dt)
#pragma unroll
            for (int e = 0; e < 16; ++e) { const float dd = acc[dt][e] - mu; s2 += dd * dd; }
        s2 += __shfl_xor(s2, 32);
        const float rstd = 1.f / sqrtf(s2 * (1.f / 128.f) + EPS);
#pragma unroll
        for (int dt = 0; dt < 4; ++dt)
#pragma unroll
            for (int g = 0; g < 4; ++g) {
                const int dv0 = 32 * dt + 8 * g + 4 * hh;
                const uint2 gr = *(const uint2*)(QKVb + (size_t)row_i * INW + C_GR + h * 128 + dv0);
                const float4 gw4 = *(const float4*)(gnw + h * 128 + dv0);
                const float y0 = (acc[dt][4 * g] - mu) * rstd * gw4.x * silu_f(bf_lo(gr.x)), y1 = (acc[dt][4 * g + 1] - mu) * rstd * gw4.y * silu_f(bf_hi(gr.x));
                const float y2 = (acc[dt][4 * g + 2] - mu) * rstd * gw4.z * silu_f(bf_lo(gr.y)), y3 = (acc[dt][4 * g + 3] - mu) * rstd * gw4.w * silu_f(bf_hi(gr.y));
                *(uint2*)(MIX + (size_t)row_i * D + 512 + h * 128 + dv0) = make_uint2(cvtpk(y0, y1), cvtpk(y2, y3));
            }
        __syncthreads();
    }
}
template <int CTRL> __device__ __forceinline__ float dppf(float x) { return __builtin_bit_cast(float, __builtin_amdgcn_mov_dpp(__builtin_bit_cast(int, x), CTRL, 0xf, 0xf, true)); }
__device__ __forceinline__ float row16_sum(float v) { v += dppf<0xB1>(v); v += dppf<0x4E>(v); v += dppf<0x141>(v); v += dppf<0x128>(v); return v; }
constexpr int SA_CH = 15, SA_KPC = 60;
__device__ __forceinline__ void sa_rows(int kk, int b, const float* ck, const float* cv, const float* out, const float*& kr, const float*& vr, int& e) {
    e = kk < 516 ? kk : 528 + 16 * ((kk - 516) >> 2) + ((kk - 516) & 3);
    const int idx = 2051 - e;
    if (idx >= WB) { kr = out + O_KS + (size_t)(b * 4 + idx - WB) * 512; vr = out + O_VS + (size_t)(b * 4 + idx - WB) * 512; }
    else { kr = ck + ((size_t)b * WB + idx) * 512; vr = cv + ((size_t)b * WB + idx) * 512; }
}
__device__ __forceinline__ void attn_sample_phase(const bf16* QKVb, const float* ck, const float* cv, const float* out, float* SPART, float2* SML, int gw, int NGW, int lane) {
    const int l16 = lane & 15, hq = lane >> 4;
    for (int item = gw; item < DBATCH * SA_CH; item += NGW) {
        const int b = item / SA_CH, c = item % SA_CH;
        f32x4 q[4][2], o[4][2]; float m[4][2], l[4][2];
#pragma unroll
        for (int i = 0; i < 4; ++i)
#pragma unroll
            for (int u = 0; u < 2; ++u) {
                { const uint2 qq = *(const uint2*)(QKVb + (size_t)(MP + b * 4 + i) * INW + C_QA + (4 * u + hq) * 64 + 4 * l16); q[i][u] = (f32x4){bf_lo(qq.x), bf_hi(qq.x), bf_lo(qq.y), bf_hi(qq.y)}; }
                o[i][u] = (f32x4){0.f, 0.f, 0.f, 0.f}; m[i][u] = -1e30f; l[i][u] = 0.f;
            }
        for (int g = 0; g < SA_KPC / 4; ++g) {
            f32x4 kx[4][2], vx[4][2]; int ee[4];
#pragma unroll
            for (int t = 0; t < 4; ++t) {
                const float *kr, *vr; sa_rows(c * SA_KPC + g * 4 + t, b, ck, cv, out, kr, vr, ee[t]);
                kx[t][0] = *(const f32x4*)(kr + 4 * lane); kx[t][1] = *(const f32x4*)(kr + 256 + 4 * lane);
                vx[t][0] = *(const f32x4*)(vr + 4 * lane); vx[t][1] = *(const f32x4*)(vr + 256 + 4 * lane);
            }
#pragma unroll
            for (int t = 0; t < 4; ++t)
#pragma unroll
                for (int i = 0; i < 4; ++i) {
                    const int dl = ee[t] - 3 + i;
                    const int mult = dl >= 0 ? (int)(dl <= 128) + (int)(((dl & 3) == 0) && dl <= 512) + (int)(((dl & 15) == 0) && dl <= 2048) : 0;
                    if (mult) {
                        const float fm = (float)mult;
#pragma unroll
                        for (int u = 0; u < 2; ++u) {
                            const f32x4 pr = q[i][u] * kx[t][u];
                            const float s = row16_sum((pr[0] + pr[1]) + (pr[2] + pr[3]));
                            const float mn = fmaxf(m[i][u], s), scl = __builtin_amdgcn_exp2f(m[i][u] - mn), p = fm * __builtin_amdgcn_exp2f(s - mn);
                            m[i][u] = mn; l[i][u] = l[i][u] * scl + p; o[i][u] = o[i][u] * scl + vx[t][u] * p;
                        }
                    }
                }
        }
#pragma unroll
        for (int i = 0; i < 4; ++i)
#pragma unroll
            for (int u = 0; u < 2; ++u) {
                const size_t base = ((size_t)(b * SA_CH + c) * 4 + i) * 8 + 4 * u + hq;
                *(f32x4*)(SPART + base * 64 + 4 * l16) = o[i][u];
                if (l16 == 0) SML[base] = make_float2(m[i][u], l[i][u]);
            }
    }
}
__device__ __forceinline__ void attn_sample_merge_phase(const float* SPART, const float2* SML, bf16* MIX, int gw, int NGW, int lane) {
    for (int item = gw; item < DBATCH * 32; item += NGW) {
        const int b = item >> 5, i = (item >> 3) & 3, h = item & 7;
        float2 ml[SA_CH]; float mx = -1e30f;
#pragma unroll
        for (int c = 0; c < SA_CH; ++c) { ml[c] = SML[((size_t)(b * SA_CH + c) * 4 + i) * 8 + h]; mx = fmaxf(mx, ml[c].x); }
        float acc = 0.f, L = 0.f;
#pragma unroll
        for (int c = 0; c < SA_CH; ++c) { const float w = __builtin_amdgcn_exp2f(ml[c].x - mx); L += w * ml[c].y; acc += w * SPART[(((size_t)(b * SA_CH + c) * 4 + i) * 8 + h) * 64 + lane]; }
        MIX[(size_t)(MP + b * 4 + i) * D + h * 64 + lane] = (bf16)f2bf(acc / L);
    }
}
__device__ __forceinline__ void ret_upd_phase(LAS unsigned char* lds, const bf16* __restrict__ QKVb, float* __restrict__ UPD, int tid) {
    LAS float* kc = (LAS float*)lds;
    LAS float* vc = (LAS float*)(lds + 32768);
    for (int it = blockIdx.x; it < 512; it += gridDim.x) {
        const int n = it >> 2, h = it & 3;
        const float lg = log_g(h);
#pragma unroll
        for (int c = 0; c < 2; ++c) { const int e = tid + NTHR * c, j = e >> 3, ch = e & 7;
            const v4u x = *(const v4u*)(QKVb + (size_t)(n * 128 + j) * INW + C_KR + h * 64 + 8 * ch);
            const float w = expf((float)(127 - j) * lg);
            *(LAS f32x4*)(kc + j * 64 + 8 * ch) = (f32x4){bf_lo(x.x) * w, bf_hi(x.x) * w, bf_lo(x.y) * w, bf_hi(x.y) * w};
            *(LAS f32x4*)(kc + j * 64 + 8 * ch + 4) = (f32x4){bf_lo(x.z) * w, bf_hi(x.z) * w, bf_lo(x.w) * w, bf_hi(x.w) * w}; }
#pragma unroll
        for (int c = 0; c < 4; ++c) { const int e = tid + NTHR * c, j = e >> 4, ch = e & 15;
            const v4u x = *(const v4u*)(QKVb + (size_t)(n * 128 + j) * INW + C_VR + h * 128 + 8 * ch);
            *(LAS f32x4*)(vc + j * 128 + 8 * ch) = (f32x4){bf_lo(x.x), bf_hi(x.x), bf_lo(x.y), bf_hi(x.y)};
            *(LAS f32x4*)(vc + j * 128 + 8 * ch + 4) = (f32x4){bf_lo(x.z), bf_hi(x.z), bf_lo(x.w), bf_hi(x.w)}; }
        __syncthreads();
        const int dv = tid & 127, qt = tid >> 7;
        float acc[16];
#pragma unroll
        for (int i = 0; i < 16; ++i) acc[i] = 0.f;
#pragma unroll 4
        for (int j = 0; j < 128; ++j) {
            const float vj = vc[j * 128 + dv];
#pragma unroll
            for (int i = 0; i < 16; i += 4) { const f32x4 k4 = *(const LAS f32x4*)(kc + j * 64 + qt * 16 + i);
                acc[i] += k4[0] * vj; acc[i + 1] += k4[1] * vj; acc[i + 2] += k4[2] * vj; acc[i + 3] += k4[3] * vj; }
        }
#pragma unroll
        for (int i = 0; i < 16; i += 4) *(float4*)(UPD + ((size_t)(n * 4 + h) * 128 + dv) * 64 + qt * 16 + i) = make_float4(acc[i], acc[i + 1], acc[i + 2], acc[i + 3]);
        __syncthreads();
    }
}
__device__ __forceinline__ void ret_scan_phase(const float* UPDT, bf16* SPT, float* out, int tid) {
    const int e = blockIdx.x * NTHR + tid;
    if (e < 32768) {
        const int h = e >> 13, dv = (e >> 6) & 127, dk = e & 63;
        const float G = expf(128.f * log_g(h));
        float S = 0.f;
        for (int n = 0; n < 128; ++n) { SPT[(size_t)n * 32768 + e] = (bf16)f2bf(S); S = G * S + UPDT[(size_t)n * 32768 + e]; }
        out[O_SP + h * 8192 + dk * 128 + dv] = S;
    }
}
__device__ __forceinline__ void ret_sample_phase(LAS unsigned char* lds, const bf16* __restrict__ QKVb, const float* __restrict__ state, const float* __restrict__ gnw, bf16* __restrict__ MIX, float* __restrict__ out, int tid) {
    const int grp = tid >> 7, t = tid & 127, dv = t;
    LAS float* qs = (LAS float*)(lds + grp * 4096);
    LAS float* ks = qs + 256;
    LAS float* red = ks + 256;
    for (int it = blockIdx.x; it < 128; it += gridDim.x) {
        const int sub = it * 4 + grp, b = sub >> 2, h = sub & 3;
        const float g = 1.f - exp2f(-5.f - (float)h);
        const float g2 = g * g, g3 = g2 * g, g4 = g2 * g2;
        const int row0 = MP + b * 4;
        const float* s0p = state + (size_t)(b * 4 + h) * 64 * 128 + dv;
        float* snp = out + O_SS + (size_t)(b * 4 + h) * 64 * 128 + dv;
        for (int e = t; e < 256; e += 128) { const int i = e >> 6, dk = e & 63;
            qs[e] = bf_lo((unsigned)QKVb[(size_t)(row0 + i) * INW + C_QR + h * 64 + dk]); ks[e] = bf_lo((unsigned)QKVb[(size_t)(row0 + i) * INW + C_KR + h * 64 + dk]); }
        float v[4];
#pragma unroll
        for (int i = 0; i < 4; ++i) v[i] = bf_lo((unsigned)QKVb[(size_t)(row0 + i) * INW + C_VR + h * 128 + dv]);
        __syncthreads();
        float c0 = 0.f, c1 = 0.f, c2 = 0.f, c3 = 0.f;
#pragma unroll 1
        for (int d0 = 0; d0 < 64; d0 += 16) {
            float s0v[16];
#pragma unroll
            for (int dk = 0; dk < 16; ++dk) s0v[dk] = __builtin_nontemporal_load(s0p + (d0 + dk) * 128);
#pragma unroll
            for (int dk = 0; dk < 16; ++dk) {
                const float s0 = s0v[dk]; const int kk = d0 + dk;
                c0 += qs[kk] * s0; c1 += qs[64 + kk] * s0; c2 += qs[128 + kk] * s0; c3 += qs[192 + kk] * s0;
                __builtin_nontemporal_store(g4 * s0 + g3 * ks[kk] * v[0] + g2 * ks[64 + kk] * v[1] + g * ks[128 + kk] * v[2] + ks[192 + kk] * v[3], snp + kk * 128);
            }
        }
        float d00 = 0.f, d10 = 0.f, d11 = 0.f, d20 = 0.f, d21 = 0.f, d22 = 0.f, d30 = 0.f, d31 = 0.f, d32 = 0.f, d33 = 0.f;
        for (int dk = 0; dk < 64; ++dk) {
            const float q0 = qs[dk], q1 = qs[64 + dk], q2 = qs[128 + dk], q3 = qs[192 + dk];
            const float k0 = ks[dk], k1 = ks[64 + dk], k2 = ks[128 + dk], k3 = ks[192 + dk];
            d00 += q0 * k0; d10 += q1 * k0; d11 += q1 * k1; d20 += q2 * k0; d21 += q2 * k1; d22 += q2 * k2;
            d30 += q3 * k0; d31 += q3 * k1; d32 += q3 * k2; d33 += q3 * k3;
        }
        float o[4];
        o[0] = g * c0 + d00 * v[0];
        o[1] = g2 * c1 + g * d10 * v[0] + d11 * v[1];
        o[2] = g3 * c2 + g2 * d20 * v[0] + g * d21 * v[1] + d22 * v[2];
        o[3] = g4 * c3 + g3 * d30 * v[0] + g2 * d31 * v[1] + g * d32 * v[2] + d33 * v[3];
#pragma unroll
        for (int i = 0; i < 4; ++i) { const float s1 = wave_sum(o[i]); if ((t & 63) == 0) red[i * 2 + (t >> 6)] = s1; }
        __syncthreads();
        float dl[4];
#pragma unroll
        for (int i = 0; i < 4; ++i) { const float mu = (red[i * 2] + red[i * 2 + 1]) * (1.f / 128.f); dl[i] = o[i] - mu; }
#pragma unroll
        for (int i = 0; i < 4; ++i) { const float s2 = wave_sum(dl[i] * dl[i]); if ((t & 63) == 0) red[8 + i * 2 + (t >> 6)] = s2; }
        __syncthreads();
#pragma unroll
        for (int i = 0; i < 4; ++i) {
            const float var = (red[8 + i * 2] + red[8 + i * 2 + 1]) * (1.f / 128.f);
            const float y = dl[i] / sqrtf(var + EPS) * gnw[h * 128 + dv];
            const float gg = bf_lo((unsigned)QKVb[(size_t)(row0 + i) * INW + C_GR + h * 128 + dv]);
            MIX[(size_t)(row0 + i) * D + 512 + h * 128 + dv] = (bf16)f2bf(silu_f(gg) * y);
        }
        __syncthreads();
    }
}

struct Args { const float* in[20]; float* out; unsigned char* ws; };
__global__ void __launch_bounds__(NTHR, 2) mk_fwd(Args a) {
    extern __shared__ __attribute__((aligned(16))) unsigned char lds_raw[];
    LAS unsigned char* lds = (LAS unsigned char*)lds_raw;
    volatile LAS unsigned* MISC = (volatile LAS unsigned*)(lds + MISC_OFF);
    const int tid = threadIdx.x, lane = tid & 63, wave = __builtin_amdgcn_readfirstlane(tid >> 6);
    const int G = gridDim.x;
    const int gw = blockIdx.x * NWAVES + wave, NGW = G * NWAVES, gtid = blockIdx.x * NTHR + tid, NGT = G * NTHR;
    unsigned char* ws = a.ws;
    Ptrs P;
    P.xp = a.in[0]; P.xs = a.in[1]; P.ck = a.in[2]; P.cv = a.in[3]; P.st = a.in[4]; P.g1a = a.in[5]; P.g1b = a.in[6]; P.w1g = a.in[7]; P.w1u = a.in[8]; P.w1d = a.in[9];
    P.gma = a.in[10]; P.gmb = a.in[11]; P.win = a.in[12]; P.gnw = a.in[13]; P.wout = a.in[14]; P.g2a = a.in[15]; P.g2b = a.in[16]; P.w2g = a.in[17]; P.w2u = a.in[18]; P.w2d = a.in[19];
    P.out = a.out;
    P.W1GU = (bf16*)(ws + WS_W1GU); P.W1D = (bf16*)(ws + WS_W1D); P.WIN = (bf16*)(ws + WS_WIN); P.WOUT = (bf16*)(ws + WS_WOUT); P.W2GU = (bf16*)(ws + WS_W2GU); P.W2D = (bf16*)(ws + WS_W2D);
    P.XN = (bf16*)(ws + WS_XN); P.H = (bf16*)(ws + WS_H); P.MIX = (bf16*)(ws + WS_MIX);
    P.TAB = (float2*)(ws + WS_TAB); P.Y = (float*)(ws + WS_Y); P.HRES = (float*)(ws + WS_HRES); P.QKV = (float*)(ws + WS_QKV); P.UPD = (float*)(ws + WS_UPD); P.SPT = (bf16*)(ws + WS_SPREV); P.QKVb = (bf16*)(ws + WS_QKVB); P.OPART = (bf16*)(ws + WS_OPART); P.ML = (float2*)(ws + WS_ML); P.SPART = (float*)(ws + WS_SPART); P.SML = (float2*)(ws + WS_SML);
    for (int u = tid; u < (LDS_BYTES - LDSCTL_OFF) / 4; u += NTHR) ((LAS unsigned*)(lds + LDSCTL_OFF))[u] = 0u;
    __syncthreads();
    XcdBarrier bar = xcd_barrier_post((unsigned*)(ws + WS_CTL) + CW_BAR, MISC + 8);

    p0_prologue(P, lds, gw, NGW, wave, lane, gtid, NGT);
    xcd_barrier(bar);
    { pg8::Gemm g{P.XN, P.W1GU, M, 2 * DFF, D}; pg8::StaticOrder S; S.init(M, 2 * DFF, G, (int)blockIdx.x); pg8::EpiSwiglu E{P.H, DFF};
      pg8::gemm_phase<pg8::EpiSwiglu, pg8::StaticOrder, true, true>(lds, g, S, E); }
    {
        constexpr int NU1 = (M / 256) * (2 * DFF / 256);
        const int rounds = (NU1 + G - 1) / G, idle0 = NU1 - (rounds - 1) * G;
        if (idle0 >= G) p0_deferred(P, lds, gw, NGW, wave, lane);
        else if ((int)blockIdx.x >= idle0) p0_deferred(P, lds, ((int)blockIdx.x - idle0) * NWAVES + wave, (G - idle0) * NWAVES, wave, lane);
    }
    xcd_barrier(bar);
    { pg8::Gemm g{P.H, P.W1D, MP, D, DFF}; pg8::StaticOrder S; S.init(MP, D, G, (int)blockIdx.x); pg8::EpiF32 E{P.Y, D};
      pg8::gemm_phase<pg8::EpiF32, pg8::StaticOrder, true, true>(lds, g, S, E); }
    sk_gemm_y(lds, P.H, DFF, P.W1D, DFF, P.Y, tid, wave, lane);
    xcd_barrier(bar);
    norm_res_phase(P.xp, P.xs, P.Y, P.g1b, 0.5f, P.HRES, P.gma, P.XN, gw, NGW, lane);
    xcd_barrier(bar);
    { pg8::Gemm g{P.XN, P.WIN, MP, INW, D}; pg8::StaticOrder S; S.init(MP, INW, G, (int)blockIdx.x);
      pg8::EpiQKV E{P.QKVb, P.TAB, P.out + O_KP, P.out + O_VP, QSCALE, MP - KEEP};
      pg8::gemm_phase<pg8::EpiQKV, pg8::StaticOrder, true, true>(lds, g, S, E); }
    sk_gemm_qkv(lds, P.XN, P.WIN, P.QKVb, P.TAB, P.out, tid, wave, lane);
    xcd_barrier(bar);
    ret_upd_phase(lds, P.QKVb, P.UPD, tid);
    ret_sample_phase(lds, P.QKVb, P.st, P.gnw, P.MIX, P.out, tid);
    attn_mfma_phase(lds, P.QKVb, P.OPART, P.ML, tid, wave, lane);
    attn_sample_phase(P.QKVb, P.ck, P.cv, P.out, P.SPART, P.SML, gw, NGW, lane);
    xcd_barrier(bar);
    ret_scan_phase(P.UPD, P.SPT, P.out, tid);
    attn_combine_phase(P.OPART, P.ML, P.MIX, gtid, NGT);
    attn_sample_merge_phase(P.SPART, P.SML, P.MIX, gw, NGW, lane);
    xcd_barrier(bar);
    ret_out_mfma_phase(lds, P.QKVb, P.SPT, P.gnw, P.MIX, tid, wave, lane);
    xcd_barrier(bar);
    { pg8::Gemm g{P.MIX, P.WOUT, MP, D, D}; pg8::StaticOrder S; S.init(MP, D, G, (int)blockIdx.x); pg8::EpiF32 E{P.Y, D};
      pg8::gemm_phase<pg8::EpiF32, pg8::StaticOrder, true, true>(lds, g, S, E); }
    sk_gemm_y(lds, P.MIX, D, P.WOUT, D, P.Y, tid, wave, lane);
    xcd_barrier(bar);
    norm_res_phase(P.HRES, P.HRES + (size_t)MP * D, P.Y, P.gmb, 1.0f, P.HRES, P.g2a, P.XN, gw, NGW, lane);
    xcd_barrier(bar);
    { pg8::Gemm g{P.XN, P.W2GU, M, 2 * DFF, D}; pg8::StaticOrder S; S.init(M, 2 * DFF, G, (int)blockIdx.x); pg8::EpiSwiglu E{P.H, DFF};
      pg8::gemm_phase<pg8::EpiSwiglu, pg8::StaticOrder, true, true>(lds, g, S, E); }
    xcd_barrier(bar);
    { pg8::Gemm g{P.H, P.W2D, MP, D, DFF}; pg8::StaticOrder S; S.init(MP, D, G, (int)blockIdx.x); pg8::EpiF32 E{P.Y, D};
      pg8::gemm_phase<pg8::EpiF32, pg8::StaticOrder, true, true>(lds, g, S, E); }
    sk_gemm_y(lds, P.H, DFF, P.W2D, DFF, P.Y, tid, wave, lane);
    xcd_barrier(bar);
    norm_res_phase(P.HRES, P.HRES + (size_t)MP * D, P.Y, P.g2b, 0.5f, P.out + O_Y, nullptr, nullptr, gw, NGW, lane);
}

extern "C" void kernel_launch(void* const* d_in, const int* in_sizes, int n_in, void* d_out, int out_size, void* d_ws, size_t ws_size, hipStream_t stream) {
    static int grid = 0;
    if (grid == 0) {
        if (n_in != 20 || (size_t)out_size != O_END || ws_size < WS_END) { fprintf(stderr, "kernel_launch: unexpected sizes (n_in %d out %d ws %zu)\n", n_in, out_size, ws_size); grid = -1; return; }
        int dev = 0, cus = 0;
        if (hipGetDevice(&dev) != hipSuccess || hipDeviceGetAttribute(&cus, hipDeviceAttributeMultiprocessorCount, dev) != hipSuccess) { grid = -1; return; }
        if (hipFuncSetAttribute((const void*)mk_fwd, hipFuncAttributeMaxDynamicSharedMemorySize, LDS_BYTES) != hipSuccess) { fprintf(stderr, "kernel_launch: hipFuncSetAttribute failed\n"); grid = -1; return; }
        int per_cu = 0;
        if (hipOccupancyMaxActiveBlocksPerMultiprocessor(&per_cu, (const void*)mk_fwd, NTHR, LDS_BYTES) != hipSuccess || per_cu < 1) fprintf(stderr, "kernel_launch: occupancy query says %d\n", per_cu);
        (void)hipGetLastError();
        grid = cus;
    }
    if (grid < 0) return;
    (void)hipMemsetAsync((char*)d_ws + WS_CTL, 0, CTL_ZERO_BYTES, stream);
    Args a{};
    for (int i = 0; i < 20; ++i) a.in[i] = (const float*)d_in[i];
    a.out = (float*)d_out; a.ws = (unsigned char*)d_ws;
    hipLaunchKernelGGL(mk_fwd, dim3(grid), dim3(NTHR), LDS_BYTES, stream, a);
}
```

```cpp
#include <hip/hip_runtime.h>
#include <cstdio>
#include <cstdint>
namespace pg8 {
#define PG8_LAS __attribute__((address_space(3)))
typedef unsigned short bf16_t;
typedef short bf16x8 __attribute__((ext_vector_type(8)));
typedef float f32x4 __attribute__((ext_vector_type(4)));
typedef unsigned u32x4 __attribute__((ext_vector_type(4)));
constexpr int BM = 256, BK = 64, HALF = 128, HTB = HALF * BK * 2  , STAGE_BYTES = 8 * HTB, NXCD = 8, WGM = 8;

__host__ __device__ __forceinline__ int lds_byte(int r, int c) { const int st = (r >> 4) * 2 + (c >> 5), rr = r & 15, cc = c & 31, ob = rr * 64 + cc * 2; return st * 1024 + (ob ^ (((ob >> 9) & 1) << 5)); }
__host__ __device__ __forceinline__ void stage_rc(int b, int& R, int& C) { const int st = b / 1024, sb = b % 1024, swz = sb ^ (((sb >> 9) & 1) << 5); R = (st >> 1) * 16 + swz / 64; C = (st & 1) * 32 + (swz % 64) / 2; }
__host__ __device__ __forceinline__ int perm32(int rho) { const int n = rho >> 4, i = rho & 15; return 8 * (i >> 2) + 4 * n + (i & 3); }

struct Unit { int pm, pn; };
struct Gemm { const bf16_t* A; const bf16_t* Bt; int M, N, K; };

struct StaticOrder {
    int nM, nN, nwg, G, c;
    __host__ __device__ void init(int M, int N, int G_, int c_) { nM = M / BM; nN = N / BM; nwg = nM * nN; G = G_; c = c_; }
    __host__ __device__ bool next(int i, Unit& u) const {
        const long L = (long)i * G + c; if (L >= nwg) return false;
        int wgid = (int)L; { const int q = nwg / NXCD, r = nwg % NXCD, xcd = wgid % NXCD, off = wgid / NXCD; wgid = (xcd < r ? xcd * (q + 1) : r * (q + 1) + (xcd - r) * q) + off; }
        const int nig = WGM * nN, gid = wgid / nig, fm = gid * WGM, gsz = (nM - fm) < WGM ? (nM - fm) : WGM;
        u.pm = fm + ((wgid % nig) % gsz); u.pn = (wgid % nig) / gsz; return true;
    }
    __device__ __forceinline__ void a_ready(const Unit&) const {}
    __device__ __forceinline__ void done(const Unit&) const {}
};

__device__ __forceinline__ unsigned cvt_pk_bf16(float lo, float hi) { unsigned r; asm volatile("v_cvt_pk_bf16_f32 %0, %1, %2" : "=v"(r) : "v"(lo), "v"(hi)); return r; }
typedef float f32x2 __attribute__((ext_vector_type(2)));
typedef unsigned u32x2 __attribute__((ext_vector_type(2)));
struct EpiQKV {
    static constexpr bool PERM = true, AFTER_DRAIN = false;
    bf16_t* QKVb; const float2* tab; float* okp; float* ovp; float qscale; int keep0;
    __device__ __forceinline__ void operator()(const f32x4 (&acc)[2][2][4][2], const Unit& u, int wr, int wc, int fr, int fq) const {
        const int pn = u.pn, g8 = (wc & 1) * 4 + fq;
#pragma unroll
        for (int ai = 0; ai < 2; ++ai)
#pragma unroll
            for (int m = 0; m < 4; ++m) {
                const int row = u.pm * BM + ai * HALF + wr * 64 + m * 16 + fr;
                bf16_t* rb = QKVb + (size_t)row * 3072;
#pragma unroll
                for (int bj = 0; bj < 2; ++bj) {
                    const int hb = pn * BM + bj * HALF + (wc >> 1) * 64;
                    const f32x4 v0 = acc[ai][bj][m][0], v1 = acc[ai][bj][m][1];
                    if (pn < 4 && g8 < 2) {
                        const float2* t = tab + (size_t)row * 40 + 4 * g8;
                        const float2 c0 = t[0], c1 = t[1], c2 = t[2], c3 = t[3];
                        const f32x4 y1 = {v0[0] * c0.x - v1[0] * c0.y, v0[1] * c1.x - v1[1] * c1.y, v0[2] * c2.x - v1[2] * c2.y, v0[3] * c3.x - v1[3] * c3.y};
                        const f32x4 y2 = {v1[0] * c0.x + v0[0] * c0.y, v1[1] * c1.x + v0[1] * c1.y, v1[2] * c2.x + v0[2] * c2.y, v1[3] * c3.x + v0[3] * c3.y};
                        const float sc = pn < 2 ? qscale : 1.f;
                        u32x2 w1, w2; w1.x = cvt_pk_bf16(y1[0] * sc, y1[1] * sc); w1.y = cvt_pk_bf16(y1[2] * sc, y1[3] * sc); w2.x = cvt_pk_bf16(y2[0] * sc, y2[1] * sc); w2.y = cvt_pk_bf16(y2[2] * sc, y2[3] * sc);
                        *(u32x2*)(rb + hb + 4 * g8) = w1; *(u32x2*)(rb + hb + 4 * g8 + 8) = w2;
                        if (pn >= 2 && row >= keep0) { float* o = okp + (size_t)(row - keep0) * 512 + (hb - 512) + 4 * g8; *(f32x4*)o = y1; *(f32x4*)(o + 8) = y2; }
                    } else if (pn == 6 || pn == 7) {
                        const float2* t = tab + (size_t)row * 40 + 8 + 4 * g8;
                        const float2 c0 = t[0], c1 = t[1], c2 = t[2], c3 = t[3];
                        const float sc = pn == 7 ? 0.125f : 1.f;
                        const f32x4 y1 = {(v0[0] * c0.x - v1[0] * c0.y) * sc, (v0[1] * c1.x - v1[1] * c1.y) * sc, (v0[2] * c2.x - v1[2] * c2.y) * sc, (v0[3] * c3.x - v1[3] * c3.y) * sc};
                        const f32x4 y2 = {(v1[0] * c0.x + v0[0] * c0.y) * sc, (v1[1] * c1.x + v0[1] * c1.y) * sc, (v1[2] * c2.x + v0[2] * c2.y) * sc, (v1[3] * c3.x + v0[3] * c3.y) * sc};
                        u32x2 w1, w2; w1.x = cvt_pk_bf16(y1[0], y1[1]); w1.y = cvt_pk_bf16(y1[2], y1[3]); w2.x = cvt_pk_bf16(y2[0], y2[1]); w2.y = cvt_pk_bf16(y2[2], y2[3]);
                        *(u32x2*)(rb + hb + 4 * g8) = w1; *(u32x2*)(rb + hb + 32 + 4 * g8) = w2;
                    } else {
                        const int col = pn * BM + bj * HALF + wc * 32 + 8 * fq;
                        const float sc = pn < 2 ? qscale : 1.f;
                        u32x4 w; w.x = cvt_pk_bf16(v0[0] * sc, v0[1] * sc); w.y = cvt_pk_bf16(v0[2] * sc, v0[3] * sc); w.z = cvt_pk_bf16(v1[0] * sc, v1[1] * sc); w.w = cvt_pk_bf16(v1[2] * sc, v1[3] * sc);
                        *(u32x4*)(rb + col) = w;
                        if (row >= keep0 && pn >= 2 && pn < 6) { float* o = (pn < 4 ? okp + (size_t)(row - keep0) * 512 + (col - 512) : ovp + (size_t)(row - keep0) * 512 + (col - 1024)); *(f32x4*)o = v0; *(f32x4*)(o + 4) = v1; }
                    }
                }
            }
    }
};
struct EpiYb {
    static constexpr bool PERM = true, AFTER_DRAIN = false;
    bf16_t* O; int ldc;
    __device__ __forceinline__ void operator()(const f32x4 (&acc)[2][2][4][2], const Unit& u, int wr, int wc, int fr, int fq) const {
        const int row0 = u.pm * BM + wr * 64 + fr, col0 = u.pn * BM + wc * 32 + 8 * fq;
#pragma unroll
        for (int ai = 0; ai < 2; ++ai)
#pragma unroll
            for (int m = 0; m < 4; ++m) {
                bf16_t* rowp = O + (size_t)(row0 + ai * HALF + m * 16) * ldc + col0;
#pragma unroll
                for (int bj = 0; bj < 2; ++bj) { const f32x4 v0 = acc[ai][bj][m][0], v1 = acc[ai][bj][m][1];
                    u32x4 w; w.x = cvt_pk_bf16(v0[0], v0[1]); w.y = cvt_pk_bf16(v0[2], v0[3]); w.z = cvt_pk_bf16(v1[0], v1[1]); w.w = cvt_pk_bf16(v1[2], v1[3]);
                    *(u32x4*)(rowp + bj * HALF) = w; }
            }
    }
};
__device__ __forceinline__ float silu_fast(float x) { return x * __builtin_amdgcn_rcpf(1.0f + __builtin_amdgcn_exp2f(-1.4426950408889634f * x)); }
struct EpiSwiglu {
    static constexpr bool PERM = true, AFTER_DRAIN = false;
    bf16_t* O; int ldc;
    __device__ __forceinline__ void operator()(const f32x4 (&acc)[2][2][4][2], const Unit& u, int wr, int wc, int fr, int fq) const {
        const int row0 = u.pm * BM + wr * 64 + fr, col0 = u.pn * HALF + wc * 32 + 8 * fq;
#pragma unroll
        for (int ai = 0; ai < 2; ++ai)
#pragma unroll
            for (int m = 0; m < 4; ++m) {
                bf16_t* rowp = O + (size_t)(row0 + ai * HALF + m * 16) * ldc + col0;
                const f32x4 g0 = acc[ai][0][m][0], g1 = acc[ai][0][m][1], u0 = acc[ai][1][m][0], u1 = acc[ai][1][m][1];
                u32x4 w;
                w.x = cvt_pk_bf16(silu_fast(g0[0]) * u0[0], silu_fast(g0[1]) * u0[1]); w.y = cvt_pk_bf16(silu_fast(g0[2]) * u0[2], silu_fast(g0[3]) * u0[3]);
                w.z = cvt_pk_bf16(silu_fast(g1[0]) * u1[0], silu_fast(g1[1]) * u1[1]); w.w = cvt_pk_bf16(silu_fast(g1[2]) * u1[2], silu_fast(g1[3]) * u1[3]);
                *(u32x4*)rowp = w;
            }
    }
};
struct EpiF32 {
    static constexpr bool PERM = false, AFTER_DRAIN = false;
    float* O; int ldc;
    __device__ __forceinline__ void operator()(const f32x4 (&acc)[2][2][4][2], const Unit& u, int wr, int wc, int fr, int fq) const {
        const int row0 = u.pm * BM + wr * 64 + fr, col0 = u.pn * BM + wc * 32 + 4 * fq;
#pragma unroll
        for (int ai = 0; ai < 2; ++ai)
#pragma unroll
            for (int m = 0; m < 4; ++m) {
                float* rowp = O + (size_t)(row0 + ai * HALF + m * 16) * ldc + col0;
#pragma unroll
                for (int bj = 0; bj < 2; ++bj)
#pragma unroll
                    for (int n = 0; n < 2; ++n) *(f32x4*)(rowp + bj * HALF + n * 16) = acc[ai][bj][m][n];
            }
    }
};
template <class Epi, class Sched, bool ALIGN_EPI = false, bool SP2 = false>
__device__ __forceinline__ void gemm_phase(PG8_LAS unsigned char* lds, const Gemm g, const Sched& S, const Epi& E) {
    int tid_ = threadIdx.x; asm volatile("" : "+v"(tid_));
    const int tid = tid_, wid = __builtin_amdgcn_readfirstlane(tid >> 6), lane = tid & 63, wr = wid >> 2, wc = wid & 3, fr = lane & 15, fq = lane >> 4;
    const int K = g.K, nt = K / BK;
    unsigned voffA[2], voffB[2];
#pragma unroll
    for (int i = 0; i < 2; ++i) { int R, C; stage_rc(tid * 16 + i * 8192, R, C); const int Rb = Epi::PERM ? ((R & ~31) + perm32(R & 31)) : R;
        voffA[i] = (unsigned)(R * K + C) * 2u; voffB[i] = (unsigned)(Rb * K + C) * 2u; }
    const size_t kstep = (size_t)(BK * 2);
    const size_t hstep = (size_t)HALF * K * 2;
    const size_t tstep = 2 * hstep;
    const unsigned ldsw = (unsigned)wid * 1024u;
    const int aoff = lds_byte(wr * 64 + fr, fq * 8), boff = lds_byte(wc * 32 + fr, fq * 8);
#define PG8_SA(b, h) (((b) * 2 + (h)) * HTB)
#define PG8_SB(b, h) ((4 + (b) * 2 + (h)) * HTB)
#define PG8_STAGE(bufoff, gbase, voff) do { _Pragma("unroll") for (int _i = 0; _i < 2; ++_i) \
        __builtin_amdgcn_global_load_lds((const unsigned*)((const char*)(gbase) + (voff)[_i]), (PG8_LAS unsigned*)(lds + (bufoff) + ldsw + _i * 8192), 16, 0, 0); } while (0)
#define PG8_LDA(dst, b, h) do { _Pragma("unroll") for (int m = 0; m < 4; ++m) _Pragma("unroll") for (int k = 0; k < 2; ++k) dst[m][k] = *(const PG8_LAS bf16x8*)(lds + PG8_SA(b, h) + aoff + m * 2048 + k * 1024); } while (0)
#define PG8_LDB(dst, b, h) do { _Pragma("unroll") for (int n = 0; n < 2; ++n) _Pragma("unroll") for (int k = 0; k < 2; ++k) dst[n][k] = *(const PG8_LAS bf16x8*)(lds + PG8_SB(b, h) + boff + n * 2048 + k * 1024); } while (0)
#define PG8_MMA(ai, bj, At, Bt) do { __builtin_amdgcn_s_setprio(1); _Pragma("unroll") for (int m = 0; m < 4; ++m) _Pragma("unroll") for (int n = 0; n < 2; ++n) _Pragma("unroll") for (int k = 0; k < 2; ++k) \
        acc[ai][bj][m][n] = __builtin_amdgcn_mfma_f32_16x16x32_bf16(Bt[n][k], At[m][k], acc[ai][bj][m][n], 0, 0, 0); __builtin_amdgcn_s_setprio(0); } while (0)
#define PG8_WAIT_V(n) asm volatile("s_waitcnt vmcnt(" #n ")" ::: "memory")
#define PG8_WAIT_L(n) asm volatile("s_waitcnt lgkmcnt(" #n ")" ::: "memory")
#define PG8_BAR __builtin_amdgcn_s_barrier()
#define PG8_SCHED __builtin_amdgcn_sched_barrier(0)
    Unit cur, nxt; int ui = 0;
    if (!S.next(0, cur)) return;
    f32x4 acc[2][2][4][2];
#pragma unroll
    for (int a = 0; a < 2; ++a)
#pragma unroll
        for (int b = 0; b < 2; ++b)
#pragma unroll
            for (int m = 0; m < 4; ++m)
#pragma unroll
                for (int n = 0; n < 2; ++n) acc[a][b][m][n] = (f32x4){0.f, 0.f, 0.f, 0.f};
    bf16x8 At[4][2], B0[2][2], B1[2][2];
    const char* cA = (const char*)g.A + (size_t)cur.pm * tstep; const char* cB = (const char*)g.Bt + (size_t)cur.pn * tstep;
    S.a_ready(cur);
    if constexpr (SP2) {
        PG8_STAGE(PG8_SB(0, 0), cB, voffB); PG8_STAGE(PG8_SB(0, 1), cB + hstep, voffB); PG8_STAGE(PG8_SA(0, 0), cA, voffA); PG8_STAGE(PG8_SA(0, 1), cA + hstep, voffA);
        if (wr == 1) PG8_BAR;
        PG8_WAIT_V(2); PG8_BAR;
        PG8_STAGE(PG8_SB(1, 0), cB + kstep, voffB); PG8_STAGE(PG8_SA(1, 0), cA + kstep, voffA); PG8_STAGE(PG8_SB(1, 1), cB + hstep + kstep, voffB);
        PG8_WAIT_V(6); PG8_BAR;
    } else {
        PG8_STAGE(PG8_SB(0, 0), cB, voffB); PG8_STAGE(PG8_SA(0, 0), cA, voffA); PG8_STAGE(PG8_SB(0, 1), cB + hstep, voffB); PG8_STAGE(PG8_SA(0, 1), cA + hstep, voffA);
        if (wr == 1) PG8_BAR;
        PG8_WAIT_V(4); PG8_BAR;
        PG8_STAGE(PG8_SB(1, 0), cB + kstep, voffB); PG8_STAGE(PG8_SA(1, 0), cA + kstep, voffA); PG8_STAGE(PG8_SB(1, 1), cB + hstep + kstep, voffB);
        PG8_WAIT_V(6); PG8_BAR;
    }
    for (;;) {
        const bool has_next = S.next(ui + 1, nxt);
        const char* nA = has_next ? (const char*)g.A + (size_t)nxt.pm * tstep : cA; const char* nB = has_next ? (const char*)g.Bt + (size_t)nxt.pn * tstep : cB;
        for (int t = 0; t < nt; t += 2) {
            const bool last = (t == nt - 2);
            const char* a1 = cA + (size_t)(t + 1) * kstep;
            const char* a2 = last ? nA : cA + (size_t)(t + 2) * kstep; const char* b2 = last ? nB : cB + (size_t)(t + 2) * kstep;
            const char* a3 = a2 + kstep; const char* b3 = b2 + kstep;
            if (last && has_next) S.a_ready(nxt);
            if constexpr (SP2) {
            PG8_LDB(B0, 0, 0); PG8_LDB(B1, 0, 1); PG8_SCHED; PG8_LDA(At, 0, 0); PG8_STAGE(PG8_SA(1, 1), a1 + hstep, voffA);
            PG8_WAIT_V(8); PG8_WAIT_L(0); PG8_BAR; PG8_MMA(0, 0, At, B0); PG8_MMA(0, 1, At, B1); PG8_BAR; PG8_SCHED;
            PG8_LDA(At, 0, 1); PG8_STAGE(PG8_SB(0, 0), b2, voffB); PG8_STAGE(PG8_SB(0, 1), b2 + hstep, voffB); PG8_STAGE(PG8_SA(0, 0), a2, voffA);
            PG8_WAIT_V(8); PG8_WAIT_L(0); PG8_BAR; PG8_MMA(1, 0, At, B0); PG8_MMA(1, 1, At, B1); PG8_BAR; PG8_SCHED;
            PG8_LDB(B0, 1, 0); PG8_LDB(B1, 1, 1); PG8_SCHED; PG8_LDA(At, 1, 0); PG8_STAGE(PG8_SA(0, 1), a2 + hstep, voffA);
            PG8_WAIT_V(8); PG8_WAIT_L(0); PG8_BAR; PG8_MMA(0, 0, At, B0); PG8_MMA(0, 1, At, B1); PG8_BAR; PG8_SCHED;
            PG8_LDA(At, 1, 1); PG8_STAGE(PG8_SB(1, 0), b3, voffB); PG8_STAGE(PG8_SB(1, 1), b3 + hstep, voffB); PG8_STAGE(PG8_SA(1, 0), a3, voffA);
            PG8_WAIT_V(8); PG8_WAIT_L(0); PG8_BAR; PG8_MMA(1, 0, At, B0); PG8_MMA(1, 1, At, B1); PG8_BAR; PG8_SCHED;
            } else {
            PG8_LDB(B0, 0, 0); PG8_SCHED; PG8_LDA(At, 0, 0); PG8_STAGE(PG8_SA(1, 1), a1 + hstep, voffA);
            PG8_WAIT_L(8); PG8_BAR; PG8_WAIT_L(0); PG8_MMA(0, 0, At, B0); PG8_BAR; PG8_SCHED;
            PG8_LDB(B1, 0, 1); PG8_STAGE(PG8_SB(0, 0), b2, voffB);
            PG8_BAR; PG8_WAIT_L(0); PG8_MMA(0, 1, At, B1); PG8_BAR;
            PG8_LDA(At, 0, 1); PG8_STAGE(PG8_SA(0, 0), a2, voffA);
            PG8_BAR; PG8_WAIT_L(0); PG8_MMA(1, 0, At, B0); PG8_BAR; PG8_SCHED;
            PG8_STAGE(PG8_SB(0, 1), b2 + hstep, voffB);
            PG8_WAIT_V(6); PG8_BAR; PG8_MMA(1, 1, At, B1); PG8_BAR;
            PG8_LDB(B0, 1, 0); PG8_SCHED; PG8_LDA(At, 1, 0); PG8_STAGE(PG8_SA(0, 1), a2 + hstep, voffA);
            PG8_WAIT_L(8); PG8_BAR; PG8_WAIT_L(0); PG8_MMA(0, 0, At, B0); PG8_BAR; PG8_SCHED;
            PG8_LDB(B1, 1, 1); PG8_STAGE(PG8_SB(1, 0), b3, voffB);
            PG8_BAR; PG8_WAIT_L(0); PG8_MMA(0, 1, At, B1); PG8_BAR;
            PG8_LDA(At, 1, 1); PG8_STAGE(PG8_SA(1, 0), a3, voffA);
            PG8_BAR; PG8_WAIT_L(0); PG8_MMA(1, 0, At, B0); PG8_BAR; PG8_SCHED;
            PG8_STAGE(PG8_SB(1, 1), b3 + hstep, voffB);
            PG8_WAIT_V(6); PG8_BAR; PG8_MMA(1, 1, At, B1); PG8_BAR;
            }
        }
        if constexpr (ALIGN_EPI) { if (wr == 0) PG8_BAR; }
        if constexpr (!Epi::AFTER_DRAIN) { E(acc, cur, wr, wc, fr, fq); S.done(cur); }
        if (!has_next) break;
#pragma unroll
        for (int a = 0; a < 2; ++a)
#pragma unroll
            for (int b = 0; b < 2; ++b)
#pragma unroll
                for (int m = 0; m < 4; ++m)
#pragma unroll
                    for (int n = 0; n < 2; ++n) acc[a][b][m][n] = (f32x4){0.f, 0.f, 0.f, 0.f};
        cur = nxt; cA = nA; cB = nB; ++ui;
        if constexpr (ALIGN_EPI) { if (wr == 1) PG8_BAR; }
    }
    PG8_WAIT_V(0);
    if constexpr (!ALIGN_EPI) { if (wr == 0) PG8_BAR; }
    PG8_BAR;
    if constexpr (Epi::AFTER_DRAIN) { E.fused(acc, cur, wr, wc, fr, fq, lds, wid, lane); S.done(cur); }
#undef PG8_SA
#undef PG8_SB
#undef PG8_STAGE
#undef PG8_LDA
#undef PG8_LDB
#undef PG8_MMA
#undef PG8_WAIT_V
#undef PG8_WAIT_L
#undef PG8_BAR
#undef PG8_SCHED
}
}
#define GAS __attribute__((address_space(1)))
#define LAS __attribute__((address_space(3)))
typedef unsigned short bf16;
typedef unsigned v4u __attribute__((ext_vector_type(4)));
typedef float f32x4 __attribute__((ext_vector_type(4)));
typedef short bf16x8 __attribute__((ext_vector_type(8)));
typedef GAS unsigned gu32;
typedef GAS unsigned long long gu64;
#define RLX_AGENT __ATOMIC_RELAXED, __HIP_MEMORY_SCOPE_AGENT
#define LDS_WAIT() asm volatile("s_waitcnt lgkmcnt(0)" ::: "memory")
#define VM_WAIT() asm volatile("s_waitcnt vmcnt(0)" ::: "memory")
__device__ __forceinline__ unsigned long long rt() { return __builtin_amdgcn_s_memrealtime(); }
__device__ __forceinline__ unsigned f2bf(float f) { unsigned u = __builtin_bit_cast(unsigned, f); return (u + 0x7fffu + ((u >> 16) & 1u)) >> 16; }
__device__ __forceinline__ unsigned pk2(float lo, float hi) { return f2bf(lo) | (f2bf(hi) << 16); }
#define XB_TMO      128
#define XB_XCNT(j)  (256  + 64 * (j))
#define XB_XSUB(j)  (1280 + 64 * (j))
#define XB_XGEN(j)  (2304 + 64 * (j))
#define XB_TOP      3328
#define XB_TOPGEN   3392
#define XCD_BAR_WORDS 3456
#define XB_SPIN_CAP (1u << 18)

__device__ __forceinline__ unsigned xb_ld(unsigned* p)              { return __hip_atomic_load(p, __ATOMIC_RELAXED, __HIP_MEMORY_SCOPE_AGENT); }
__device__ __forceinline__ unsigned xb_add(unsigned* p, unsigned v) { return __hip_atomic_fetch_add(p, v, __ATOMIC_RELAXED, __HIP_MEMORY_SCOPE_AGENT); }
__device__ __forceinline__ unsigned xb_xcc_id() { return (unsigned)__builtin_amdgcn_s_getreg((3 << 11) | 20) & 0xFu; }
#define XB_SPIN(cond, bar) do { unsigned _sp = 0; while (cond) { __builtin_amdgcn_s_sleep(1); \
    if ((++_sp & 255u) == 0u) { if (xb_ld(&(bar)[XB_TMO])) break; if (_sp > XB_SPIN_CAP) { atomicAdd(&(bar)[XB_TMO], 1u); break; } } } } while (0)

struct XcdBarrier {
    unsigned* bar; unsigned x;
    volatile LAS unsigned* st;
};

__device__ __forceinline__ XcdBarrier xcd_barrier_post(unsigned* bar, volatile LAS unsigned* st) {
    XcdBarrier b; b.bar = bar; b.x = xb_xcc_id(); b.st = st;
    if (threadIdx.x == 0) (void)xb_add(&bar[XB_XCNT(b.x)], 1u);
    return b;
}
__device__ __forceinline__ void xcd_barrier_complete(unsigned* bar, unsigned x, unsigned& nloc, unsigned& nx) {
    const unsigned G = gridDim.x * gridDim.y * gridDim.z;
    unsigned sum, cnt, mine, sp = 0u;
    for (;;) {
        sum = 0u; cnt = 0u; mine = 0u;
#pragma unroll
        for (unsigned j = 0; j < 16; ++j) { const unsigned c = xb_ld(&bar[XB_XCNT(j)]); sum += c; cnt += (c > 0u) ? 1u : 0u; mine = (j == x) ? c : mine; }
        if (sum == G) break;
        __builtin_amdgcn_s_sleep(1);
        if ((++sp & 255u) == 0u) { if (xb_ld(&bar[XB_TMO])) break; if (sp > XB_SPIN_CAP) { atomicAdd(&bar[XB_TMO], 1u); break; } }
    }
    nloc = mine > 0u ? mine : 1u; nx = cnt > 0u ? cnt : 1u;
}

__device__ __forceinline__ void xcd_barrier(const XcdBarrier& b) {
    asm volatile("s_waitcnt vmcnt(0)" ::: "memory");
    __syncthreads();
    if (threadIdx.x == 0) {
        unsigned* bar = b.bar;
        __builtin_amdgcn_s_waitcnt(0);
        unsigned nloc = b.st[0], nx = b.st[1];
        if (nloc == 0u) { xcd_barrier_complete(bar, b.x, nloc, nx); b.st[0] = nloc; b.st[1] = nx; }
        const unsigned old = xb_add(&bar[XB_XSUB(b.x)], 1u);
        const unsigned gen = old / nloc;
        if (old + 1u == (gen + 1u) * nloc) {
            __builtin_amdgcn_fence(__ATOMIC_RELEASE, "agent");
            asm volatile("s_waitcnt vmcnt(0)" ::: "memory");
            const unsigned og = xb_add(&bar[XB_TOP], 1u);
            const unsigned tg = og / nx;
            if (og + 1u == (tg + 1u) * nx) xb_add(&bar[XB_TOPGEN], 1u);
            else XB_SPIN(xb_ld(&bar[XB_TOPGEN]) == tg, bar);
            __builtin_amdgcn_fence(__ATOMIC_ACQUIRE, "agent");
            xb_add(&bar[XB_XGEN(b.x)], 1u);
            asm volatile("s_waitcnt vmcnt(0)" ::: "memory");
        } else {
            XB_SPIN(xb_ld(&bar[XB_XGEN(b.x)]) == gen, bar);
            __builtin_amdgcn_fence(__ATOMIC_ACQUIRE, "agent");
            asm volatile("s_waitcnt vmcnt(0)" ::: "memory");
        }
    }
    __syncthreads();
}
constexpr int NWAVES = 8, NTHR = 512;
constexpr int D = 1024, SEQ = 16384, DBATCH = 128, MP = SEQ, MS = 512, M = MP + MS;
constexpr int DFF = 2816, INW = 3072, PAST = 8192, WB = 2048, KEEP = 2048, NH = 8;
constexpr float EPS = 1e-6f;
constexpr int C_QA = 0, C_KA = 512, C_VA = 1024, C_QR = 1536, C_KR = 1792, C_VR = 2048, C_GR = 2560;
constexpr size_t O_Y = 0, O_KP = (size_t)M * D, O_VP = O_KP + (size_t)KEEP * 512, O_SP = O_VP + (size_t)KEEP * 512,
                 O_KS = O_SP + 32768, O_VS = O_KS + (size_t)MS * 512, O_SS = O_VS + (size_t)MS * 512, O_END = O_SS + (size_t)DBATCH * 32768;
constexpr size_t MiB = 1u << 20;
constexpr size_t WS_CTL = 0, CTL_ZERO_BYTES = 1 * MiB;
constexpr size_t WS_W1GU = 1 * MiB, WS_W1D = 12 * MiB, WS_WIN = 18 * MiB, WS_WOUT = 24 * MiB, WS_W2GU = 26 * MiB, WS_W2D = 37 * MiB, WS_TAB = 43 * MiB;
constexpr size_t WS_XN = 48 * MiB, WS_H = 81 * MiB, WS_Y = 172 * MiB, WS_HRES = 238 * MiB, WS_QKV = 304 * MiB, WS_MIX = 502 * MiB, WS_UPD = 535 * MiB, WS_SPREV = 551 * MiB, WS_QKVB = 567 * MiB, WS_OPART = 667 * MiB, WS_ML = 716 * MiB, WS_SPART = 720 * MiB, WS_SML = 736 * MiB, WS_END = 737 * MiB;
constexpr int CW_BAR = 4096;
constexpr int RING_BYTES = 131072, LDSCTL_OFF = RING_BYTES, MISC_OFF = LDSCTL_OFF + 320, LDS_BYTES = 147456;

__constant__ float INVF[40] = {
    1.f, 0.193922743f, 0.0376060307f, 0.00729266461f, 0.00141421356f, 0.000274248188f, 5.3182961e-05f, 1.03133862e-05f,
    1.f, 0.749894261f, 0.562341332f, 0.421696514f, 0.316227764f, 0.237137377f, 0.177827939f, 0.133352131f, 0.100000001f, 0.0749894157f,
    0.0562341325f, 0.0421696529f, 0.0316227749f, 0.0237137377f, 0.0177827943f, 0.0133352149f, 0.00999999978f, 0.00749894185f,
    0.00562341325f, 0.00421696482f, 0.00316227763f, 0.00237137359f, 0.00177827943f, 0.00133352145f, 0.00100000005f, 0.000749894243f,
    0.000562341302f, 0.000421696517f, 0.000316227757f, 0.00023713737f, 0.00017782794f, 0.00013335215f};
__device__ __forceinline__ float log_g(int h) { return h == 0 ? -0.0317486983145803f : h == 1 ? -0.015748356968139168f : h == 2 ? -0.007843177461025893f : -0.003913899321136329f; }
__device__ __forceinline__ float wave_sum(float v) {
#pragma unroll
    for (int o = 32; o >= 1; o >>= 1) v += __shfl_xor(v, o);
    return v;
}
__device__ __forceinline__ float wave_max(float v) {
#pragma unroll
    for (int o = 32; o >= 1; o >>= 1) v = fmaxf(v, __shfl_xor(v, o));
    return v;
}
__device__ __forceinline__ float silu_f(float x) { return x / (1.f + expf(-x)); }

__host__ __device__ __forceinline__ int win_perm(int col) {
    if (col < 1024) { const int dd = col & 63; return dd < 16 ? (col & ~63) + 8 * ((dd >> 2) & 1) + 4 * (dd >> 3) + (dd & 3) : col; }
    if (col >= 1536 && col < 2048) { const int dd = col & 63; return (col & ~63) + 8 * ((dd & 31) >> 2) + 4 * (dd >> 5) + (dd & 3); }
    return col;
}
__device__ __forceinline__ void tr_item(const float* W, int K, int N, bf16* WT, int mode, LAS float* scr, int item, int lane) {
    const int nblk = N / 32, kb = item / nblk, nb = item % nblk, k0 = 64 * kb, n0 = 32 * nb;
    const int rbase = mode == 0 ? n0 : (256 * (n0 >> 7) + (n0 & 127) + (mode == 2 ? 128 : 0));
    {
        const int row8 = lane >> 3, c4 = lane & 7;
        float4 v[8];
#pragma unroll
        for (int i = 0; i < 8; ++i) v[i] = *(const float4*)(W + (size_t)(k0 + 8 * i + row8) * N + n0 + 4 * c4);
#pragma unroll
        for (int i = 0; i < 8; ++i) { LAS float* d = scr + (8 * i + row8) * 33 + 4 * c4; d[0] = v[i].x; d[1] = v[i].y; d[2] = v[i].z; d[3] = v[i].w; }
    }
    LDS_WAIT(); asm volatile("" ::: "memory");
    const int c = lane & 7;
#pragma unroll
    for (int j = 0; j < 4; ++j) { const int n = (lane >> 3) + 8 * j; const LAS float* s = scr + (8 * c) * 33 + n;
        v4u o; o.x = pk2(s[0 * 33], s[1 * 33]); o.y = pk2(s[2 * 33], s[3 * 33]); o.z = pk2(s[4 * 33], s[5 * 33]); o.w = pk2(s[6 * 33], s[7 * 33]);
        const int orow = mode == 3 ? win_perm(n0 + n) : rbase + n;
        *(GAS v4u*)(WT + (size_t)orow * K + k0 + 8 * c) = o; }
    LDS_WAIT(); asm volatile("" ::: "memory");
}
struct Ptrs {
    const float *xp, *xs, *ck, *cv, *st, *g1a, *g1b, *w1g, *w1u, *w1d, *gma, *gmb, *win, *gnw, *wout, *g2a, *g2b, *w2g, *w2u, *w2d;
    float* out;
    bf16 *W1GU, *W1D, *WIN, *WOUT, *W2GU, *W2D, *XN, *H, *MIX;
    float2* TAB; bf16 *Y, *HRES; float *QKV, *UPD; bf16 *SPT, *QKVb, *OPART; float2 *ML, *SML; float* SPART;
};
__device__ __forceinline__ void p0_prologue(const Ptrs& P, LAS unsigned char* lds, int gw, int NGW, int wave, int lane, int gtid, int NGT) {
    LAS float* scr = (LAS float*)(lds + wave * 16384);
    constexpr int I_GU = 16 * 88;
    for (int it = gw; it < 2 * I_GU; it += NGW) {
        if (it < I_GU) tr_item(P.w1g, D, DFF, P.W1GU, 1, scr, it, lane); else tr_item(P.w1u, D, DFF, P.W1GU, 2, scr, it - I_GU, lane);
    }
    for (int idx = gtid; idx < SEQ * 40; idx += NGT) {
        const int pos = idx / 40, f = idx % 40;
        const float ang = (float)pos * INVF[f];
        const double rev = (double)ang * 0.15915494309189535;
        const float fr = (float)(rev - rint(rev));
        P.TAB[idx] = make_float2(__builtin_amdgcn_cosf(fr), __builtin_amdgcn_sinf(fr));
    }
    for (int r = gw; r < M; r += NGW) {
        const float4* x = (const float4*)(r < MP ? P.xp + (size_t)r * D : P.xs + (size_t)(r - MP) * D);
        float4 v[4]; float ss = 0.f;
#pragma unroll
        for (int j = 0; j < 4; ++j) { v[j] = x[lane + 64 * j]; ss += v[j].x * v[j].x + v[j].y * v[j].y + v[j].z * v[j].z + v[j].w * v[j].w; }
        const float rstd = 1.f / sqrtf(wave_sum(ss) * (1.f / D) + EPS);
        uint2* o = (uint2*)(P.XN + (size_t)r * D);
#pragma unroll
        for (int j = 0; j < 4; ++j) { const float4 gg = ((const float4*)P.g1a)[lane + 64 * j];
            o[lane + 64 * j] = make_uint2(pk2(v[j].x * rstd * gg.x, v[j].y * rstd * gg.y), pk2(v[j].z * rstd * gg.z, v[j].w * rstd * gg.w)); }
    }
}
__device__ __forceinline__ void p0_deferred(const Ptrs& P, LAS unsigned char* lds, int gw, int NGW, int wave, int lane) {
    LAS float* scr = (LAS float*)(lds + wave * 16384);
    constexpr int I_GU = 16 * 88, I_D = 44 * 32, I_IN = 16 * 96, I_OUT = 16 * 32;
    constexpr int NITEMS = 2 * I_D + 2 * I_GU + I_IN + I_OUT;
    for (int it = gw; it < NITEMS; it += NGW) {
        int r = it;
        if (r < I_D) { tr_item(P.w1d, DFF, D, P.W1D, 0, scr, r, lane); continue; } r -= I_D;
        if (r < I_IN) { tr_item(P.win, D, INW, P.WIN, 3, scr, r, lane); continue; } r -= I_IN;
        if (r < I_OUT) { tr_item(P.wout, D, D, P.WOUT, 0, scr, r, lane); continue; } r -= I_OUT;
        if (r < I_GU) { tr_item(P.w2g, D, DFF, P.W2GU, 1, scr, r, lane); continue; } r -= I_GU;
        if (r < I_GU) { tr_item(P.w2u, D, DFF, P.W2GU, 2, scr, r, lane); continue; } r -= I_GU;
        tr_item(P.w2d, DFF, D, P.W2D, 0, scr, r, lane);
    }
}
__device__ __forceinline__ void unpack8(const v4u x, float (&f)[8]) { f[0] = __builtin_bit_cast(float, x.x << 16); f[1] = __builtin_bit_cast(float, x.x & 0xffff0000u); f[2] = __builtin_bit_cast(float, x.y << 16); f[3] = __builtin_bit_cast(float, x.y & 0xffff0000u);
    f[4] = __builtin_bit_cast(float, x.z << 16); f[5] = __builtin_bit_cast(float, x.z & 0xffff0000u); f[6] = __builtin_bit_cast(float, x.w << 16); f[7] = __builtin_bit_cast(float, x.w & 0xffff0000u); }
__device__ __forceinline__ v4u pack8(const float (&f)[8]) { v4u w; w.x = pk2(f[0], f[1]); w.y = pk2(f[2], f[3]); w.z = pk2(f[4], f[5]); w.w = pk2(f[6], f[7]); return w; }
template <bool RES_F32, bool OUT_F32>
__device__ __forceinline__ void norm_res_phase(const float* resA, const float* resB, const bf16* resH, const bf16* Y, const float* gpost, float scale, bf16* hout, float* fout, const float* gnext, bf16* XN, int gw, int NGW, int lane) {
    for (int r = gw; r < M; r += NGW) {
        float y[2][8], h[2][8]; float ss = 0.f;
#pragma unroll
        for (int c = 0; c < 2; ++c) {
            const int col = 512 * c + 8 * lane;
            unpack8(*(const v4u*)(Y + (size_t)r * D + col), y[c]);
            if (RES_F32) { const float* x = (r < MP ? resA + (size_t)r * D : resB + (size_t)(r - MP) * D) + col; const float4 a = *(const float4*)x, b = *(const float4*)(x + 4);
                h[c][0] = a.x; h[c][1] = a.y; h[c][2] = a.z; h[c][3] = a.w; h[c][4] = b.x; h[c][5] = b.y; h[c][6] = b.z; h[c][7] = b.w; }
            else unpack8(*(const v4u*)(resH + (size_t)r * D + col), h[c]);
#pragma unroll
            for (int e = 0; e < 8; ++e) ss += y[c][e] * y[c][e];
        }
        const float rstd = scale / sqrtf(wave_sum(ss) * (1.f / D) + EPS);
        float s2 = 0.f;
#pragma unroll
        for (int c = 0; c < 2; ++c) {
            const int col = 512 * c + 8 * lane;
            const float4 g0 = *(const float4*)(gpost + col), g1 = *(const float4*)(gpost + col + 4);
            const float gg[8] = {g0.x, g0.y, g0.z, g0.w, g1.x, g1.y, g1.z, g1.w};
#pragma unroll
            for (int e = 0; e < 8; ++e) { h[c][e] += y[c][e] * rstd * gg[e]; s2 += h[c][e] * h[c][e]; }
            if (OUT_F32) { float* o = fout + (size_t)r * D + col; *(float4*)o = make_float4(h[c][0], h[c][1], h[c][2], h[c][3]); *(float4*)(o + 4) = make_float4(h[c][4], h[c][5], h[c][6], h[c][7]); }
            else *(v4u*)(hout + (size_t)r * D + col) = pack8(h[c]);
        }
        if (gnext) {
            const float r2 = 1.f / sqrtf(wave_sum(s2) * (1.f / D) + EPS);
#pragma unroll
            for (int c = 0; c < 2; ++c) {
                const int col = 512 * c + 8 * lane;
                const float4 g0 = *(const float4*)(gnext + col), g1 = *(const float4*)(gnext + col + 4);
                const float gg[8] = {g0.x, g0.y, g0.z, g0.w, g1.x, g1.y, g1.z, g1.w};
                float o[8];
#pragma unroll
                for (int e = 0; e < 8; ++e) o[e] = h[c][e] * r2 * gg[e];
                *(v4u*)(XN + (size_t)r * D + col) = pack8(o);
            }
        }
    }
}
typedef float f32x16 __attribute__((ext_vector_type(16)));
typedef short s16x4 __attribute__((ext_vector_type(4)));
typedef float f32x2_t __attribute__((ext_vector_type(2)));
typedef __bf16 bf16x2_t __attribute__((ext_vector_type(2)));
__device__ __forceinline__ unsigned cvtpk(float lo, float hi) { f32x2_t v = {lo, hi}; bf16x2_t b = __builtin_convertvector(v, bf16x2_t); return __builtin_bit_cast(unsigned, b); }
__device__ __forceinline__ s16x4 vtr(const LAS unsigned char* p) { return __builtin_bit_cast(s16x4, __builtin_amdgcn_ds_read_tr16_b64_v4i16((LAS s16x4*)p)); }
#define MFMA32(a, b, c) __builtin_amdgcn_mfma_f32_32x32x16_bf16((a), (b), (c), 0, 0, 0)
__device__ __forceinline__ int crow(int reg, int hh) { return (reg & 3) + 8 * (reg >> 2) + 4 * hh; }
__device__ __forceinline__ float bf_lo(unsigned u) { return __builtin_bit_cast(float, u << 16); }
__device__ __forceinline__ float bf_hi(unsigned u) { return __builtin_bit_cast(float, u & 0xffff0000u); }
constexpr float QSCALE = 0.125f * 1.4426950408889634f;

__device__ __forceinline__ void sk_tile(LAS unsigned char* lds, const bf16* A, int lda, const bf16* Wt, int K, int r0, int c0, int tid, int wave, int lane) {
    const int i = lane & 31, hh = lane >> 5;
    const int ksl = K >> 3, k0 = wave * ksl;
    const bf16* ap = A + (size_t)(r0 + i) * lda + k0 + 8 * hh;
    const bf16* bp0 = Wt + (size_t)(c0 + i) * K + k0 + 8 * hh;
    const bf16* bp1 = bp0 + (size_t)32 * K;
    f32x16 acc0, acc1;
#pragma unroll
    for (int e = 0; e < 16; ++e) { acc0[e] = 0.f; acc1[e] = 0.f; }
#pragma unroll 4
    for (int ks = 0; ks < (ksl >> 4); ++ks) {
        const bf16x8 a = *(const bf16x8*)(ap + 16 * ks), b0 = *(const bf16x8*)(bp0 + 16 * ks), b1 = *(const bf16x8*)(bp1 + 16 * ks);
        acc0 = MFMA32(a, b0, acc0); acc1 = MFMA32(a, b1, acc1);
    }
    LAS float* part = (LAS float*)lds + wave * 2048;
#pragma unroll
    for (int e = 0; e < 16; ++e) { const int row = crow(e, hh); part[row * 64 + i] = acc0[e]; part[row * 64 + 32 + i] = acc1[e]; }
    __syncthreads();
    {
        const LAS f32x4* p4 = (const LAS f32x4*)lds + tid;
        f32x4 s = p4[0];
#pragma unroll
        for (int w = 1; w < 8; ++w) s += p4[w * 512];
        ((LAS f32x4*)(lds + 65536))[tid] = s;
    }
    __syncthreads();
}
__device__ __forceinline__ void sk_gemm_y(LAS unsigned char* lds, const bf16* A, int lda, const bf16* Wt, int K, bf16* Y, int tid, int wave, int lane) {
    for (int item = blockIdx.x; item < 256; item += gridDim.x) {
        const int rt = item >> 4, ct = item & 15;
        sk_tile(lds, A, lda, Wt, K, MP + 32 * rt, 64 * ct, tid, wave, lane);
        const f32x4 v = ((const LAS f32x4*)(lds + 65536))[tid];
        *(uint2*)(Y + (size_t)(MP + 32 * rt + (tid >> 4)) * D + 64 * ct + 4 * (tid & 15)) = make_uint2(cvtpk(v[0], v[1]), cvtpk(v[2], v[3]));
        __syncthreads();
    }
}
__device__ __forceinline__ void sk_gemm_qkv(LAS unsigned char* lds, const bf16* XN, const bf16* WIN, bf16* QKVb, const float2* tab, float* out, int tid, int wave, int lane) {
    const LAS float* red = (const LAS float*)(lds + 65536);
    for (int item = blockIdx.x; item < 768; item += gridDim.x) {
        const int rt = item / 48, ct = item % 48;
        sk_tile(lds, XN, D, WIN, D, MP + 32 * rt, 64 * ct, tid, wave, lane);
        const int row = tid >> 4, c4 = tid & 15, srow = 32 * rt + row, pos = PAST + (srow & 3), nc0 = 64 * ct;
        float y[4];
#pragma unroll
        for (int k = 0; k < 4; ++k) {
            const int dd = 4 * c4 + k;
            const float x = red[row * 64 + (win_perm(nc0 + dd) - nc0)];
            float r = x;
            if (ct < 16) {
                if (dd < 16) { const float xp = red[row * 64 + (win_perm(nc0 + (dd ^ 8)) - nc0)]; const float2 cs = tab[pos * 40 + (dd & 7)];
                    r = dd < 8 ? x * cs.x - xp * cs.y : x * cs.x + xp * cs.y; }
                if (ct < 8) r *= QSCALE;
            } else if (ct >= 24 && ct < 32) {
                const float xp = red[row * 64 + (win_perm(nc0 + (dd ^ 32)) - nc0)]; const float2 cs = tab[pos * 40 + 8 + (dd & 31)];
                r = dd < 32 ? x * cs.x - xp * cs.y : x * cs.x + xp * cs.y;
                if (ct >= 28) r *= 0.125f;
            }
            y[k] = r;
        }
        *(uint2*)(QKVb + (size_t)(MP + srow) * INW + nc0 + 4 * c4) = make_uint2(cvtpk(y[0], y[1]), cvtpk(y[2], y[3]));
        if (ct >= 8 && ct < 16) *(float4*)(out + O_KS + (size_t)srow * 512 + (nc0 - C_KA) + 4 * c4) = make_float4(y[0], y[1], y[2], y[3]);
        if (ct >= 16 && ct < 24) *(float4*)(out + O_VS + (size_t)srow * 512 + (nc0 - C_VA) + 4 * c4) = make_float4(y[0], y[1], y[2], y[3]);
        __syncthreads();
    }
}
__device__ __forceinline__ void attn_mfma_phase(LAS unsigned char* lds, const bf16* QKVb, bf16* OPART, float2* ML, int tid, int wave, int lane) {
    constexpr int RSK = 144, RSV = 192;
    LAS unsigned char* kimg = lds;
    LAS unsigned char* vimg = lds + 384 * RSK;
    const int i = lane & 31, hh = lane >> 5, i16 = lane & 15, tq = i16 >> 2, tp = i16 & 3, blk = (lane >> 4) & 1;
    for (int item = blockIdx.x; item < 1536; item += gridDim.x) {
        const int h = item / 192, w = item % 192;
        int b, r, bk;
        if (w < 64) { b = 0; r = 0; bk = w; } else if (w < 128) { b = 1; r = (w - 64) >> 4; bk = (w - 64) & 15; } else { b = 2; r = (w - 128) >> 2; bk = (w - 128) & 3; }
        const int d = 1 << (2 * b), L0 = bk * 256;
#pragma unroll
        for (int c = 0; c < 6; ++c) {
            const int e = tid + NTHR * c, j = e >> 3, ch = e & 7, l = L0 - 128 + j;
            if (l >= 0) {
                const bf16* src = QKVb + (size_t)(l * d + r) * INW + h * 64 + 8 * ch;
                *(LAS v4u*)(kimg + j * RSK + 16 * ch) = *(const v4u*)(src + C_KA);
                *(LAS v4u*)(vimg + j * RSV + 16 * ch) = *(const v4u*)(src + C_VA);
            }
        }
        const int l0 = L0 + 32 * wave;
        const int tok_q = (l0 + i) * d + r;
        const bf16* qp = QKVb + (size_t)tok_q * INW + C_QA + h * 64 + 8 * hh;
        bf16x8 qf[4];
#pragma unroll
        for (int ks = 0; ks < 4; ++ks) qf[ks] = *(const bf16x8*)(qp + 16 * ks);
        __syncthreads();
        f32x16 o0, o1;
#pragma unroll
        for (int e = 0; e < 16; ++e) { o0[e] = 0.f; o1[e] = 0.f; }
        float m = -1e30f, l = 0.f;
        const int kt0 = l0 >= 128 ? 0 : ((128 - l0) >> 5);
        for (int kt = kt0; kt < 5; ++kt) {
            const int jb = 32 * wave + 32 * kt;
            const LAS unsigned char* kp = kimg + (jb + i) * RSK + 16 * hh;
            f32x16 s;
#pragma unroll
            for (int e = 0; e < 16; ++e) s[e] = 0.f;
#pragma unroll
            for (int ks = 0; ks < 4; ++ks) { const bf16x8 kf = *(const LAS bf16x8*)(kp + 32 * ks); s = MFMA32(kf, qf[ks], s); }
            float tm = -1e30f;
#pragma unroll
            for (int e = 0; e < 16; ++e) { const int j = crow(e, hh); const bool bad = (kt == 0 && j < i) || (kt == 4 && j > i); s[e] = bad ? -1e30f : s[e]; tm = fmaxf(tm, s[e]); }
            tm = fmaxf(tm, __shfl_xor(tm, 32));
            const float mn = fmaxf(m, tm), scl = __builtin_amdgcn_exp2f(m - mn);
            m = mn; l *= scl;
#pragma unroll
            for (int e = 0; e < 16; ++e) { o0[e] *= scl; o1[e] *= scl; }
            float psum = 0.f;
#pragma unroll
            for (int e = 0; e < 16; ++e) { s[e] = __builtin_amdgcn_exp2f(s[e] - mn); psum += s[e]; }
            l += psum;
            v4u pw0, pw1;
            pw0.x = cvtpk(s[0], s[1]); pw0.y = cvtpk(s[2], s[3]); pw0.z = cvtpk(s[4], s[5]); pw0.w = cvtpk(s[6], s[7]);
            pw1.x = cvtpk(s[8], s[9]); pw1.y = cvtpk(s[10], s[11]); pw1.z = cvtpk(s[12], s[13]); pw1.w = cvtpk(s[14], s[15]);
            const bf16x8 pf0 = __builtin_bit_cast(bf16x8, pw0), pf1 = __builtin_bit_cast(bf16x8, pw1);
#pragma unroll
            for (int st = 0; st < 2; ++st) {
                const LAS unsigned char* a0 = vimg + (jb + 16 * st + 4 * hh + tq) * RSV + (16 * blk + 4 * tp) * 2;
                const s16x4 lo0 = vtr(a0), hi0 = vtr(a0 + 8 * RSV), lo1 = vtr(a0 + 64), hi1 = vtr(a0 + 8 * RSV + 64);
                const bf16x8 v0 = __builtin_shufflevector(lo0, hi0, 0, 1, 2, 3, 4, 5, 6, 7), v1 = __builtin_shufflevector(lo1, hi1, 0, 1, 2, 3, 4, 5, 6, 7);
                o0 = MFMA32(v0, st == 0 ? pf0 : pf1, o0);
                o1 = MFMA32(v1, st == 0 ? pf0 : pf1, o1);
            }
        }
        const float lt = l + __shfl_xor(l, 32), inv = 1.f / lt;
        bf16* op = OPART + ((size_t)b * MP + tok_q) * 512 + h * 64 + 4 * hh;
#pragma unroll
        for (int g = 0; g < 4; ++g) {
            *(uint2*)(op + 8 * g) = make_uint2(cvtpk(o0[4 * g] * inv, o0[4 * g + 1] * inv), cvtpk(o0[4 * g + 2] * inv, o0[4 * g + 3] * inv));
            *(uint2*)(op + 32 + 8 * g) = make_uint2(cvtpk(o1[4 * g] * inv, o1[4 * g + 1] * inv), cvtpk(o1[4 * g + 2] * inv, o1[4 * g + 3] * inv));
        }
        if (hh == 0) ML[((size_t)b * MP + tok_q) * 8 + h] = make_float2(m, lt);
        __syncthreads();
    }
}
__device__ __forceinline__ void attn_combine_phase(const bf16* OPART, const float2* ML, bf16* MIX, int gtid, int NGT) {
    for (int idx = gtid; idx < MP * 64; idx += NGT) {
        const int tok = idx >> 6, h = (idx >> 3) & 7, c = idx & 7;
        const float2 a0 = ML[((size_t)0 * MP + tok) * 8 + h], a1 = ML[((size_t)1 * MP + tok) * 8 + h], a2 = ML[((size_t)2 * MP + tok) * 8 + h];
        const float mx = fmaxf(a0.x, fmaxf(a1.x, a2.x));
        float w0 = a0.y * __builtin_amdgcn_exp2f(a0.x - mx), w1 = a1.y * __builtin_amdgcn_exp2f(a1.x - mx), w2 = a2.y * __builtin_amdgcn_exp2f(a2.x - mx);
        const float iw = 1.f / (w0 + w1 + w2); w0 *= iw; w1 *= iw; w2 *= iw;
        const v4u x0 = *(const v4u*)(OPART + ((size_t)0 * MP + tok) * 512 + h * 64 + 8 * c);
        const v4u x1 = *(const v4u*)(OPART + ((size_t)1 * MP + tok) * 512 + h * 64 + 8 * c);
        const v4u x2 = *(const v4u*)(OPART + ((size_t)2 * MP + tok) * 512 + h * 64 + 8 * c);
        v4u o;
        o.x = cvtpk(w0 * bf_lo(x0.x) + w1 * bf_lo(x1.x) + w2 * bf_lo(x2.x), w0 * bf_hi(x0.x) + w1 * bf_hi(x1.x) + w2 * bf_hi(x2.x));
        o.y = cvtpk(w0 * bf_lo(x0.y) + w1 * bf_lo(x1.y) + w2 * bf_lo(x2.y), w0 * bf_hi(x0.y) + w1 * bf_hi(x1.y) + w2 * bf_hi(x2.y));
        o.z = cvtpk(w0 * bf_lo(x0.z) + w1 * bf_lo(x1.z) + w2 * bf_lo(x2.z), w0 * bf_hi(x0.z) + w1 * bf_hi(x1.z) + w2 * bf_hi(x2.z));
        o.w = cvtpk(w0 * bf_lo(x0.w) + w1 * bf_lo(x1.w) + w2 * bf_lo(x2.w), w0 * bf_hi(x0.w) + w1 * bf_hi(x1.w) + w2 * bf_hi(x2.w));
        *(v4u*)(MIX + (size_t)tok * D + h * 64 + 8 * c) = o;
    }
}
__device__ __forceinline__ void ret_out_mfma_phase(LAS unsigned char* lds, const bf16* QKVb, const bf16* SPT, const float* gnw, bf16* MIX, int tid, int wave, int lane) {
    constexpr int RSV = 272;
    const int grp = wave >> 2, itile = wave & 3;
    LAS unsigned char* vb = lds + grp * (128 * RSV);
    const int i = lane & 31, hh = lane >> 5, i16 = lane & 15, tq = i16 >> 2, tp = i16 & 3, blk = (lane >> 4) & 1;
    for (int it = blockIdx.x; it < 256; it += gridDim.x) {
        const int item = it * 2 + grp, n = item >> 2, h = item & 3;
        const float lg2 = log_g(h) * 1.4426950408889634f;
        {
            const int t4 = tid & 255;
#pragma unroll
            for (int c = 0; c < 8; ++c) { const int e = t4 + 256 * c, rowk = e >> 4, ch = e & 15;
                *(LAS v4u*)(vb + rowk * RSV + 16 * ch) = *(const v4u*)(QKVb + (size_t)(n * 128 + rowk) * INW + C_VR + h * 128 + 8 * ch); }
        }
        __syncthreads();
        const int row_i = n * 128 + 32 * itile + i;
        bf16x8 qf[4];
#pragma unroll
        for (int ks = 0; ks < 4; ++ks) qf[ks] = *(const bf16x8*)(QKVb + (size_t)row_i * INW + C_QR + h * 64 + 16 * ks + 8 * hh);
        f32x16 acc[4];
#pragma unroll
        for (int dt = 0; dt < 4; ++dt) {
#pragma unroll
            for (int e = 0; e < 16; ++e) acc[dt][e] = 0.f;
#pragma unroll
            for (int ks = 0; ks < 4; ++ks) { const bf16x8 a = *(const bf16x8*)(SPT + ((size_t)(n * 4 + h) * 128 + 32 * dt + i) * 64 + 16 * ks + 8 * hh); acc[dt] = MFMA32(a, qf[ks], acc[dt]); }
        }
        const float wh = __builtin_amdgcn_exp2f((float)(32 * itile + i + 1) * lg2);
#pragma unroll
        for (int dt = 0; dt < 4; ++dt)
#pragma unroll
            for (int e = 0; e < 16; ++e) acc[dt][e] *= wh;
        for (int jt = 0; jt <= itile; ++jt) {
            bf16x8 kf[4];
#pragma unroll
            for (int ks = 0; ks < 4; ++ks) kf[ks] = *(const bf16x8*)(QKVb + (size_t)(n * 128 + 32 * jt + i) * INW + C_KR + h * 64 + 16 * ks + 8 * hh);
            f32x16 s;
#pragma unroll
            for (int e = 0; e < 16; ++e) s[e] = 0.f;
#pragma unroll
            for (int ks = 0; ks < 4; ++ks) s = MFMA32(kf[ks], qf[ks], s);
#pragma unroll
            for (int e = 0; e < 16; ++e) { const int dl = 32 * (itile - jt) + i - crow(e, hh); s[e] = dl >= 0 ? s[e] * __builtin_amdgcn_exp2f((float)dl * lg2) : 0.f; }
            v4u pw0, pw1;
            pw0.x = cvtpk(s[0], s[1]); pw0.y = cvtpk(s[2], s[3]); pw0.z = cvtpk(s[4], s[5]); pw0.w = cvtpk(s[6], s[7]);
            pw1.x = cvtpk(s[8], s[9]); pw1.y = cvtpk(s[10], s[11]); pw1.z = cvtpk(s[12], s[13]); pw1.w = cvtpk(s[14], s[15]);
            const bf16x8 pf0 = __builtin_bit_cast(bf16x8, pw0), pf1 = __builtin_bit_cast(bf16x8, pw1);
#pragma unroll
            for (int st = 0; st < 2; ++st) {
                const LAS unsigned char* a0 = vb + (32 * jt + 16 * st + 4 * hh + tq) * RSV + (16 * blk + 4 * tp) * 2;
#pragma unroll
                for (int dt = 0; dt < 4; ++dt) {
                    const s16x4 lo = vtr(a0 + 64 * dt), hi = vtr(a0 + 8 * RSV + 64 * dt);
                    const bf16x8 vf = __builtin_shufflevector(lo, hi, 0, 1, 2, 3, 4, 5, 6, 7);
                    acc[dt] = MFMA32(vf, st == 0 ? pf0 : pf1, acc[dt]);
                }
            }
        }
        float s1 = 0.f;
#pragma unroll
        for (int dt = 0; dt < 4; ++dt)
#pragma unroll
            for (int e = 0; e < 16; ++e) s1 += acc[dt][e];
        s1 += __shfl_xor(s1, 32);
        const float mu = s1 * (1.f / 128.f);
        float s2 = 0.f;
#pragma unroll
        for (int dt = 0; dt < 4; ++dt)
#pragma unroll
            for (int e = 0; e < 16; ++e) { const float dd = acc[dt][e] - mu; s2 += dd * dd; }
        s2 += __shfl_xor(s2, 32);
        const float rstd = 1.f / sqrtf(s2 * (1.f / 128.f) + EPS);
#pragma unroll
        for (int dt = 0; dt < 4; ++dt)
#pragma unroll
            for (int g = 0; g < 4; ++g) {
                const int dv0 = 32 * dt + 8 * g + 4 * hh;
                const uint2 gr = *(const uint2*)(QKVb + (size_t)row_i * INW + C_GR + h * 128 + dv0);
                const float4 gw4 = *(const float4*)(gnw + h * 128 + dv0);
                const float y0 = (acc[dt][4 * g] - mu) * rstd * gw4.x * silu_f(bf_lo(gr.x)), y1 = (acc[dt][4 * g + 1] - mu) * rstd * gw4.y * silu_f(bf_hi(gr.x));
                const float y2 = (acc[dt][4 * g + 2] - mu) * rstd * gw4.z * silu_f(bf_lo(gr.y)), y3 = (acc[dt][4 * g + 3] - mu) * rstd * gw4.w * silu_f(bf_hi(gr.y));
                *(uint2*)(MIX + (size_t)row_i * D + 512 + h * 128 + dv0) = make_uint2(cvtpk(y0, y1), cvtpk(y2, y3));
            }
        __syncthreads();
    }
}
template <int CTRL> __device__ __forceinline__ float dppf(float x) { return __builtin_bit_cast(float, __builtin_amdgcn_mov_dpp(__builtin_bit_cast(int, x), CTRL, 0xf, 0xf, true)); }
__device__ __forceinline__ float row16_sum(float v) { v += dppf<0xB1>(v); v += dppf<0x4E>(v); v += dppf<0x141>(v); v += dppf<0x128>(v); return v; }
constexpr int SA_CH = 15, SA_KPC = 60;
__device__ __forceinline__ void sa_rows(int kk, int b, const float* ck, const float* cv, const float* out, const float*& kr, const float*& vr, int& e) {
    e = kk < 516 ? kk : 528 + 16 * ((kk - 516) >> 2) + ((kk - 516) & 3);
    const int idx = 2051 - e;
    if (idx >= WB) { kr = out + O_KS + (size_t)(b * 4 + idx - WB) * 512; vr = out + O_VS + (size_t)(b * 4 + idx - WB) * 512; }
    else { kr = ck + ((size_t)b * WB + idx) * 512; vr = cv + ((size_t)b * WB + idx) * 512; }
}
__device__ __forceinline__ void attn_sample_phase(const bf16* QKVb, const float* ck, const float* cv, const float* out, float* SPART, float2* SML, int gw, int NGW, int lane) {
    const int l16 = lane & 15, hq = lane >> 4;
    for (int item = gw; item < DBATCH * SA_CH; item += NGW) {
        const int b = item / SA_CH, c = item % SA_CH;
        f32x4 q[4][2], o[4][2]; float m[4][2], l[4][2];
#pragma unroll
        for (int i = 0; i < 4; ++i)
#pragma unroll
            for (int u = 0; u < 2; ++u) {
                { const uint2 qq = *(const uint2*)(QKVb + (size_t)(MP + b * 4 + i) * INW + C_QA + (4 * u + hq) * 64 + 4 * l16); q[i][u] = (f32x4){bf_lo(qq.x), bf_hi(qq.x), bf_lo(qq.y), bf_hi(qq.y)}; }
                o[i][u] = (f32x4){0.f, 0.f, 0.f, 0.f}; m[i][u] = -1e30f; l[i][u] = 0.f;
            }
        for (int g = 0; g < SA_KPC / 4; ++g) {
            f32x4 kx[4][2], vx[4][2]; int ee[4];
#pragma unroll
            for (int t = 0; t < 4; ++t) {
                const float *kr, *vr; sa_rows(c * SA_KPC + g * 4 + t, b, ck, cv, out, kr, vr, ee[t]);
                kx[t][0] = *(const f32x4*)(kr + 4 * lane); kx[t][1] = *(const f32x4*)(kr + 256 + 4 * lane);
                vx[t][0] = *(const f32x4*)(vr + 4 * lane); vx[t][1] = *(const f32x4*)(vr + 256 + 4 * lane);
            }
#pragma unroll
            for (int t = 0; t < 4; ++t)
#pragma unroll
                for (int i = 0; i < 4; ++i) {
                    const int dl = ee[t] - 3 + i;
                    const int mult = dl >= 0 ? (int)(dl <= 128) + (int)(((dl & 3) == 0) && dl <= 512) + (int)(((dl & 15) == 0) && dl <= 2048) : 0;
                    if (mult) {
                        const float fm = (float)mult;
#pragma unroll
                        for (int u = 0; u < 2; ++u) {
                            const f32x4 pr = q[i][u] * kx[t][u];
                            const float s = row16_sum((pr[0] + pr[1]) + (pr[2] + pr[3]));
                            const float mn = fmaxf(m[i][u], s), scl = __builtin_amdgcn_exp2f(m[i][u] - mn), p = fm * __builtin_amdgcn_exp2f(s - mn);
                            m[i][u] = mn; l[i][u] = l[i][u] * scl + p; o[i][u] = o[i][u] * scl + vx[t][u] * p;
                        }
                    }
                }
        }
#pragma unroll
        for (int i = 0; i < 4; ++i)
#pragma unroll
            for (int u = 0; u < 2; ++u) {
                const size_t base = ((size_t)(b * SA_CH + c) * 4 + i) * 8 + 4 * u + hq;
                *(f32x4*)(SPART + base * 64 + 4 * l16) = o[i][u];
                if (l16 == 0) SML[base] = make_float2(m[i][u], l[i][u]);
            }
    }
}
__device__ __forceinline__ void attn_sample_merge_phase(const float* SPART, const float2* SML, bf16* MIX, int gw, int NGW, int lane) {
    for (int item = gw; item < DBATCH * 32; item += NGW) {
        const int b = item >> 5, i = (item >> 3) & 3, h = item & 7;
        float2 ml[SA_CH]; float mx = -1e30f;
#pragma unroll
        for (int c = 0; c < SA_CH; ++c) { ml[c] = SML[((size_t)(b * SA_CH + c) * 4 + i) * 8 + h]; mx = fmaxf(mx, ml[c].x); }
        float acc = 0.f, L = 0.f;
#pragma unroll
        for (int c = 0; c < SA_CH; ++c) { const float w = __builtin_amdgcn_exp2f(ml[c].x - mx); L += w * ml[c].y; acc += w * SPART[(((size_t)(b * SA_CH + c) * 4 + i) * 8 + h) * 64 + lane]; }
        MIX[(size_t)(MP + b * 4 + i) * D + h * 64 + lane] = (bf16)f2bf(acc / L);
    }
}
__device__ __forceinline__ void ret_upd_phase(LAS unsigned char* lds, const bf16* __restrict__ QKVb, float* __restrict__ UPD, int tid) {
    LAS float* kc = (LAS float*)lds;
    LAS float* vc = (LAS float*)(lds + 32768);
    for (int it = blockIdx.x; it < 512; it += gridDim.x) {
        const int n = it >> 2, h = it & 3;
        const float lg = log_g(h);
#pragma unroll
        for (int c = 0; c < 2; ++c) { const int e = tid + NTHR * c, j = e >> 3, ch = e & 7;
            const v4u x = *(const v4u*)(QKVb + (size_t)(n * 128 + j) * INW + C_KR + h * 64 + 8 * ch);
            const float w = expf((float)(127 - j) * lg);
            *(LAS f32x4*)(kc + j * 64 + 8 * ch) = (f32x4){bf_lo(x.x) * w, bf_hi(x.x) * w, bf_lo(x.y) * w, bf_hi(x.y) * w};
            *(LAS f32x4*)(kc + j * 64 + 8 * ch + 4) = (f32x4){bf_lo(x.z) * w, bf_hi(x.z) * w, bf_lo(x.w) * w, bf_hi(x.w) * w}; }
#pragma unroll
        for (int c = 0; c < 4; ++c) { const int e = tid + NTHR * c, j = e >> 4, ch = e & 15;
            const v4u x = *(const v4u*)(QKVb + (size_t)(n * 128 + j) * INW + C_VR + h * 128 + 8 * ch);
            *(LAS f32x4*)(vc + j * 128 + 8 * ch) = (f32x4){bf_lo(x.x), bf_hi(x.x), bf_lo(x.y), bf_hi(x.y)};
            *(LAS f32x4*)(vc + j * 128 + 8 * ch + 4) = (f32x4){bf_lo(x.z), bf_hi(x.z), bf_lo(x.w), bf_hi(x.w)}; }
        __syncthreads();
        const int dv = tid & 127, qt = tid >> 7;
        float acc[16];
#pragma unroll
        for (int i = 0; i < 16; ++i) acc[i] = 0.f;
#pragma unroll 4
        for (int j = 0; j < 128; ++j) {
            const float vj = vc[j * 128 + dv];
#pragma unroll
            for (int i = 0; i < 16; i += 4) { const f32x4 k4 = *(const LAS f32x4*)(kc + j * 64 + qt * 16 + i);
                acc[i] += k4[0] * vj; acc[i + 1] += k4[1] * vj; acc[i + 2] += k4[2] * vj; acc[i + 3] += k4[3] * vj; }
        }
#pragma unroll
        for (int i = 0; i < 16; i += 4) *(float4*)(UPD + ((size_t)(n * 4 + h) * 128 + dv) * 64 + qt * 16 + i) = make_float4(acc[i], acc[i + 1], acc[i + 2], acc[i + 3]);
        __syncthreads();
    }
}
__device__ __forceinline__ void ret_scan_phase(const float* UPDT, bf16* SPT, float* out, int tid) {
    const int e = blockIdx.x * NTHR + tid;
    if (e < 32768) {
        const int h = e >> 13, dv = (e >> 6) & 127, dk = e & 63;
        const float G = expf(128.f * log_g(h));
        float S = 0.f;
        for (int n = 0; n < 128; ++n) { SPT[(size_t)n * 32768 + e] = (bf16)f2bf(S); S = G * S + UPDT[(size_t)n * 32768 + e]; }
        out[O_SP + h * 8192 + dk * 128 + dv] = S;
    }
}
__device__ __forceinline__ void ret_sample_phase(LAS unsigned char* lds, const bf16* __restrict__ QKVb, const float* __restrict__ state, const float* __restrict__ gnw, bf16* __restrict__ MIX, float* __restrict__ out, int tid) {
    const int grp = tid >> 7, t = tid & 127, dv = t;
    LAS float* qs = (LAS float*)(lds + grp * 4096);
    LAS float* ks = qs + 256;
    LAS float* red = ks + 256;
    for (int it = blockIdx.x; it < 128; it += gridDim.x) {
        const int sub = it * 4 + grp, b = sub >> 2, h = sub & 3;
        const float g = 1.f - exp2f(-5.f - (float)h);
        const float g2 = g * g, g3 = g2 * g, g4 = g2 * g2;
        const int row0 = MP + b * 4;
        const float* s0p = state + (size_t)(b * 4 + h) * 64 * 128 + dv;
        float* snp = out + O_SS + (size_t)(b * 4 + h) * 64 * 128 + dv;
        for (int e = t; e < 256; e += 128) { const int i = e >> 6, dk = e & 63;
            qs[e] = bf_lo((unsigned)QKVb[(size_t)(row0 + i) * INW + C_QR + h * 64 + dk]); ks[e] = bf_lo((unsigned)QKVb[(size_t)(row0 + i) * INW + C_KR + h * 64 + dk]); }
        float v[4];
#pragma unroll
        for (int i = 0; i < 4; ++i) v[i] = bf_lo((unsigned)QKVb[(size_t)(row0 + i) * INW + C_VR + h * 128 + dv]);
        __syncthreads();
        float c0 = 0.f, c1 = 0.f, c2 = 0.f, c3 = 0.f;
#pragma unroll 1
        for (int d0 = 0; d0 < 64; d0 += 16) {
            float s0v[16];
#pragma unroll
            for (int dk = 0; dk < 16; ++dk) s0v[dk] = __builtin_nontemporal_load(s0p + (d0 + dk) * 128);
#pragma unroll
            for (int dk = 0; dk < 16; ++dk) {
                const float s0 = s0v[dk]; const int kk = d0 + dk;
                c0 += qs[kk] * s0; c1 += qs[64 + kk] * s0; c2 += qs[128 + kk] * s0; c3 += qs[192 + kk] * s0;
                __builtin_nontemporal_store(g4 * s0 + g3 * ks[kk] * v[0] + g2 * ks[64 + kk] * v[1] + g * ks[128 + kk] * v[2] + ks[192 + kk] * v[3], snp + kk * 128);
            }
        }
        float d00 = 0.f, d10 = 0.f, d11 = 0.f, d20 = 0.f, d21 = 0.f, d22 = 0.f, d30 = 0.f, d31 = 0.f, d32 = 0.f, d33 = 0.f;
        for (int dk = 0; dk < 64; ++dk) {
            const float q0 = qs[dk], q1 = qs[64 + dk], q2 = qs[128 + dk], q3 = qs[192 + dk];
            const float k0 = ks[dk], k1 = ks[64 + dk], k2 = ks[128 + dk], k3 = ks[192 + dk];
            d00 += q0 * k0; d10 += q1 * k0; d11 += q1 * k1; d20 += q2 * k0; d21 += q2 * k1; d22 += q2 * k2;
            d30 += q3 * k0; d31 += q3 * k1; d32 += q3 * k2; d33 += q3 * k3;
        }
        float o[4];
        o[0] = g * c0 + d00 * v[0];
        o[1] = g2 * c1 + g * d10 * v[0] + d11 * v[1];
        o[2] = g3 * c2 + g2 * d20 * v[0] + g * d21 * v[1] + d22 * v[2];
        o[3] = g4 * c3 + g3 * d30 * v[0] + g2 * d31 * v[1] + g * d32 * v[2] + d33 * v[3];
#pragma unroll
        for (int i = 0; i < 4; ++i) { const float s1 = wave_sum(o[i]); if ((t & 63) == 0) red[i * 2 + (t >> 6)] = s1; }
        __syncthreads();
        float dl[4];
#pragma unroll
        for (int i = 0; i < 4; ++i) { const float mu = (red[i * 2] + red[i * 2 + 1]) * (1.f / 128.f); dl[i] = o[i] - mu; }
#pragma unroll
        for (int i = 0; i < 4; ++i) { const float s2 = wave_sum(dl[i] * dl[i]); if ((t & 63) == 0) red[8 + i * 2 + (t >> 6)] = s2; }
        __syncthreads();
#pragma unroll
        for (int i = 0; i < 4; ++i) {
            const float var = (red[8 + i * 2] + red[8 + i * 2 + 1]) * (1.f / 128.f);
            const float y = dl[i] / sqrtf(var + EPS) * gnw[h * 128 + dv];
            const float gg = bf_lo((unsigned)QKVb[(size_t)(row0 + i) * INW + C_GR + h * 128 + dv]);
            MIX[(size_t)(row0 + i) * D + 512 + h * 128 + dv] = (bf16)f2bf(silu_f(gg) * y);
        }
        __syncthreads();
    }
}

struct Args { const float* in[20]; float* out; unsigned char* ws; };
__global__ void __launch_bounds__(NTHR, 2) mk_fwd(Args a) {
    extern __shared__ __attribute__((aligned(16))) unsigned char lds_raw[];
    LAS unsigned char* lds = (LAS unsigned char*)lds_raw;
    volatile LAS unsigned* MISC = (volatile LAS unsigned*)(lds + MISC_OFF);
    const int tid = threadIdx.x, lane = tid & 63, wave = __builtin_amdgcn_readfirstlane(tid >> 6);
    const int G = gridDim.x;
    const int gw = blockIdx.x * NWAVES + wave, NGW = G * NWAVES, gtid = blockIdx.x * NTHR + tid, NGT = G * NTHR;
    unsigned char* ws = a.ws;
    Ptrs P;
    P.xp = a.in[0]; P.xs = a.in[1]; P.ck = a.in[2]; P.cv = a.in[3]; P.st = a.in[4]; P.g1a = a.in[5]; P.g1b = a.in[6]; P.w1g = a.in[7]; P.w1u = a.in[8]; P.w1d = a.in[9];
    P.gma = a.in[10]; P.gmb = a.in[11]; P.win = a.in[12]; P.gnw = a.in[13]; P.wout = a.in[14]; P.g2a = a.in[15]; P.g2b = a.in[16]; P.w2g = a.in[17]; P.w2u = a.in[18]; P.w2d = a.in[19];
    P.out = a.out;
    P.W1GU = (bf16*)(ws + WS_W1GU); P.W1D = (bf16*)(ws + WS_W1D); P.WIN = (bf16*)(ws + WS_WIN); P.WOUT = (bf16*)(ws + WS_WOUT); P.W2GU = (bf16*)(ws + WS_W2GU); P.W2D = (bf16*)(ws + WS_W2D);
    P.XN = (bf16*)(ws + WS_XN); P.H = (bf16*)(ws + WS_H); P.MIX = (bf16*)(ws + WS_MIX);
    P.TAB = (float2*)(ws + WS_TAB); P.Y = (bf16*)(ws + WS_Y); P.HRES = (bf16*)(ws + WS_HRES); P.QKV = (float*)(ws + WS_QKV); P.UPD = (float*)(ws + WS_UPD); P.SPT = (bf16*)(ws + WS_SPREV); P.QKVb = (bf16*)(ws + WS_QKVB); P.OPART = (bf16*)(ws + WS_OPART); P.ML = (float2*)(ws + WS_ML); P.SPART = (float*)(ws + WS_SPART); P.SML = (float2*)(ws + WS_SML);
    for (int u = tid; u < (LDS_BYTES - LDSCTL_OFF) / 4; u += NTHR) ((LAS unsigned*)(lds + LDSCTL_OFF))[u] = 0u;
    __syncthreads();
    XcdBarrier bar = xcd_barrier_post((unsigned*)(ws + WS_CTL) + CW_BAR, MISC + 8);

    p0_prologue(P, lds, gw, NGW, wave, lane, gtid, NGT);
    xcd_barrier(bar);
    { pg8::Gemm g{P.XN, P.W1GU, M, 2 * DFF, D}; pg8::StaticOrder S; S.init(M, 2 * DFF, G, (int)blockIdx.x); pg8::EpiSwiglu E{P.H, DFF};
      pg8::gemm_phase<pg8::EpiSwiglu, pg8::StaticOrder, true, true>(lds, g, S, E); }
    {
        constexpr int NU1 = (M / 256) * (2 * DFF / 256);
        const int rounds = (NU1 + G - 1) / G, idle0 = NU1 - (rounds - 1) * G;
        if (idle0 >= G) p0_deferred(P, lds, gw, NGW, wave, lane);
        else if ((int)blockIdx.x >= idle0) p0_deferred(P, lds, ((int)blockIdx.x - idle0) * NWAVES + wave, (G - idle0) * NWAVES, wave, lane);
    }
    xcd_barrier(bar);
    { pg8::Gemm g{P.H, P.W1D, MP, D, DFF}; pg8::StaticOrder S; S.init(MP, D, G, (int)blockIdx.x); pg8::EpiYb E{P.Y, D};
      pg8::gemm_phase<pg8::EpiYb, pg8::StaticOrder, true, true>(lds, g, S, E); }
    sk_gemm_y(lds, P.H, DFF, P.W1D, DFF, P.Y, tid, wave, lane);
    xcd_barrier(bar);
    norm_res_phase<true, false>(P.xp, P.xs, nullptr, P.Y, P.g1b, 0.5f, P.HRES, nullptr, P.gma, P.XN, gw, NGW, lane);
    xcd_barrier(bar);
    { pg8::Gemm g{P.XN, P.WIN, MP, INW, D}; pg8::StaticOrder S; S.init(MP, INW, G, (int)blockIdx.x);
      pg8::EpiQKV E{P.QKVb, P.TAB, P.out + O_KP, P.out + O_VP, QSCALE, MP - KEEP};
      pg8::gemm_phase<pg8::EpiQKV, pg8::StaticOrder, true, true>(lds, g, S, E); }
    sk_gemm_qkv(lds, P.XN, P.WIN, P.QKVb, P.TAB, P.out, tid, wave, lane);
    xcd_barrier(bar);
    ret_upd_phase(lds, P.QKVb, P.UPD, tid);
    ret_sample_phase(lds, P.QKVb, P.st, P.gnw, P.MIX, P.out, tid);
    attn_mfma_phase(lds, P.QKVb, P.OPART, P.ML, tid, wave, lane);
    attn_sample_phase(P.QKVb, P.ck, P.cv, P.out, P.SPART, P.SML, gw, NGW, lane);
    xcd_barrier(bar);
    ret_scan_phase(P.UPD, P.SPT, P.out, tid);
    attn_combine_phase(P.OPART, P.ML, P.MIX, gtid, NGT);
    attn_sample_merge_phase(P.SPART, P.SML, P.MIX, gw, NGW, lane);
    xcd_barrier(bar);
    ret_out_mfma_phase(lds, P.QKVb, P.SPT, P.gnw, P.MIX, tid, wave, lane);
    xcd_barrier(bar);
    { pg8::Gemm g{P.MIX, P.WOUT, MP, D, D}; pg8::StaticOrder S; S.init(MP, D, G, (int)blockIdx.x); pg8::EpiYb E{P.Y, D};
      pg8::gemm_phase<pg8::EpiYb, pg8::StaticOrder, true, true>(lds, g, S, E); }
    sk_gemm_y(lds, P.MIX, D, P.WOUT, D, P.Y, tid, wave, lane);
    xcd_barrier(bar);
    norm_res_phase<false, false>(nullptr, nullptr, P.HRES, P.Y, P.gmb, 1.0f, P.HRES, nullptr, P.g2a, P.XN, gw, NGW, lane);
    xcd_barrier(bar);
    { pg8::Gemm g{P.XN, P.W2GU, M, 2 * DFF, D}; pg8::StaticOrder S; S.init(M, 2 * DFF, G, (int)blockIdx.x); pg8::EpiSwiglu E{P.H, DFF};
      pg8::gemm_phase<pg8::EpiSwiglu, pg8::StaticOrder, true, true>(lds, g, S, E); }
    xcd_barrier(bar);
    { pg8::Gemm g{P.H, P.W2D, MP, D, DFF}; pg8::StaticOrder S; S.init(MP, D, G, (int)blockIdx.x); pg8::EpiYb E{P.Y, D};
      pg8::gemm_phase<pg8::EpiYb, pg8::StaticOrder, true, true>(lds, g, S, E); }
    sk_gemm_y(lds, P.H, DFF, P.W2D, DFF, P.Y, tid, wave, lane);
    xcd_barrier(bar);
    norm_res_phase<false, true>(nullptr, nullptr, P.HRES, P.Y, P.g2b, 0.5f, nullptr, P.out + O_Y, nullptr, nullptr, gw, NGW, lane);
}

extern "C" void kernel_launch(void* const* d_in, const int* in_sizes, int n_in, void* d_out, int out_size, void* d_ws, size_t ws_size, hipStream_t stream) {
    static int grid = 0;
    if (grid == 0) {
        if (n_in != 20 || (size_t)out_size != O_END || ws_size < WS_END) { fprintf(stderr, "kernel_launch: unexpected sizes (n_in %d out %d ws %zu)\n", n_in, out_size, ws_size); grid = -1; return; }
        int dev = 0, cus = 0;
        if (hipGetDevice(&dev) != hipSuccess || hipDeviceGetAttribute(&cus, hipDeviceAttributeMultiprocessorCount, dev) != hipSuccess) { grid = -1; return; }
        if (hipFuncSetAttribute((const void*)mk_fwd, hipFuncAttributeMaxDynamicSharedMemorySize, LDS_BYTES) != hipSuccess) { fprintf(stderr, "kernel_launch: hipFuncSetAttribute failed\n"); grid = -1; return; }
        int per_cu = 0;
        if (hipOccupancyMaxActiveBlocksPerMultiprocessor(&per_cu, (const void*)mk_fwd, NTHR, LDS_BYTES) != hipSuccess || per_cu < 1) fprintf(stderr, "kernel_launch: occupancy query says %d\n", per_cu);
        (void)hipGetLastError();
        grid = cus;
    }
    if (grid < 0) return;
    (void)hipMemsetAsync((char*)d_ws + WS_CTL, 0, CTL_ZERO_BYTES, stream);
    Args a{};
    for (int i = 0; i < 20; ++i) a.in[i] = (const float*)d_in[i];
    a.out = (float*)d_out; a.ws = (unsigned char*)d_ws;
    hipLaunchKernelGGL(mk_fwd, dim3(grid), dim3(NTHR), LDS_BYTES, stream, a);
}
```

```cpp
#include <hip/hip_runtime.h>
#include <cstdio>
#include <cstdint>
namespace pg8 {
#define PG8_LAS __attribute__((address_space(3)))
typedef unsigned short bf16_t;
typedef short bf16x8 __attribute__((ext_vector_type(8)));
typedef float f32x4 __attribute__((ext_vector_type(4)));
typedef unsigned u32x4 __attribute__((ext_vector_type(4)));
constexpr int BM = 256, BK = 64, HALF = 128, HTB = HALF * BK * 2  , STAGE_BYTES = 8 * HTB, NXCD = 8, WGM = 8;

__host__ __device__ __forceinline__ int lds_byte(int r, int c) { const int st = (r >> 4) * 2 + (c >> 5), rr = r & 15, cc = c & 31, ob = rr * 64 + cc * 2; return st * 1024 + (ob ^ (((ob >> 9) & 1) << 5)); }
__host__ __device__ __forceinline__ void stage_rc(int b, int& R, int& C) { const int st = b / 1024, sb = b % 1024, swz = sb ^ (((sb >> 9) & 1) << 5); R = (st >> 1) * 16 + swz / 64; C = (st & 1) * 32 + (swz % 64) / 2; }
__host__ __device__ __forceinline__ int perm32(int rho) { const int n = rho >> 4, i = rho & 15; return 8 * (i >> 2) + 4 * n + (i & 3); }

struct Unit { int pm, pn; };
struct Gemm { const bf16_t* A; const bf16_t* Bt; int M, N, K; };

struct StaticOrder {
    int nM, nN, nwg, G, c;
    __host__ __device__ void init(int M, int N, int G_, int c_) { nM = M / BM; nN = N / BM; nwg = nM * nN; G = G_; c = c_; }
    __host__ __device__ bool next(int i, Unit& u) const {
        const long L = (long)i * G + c; if (L >= nwg) return false;
        int wgid = (int)L; { const int q = nwg / NXCD, r = nwg % NXCD, xcd = wgid % NXCD, off = wgid / NXCD; wgid = (xcd < r ? xcd * (q + 1) : r * (q + 1) + (xcd - r) * q) + off; }
        const int nig = WGM * nN, gid = wgid / nig, fm = gid * WGM, gsz = (nM - fm) < WGM ? (nM - fm) : WGM;
        u.pm = fm + ((wgid % nig) % gsz); u.pn = (wgid % nig) / gsz; return true;
    }
    __device__ __forceinline__ void a_ready(const Unit&) const {}
    __device__ __forceinline__ void done(const Unit&) const {}
};

__device__ __forceinline__ unsigned cvt_pk_bf16(float lo, float hi) { unsigned r; asm volatile("v_cvt_pk_bf16_f32 %0, %1, %2" : "=v"(r) : "v"(lo), "v"(hi)); return r; }
typedef float f32x2 __attribute__((ext_vector_type(2)));
typedef unsigned u32x2 __attribute__((ext_vector_type(2)));
struct EpiQKV {
    static constexpr bool PERM = true, AFTER_DRAIN = false;
    bf16_t* QKVb; const float2* tab; float* okp; float* ovp; float qscale; int keep0;
    __device__ __forceinline__ void operator()(const f32x4 (&acc)[2][2][4][2], const Unit& u, int wr, int wc, int fr, int fq) const {
        const int pn = u.pn, g8 = (wc & 1) * 4 + fq;
#pragma unroll
        for (int ai = 0; ai < 2; ++ai)
#pragma unroll
            for (int m = 0; m < 4; ++m) {
                const int row = u.pm * BM + ai * HALF + wr * 64 + m * 16 + fr;
                bf16_t* rb = QKVb + (size_t)row * 3072;
#pragma unroll
                for (int bj = 0; bj < 2; ++bj) {
                    const int hb = pn * BM + bj * HALF + (wc >> 1) * 64;
                    const f32x4 v0 = acc[ai][bj][m][0], v1 = acc[ai][bj][m][1];
                    if (pn < 4 && g8 < 2) {
                        const float2* t = tab + (size_t)row * 40 + 4 * g8;
                        const float2 c0 = t[0], c1 = t[1], c2 = t[2], c3 = t[3];
                        const f32x4 y1 = {v0[0] * c0.x - v1[0] * c0.y, v0[1] * c1.x - v1[1] * c1.y, v0[2] * c2.x - v1[2] * c2.y, v0[3] * c3.x - v1[3] * c3.y};
                        const f32x4 y2 = {v1[0] * c0.x + v0[0] * c0.y, v1[1] * c1.x + v0[1] * c1.y, v1[2] * c2.x + v0[2] * c2.y, v1[3] * c3.x + v0[3] * c3.y};
                        const float sc = pn < 2 ? qscale : 1.f;
                        u32x2 w1, w2; w1.x = cvt_pk_bf16(y1[0] * sc, y1[1] * sc); w1.y = cvt_pk_bf16(y1[2] * sc, y1[3] * sc); w2.x = cvt_pk_bf16(y2[0] * sc, y2[1] * sc); w2.y = cvt_pk_bf16(y2[2] * sc, y2[3] * sc);
                        *(u32x2*)(rb + hb + 4 * g8) = w1; *(u32x2*)(rb + hb + 4 * g8 + 8) = w2;
                        if (pn >= 2 && row >= keep0) { float* o = okp + (size_t)(row - keep0) * 512 + (hb - 512) + 4 * g8; *(f32x4*)o = y1; *(f32x4*)(o + 8) = y2; }
                    } else if (pn == 6 || pn == 7) {
                        const float2* t = tab + (size_t)row * 40 + 8 + 4 * g8;
                        const float2 c0 = t[0], c1 = t[1], c2 = t[2], c3 = t[3];
                        const float sc = pn == 7 ? 0.125f : 1.f;
                        const f32x4 y1 = {(v0[0] * c0.x - v1[0] * c0.y) * sc, (v0[1] * c1.x - v1[1] * c1.y) * sc, (v0[2] * c2.x - v1[2] * c2.y) * sc, (v0[3] * c3.x - v1[3] * c3.y) * sc};
                        const f32x4 y2 = {(v1[0] * c0.x + v0[0] * c0.y) * sc, (v1[1] * c1.x + v0[1] * c1.y) * sc, (v1[2] * c2.x + v0[2] * c2.y) * sc, (v1[3] * c3.x + v0[3] * c3.y) * sc};
                        u32x2 w1, w2; w1.x = cvt_pk_bf16(y1[0], y1[1]); w1.y = cvt_pk_bf16(y1[2], y1[3]); w2.x = cvt_pk_bf16(y2[0], y2[1]); w2.y = cvt_pk_bf16(y2[2], y2[3]);
                        *(u32x2*)(rb + hb + 4 * g8) = w1; *(u32x2*)(rb + hb + 32 + 4 * g8) = w2;
                    } else {
                        const int col = pn * BM + bj * HALF + wc * 32 + 8 * fq;
                        const float sc = pn < 2 ? qscale : 1.f;
                        u32x4 w; w.x = cvt_pk_bf16(v0[0] * sc, v0[1] * sc); w.y = cvt_pk_bf16(v0[2] * sc, v0[3] * sc); w.z = cvt_pk_bf16(v1[0] * sc, v1[1] * sc); w.w = cvt_pk_bf16(v1[2] * sc, v1[3] * sc);
                        *(u32x4*)(rb + col) = w;
                        if (row >= keep0 && pn >= 2 && pn < 6) { float* o = (pn < 4 ? okp + (size_t)(row - keep0) * 512 + (col - 512) : ovp + (size_t)(row - keep0) * 512 + (col - 1024)); *(f32x4*)o = v0; *(f32x4*)(o + 4) = v1; }
                    }
                }
            }
    }
};
struct EpiYb {
    static constexpr bool PERM = true, AFTER_DRAIN = false;
    bf16_t* O; int ldc;
    __device__ __forceinline__ void operator()(const f32x4 (&acc)[2][2][4][2], const Unit& u, int wr, int wc, int fr, int fq) const {
        const int row0 = u.pm * BM + wr * 64 + fr, col0 = u.pn * BM + wc * 32 + 8 * fq;
#pragma unroll
        for (int ai = 0; ai < 2; ++ai)
#pragma unroll
            for (int m = 0; m < 4; ++m) {
                bf16_t* rowp = O + (size_t)(row0 + ai * HALF + m * 16) * ldc + col0;
#pragma unroll
                for (int bj = 0; bj < 2; ++bj) { const f32x4 v0 = acc[ai][bj][m][0], v1 = acc[ai][bj][m][1];
                    u32x4 w; w.x = cvt_pk_bf16(v0[0], v0[1]); w.y = cvt_pk_bf16(v0[2], v0[3]); w.z = cvt_pk_bf16(v1[0], v1[1]); w.w = cvt_pk_bf16(v1[2], v1[3]);
                    *(u32x4*)(rowp + bj * HALF) = w; }
            }
    }
};
__device__ __forceinline__ float silu_fast(float x) { return x * __builtin_amdgcn_rcpf(1.0f + __builtin_amdgcn_exp2f(-1.4426950408889634f * x)); }
struct EpiSwiglu {
    static constexpr bool PERM = true, AFTER_DRAIN = false;
    bf16_t* O; int ldc;
    __device__ __forceinline__ void operator()(const f32x4 (&acc)[2][2][4][2], const Unit& u, int wr, int wc, int fr, int fq) const {
        const int row0 = u.pm * BM + wr * 64 + fr, col0 = u.pn * HALF + wc * 32 + 8 * fq;
#pragma unroll
        for (int ai = 0; ai < 2; ++ai)
#pragma unroll
            for (int m = 0; m < 4; ++m) {
                bf16_t* rowp = O + (size_t)(row0 + ai * HALF + m * 16) * ldc + col0;
                const f32x4 g0 = acc[ai][0][m][0], g1 = acc[ai][0][m][1], u0 = acc[ai][1][m][0], u1 = acc[ai][1][m][1];
                u32x4 w;
                w.x = cvt_pk_bf16(silu_fast(g0[0]) * u0[0], silu_fast(g0[1]) * u0[1]); w.y = cvt_pk_bf16(silu_fast(g0[2]) * u0[2], silu_fast(g0[3]) * u0[3]);
                w.z = cvt_pk_bf16(silu_fast(g1[0]) * u1[0], silu_fast(g1[1]) * u1[1]); w.w = cvt_pk_bf16(silu_fast(g1[2]) * u1[2], silu_fast(g1[3]) * u1[3]);
                *(u32x4*)rowp = w;
            }
    }
};
struct EpiF32 {
    static constexpr bool PERM = false, AFTER_DRAIN = false;
    float* O; int ldc;
    __device__ __forceinline__ void operator()(const f32x4 (&acc)[2][2][4][2], const Unit& u, int wr, int wc, int fr, int fq) const {
        const int row0 = u.pm * BM + wr * 64 + fr, col0 = u.pn * BM + wc * 32 + 4 * fq;
#pragma unroll
        for (int ai = 0; ai < 2; ++ai)
#pragma unroll
            for (int m = 0; m < 4; ++m) {
                float* rowp = O + (size_t)(row0 + ai * HALF + m * 16) * ldc + col0;
#pragma unroll
                for (int bj = 0; bj < 2; ++bj)
#pragma unroll
                    for (int n = 0; n < 2; ++n) *(f32x4*)(rowp + bj * HALF + n * 16) = acc[ai][bj][m][n];
            }
    }
};
template <class Epi, class Sched, bool ALIGN_EPI = false, bool SP2 = false>
__device__ __forceinline__ void gemm_phase(PG8_LAS unsigned char* lds, const Gemm g, const Sched& S, const Epi& E) {
    int tid_ = threadIdx.x; asm volatile("" : "+v"(tid_));
    const int tid = tid_, wid = __builtin_amdgcn_readfirstlane(tid >> 6), lane = tid & 63, wr = wid >> 2, wc = wid & 3, fr = lane & 15, fq = lane >> 4;
    const int K = g.K, nt = K / BK;
    unsigned voffA[2], voffB[2];
#pragma unroll
    for (int i = 0; i < 2; ++i) { int R, C; stage_rc(tid * 16 + i * 8192, R, C); const int Rb = Epi::PERM ? ((R & ~31) + perm32(R & 31)) : R;
        voffA[i] = (unsigned)(R * K + C) * 2u; voffB[i] = (unsigned)(Rb * K + C) * 2u; }
    const size_t kstep = (size_t)(BK * 2);
    const size_t hstep = (size_t)HALF * K * 2;
    const size_t tstep = 2 * hstep;
    const unsigned ldsw = (unsigned)wid * 1024u;
    const int aoff = lds_byte(wr * 64 + fr, fq * 8), boff = lds_byte(wc * 32 + fr, fq * 8);
#define PG8_SA(b, h) (((b) * 2 + (h)) * HTB)
#define PG8_SB(b, h) ((4 + (b) * 2 + (h)) * HTB)
#define PG8_STAGE(bufoff, gbase, voff) do { _Pragma("unroll") for (int _i = 0; _i < 2; ++_i) \
        __builtin_amdgcn_global_load_lds((const unsigned*)((const char*)(gbase) + (voff)[_i]), (PG8_LAS unsigned*)(lds + (bufoff) + ldsw + _i * 8192), 16, 0, 0); } while (0)
#define PG8_LDA(dst, b, h) do { _Pragma("unroll") for (int m = 0; m < 4; ++m) _Pragma("unroll") for (int k = 0; k < 2; ++k) dst[m][k] = *(const PG8_LAS bf16x8*)(lds + PG8_SA(b, h) + aoff + m * 2048 + k * 1024); } while (0)
#define PG8_LDB(dst, b, h) do { _Pragma("unroll") for (int n = 0; n < 2; ++n) _Pragma("unroll") for (int k = 0; k < 2; ++k) dst[n][k] = *(const PG8_LAS bf16x8*)(lds + PG8_SB(b, h) + boff + n * 2048 + k * 1024); } while (0)
#define PG8_MMA(ai, bj, At, Bt) do { __builtin_amdgcn_s_setprio(1); _Pragma("unroll") for (int m = 0; m < 4; ++m) _Pragma("unroll") for (int n = 0; n < 2; ++n) _Pragma("unroll") for (int k = 0; k < 2; ++k) \
        acc[ai][bj][m][n] = __builtin_amdgcn_mfma_f32_16x16x32_bf16(Bt[n][k], At[m][k], acc[ai][bj][m][n], 0, 0, 0); __builtin_amdgcn_s_setprio(0); } while (0)
#define PG8_WAIT_V(n) asm volatile("s_waitcnt vmcnt(" #n ")" ::: "memory")
#define PG8_WAIT_L(n) asm volatile("s_waitcnt lgkmcnt(" #n ")" ::: "memory")
#define PG8_BAR __builtin_amdgcn_s_barrier()
#define PG8_SCHED __builtin_amdgcn_sched_barrier(0)
    Unit cur, nxt; int ui = 0;
    if (!S.next(0, cur)) return;
    f32x4 acc[2][2][4][2];
#pragma unroll
    for (int a = 0; a < 2; ++a)
#pragma unroll
        for (int b = 0; b < 2; ++b)
#pragma unroll
            for (int m = 0; m < 4; ++m)
#pragma unroll
                for (int n = 0; n < 2; ++n) acc[a][b][m][n] = (f32x4){0.f, 0.f, 0.f, 0.f};
    bf16x8 At[4][2], B0[2][2], B1[2][2];
    const char* cA = (const char*)g.A + (size_t)cur.pm * tstep; const char* cB = (const char*)g.Bt + (size_t)cur.pn * tstep;
    S.a_ready(cur);
    if constexpr (SP2) {
        PG8_STAGE(PG8_SB(0, 0), cB, voffB); PG8_STAGE(PG8_SB(0, 1), cB + hstep, voffB); PG8_STAGE(PG8_SA(0, 0), cA, voffA); PG8_STAGE(PG8_SA(0, 1), cA + hstep, voffA);
        if (wr == 1) PG8_BAR;
        PG8_WAIT_V(2); PG8_BAR;
        PG8_STAGE(PG8_SB(1, 0), cB + kstep, voffB); PG8_STAGE(PG8_SA(1, 0), cA + kstep, voffA); PG8_STAGE(PG8_SB(1, 1), cB + hstep + kstep, voffB);
        PG8_WAIT_V(6); PG8_BAR;
    } else {
        PG8_STAGE(PG8_SB(0, 0), cB, voffB); PG8_STAGE(PG8_SA(0, 0), cA, voffA); PG8_STAGE(PG8_SB(0, 1), cB + hstep, voffB); PG8_STAGE(PG8_SA(0, 1), cA + hstep, voffA);
        if (wr == 1) PG8_BAR;
        PG8_WAIT_V(4); PG8_BAR;
        PG8_STAGE(PG8_SB(1, 0), cB + kstep, voffB); PG8_STAGE(PG8_SA(1, 0), cA + kstep, voffA); PG8_STAGE(PG8_SB(1, 1), cB + hstep + kstep, voffB);
        PG8_WAIT_V(6); PG8_BAR;
    }
    for (;;) {
        const bool has_next = S.next(ui + 1, nxt);
        const char* nA = has_next ? (const char*)g.A + (size_t)nxt.pm * tstep : cA; const char* nB = has_next ? (const char*)g.Bt + (size_t)nxt.pn * tstep : cB;
        for (int t = 0; t < nt; t += 2) {
            const bool last = (t == nt - 2);
            const char* a1 = cA + (size_t)(t + 1) * kstep;
            const char* a2 = last ? nA : cA + (size_t)(t + 2) * kstep; const char* b2 = last ? nB : cB + (size_t)(t + 2) * kstep;
            const char* a3 = a2 + kstep; const char* b3 = b2 + kstep;
            if (last && has_next) S.a_ready(nxt);
            if constexpr (SP2) {
            PG8_LDB(B0, 0, 0); PG8_LDB(B1, 0, 1); PG8_SCHED; PG8_LDA(At, 0, 0); PG8_STAGE(PG8_SA(1, 1), a1 + hstep, voffA);
            PG8_WAIT_V(8); PG8_WAIT_L(0); PG8_BAR; PG8_MMA(0, 0, At, B0); PG8_MMA(0, 1, At, B1); PG8_BAR; PG8_SCHED;
            PG8_LDA(At, 0, 1); PG8_STAGE(PG8_SB(0, 0), b2, voffB); PG8_STAGE(PG8_SB(0, 1), b2 + hstep, voffB); PG8_STAGE(PG8_SA(0, 0), a2, voffA);
            PG8_WAIT_V(8); PG8_WAIT_L(0); PG8_BAR; PG8_MMA(1, 0, At, B0); PG8_MMA(1, 1, At, B1); PG8_BAR; PG8_SCHED;
            PG8_LDB(B0, 1, 0); PG8_LDB(B1, 1, 1); PG8_SCHED; PG8_LDA(At, 1, 0); PG8_STAGE(PG8_SA(0, 1), a2 + hstep, voffA);
            PG8_WAIT_V(8); PG8_WAIT_L(0); PG8_BAR; PG8_MMA(0, 0, At, B0); PG8_MMA(0, 1, At, B1); PG8_BAR; PG8_SCHED;
            PG8_LDA(At, 1, 1); PG8_STAGE(PG8_SB(1, 0), b3, voffB); PG8_STAGE(PG8_SB(1, 1), b3 + hstep, voffB); PG8_STAGE(PG8_SA(1, 0), a3, voffA);
            PG8_WAIT_V(8); PG8_WAIT_L(0); PG8_BAR; PG8_MMA(1, 0, At, B0); PG8_MMA(1, 1, At, B1); PG8_BAR; PG8_SCHED;
            } else {
            PG8_LDB(B0, 0, 0); PG8_SCHED; PG8_LDA(At, 0, 0); PG8_STAGE(PG8_SA(1, 1), a1 + hstep, voffA);
            PG8_WAIT_L(8); PG8_BAR; PG8_WAIT_L(0); PG8_MMA(0, 0, At, B0); PG8_BAR; PG8_SCHED;
            PG8_LDB(B1, 0, 1); PG8_STAGE(PG8_SB(0, 0), b2, voffB);
            PG8_BAR; PG8_WAIT_L(0); PG8_MMA(0, 1, At, B1); PG8_BAR;
            PG8_LDA(At, 0, 1); PG8_STAGE(PG8_SA(0, 0), a2, voffA);
            PG8_BAR; PG8_WAIT_L(0); PG8_MMA(1, 0, At, B0); PG8_BAR; PG8_SCHED;
            PG8_STAGE(PG8_SB(0, 1), b2 + hstep, voffB);
            PG8_WAIT_V(6); PG8_BAR; PG8_MMA(1, 1, At, B1); PG8_BAR;
            PG8_LDB(B0, 1, 0); PG8_SCHED; PG8_LDA(At, 1, 0); PG8_STAGE(PG8_SA(0, 1), a2 + hstep, voffA);
            PG8_WAIT_L(8); PG8_BAR; PG8_WAIT_L(0); PG8_MMA(0, 0, At, B0); PG8_BAR; PG8_SCHED;
            PG8_LDB(B1, 1, 1); PG8_STAGE(PG8_SB(1, 0), b3, voffB);
            PG8_BAR; PG8_WAIT_L(0); PG8_MMA(0, 1, At, B1); PG8_BAR;
            PG8_LDA(At, 1, 1); PG8_STAGE(PG8_SA(1, 0), a3, voffA);
            PG8_BAR; PG8_WAIT_L(0); PG8_MMA(1, 0, At, B0); PG8_BAR; PG8_SCHED;
            PG8_STAGE(PG8_SB(1, 1), b3 + hstep, voffB);
            PG8_WAIT_V(6); PG8_BAR; PG8_MMA(1, 1, At, B1); PG8_BAR;
            }
        }
        if constexpr (ALIGN_EPI) { if (wr == 0) PG8_BAR; }
        if constexpr (!Epi::AFTER_DRAIN) { E(acc, cur, wr, wc, fr, fq); S.done(cur); }
        if (!has_next) break;
#pragma unroll
        for (int a = 0; a < 2; ++a)
#pragma unroll
            for (int b = 0; b < 2; ++b)
#pragma unroll
                for (int m = 0; m < 4; ++m)
#pragma unroll
                    for (int n = 0; n < 2; ++n) acc[a][b][m][n] = (f32x4){0.f, 0.f, 0.f, 0.f};
        cur = nxt; cA = nA; cB = nB; ++ui;
        if constexpr (ALIGN_EPI) { if (wr == 1) PG8_BAR; }
    }
    PG8_WAIT_V(0);
    if constexpr (!ALIGN_EPI) { if (wr == 0) PG8_BAR; }
    PG8_BAR;
    if constexpr (Epi::AFTER_DRAIN) { E.fused(acc, cur, wr, wc, fr, fq, lds, wid, lane); S.done(cur); }
#undef PG8_SA
#undef PG8_SB
#undef PG8_STAGE
#undef PG8_LDA
#undef PG8_LDB
#undef PG8_MMA
#undef PG8_WAIT_V
#undef PG8_WAIT_L
#undef PG8_BAR
#undef PG8_SCHED
}
}
#define GAS __attribute__((address_space(1)))
#define LAS __attribute__((address_space(3)))
typedef unsigned short bf16;
typedef unsigned v4u __attribute__((ext_vector_type(4)));
typedef float f32x4 __attribute__((ext_vector_type(4)));
typedef short bf16x8 __attribute__((ext_vector_type(8)));
typedef GAS unsigned gu32;
typedef GAS unsigned long long gu64;
#define RLX_AGENT __ATOMIC_RELAXED, __HIP_MEMORY_SCOPE_AGENT
#define LDS_WAIT() asm volatile("s_waitcnt lgkmcnt(0)" ::: "memory")
#define VM_WAIT() asm volatile("s_waitcnt vmcnt(0)" ::: "memory")
__device__ __forceinline__ unsigned long long rt() { return __builtin_amdgcn_s_memrealtime(); }
__device__ __forceinline__ unsigned f2bf(float f) { unsigned u = __builtin_bit_cast(unsigned, f); return (u + 0x7fffu + ((u >> 16) & 1u)) >> 16; }
__device__ __forceinline__ unsigned pk2(float lo, float hi) { return f2bf(lo) | (f2bf(hi) << 16); }
#define XB_TMO      128
#define XB_XCNT(j)  (256  + 64 * (j))
#define XB_XSUB(j)  (1280 + 64 * (j))
#define XB_XGEN(j)  (2304 + 64 * (j))
#define XB_TOP      3328
#define XB_TOPGEN   3392
#define XCD_BAR_WORDS 3456
#define XB_SPIN_CAP (1u << 18)

__device__ __forceinline__ unsigned xb_ld(unsigned* p)              { return __hip_atomic_load(p, __ATOMIC_RELAXED, __HIP_MEMORY_SCOPE_AGENT); }
__device__ __forceinline__ unsigned xb_add(unsigned* p, unsigned v) { return __hip_atomic_fetch_add(p, v, __ATOMIC_RELAXED, __HIP_MEMORY_SCOPE_AGENT); }
__device__ __forceinline__ unsigned xb_xcc_id() { return (unsigned)__builtin_amdgcn_s_getreg((3 << 11) | 20) & 0xFu; }
#define XB_SPIN(cond, bar) do { unsigned _sp = 0; while (cond) { __builtin_amdgcn_s_sleep(1); \
    if ((++_sp & 255u) == 0u) { if (xb_ld(&(bar)[XB_TMO])) break; if (_sp > XB_SPIN_CAP) { atomicAdd(&(bar)[XB_TMO], 1u); break; } } } } while (0)

struct XcdBarrier {
    unsigned* bar; unsigned x;
    volatile LAS unsigned* st;
};

__device__ __forceinline__ XcdBarrier xcd_barrier_post(unsigned* bar, volatile LAS unsigned* st) {
    XcdBarrier b; b.bar = bar; b.x = xb_xcc_id(); b.st = st;
    if (threadIdx.x == 0) (void)xb_add(&bar[XB_XCNT(b.x)], 1u);
    return b;
}
__device__ __forceinline__ void xcd_barrier_complete(unsigned* bar, unsigned x, unsigned& nloc, unsigned& nx) {
    const unsigned G = gridDim.x * gridDim.y * gridDim.z;
    unsigned sum, cnt, mine, sp = 0u;
    for (;;) {
        sum = 0u; cnt = 0u; mine = 0u;
#pragma unroll
        for (unsigned j = 0; j < 16; ++j) { const unsigned c = xb_ld(&bar[XB_XCNT(j)]); sum += c; cnt += (c > 0u) ? 1u : 0u; mine = (j == x) ? c : mine; }
        if (sum == G) break;
        __builtin_amdgcn_s_sleep(1);
        if ((++sp & 255u) == 0u) { if (xb_ld(&bar[XB_TMO])) break; if (sp > XB_SPIN_CAP) { atomicAdd(&bar[XB_TMO], 1u); break; } }
    }
    nloc = mine > 0u ? mine : 1u; nx = cnt > 0u ? cnt : 1u;
}

__device__ __forceinline__ void xcd_barrier(const XcdBarrier& b) {
    asm volatile("s_waitcnt vmcnt(0)" ::: "memory");
    __syncthreads();
    if (threadIdx.x == 0) {
        unsigned* bar = b.bar;
        __builtin_amdgcn_s_waitcnt(0);
        unsigned nloc = b.st[0], nx = b.st[1];
        if (nloc == 0u) { xcd_barrier_complete(bar, b.x, nloc, nx); b.st[0] = nloc; b.st[1] = nx; }
        const unsigned old = xb_add(&bar[XB_XSUB(b.x)], 1u);
        const unsigned gen = old / nloc;
        if (old + 1u == (gen + 1u) * nloc) {
            __builtin_amdgcn_fence(__ATOMIC_RELEASE, "agent");
            asm volatile("s_waitcnt vmcnt(0)" ::: "memory");
            const unsigned og = xb_add(&bar[XB_TOP], 1u);
            const unsigned tg = og / nx;
            if (og + 1u == (tg + 1u) * nx) xb_add(&bar[XB_TOPGEN], 1u);
            else XB_SPIN(xb_ld(&bar[XB_TOPGEN]) == tg, bar);
            __builtin_amdgcn_fence(__ATOMIC_ACQUIRE, "agent");
            xb_add(&bar[XB_XGEN(b.x)], 1u);
            asm volatile("s_waitcnt vmcnt(0)" ::: "memory");
        } else {
            XB_SPIN(xb_ld(&bar[XB_XGEN(b.x)]) == gen, bar);
            __builtin_amdgcn_fence(__ATOMIC_ACQUIRE, "agent");
            asm volatile("s_waitcnt vmcnt(0)" ::: "memory");
        }
    }
    __syncthreads();
}
constexpr int NWAVES = 8, NTHR = 512;
constexpr int D = 1024, SEQ = 16384, DBATCH = 128, MP = SEQ, MS = 512, M = MP + MS;
constexpr int DFF = 2816, INW = 3072, PAST = 8192, WB = 2048, KEEP = 2048, NH = 8;
constexpr float EPS = 1e-6f;
constexpr int C_QA = 0, C_KA = 512, C_VA = 1024, C_QR = 1536, C_KR = 1792, C_VR = 2048, C_GR = 2560;
constexpr size_t O_Y = 0, O_KP = (size_t)M * D, O_VP = O_KP + (size_t)KEEP * 512, O_SP = O_VP + (size_t)KEEP * 512,
                 O_KS = O_SP + 32768, O_VS = O_KS + (size_t)MS * 512, O_SS = O_VS + (size_t)MS * 512, O_END = O_SS + (size_t)DBATCH * 32768;
constexpr size_t MiB = 1u << 20;
constexpr size_t WS_CTL = 0, CTL_ZERO_BYTES = 1 * MiB;
constexpr size_t WS_W1GU = 1 * MiB, WS_W1D = 12 * MiB, WS_WIN = 18 * MiB, WS_WOUT = 24 * MiB, WS_W2GU = 26 * MiB, WS_W2D = 37 * MiB, WS_TAB = 43 * MiB;
constexpr size_t WS_XN = 48 * MiB, WS_H = 81 * MiB, WS_Y = 172 * MiB, WS_HRES = 238 * MiB, WS_QKV = 304 * MiB, WS_MIX = 502 * MiB, WS_UPD = 535 * MiB, WS_SPREV = 551 * MiB, WS_QKVB = 567 * MiB, WS_OPART = 667 * MiB, WS_ML = 716 * MiB, WS_SPART = 720 * MiB, WS_SML = 736 * MiB, WS_END = 737 * MiB;
constexpr int CW_BAR = 4096;
constexpr int RING_BYTES = 131072, LDSCTL_OFF = RING_BYTES, MISC_OFF = LDSCTL_OFF + 320, LDS_BYTES = 147456;

__constant__ float INVF[40] = {
    1.f, 0.193922743f, 0.0376060307f, 0.00729266461f, 0.00141421356f, 0.000274248188f, 5.3182961e-05f, 1.03133862e-05f,
    1.f, 0.749894261f, 0.562341332f, 0.421696514f, 0.316227764f, 0.237137377f, 0.177827939f, 0.133352131f, 0.100000001f, 0.0749894157f,
    0.0562341325f, 0.0421696529f, 0.0316227749f, 0.0237137377f, 0.0177827943f, 0.0133352149f, 0.00999999978f, 0.00749894185f,
    0.00562341325f, 0.00421696482f, 0.00316227763f, 0.00237137359f, 0.00177827943f, 0.00133352145f, 0.00100000005f, 0.000749894243f,
    0.000562341302f, 0.000421696517f, 0.000316227757f, 0.00023713737f, 0.00017782794f, 0.00013335215f};
__device__ __forceinline__ float log_g(int h) { return h == 0 ? -0.0317486983145803f : h == 1 ? -0.015748356968139168f : h == 2 ? -0.007843177461025893f : -0.003913899321136329f; }
__device__ __forceinline__ float wave_sum(float v) {
#pragma unroll
    for (int o = 32; o >= 1; o >>= 1) v += __shfl_xor(v, o);
    return v;
}
__device__ __forceinline__ float wave_max(float v) {
#pragma unroll
    for (int o = 32; o >= 1; o >>= 1) v = fmaxf(v, __shfl_xor(v, o));
    return v;
}
__device__ __forceinline__ float silu_f(float x) { return x / (1.f + expf(-x)); }

__host__ __device__ __forceinline__ int win_perm(int col) {
    if (col < 1024) { const int dd = col & 63; return dd < 16 ? (col & ~63) + 8 * ((dd >> 2) & 1) + 4 * (dd >> 3) + (dd & 3) : col; }
    if (col >= 1536 && col < 2048) { const int dd = col & 63; return (col & ~63) + 8 * ((dd & 31) >> 2) + 4 * (dd >> 5) + (dd & 3); }
    return col;
}
__device__ __forceinline__ void tr_item(const float* W, int K, int N, bf16* WT, int mode, LAS float* scr, int item, int lane) {
    const int nblk = N / 32, kb = item / nblk, nb = item % nblk, k0 = 64 * kb, n0 = 32 * nb;
    const int rbase = mode == 0 ? n0 : (256 * (n0 >> 7) + (n0 & 127) + (mode == 2 ? 128 : 0));
    {
        const int row8 = lane >> 3, c4 = lane & 7;
        float4 v[8];
#pragma unroll
        for (int i = 0; i < 8; ++i) v[i] = *(const float4*)(W + (size_t)(k0 + 8 * i + row8) * N + n0 + 4 * c4);
#pragma unroll
        for (int i = 0; i < 8; ++i) { LAS float* d = scr + (8 * i + row8) * 33 + 4 * c4; d[0] = v[i].x; d[1] = v[i].y; d[2] = v[i].z; d[3] = v[i].w; }
    }
    LDS_WAIT(); asm volatile("" ::: "memory");
    const int c = lane & 7;
#pragma unroll
    for (int j = 0; j < 4; ++j) { const int n = (lane >> 3) + 8 * j; const LAS float* s = scr + (8 * c) * 33 + n;
        v4u o; o.x = pk2(s[0 * 33], s[1 * 33]); o.y = pk2(s[2 * 33], s[3 * 33]); o.z = pk2(s[4 * 33], s[5 * 33]); o.w = pk2(s[6 * 33], s[7 * 33]);
        const int orow = mode == 3 ? win_perm(n0 + n) : rbase + n;
        *(GAS v4u*)(WT + (size_t)orow * K + k0 + 8 * c) = o; }
    LDS_WAIT(); asm volatile("" ::: "memory");
}
struct Ptrs {
    const float *xp, *xs, *ck, *cv, *st, *g1a, *g1b, *w1g, *w1u, *w1d, *gma, *gmb, *win, *gnw, *wout, *g2a, *g2b, *w2g, *w2u, *w2d;
    float* out;
    bf16 *W1GU, *W1D, *WIN, *WOUT, *W2GU, *W2D, *XN, *H, *MIX;
    float2* TAB; bf16 *Y, *HRES; float *QKV, *UPD; bf16 *SPT, *QKVb, *OPART; float2 *ML, *SML; float* SPART;
};
__device__ __forceinline__ void p0_prologue(const Ptrs& P, LAS unsigned char* lds, int gw, int NGW, int wave, int lane, int gtid, int NGT) {
    LAS float* scr = (LAS float*)(lds + wave * 16384);
    constexpr int I_GU = 16 * 88;
    for (int it = gw; it < 2 * I_GU; it += NGW) {
        if (it < I_GU) tr_item(P.w1g, D, DFF, P.W1GU, 1, scr, it, lane); else tr_item(P.w1u, D, DFF, P.W1GU, 2, scr, it - I_GU, lane);
    }
    for (int idx = gtid; idx < SEQ * 40; idx += NGT) {
        const int pos = idx / 40, f = idx % 40;
        const float ang = (float)pos * INVF[f];
        const double rev = (double)ang * 0.15915494309189535;
        const float fr = (float)(rev - rint(rev));
        P.TAB[idx] = make_float2(__builtin_amdgcn_cosf(fr), __builtin_amdgcn_sinf(fr));
    }
    for (int r = gw; r < M; r += NGW) {
        const float4* x = (const float4*)(r < MP ? P.xp + (size_t)r * D : P.xs + (size_t)(r - MP) * D);
        float4 v[4]; float ss = 0.f;
#pragma unroll
        for (int j = 0; j < 4; ++j) { v[j] = x[lane + 64 * j]; ss += v[j].x * v[j].x + v[j].y * v[j].y + v[j].z * v[j].z + v[j].w * v[j].w; }
        const float rstd = 1.f / sqrtf(wave_sum(ss) * (1.f / D) + EPS);
        uint2* o = (uint2*)(P.XN + (size_t)r * D);
#pragma unroll
        for (int j = 0; j < 4; ++j) { const float4 gg = ((const float4*)P.g1a)[lane + 64 * j];
            o[lane + 64 * j] = make_uint2(pk2(v[j].x * rstd * gg.x, v[j].y * rstd * gg.y), pk2(v[j].z * rstd * gg.z, v[j].w * rstd * gg.w)); }
    }
}
__device__ __forceinline__ void p0_deferred(const Ptrs& P, LAS unsigned char* lds, int gw, int NGW, int wave, int lane) {
    LAS float* scr = (LAS float*)(lds + wave * 16384);
    constexpr int I_GU = 16 * 88, I_D = 44 * 32, I_IN = 16 * 96, I_OUT = 16 * 32;
    constexpr int NITEMS = 2 * I_D + 2 * I_GU + I_IN + I_OUT;
    for (int it = gw; it < NITEMS; it += NGW) {
        int r = it;
        if (r < I_D) { tr_item(P.w1d, DFF, D, P.W1D, 0, scr, r, lane); continue; } r -= I_D;
        if (r < I_IN) { tr_item(P.win, D, INW, P.WIN, 3, scr, r, lane); continue; } r -= I_IN;
        if (r < I_OUT) { tr_item(P.wout, D, D, P.WOUT, 0, scr, r, lane); continue; } r -= I_OUT;
        if (r < I_GU) { tr_item(P.w2g, D, DFF, P.W2GU, 1, scr, r, lane); continue; } r -= I_GU;
        if (r < I_GU) { tr_item(P.w2u, D, DFF, P.W2GU, 2, scr, r, lane); continue; } r -= I_GU;
        tr_item(P.w2d, DFF, D, P.W2D, 0, scr, r, lane);
    }
}
__device__ __forceinline__ void unpack8(const v4u x, float (&f)[8]) { f[0] = __builtin_bit_cast(float, x.x << 16); f[1] = __builtin_bit_cast(float, x.x & 0xffff0000u); f[2] = __builtin_bit_cast(float, x.y << 16); f[3] = __builtin_bit_cast(float, x.y & 0xffff0000u);
    f[4] = __builtin_bit_cast(float, x.z << 16); f[5] = __builtin_bit_cast(float, x.z & 0xffff0000u); f[6] = __builtin_bit_cast(float, x.w << 16); f[7] = __builtin_bit_cast(float, x.w & 0xffff0000u); }
__device__ __forceinline__ v4u pack8(const float (&f)[8]) { v4u w; w.x = pk2(f[0], f[1]); w.y = pk2(f[2], f[3]); w.z = pk2(f[4], f[5]); w.w = pk2(f[6], f[7]); return w; }
template <bool RES_F32, bool OUT_F32>
__device__ __forceinline__ void norm_res_phase(const float* resA, const float* resB, const bf16* resH, const bf16* Y, const float* gpost, float scale, bf16* hout, float* fout, const float* gnext, bf16* XN, int gw, int NGW, int lane) {
    for (int r = gw; r < M; r += NGW) {
        float y[2][8], h[2][8]; float ss = 0.f;
#pragma unroll
        for (int c = 0; c < 2; ++c) {
            const int col = 512 * c + 8 * lane;
            unpack8(*(const v4u*)(Y + (size_t)r * D + col), y[c]);
            if (RES_F32) { const float* x = (r < MP ? resA + (size_t)r * D : resB + (size_t)(r - MP) * D) + col; const float4 a = *(const float4*)x, b = *(const float4*)(x + 4);
                h[c][0] = a.x; h[c][1] = a.y; h[c][2] = a.z; h[c][3] = a.w; h[c][4] = b.x; h[c][5] = b.y; h[c][6] = b.z; h[c][7] = b.w; }
            else unpack8(*(const v4u*)(resH + (size_t)r * D + col), h[c]);
#pragma unroll
            for (int e = 0; e < 8; ++e) ss += y[c][e] * y[c][e];
        }
        const float rstd = scale / sqrtf(wave_sum(ss) * (1.f / D) + EPS);
        float s2 = 0.f;
#pragma unroll
        for (int c = 0; c < 2; ++c) {
            const int col = 512 * c + 8 * lane;
            const float4 g0 = *(const float4*)(gpost + col), g1 = *(const float4*)(gpost + col + 4);
            const float gg[8] = {g0.x, g0.y, g0.z, g0.w, g1.x, g1.y, g1.z, g1.w};
#pragma unroll
            for (int e = 0; e < 8; ++e) { h[c][e] += y[c][e] * rstd * gg[e]; s2 += h[c][e] * h[c][e]; }
            if (OUT_F32) { float* o = fout + (size_t)r * D + col; *(float4*)o = make_float4(h[c][0], h[c][1], h[c][2], h[c][3]); *(float4*)(o + 4) = make_float4(h[c][4], h[c][5], h[c][6], h[c][7]); }
            else *(v4u*)(hout + (size_t)r * D + col) = pack8(h[c]);
        }
        if (gnext) {
            const float r2 = 1.f / sqrtf(wave_sum(s2) * (1.f / D) + EPS);
#pragma unroll
            for (int c = 0; c < 2; ++c) {
                const int col = 512 * c + 8 * lane;
                const float4 g0 = *(const float4*)(gnext + col), g1 = *(const float4*)(gnext + col + 4);
                const float gg[8] = {g0.x, g0.y, g0.z, g0.w, g1.x, g1.y, g1.z, g1.w};
                float o[8];
#pragma unroll
                for (int e = 0; e < 8; ++e) o[e] = h[c][e] * r2 * gg[e];
                *(v4u*)(XN + (size_t)r * D + col) = pack8(o);
            }
        }
    }
}
typedef float f32x16 __attribute__((ext_vector_type(16)));
typedef short s16x4 __attribute__((ext_vector_type(4)));
typedef float f32x2_t __attribute__((ext_vector_type(2)));
typedef __bf16 bf16x2_t __attribute__((ext_vector_type(2)));
__device__ __forceinline__ unsigned cvtpk(float lo, float hi) { f32x2_t v = {lo, hi}; bf16x2_t b = __builtin_convertvector(v, bf16x2_t); return __builtin_bit_cast(unsigned, b); }
__device__ __forceinline__ s16x4 vtr(const LAS unsigned char* p) { return __builtin_bit_cast(s16x4, __builtin_amdgcn_ds_read_tr16_b64_v4i16((LAS s16x4*)p)); }
#define MFMA32(a, b, c) __builtin_amdgcn_mfma_f32_32x32x16_bf16((a), (b), (c), 0, 0, 0)
__device__ __forceinline__ int crow(int reg, int hh) { return (reg & 3) + 8 * (reg >> 2) + 4 * hh; }
__device__ __forceinline__ float bf_lo(unsigned u) { return __builtin_bit_cast(float, u << 16); }
__device__ __forceinline__ float bf_hi(unsigned u) { return __builtin_bit_cast(float, u & 0xffff0000u); }
constexpr float QSCALE = 0.125f * 1.4426950408889634f;

__device__ __forceinline__ void sk_tile(LAS unsigned char* lds, const bf16* A, int lda, const bf16* Wt, int K, int r0, int c0, int tid, int wave, int lane) {
    const int i = lane & 31, hh = lane >> 5;
    const int ksl = K >> 3, k0 = wave * ksl;
    const bf16* ap = A + (size_t)(r0 + i) * lda + k0 + 8 * hh;
    const bf16* bp0 = Wt + (size_t)(c0 + i) * K + k0 + 8 * hh;
    const bf16* bp1 = bp0 + (size_t)32 * K;
    f32x16 acc0, acc1;
#pragma unroll
    for (int e = 0; e < 16; ++e) { acc0[e] = 0.f; acc1[e] = 0.f; }
#pragma unroll 4
    for (int ks = 0; ks < (ksl >> 4); ++ks) {
        const bf16x8 a = *(const bf16x8*)(ap + 16 * ks), b0 = *(const bf16x8*)(bp0 + 16 * ks), b1 = *(const bf16x8*)(bp1 + 16 * ks);
        acc0 = MFMA32(a, b0, acc0); acc1 = MFMA32(a, b1, acc1);
    }
    LAS float* part = (LAS float*)lds + wave * 2048;
#pragma unroll
    for (int e = 0; e < 16; ++e) { const int row = crow(e, hh); part[row * 64 + i] = acc0[e]; part[row * 64 + 32 + i] = acc1[e]; }
    __syncthreads();
    {
        const LAS f32x4* p4 = (const LAS f32x4*)lds + tid;
        f32x4 s = p4[0];
#pragma unroll
        for (int w = 1; w < 8; ++w) s += p4[w * 512];
        ((LAS f32x4*)(lds + 65536))[tid] = s;
    }
    __syncthreads();
}
__device__ __forceinline__ void sk_gemm_y(LAS unsigned char* lds, const bf16* A, int lda, const bf16* Wt, int K, bf16* Y, int tid, int wave, int lane) {
    for (int item = blockIdx.x; item < 256; item += gridDim.x) {
        const int rt = item >> 4, ct = item & 15;
        sk_tile(lds, A, lda, Wt, K, MP + 32 * rt, 64 * ct, tid, wave, lane);
        const f32x4 v = ((const LAS f32x4*)(lds + 65536))[tid];
        *(uint2*)(Y + (size_t)(MP + 32 * rt + (tid >> 4)) * D + 64 * ct + 4 * (tid & 15)) = make_uint2(cvtpk(v[0], v[1]), cvtpk(v[2], v[3]));
        __syncthreads();
    }
}
__device__ __forceinline__ void sk_gemm_qkv(LAS unsigned char* lds, const bf16* XN, const bf16* WIN, bf16* QKVb, const float2* tab, float* out, int tid, int wave, int lane) {
    const LAS float* red = (const LAS float*)(lds + 65536);
    for (int item = blockIdx.x; item < 768; item += gridDim.x) {
        const int rt = item / 48, ct = item % 48;
        sk_tile(lds, XN, D, WIN, D, MP + 32 * rt, 64 * ct, tid, wave, lane);
        const int row = tid >> 4, c4 = tid & 15, srow = 32 * rt + row, pos = PAST + (srow & 3), nc0 = 64 * ct;
        float y[4];
#pragma unroll
        for (int k = 0; k < 4; ++k) {
            const int dd = 4 * c4 + k;
            const float x = red[row * 64 + (win_perm(nc0 + dd) - nc0)];
            float r = x;
            if (ct < 16) {
                if (dd < 16) { const float xp = red[row * 64 + (win_perm(nc0 + (dd ^ 8)) - nc0)]; const float2 cs = tab[pos * 40 + (dd & 7)];
                    r = dd < 8 ? x * cs.x - xp * cs.y : x * cs.x + xp * cs.y; }
                if (ct < 8) r *= QSCALE;
            } else if (ct >= 24 && ct < 32) {
                const float xp = red[row * 64 + (win_perm(nc0 + (dd ^ 32)) - nc0)]; const float2 cs = tab[pos * 40 + 8 + (dd & 31)];
                r = dd < 32 ? x * cs.x - xp * cs.y : x * cs.x + xp * cs.y;
                if (ct >= 28) r *= 0.125f;
            }
            y[k] = r;
        }
        *(uint2*)(QKVb + (size_t)(MP + srow) * INW + nc0 + 4 * c4) = make_uint2(cvtpk(y[0], y[1]), cvtpk(y[2], y[3]));
        if (ct >= 8 && ct < 16) *(float4*)(out + O_KS + (size_t)srow * 512 + (nc0 - C_KA) + 4 * c4) = make_float4(y[0], y[1], y[2], y[3]);
        if (ct >= 16 && ct < 24) *(float4*)(out + O_VS + (size_t)srow * 512 + (nc0 - C_VA) + 4 * c4) = make_float4(y[0], y[1], y[2], y[3]);
        __syncthreads();
    }
}
__device__ __forceinline__ void attn_mfma_phase(LAS unsigned char* lds, const bf16* QKVb, bf16* OPART, float2* ML, int tid, int wave, int lane) {
    constexpr int RSK = 144, RSV = 192;
    LAS unsigned char* kimg = lds;
    LAS unsigned char* vimg = lds + 384 * RSK;
    const int i = lane & 31, hh = lane >> 5, i16 = lane & 15, tq = i16 >> 2, tp = i16 & 3, blk = (lane >> 4) & 1;
    v4u pk[6], pv[6];
    auto decode = [](int item, int& h, int& b, int& r, int& bk) { h = item / 192; const int w = item % 192;
        if (w < 64) { b = 0; r = 0; bk = w; } else if (w < 128) { b = 1; r = (w - 64) >> 4; bk = (w - 64) & 15; } else { b = 2; r = (w - 128) >> 2; bk = (w - 128) & 3; } };
    auto issue = [&](int item) { int h, b, r, bk; decode(item, h, b, r, bk); const int d = 1 << (2 * b), L0 = bk * 256;
#pragma unroll
        for (int c = 0; c < 6; ++c) { const int e = tid + NTHR * c, j = e >> 3, ch = e & 7, l = L0 - 128 + j;
            if (l >= 0) { const bf16* src = QKVb + (size_t)(l * d + r) * INW + h * 64 + 8 * ch; pk[c] = *(const v4u*)(src + C_KA); pv[c] = *(const v4u*)(src + C_VA); } } };
    if ((int)blockIdx.x < 1536) issue(blockIdx.x);
    for (int item = blockIdx.x; item < 1536; item += gridDim.x) {
        int h, b, r, bk; decode(item, h, b, r, bk);
        const int d = 1 << (2 * b), L0 = bk * 256;
#pragma unroll
        for (int c = 0; c < 6; ++c) { const int e = tid + NTHR * c, j = e >> 3, ch = e & 7;
            *(LAS v4u*)(kimg + j * RSK + 16 * ch) = pk[c]; *(LAS v4u*)(vimg + j * RSV + 16 * ch) = pv[c]; }
        const int l0 = L0 + 32 * wave;
        const int tok_q = (l0 + i) * d + r;
        const bf16* qp = QKVb + (size_t)tok_q * INW + C_QA + h * 64 + 8 * hh;
        bf16x8 qf[4];
#pragma unroll
        for (int ks = 0; ks < 4; ++ks) qf[ks] = *(const bf16x8*)(qp + 16 * ks);
        __syncthreads();
        if (item + (int)gridDim.x < 1536) issue(item + gridDim.x);
        f32x16 o0, o1;
#pragma unroll
        for (int e = 0; e < 16; ++e) { o0[e] = 0.f; o1[e] = 0.f; }
        float m = -1e30f, l = 0.f;
        const int kt0 = l0 >= 128 ? 0 : ((128 - l0) >> 5);
        for (int kt = kt0; kt < 5; ++kt) {
            const int jb = 32 * wave + 32 * kt;
            const LAS unsigned char* kp = kimg + (jb + i) * RSK + 16 * hh;
            f32x16 s;
#pragma unroll
            for (int e = 0; e < 16; ++e) s[e] = 0.f;
#pragma unroll
            for (int ks = 0; ks < 4; ++ks) { const bf16x8 kf = *(const LAS bf16x8*)(kp + 32 * ks); s = MFMA32(kf, qf[ks], s); }
            float tm = -1e30f;
#pragma unroll
            for (int e = 0; e < 16; ++e) { const int j = crow(e, hh); const bool bad = (kt == 0 && j < i) || (kt == 4 && j > i); s[e] = bad ? -1e30f : s[e]; tm = fmaxf(tm, s[e]); }
            tm = fmaxf(tm, __shfl_xor(tm, 32));
            const float mn = fmaxf(m, tm), scl = __builtin_amdgcn_exp2f(m - mn);
            m = mn; l *= scl;
#pragma unroll
            for (int e = 0; e < 16; ++e) { o0[e] *= scl; o1[e] *= scl; }
            float psum = 0.f;
#pragma unroll
            for (int e = 0; e < 16; ++e) { s[e] = __builtin_amdgcn_exp2f(s[e] - mn); psum += s[e]; }
            l += psum;
            v4u pw0, pw1;
            pw0.x = cvtpk(s[0], s[1]); pw0.y = cvtpk(s[2], s[3]); pw0.z = cvtpk(s[4], s[5]); pw0.w = cvtpk(s[6], s[7]);
            pw1.x = cvtpk(s[8], s[9]); pw1.y = cvtpk(s[10], s[11]); pw1.z = cvtpk(s[12], s[13]); pw1.w = cvtpk(s[14], s[15]);
            const bf16x8 pf0 = __builtin_bit_cast(bf16x8, pw0), pf1 = __builtin_bit_cast(bf16x8, pw1);
#pragma unroll
            for (int st = 0; st < 2; ++st) {
                const LAS unsigned char* a0 = vimg + (jb + 16 * st + 4 * hh + tq) * RSV + (16 * blk + 4 * tp) * 2;
                const s16x4 lo0 = vtr(a0), hi0 = vtr(a0 + 8 * RSV), lo1 = vtr(a0 + 64), hi1 = vtr(a0 + 8 * RSV + 64);
                const bf16x8 v0 = __builtin_shufflevector(lo0, hi0, 0, 1, 2, 3, 4, 5, 6, 7), v1 = __builtin_shufflevector(lo1, hi1, 0, 1, 2, 3, 4, 5, 6, 7);
                o0 = MFMA32(v0, st == 0 ? pf0 : pf1, o0);
                o1 = MFMA32(v1, st == 0 ? pf0 : pf1, o1);
            }
        }
        const float lt = l + __shfl_xor(l, 32), inv = 1.f / lt;
        bf16* op = OPART + ((size_t)b * MP + tok_q) * 512 + h * 64 + 4 * hh;
#pragma unroll
        for (int g = 0; g < 4; ++g) {
            *(uint2*)(op + 8 * g) = make_uint2(cvtpk(o0[4 * g] * inv, o0[4 * g + 1] * inv), cvtpk(o0[4 * g + 2] * inv, o0[4 * g + 3] * inv));
            *(uint2*)(op + 32 + 8 * g) = make_uint2(cvtpk(o1[4 * g] * inv, o1[4 * g + 1] * inv), cvtpk(o1[4 * g + 2] * inv, o1[4 * g + 3] * inv));
        }
        if (hh == 0) ML[((size_t)b * MP + tok_q) * 8 + h] = make_float2(m, lt);
        __syncthreads();
    }
}
__device__ __forceinline__ void attn_combine_phase(const bf16* OPART, const float2* ML, bf16* MIX, int gtid, int NGT) {
    for (int idx = gtid; idx < MP * 64; idx += NGT) {
        const int tok = idx >> 6, h = (idx >> 3) & 7, c = idx & 7;
        const float2 a0 = ML[((size_t)0 * MP + tok) * 8 + h], a1 = ML[((size_t)1 * MP + tok) * 8 + h], a2 = ML[((size_t)2 * MP + tok) * 8 + h];
        const float mx = fmaxf(a0.x, fmaxf(a1.x, a2.x));
        float w0 = a0.y * __builtin_amdgcn_exp2f(a0.x - mx), w1 = a1.y * __builtin_amdgcn_exp2f(a1.x - mx), w2 = a2.y * __builtin_amdgcn_exp2f(a2.x - mx);
        const float iw = 1.f / (w0 + w1 + w2); w0 *= iw; w1 *= iw; w2 *= iw;
        const v4u x0 = *(const v4u*)(OPART + ((size_t)0 * MP + tok) * 512 + h * 64 + 8 * c);
        const v4u x1 = *(const v4u*)(OPART + ((size_t)1 * MP + tok) * 512 + h * 64 + 8 * c);
        const v4u x2 = *(const v4u*)(OPART + ((size_t)2 * MP + tok) * 512 + h * 64 + 8 * c);
        v4u o;
        o.x = cvtpk(w0 * bf_lo(x0.x) + w1 * bf_lo(x1.x) + w2 * bf_lo(x2.x), w0 * bf_hi(x0.x) + w1 * bf_hi(x1.x) + w2 * bf_hi(x2.x));
        o.y = cvtpk(w0 * bf_lo(x0.y) + w1 * bf_lo(x1.y) + w2 * bf_lo(x2.y), w0 * bf_hi(x0.y) + w1 * bf_hi(x1.y) + w2 * bf_hi(x2.y));
        o.z = cvtpk(w0 * bf_lo(x0.z) + w1 * bf_lo(x1.z) + w2 * bf_lo(x2.z), w0 * bf_hi(x0.z) + w1 * bf_hi(x1.z) + w2 * bf_hi(x2.z));
        o.w = cvtpk(w0 * bf_lo(x0.w) + w1 * bf_lo(x1.w) + w2 * bf_lo(x2.w), w0 * bf_hi(x0.w) + w1 * bf_hi(x1.w) + w2 * bf_hi(x2.w));
        *(v4u*)(MIX + (size_t)tok * D + h * 64 + 8 * c) = o;
    }
}
__device__ __forceinline__ void ret_out_mfma_phase(LAS unsigned char* lds, const bf16* QKVb, const bf16* SPT, const float* gnw, bf16* MIX, int tid, int wave, int lane) {
    constexpr int RSV = 272;
    const int grp = wave >> 2, itile = wave & 3;
    LAS unsigned char* vb = lds + grp * (128 * RSV);
    const int i = lane & 31, hh = lane >> 5, i16 = lane & 15, tq = i16 >> 2, tp = i16 & 3, blk = (lane >> 4) & 1;
    for (int it = blockIdx.x; it < 256; it += gridDim.x) {
        const int item = it * 2 + grp, n = item >> 2, h = item & 3;
        const float lg2 = log_g(h) * 1.4426950408889634f;
        {
            const int t4 = tid & 255;
#pragma unroll
            for (int c = 0; c < 8; ++c) { const int e = t4 + 256 * c, rowk = e >> 4, ch = e & 15;
                *(LAS v4u*)(vb + rowk * RSV + 16 * ch) = *(const v4u*)(QKVb + (size_t)(n * 128 + rowk) * INW + C_VR + h * 128 + 8 * ch); }
        }
        __syncthreads();
        const int row_i = n * 128 + 32 * itile + i;
        bf16x8 qf[4];
#pragma unroll
        for (int ks = 0; ks < 4; ++ks) qf[ks] = *(const bf16x8*)(QKVb + (size_t)row_i * INW + C_QR + h * 64 + 16 * ks + 8 * hh);
        f32x16 acc[4];
#pragma unroll
        for (int dt = 0; dt < 4; ++dt) {
#pragma unroll
            for (int e = 0; e < 16; ++e) acc[dt][e] = 0.f;
#pragma unroll
            for (int ks = 0; ks < 4; ++ks) { const bf16x8 a = *(const bf16x8*)(SPT + ((size_t)(n * 4 + h) * 128 + 32 * dt + i) * 64 + 16 * ks + 8 * hh); acc[dt] = MFMA32(a, qf[ks], acc[dt]); }
        }
        const float wh = __builtin_amdgcn_exp2f((float)(32 * itile + i + 1) * lg2);
#pragma unroll
        for (int dt = 0; dt < 4; ++dt)
#pragma unroll
            for (int e = 0; e < 16; ++e) acc[dt][e] *= wh;
        for (int jt = 0; jt <= itile; ++jt) {
            bf16x8 kf[4];
#pragma unroll
            for (int ks = 0; ks < 4; ++ks) kf[ks] = *(const bf16x8*)(QKVb + (size_t)(n * 128 + 32 * jt + i) * INW + C_KR + h * 64 + 16 * ks + 8 * hh);
            f32x16 s;
#pragma unroll
            for (int e = 0; e < 16; ++e) s[e] = 0.f;
#pragma unroll
            for (int ks = 0; ks < 4; ++ks) s = MFMA32(kf[ks], qf[ks], s);
#pragma unroll
            for (int e = 0; e < 16; ++e) { const int dl = 32 * (itile - jt) + i - crow(e, hh); s[e] = dl >= 0 ? s[e] * __builtin_amdgcn_exp2f((float)dl * lg2) : 0.f; }
            v4u pw0, pw1;
            pw0.x = cvtpk(s[0], s[1]); pw0.y = cvtpk(s[2], s[3]); pw0.z = cvtpk(s[4], s[5]); pw0.w = cvtpk(s[6], s[7]);
            pw1.x = cvtpk(s[8], s[9]); pw1.y = cvtpk(s[10], s[11]); pw1.z = cvtpk(s[12], s[13]); pw1.w = cvtpk(s[14], s[15]);
            const bf16x8 pf0 = __builtin_bit_cast(bf16x8, pw0), pf1 = __builtin_bit_cast(bf16x8, pw1);
#pragma unroll
            for (int st = 0; st < 2; ++st) {
                const LAS unsigned char* a0 = vb + (32 * jt + 16 * st + 4 * hh + tq) * RSV + (16 * blk + 4 * tp) * 2;
#pragma unroll
                for (int dt = 0; dt < 4; ++dt) {
                    const s16x4 lo = vtr(a0 + 64 * dt), hi = vtr(a0 + 8 * RSV + 64 * dt);
                    const bf16x8 vf = __builtin_shufflevector(lo, hi, 0, 1, 2, 3, 4, 5, 6, 7);
                    acc[dt] = MFMA32(vf, st == 0 ? pf0 : pf1, acc[dt]);
                }
            }
        }
        float s1 = 0.f;
#pragma unroll
        for (int dt = 0; dt < 4; ++dt)
#pragma unroll
            for (int e = 0; e < 16; ++e) s1 += acc[dt][e];
        s1 += __shfl_xor(s1, 32);
        const float mu = s1 * (1.f / 128.f);
        float s2 = 0.f;
#pragma unroll
        for (int dt = 0; dt < 4; ++dt)
#pragma unroll
            for (int e = 0; e < 16; ++e) { const float dd = acc[dt][e] - mu; s2 += dd * dd; }
        s2 += __shfl_xor(s2, 32);
        const float rstd = 1.f / sqrtf(s2 * (1.f / 128.f) + EPS);
#pragma unroll
        for (int dt = 0; dt < 4; ++dt)
#pragma unroll
            for (int g = 0; g < 4; ++g) {
                const int dv0 = 32 * dt + 8 * g + 4 * hh;
                const uint2 gr = *(const uint2*)(QKVb + (size_t)row_i * INW + C_GR + h * 128 + dv0);
                const float4 gw4 = *(const float4*)(gnw + h * 128 + dv0);
                const float y0 = (acc[dt][4 * g] - mu) * rstd * gw4.x * silu_f(bf_lo(gr.x)), y1 = (acc[dt][4 * g + 1] - mu) * rstd * gw4.y * silu_f(bf_hi(gr.x));
                const float y2 = (acc[dt][4 * g + 2] - mu) * rstd * gw4.z * silu_f(bf_lo(gr.y)), y3 = (acc[dt][4 * g + 3] - mu) * rstd * gw4.w * silu_f(bf_hi(gr.y));
                *(uint2*)(MIX + (size_t)row_i * D + 512 + h * 128 + dv0) = make_uint2(cvtpk(y0, y1), cvtpk(y2, y3));
            }
        __syncthreads();
    }
}
template <int CTRL> __device__ __forceinline__ float dppf(float x) { return __builtin_bit_cast(float, __builtin_amdgcn_mov_dpp(__builtin_bit_cast(int, x), CTRL, 0xf, 0xf, true)); }
__device__ __forceinline__ float row16_sum(float v) { v += dppf<0xB1>(v); v += dppf<0x4E>(v); v += dppf<0x141>(v); v += dppf<0x128>(v); return v; }
constexpr int SA_CH = 15, SA_KPC = 60;
__device__ __forceinline__ void sa_rows(int kk, int b, const float* ck, const float* cv, const float* out, const float*& kr, const float*& vr, int& e) {
    e = kk < 516 ? kk : 528 + 16 * ((kk - 516) >> 2) + ((kk - 516) & 3);
    const int idx = 2051 - e;
    if (idx >= WB) { kr = out + O_KS + (size_t)(b * 4 + idx - WB) * 512; vr = out + O_VS + (size_t)(b * 4 + idx - WB) * 512; }
    else { kr = ck + ((size_t)b * WB + idx) * 512; vr = cv + ((size_t)b * WB + idx) * 512; }
}
__device__ __forceinline__ void attn_sample_phase(const bf16* QKVb, const float* ck, const float* cv, const float* out, float* SPART, float2* SML, int gw, int NGW, int lane) {
    const int l16 = lane & 15, hq = lane >> 4;
    for (int item = gw; item < DBATCH * SA_CH; item += NGW) {
        const int b = item / SA_CH, c = item % SA_CH;
        f32x4 q[4][2], o[4][2]; float m[4][2], l[4][2];
#pragma unroll
        for (int i = 0; i < 4; ++i)
#pragma unroll
            for (int u = 0; u < 2; ++u) {
                { const uint2 qq = *(const uint2*)(QKVb + (size_t)(MP + b * 4 + i) * INW + C_QA + (4 * u + hq) * 64 + 4 * l16); q[i][u] = (f32x4){bf_lo(qq.x), bf_hi(qq.x), bf_lo(qq.y), bf_hi(qq.y)}; }
                o[i][u] = (f32x4){0.f, 0.f, 0.f, 0.f}; m[i][u] = -1e30f; l[i][u] = 0.f;
            }
        for (int g = 0; g < SA_KPC / 4; ++g) {
            f32x4 kx[4][2], vx[4][2]; int ee[4];
#pragma unroll
            for (int t = 0; t < 4; ++t) {
                const float *kr, *vr; sa_rows(c * SA_KPC + g * 4 + t, b, ck, cv, out, kr, vr, ee[t]);
                kx[t][0] = __builtin_nontemporal_load((const f32x4*)(kr + 4 * lane)); kx[t][1] = __builtin_nontemporal_load((const f32x4*)(kr + 256 + 4 * lane));
                vx[t][0] = __builtin_nontemporal_load((const f32x4*)(vr + 4 * lane)); vx[t][1] = __builtin_nontemporal_load((const f32x4*)(vr + 256 + 4 * lane));
            }
#pragma unroll
            for (int t = 0; t < 4; ++t)
#pragma unroll
                for (int i = 0; i < 4; ++i) {
                    const int dl = ee[t] - 3 + i;
                    const int mult = dl >= 0 ? (int)(dl <= 128) + (int)(((dl & 3) == 0) && dl <= 512) + (int)(((dl & 15) == 0) && dl <= 2048) : 0;
                    if (mult) {
                        const float fm = (float)mult;
#pragma unroll
                        for (int u = 0; u < 2; ++u) {
                            const f32x4 pr = q[i][u] * kx[t][u];
                            const float s = row16_sum((pr[0] + pr[1]) + (pr[2] + pr[3]));
                            const float mn = fmaxf(m[i][u], s), scl = __builtin_amdgcn_exp2f(m[i][u] - mn), p = fm * __builtin_amdgcn_exp2f(s - mn);
                            m[i][u] = mn; l[i][u] = l[i][u] * scl + p; o[i][u] = o[i][u] * scl + vx[t][u] * p;
                        }
                    }
                }
        }
#pragma unroll
        for (int i = 0; i < 4; ++i)
#pragma unroll
            for (int u = 0; u < 2; ++u) {
                const size_t base = ((size_t)(b * SA_CH + c) * 4 + i) * 8 + 4 * u + hq;
                *(f32x4*)(SPART + base * 64 + 4 * l16) = o[i][u];
                if (l16 == 0) SML[base] = make_float2(m[i][u], l[i][u]);
            }
    }
}
__device__ __forceinline__ void attn_sample_merge_phase(const float* SPART, const float2* SML, bf16* MIX, int gw, int NGW, int lane) {
    for (int item = gw; item < DBATCH * 32; item += NGW) {
        const int b = item >> 5, i = (item >> 3) & 3, h = item & 7;
        float2 ml[SA_CH]; float mx = -1e30f;
#pragma unroll
        for (int c = 0; c < SA_CH; ++c) { ml[c] = SML[((size_t)(b * SA_CH + c) * 4 + i) * 8 + h]; mx = fmaxf(mx, ml[c].x); }
        float acc = 0.f, L = 0.f;
#pragma unroll
        for (int c = 0; c < SA_CH; ++c) { const float w = __builtin_amdgcn_exp2f(ml[c].x - mx); L += w * ml[c].y; acc += w * SPART[(((size_t)(b * SA_CH + c) * 4 + i) * 8 + h) * 64 + lane]; }
        MIX[(size_t)(MP + b * 4 + i) * D + h * 64 + lane] = (bf16)f2bf(acc / L);
    }
}
__device__ __forceinline__ void ret_upd_phase(LAS unsigned char* lds, const bf16* __restrict__ QKVb, float* __restrict__ UPD, int tid, int wave, int lane) {
    constexpr int RSV = 272, RSK = 144, GRP = 128 * RSV + 128 * RSK;
    const int grp = wave >> 2, dt = wave & 3;
    LAS unsigned char* vb = lds + grp * GRP;
    LAS unsigned char* kb = vb + 128 * RSV;
    const int i = lane & 31, hh = lane >> 5, i16 = lane & 15, tq = i16 >> 2, tp = i16 & 3, blk = (lane >> 4) & 1;
    for (int it = blockIdx.x; it < 256; it += gridDim.x) {
        const int item = it * 2 + grp, n = item >> 2, h = item & 3;
        const float lg2 = log_g(h) * 1.4426950408889634f;
        const int t4 = tid & 255;
#pragma unroll
        for (int c = 0; c < 8; ++c) { const int e = t4 + 256 * c, rowk = e >> 4, ch = e & 15;
            *(LAS v4u*)(vb + rowk * RSV + 16 * ch) = *(const v4u*)(QKVb + (size_t)(n * 128 + rowk) * INW + C_VR + h * 128 + 8 * ch); }
#pragma unroll
        for (int c = 0; c < 4; ++c) { const int e = t4 + 256 * c, rowk = e >> 3, ch = e & 7;
            const v4u x = *(const v4u*)(QKVb + (size_t)(n * 128 + rowk) * INW + C_KR + h * 64 + 8 * ch);
            const float w = __builtin_amdgcn_exp2f((float)(127 - rowk) * lg2);
            v4u y; y.x = cvtpk(bf_lo(x.x) * w, bf_hi(x.x) * w); y.y = cvtpk(bf_lo(x.y) * w, bf_hi(x.y) * w); y.z = cvtpk(bf_lo(x.z) * w, bf_hi(x.z) * w); y.w = cvtpk(bf_lo(x.w) * w, bf_hi(x.w) * w);
            *(LAS v4u*)(kb + rowk * RSK + 16 * ch) = y; }
        __syncthreads();
        f32x16 a0, a1;
#pragma unroll
        for (int e = 0; e < 16; ++e) { a0[e] = 0.f; a1[e] = 0.f; }
#pragma unroll
        for (int ks = 0; ks < 8; ++ks) {
            const LAS unsigned char* va = vb + (16 * ks + 8 * hh + tq) * RSV + (32 * dt + 16 * blk + 4 * tp) * 2;
            const LAS unsigned char* ka = kb + (16 * ks + 8 * hh + tq) * RSK + (16 * blk + 4 * tp) * 2;
            const s16x4 vlo = vtr(va), vhi = vtr(va + 4 * RSV), k0lo = vtr(ka), k0hi = vtr(ka + 4 * RSK), k1lo = vtr(ka + 64), k1hi = vtr(ka + 4 * RSK + 64);
            const bf16x8 vf = __builtin_shufflevector(vlo, vhi, 0, 1, 2, 3, 4, 5, 6, 7);
            a0 = MFMA32(vf, __builtin_shufflevector(k0lo, k0hi, 0, 1, 2, 3, 4, 5, 6, 7), a0);
            a1 = MFMA32(vf, __builtin_shufflevector(k1lo, k1hi, 0, 1, 2, 3, 4, 5, 6, 7), a1);
        }
        float* up = UPD + ((size_t)(n * 4 + h) * 128 + 32 * dt) * 64 + i;
#pragma unroll
        for (int e = 0; e < 16; ++e) { const int dv = crow(e, hh); up[dv * 64] = a0[e]; up[dv * 64 + 32] = a1[e]; }
        __syncthreads();
    }
}
__device__ __forceinline__ void ret_scan_phase(const float* __restrict__ UPDT, bf16* __restrict__ SPT, float* __restrict__ out, int tid) {
    const int e = blockIdx.x * NTHR + tid;
    if (e < 32768) {
        const int h = e >> 13, dv = (e >> 6) & 127, dk = e & 63;
        const float G = expf(128.f * log_g(h));
        float S = 0.f;
#pragma unroll 1
        for (int n0 = 0; n0 < 128; n0 += 32) {
            float u[32];
#pragma unroll
            for (int k = 0; k < 32; ++k) u[k] = UPDT[(size_t)(n0 + k) * 32768 + e];
#pragma unroll
            for (int k = 0; k < 32; ++k) { SPT[(size_t)(n0 + k) * 32768 + e] = (bf16)f2bf(S); S = G * S + u[k]; }
        }
        out[O_SP + h * 8192 + dk * 128 + dv] = S;
    }
}
__device__ __forceinline__ void ret_sample_phase(LAS unsigned char* lds, const bf16* __restrict__ QKVb, const float* __restrict__ state, const float* __restrict__ gnw, bf16* __restrict__ MIX, float* __restrict__ out, int tid) {
    const int grp = tid >> 7, t = tid & 127, dv = t;
    LAS float* qs = (LAS float*)(lds + grp * 4096);
    LAS float* ks = qs + 256;
    LAS float* red = ks + 256;
    for (int it = blockIdx.x; it < 128; it += gridDim.x) {
        const int sub = it * 4 + grp, b = sub >> 2, h = sub & 3;
        const float g = 1.f - exp2f(-5.f - (float)h);
        const float g2 = g * g, g3 = g2 * g, g4 = g2 * g2;
        const int row0 = MP + b * 4;
        const float* s0p = state + (size_t)(b * 4 + h) * 64 * 128 + dv;
        float* snp = out + O_SS + (size_t)(b * 4 + h) * 64 * 128 + dv;
        for (int e = t; e < 256; e += 128) { const int i = e >> 6, dk = e & 63;
            qs[e] = bf_lo((unsigned)QKVb[(size_t)(row0 + i) * INW + C_QR + h * 64 + dk]); ks[e] = bf_lo((unsigned)QKVb[(size_t)(row0 + i) * INW + C_KR + h * 64 + dk]); }
        float v[4];
#pragma unroll
        for (int i = 0; i < 4; ++i) v[i] = bf_lo((unsigned)QKVb[(size_t)(row0 + i) * INW + C_VR + h * 128 + dv]);
        __syncthreads();
        float c0 = 0.f, c1 = 0.f, c2 = 0.f, c3 = 0.f;
#pragma unroll 1
        for (int d0 = 0; d0 < 64; d0 += 16) {
            float s0v[16];
#pragma unroll
            for (int dk = 0; dk < 16; ++dk) s0v[dk] = __builtin_nontemporal_load(s0p + (d0 + dk) * 128);
#pragma unroll
            for (int dk = 0; dk < 16; ++dk) {
                const float s0 = s0v[dk]; const int kk = d0 + dk;
                c0 += qs[kk] * s0; c1 += qs[64 + kk] * s0; c2 += qs[128 + kk] * s0; c3 += qs[192 + kk] * s0;
                __builtin_nontemporal_store(g4 * s0 + g3 * ks[kk] * v[0] + g2 * ks[64 + kk] * v[1] + g * ks[128 + kk] * v[2] + ks[192 + kk] * v[3], snp + kk * 128);
            }
        }
        float d00 = 0.f, d10 = 0.f, d11 = 0.f, d20 = 0.f, d21 = 0.f, d22 = 0.f, d30 = 0.f, d31 = 0.f, d32 = 0.f, d33 = 0.f;
        for (int dk = 0; dk < 64; ++dk) {
            const float q0 = qs[dk], q1 = qs[64 + dk], q2 = qs[128 + dk], q3 = qs[192 + dk];
            const float k0 = ks[dk], k1 = ks[64 + dk], k2 = ks[128 + dk], k3 = ks[192 + dk];
            d00 += q0 * k0; d10 += q1 * k0; d11 += q1 * k1; d20 += q2 * k0; d21 += q2 * k1; d22 += q2 * k2;
            d30 += q3 * k0; d31 += q3 * k1; d32 += q3 * k2; d33 += q3 * k3;
        }
        float o[4];
        o[0] = g * c0 + d00 * v[0];
        o[1] = g2 * c1 + g * d10 * v[0] + d11 * v[1];
        o[2] = g3 * c2 + g2 * d20 * v[0] + g * d21 * v[1] + d22 * v[2];
        o[3] = g4 * c3 + g3 * d30 * v[0] + g2 * d31 * v[1] + g * d32 * v[2] + d33 * v[3];
#pragma unroll
        for (int i = 0; i < 4; ++i) { const float s1 = wave_sum(o[i]); if ((t & 63) == 0) red[i * 2 + (t >> 6)] = s1; }
        __syncthreads();
        float dl[4];
#pragma unroll
        for (int i = 0; i < 4; ++i) { const float mu = (red[i * 2] + red[i * 2 + 1]) * (1.f / 128.f); dl[i] = o[i] - mu; }
#pragma unroll
        for (int i = 0; i < 4; ++i) { const float s2 = wave_sum(dl[i] * dl[i]); if ((t & 63) == 0) red[8 + i * 2 + (t >> 6)] = s2; }
        __syncthreads();
#pragma unroll
        for (int i = 0; i < 4; ++i) {
            const float var = (red[8 + i * 2] + red[8 + i * 2 + 1]) * (1.f / 128.f);
            const float y = dl[i] / sqrtf(var + EPS) * gnw[h * 128 + dv];
            const float gg = bf_lo((unsigned)QKVb[(size_t)(row0 + i) * INW + C_GR + h * 128 + dv]);
            MIX[(size_t)(row0 + i) * D + 512 + h * 128 + dv] = (bf16)f2bf(silu_f(gg) * y);
        }
        __syncthreads();
    }
}

struct Args { const float* in[20]; float* out; unsigned char* ws; };
__global__ void __launch_bounds__(NTHR, 2) mk_fwd(Args a) {
    extern __shared__ __attribute__((aligned(16))) unsigned char lds_raw[];
    LAS unsigned char* lds = (LAS unsigned char*)lds_raw;
    volatile LAS unsigned* MISC = (volatile LAS unsigned*)(lds + MISC_OFF);
    const int tid = threadIdx.x, lane = tid & 63, wave = __builtin_amdgcn_readfirstlane(tid >> 6);
    const int G = gridDim.x;
    const int gw = blockIdx.x * NWAVES + wave, NGW = G * NWAVES, gtid = blockIdx.x * NTHR + tid, NGT = G * NTHR;
    unsigned char* ws = a.ws;
    Ptrs P;
    P.xp = a.in[0]; P.xs = a.in[1]; P.ck = a.in[2]; P.cv = a.in[3]; P.st = a.in[4]; P.g1a = a.in[5]; P.g1b = a.in[6]; P.w1g = a.in[7]; P.w1u = a.in[8]; P.w1d = a.in[9];
    P.gma = a.in[10]; P.gmb = a.in[11]; P.win = a.in[12]; P.gnw = a.in[13]; P.wout = a.in[14]; P.g2a = a.in[15]; P.g2b = a.in[16]; P.w2g = a.in[17]; P.w2u = a.in[18]; P.w2d = a.in[19];
    P.out = a.out;
    P.W1GU = (bf16*)(ws + WS_W1GU); P.W1D = (bf16*)(ws + WS_W1D); P.WIN = (bf16*)(ws + WS_WIN); P.WOUT = (bf16*)(ws + WS_WOUT); P.W2GU = (bf16*)(ws + WS_W2GU); P.W2D = (bf16*)(ws + WS_W2D);
    P.XN = (bf16*)(ws + WS_XN); P.H = (bf16*)(ws + WS_H); P.MIX = (bf16*)(ws + WS_MIX);
    P.TAB = (float2*)(ws + WS_TAB); P.Y = (bf16*)(ws + WS_Y); P.HRES = (bf16*)(ws + WS_HRES); P.QKV = (float*)(ws + WS_QKV); P.UPD = (float*)(ws + WS_UPD); P.SPT = (bf16*)(ws + WS_SPREV); P.QKVb = (bf16*)(ws + WS_QKVB); P.OPART = (bf16*)(ws + WS_OPART); P.ML = (float2*)(ws + WS_ML); P.SPART = (float*)(ws + WS_SPART); P.SML = (float2*)(ws + WS_SML);
    for (int u = tid; u < (LDS_BYTES - LDSCTL_OFF) / 4; u += NTHR) ((LAS unsigned*)(lds + LDSCTL_OFF))[u] = 0u;
    __syncthreads();
    XcdBarrier bar = xcd_barrier_post((unsigned*)(ws + WS_CTL) + CW_BAR, MISC + 8);

    p0_prologue(P, lds, gw, NGW, wave, lane, gtid, NGT);
    xcd_barrier(bar);
    { pg8::Gemm g{P.XN, P.W1GU, M, 2 * DFF, D}; pg8::StaticOrder S; S.init(M, 2 * DFF, G, (int)blockIdx.x); pg8::EpiSwiglu E{P.H, DFF};
      pg8::gemm_phase<pg8::EpiSwiglu, pg8::StaticOrder, true, true>(lds, g, S, E); }
    {
        constexpr int NU1 = (M / 256) * (2 * DFF / 256);
        const int rounds = (NU1 + G - 1) / G, idle0 = NU1 - (rounds - 1) * G;
        if (idle0 >= G) p0_deferred(P, lds, gw, NGW, wave, lane);
        else if ((int)blockIdx.x >= idle0) p0_deferred(P, lds, ((int)blockIdx.x - idle0) * NWAVES + wave, (G - idle0) * NWAVES, wave, lane);
    }
    xcd_barrier(bar);
    { pg8::Gemm g{P.H, P.W1D, MP, D, DFF}; pg8::StaticOrder S; S.init(MP, D, G, (int)blockIdx.x); pg8::EpiYb E{P.Y, D};
      pg8::gemm_phase<pg8::EpiYb, pg8::StaticOrder, true, true>(lds, g, S, E); }
    sk_gemm_y(lds, P.H, DFF, P.W1D, DFF, P.Y, tid, wave, lane);
    xcd_barrier(bar);
    norm_res_phase<true, false>(P.xp, P.xs, nullptr, P.Y, P.g1b, 0.5f, P.HRES, nullptr, P.gma, P.XN, gw, NGW, lane);
    xcd_barrier(bar);
    { pg8::Gemm g{P.XN, P.WIN, MP, INW, D}; pg8::StaticOrder S; S.init(MP, INW, G, (int)blockIdx.x);
      pg8::EpiQKV E{P.QKVb, P.TAB, P.out + O_KP, P.out + O_VP, QSCALE, MP - KEEP};
      pg8::gemm_phase<pg8::EpiQKV, pg8::StaticOrder, true, true>(lds, g, S, E); }
    sk_gemm_qkv(lds, P.XN, P.WIN, P.QKVb, P.TAB, P.out, tid, wave, lane);
    xcd_barrier(bar);
    ret_upd_phase(lds, P.QKVb, P.UPD, tid, wave, lane);
    ret_sample_phase(lds, P.QKVb, P.st, P.gnw, P.MIX, P.out, tid);
    attn_mfma_phase(lds, P.QKVb, P.OPART, P.ML, tid, wave, lane);
    attn_sample_phase(P.QKVb, P.ck, P.cv, P.out, P.SPART, P.SML, gw, NGW, lane);
    xcd_barrier(bar);
    ret_scan_phase(P.UPD, P.SPT, P.out, tid);
    attn_combine_phase(P.OPART, P.ML, P.MIX, gtid, NGT);
    attn_sample_merge_phase(P.SPART, P.SML, P.MIX, gw, NGW, lane);
    xcd_barrier(bar);
    ret_out_mfma_phase(lds, P.QKVb, P.SPT, P.gnw, P.MIX, tid, wave, lane);
    xcd_barrier(bar);
    { pg8::Gemm g{P.MIX, P.WOUT, MP, D, D}; pg8::StaticOrder S; S.init(MP, D, G, (int)blockIdx.x); pg8::EpiYb E{P.Y, D};
      pg8::gemm_phase<pg8::EpiYb, pg8::StaticOrder, true, true>(lds, g, S, E); }
    sk_gemm_y(lds, P.MIX, D, P.WOUT, D, P.Y, tid, wave, lane);
    xcd_barrier(bar);
    norm_res_phase<false, false>(nullptr, nullptr, P.HRES, P.Y, P.gmb, 1.0f, P.HRES, nullptr, P.g2a, P.XN, gw, NGW, lane);
    xcd_barrier(bar);
    { pg8::Gemm g{P.XN, P.W2GU, M, 2 * DFF, D}; pg8::StaticOrder S; S.init(M, 2 * DFF, G, (int)blockIdx.x); pg8::EpiSwiglu E{P.H, DFF};
      pg8::gemm_phase<pg8::EpiSwiglu, pg8::StaticOrder, true, true>(lds, g, S, E); }
    xcd_barrier(bar);
    { pg8::Gemm g{P.H, P.W2D, MP, D, DFF}; pg8::StaticOrder S; S.init(MP, D, G, (int)blockIdx.x); pg8::EpiYb E{P.Y, D};
      pg8::gemm_phase<pg8::EpiYb, pg8::StaticOrder, true, true>(lds, g, S, E); }
    sk_gemm_y(lds, P.H, DFF, P.W2D, DFF, P.Y, tid, wave, lane);
    xcd_barrier(bar);
    norm_res_phase<false, true>(nullptr, nullptr, P.HRES, P.Y, P.g2b, 0.5f, nullptr, P.out + O_Y, nullptr, nullptr, gw, NGW, lane);
}

extern "C" void kernel_launch(void* const* d_in, const int* in_sizes, int n_in, void* d_out, int out_size, void* d_ws, size_t ws_size, hipStream_t stream) {
    static int grid = 0;
    if (grid == 0) {
        if (n_in != 20 || (size_t)out_size != O_END || ws_size < WS_END) { fprintf(stderr, "kernel_launch: unexpected sizes (n_in %d out %d ws %zu)\n", n_in, out_size, ws_size); grid = -1; return; }
        int dev = 0, cus = 0;
        if (hipGetDevice(&dev) != hipSuccess || hipDeviceGetAttribute(&cus, hipDeviceAttributeMultiprocessorCount, dev) != hipSuccess) { grid = -1; return; }
        if (hipFuncSetAttribute((const void*)mk_fwd, hipFuncAttributeMaxDynamicSharedMemorySize, LDS_BYTES) != hipSuccess) { fprintf(stderr, "kernel_launch: hipFuncSetAttribute failed\n"); grid = -1; return; }
        int per_cu = 0;
        if (hipOccupancyMaxActiveBlocksPerMultiprocessor(&per_cu, (const void*)mk_fwd, NTHR, LDS_BYTES) != hipSuccess || per_cu < 1) fprintf(stderr, "kernel_launch: occupancy query says %d\n", per_cu);
        (void)hipGetLastError();
        grid = cus;
    }
    if (grid < 0) return;
    (void)hipMemsetAsync((char*)d_ws + WS_CTL, 0, CTL_ZERO_BYTES, stream);
    Args a{};
    for (int i = 0; i < 20; ++i) a.in[i] = (const float*)d_in[i];
    a.out = (float*)d_out; a.ws = (unsigned char*)d_ws;
    hipLaunchKernelGGL(mk_fwd, dim3(grid), dim3(NTHR), LDS_BYTES, stream, a);
}
```

```cpp
#include <hip/hip_runtime.h>
#include <cstdio>
#include <cstdint>
namespace pg8 {
#define PG8_LAS __attribute__((address_space(3)))
typedef unsigned short bf16_t;
typedef short bf16x8 __attribute__((ext_vector_type(8)));
typedef float f32x4 __attribute__((ext_vector_type(4)));
typedef unsigned u32x4 __attribute__((ext_vector_type(4)));
constexpr int BM = 256, BK = 64, HALF = 128, HTB = HALF * BK * 2  , STAGE_BYTES = 8 * HTB, NXCD = 8, WGM = 8;

__host__ __device__ __forceinline__ int lds_byte(int r, int c) { const int st = (r >> 4) * 2 + (c >> 5), rr = r & 15, cc = c & 31, ob = rr * 64 + cc * 2; return st * 1024 + (ob ^ (((ob >> 9) & 1) << 5)); }
__host__ __device__ __forceinline__ void stage_rc(int b, int& R, int& C) { const int st = b / 1024, sb = b % 1024, swz = sb ^ (((sb >> 9) & 1) << 5); R = (st >> 1) * 16 + swz / 64; C = (st & 1) * 32 + (swz % 64) / 2; }
__host__ __device__ __forceinline__ int perm32(int rho) { const int n = rho >> 4, i = rho & 15; return 8 * (i >> 2) + 4 * n + (i & 3); }

struct Unit { int pm, pn; };
struct Gemm { const bf16_t* A; const bf16_t* Bt; int M, N, K; };

struct StaticOrder {
    int nM, nN, nwg, G, c;
    __host__ __device__ void init(int M, int N, int G_, int c_) { nM = M / BM; nN = N / BM; nwg = nM * nN; G = G_; c = c_; }
    __host__ __device__ bool next(int i, Unit& u) const {
        const long L = (long)i * G + c; if (L >= nwg) return false;
        int wgid = (int)L; { const int q = nwg / NXCD, r = nwg % NXCD, xcd = wgid % NXCD, off = wgid / NXCD; wgid = (xcd < r ? xcd * (q + 1) : r * (q + 1) + (xcd - r) * q) + off; }
        const int nig = WGM * nN, gid = wgid / nig, fm = gid * WGM, gsz = (nM - fm) < WGM ? (nM - fm) : WGM;
        u.pm = fm + ((wgid % nig) % gsz); u.pn = (wgid % nig) / gsz; return true;
    }
    __device__ __forceinline__ void a_ready(const Unit&) const {}
    __device__ __forceinline__ void done(const Unit&) const {}
};

__device__ __forceinline__ unsigned cvt_pk_bf16(float lo, float hi) { unsigned r; asm volatile("v_cvt_pk_bf16_f32 %0, %1, %2" : "=v"(r) : "v"(lo), "v"(hi)); return r; }
typedef float f32x2 __attribute__((ext_vector_type(2)));
typedef unsigned u32x2 __attribute__((ext_vector_type(2)));
struct EpiQKV {
    static constexpr bool PERM = true, AFTER_DRAIN = false;
    bf16_t* QKVb; const float2* tab; float* okp; float* ovp; float qscale; int keep0;
    __device__ __forceinline__ void operator()(const f32x4 (&acc)[2][2][4][2], const Unit& u, int wr, int wc, int fr, int fq) const {
        const int pn = u.pn, g8 = (wc & 1) * 4 + fq;
#pragma unroll
        for (int ai = 0; ai < 2; ++ai)
#pragma unroll
            for (int m = 0; m < 4; ++m) {
                const int row = u.pm * BM + ai * HALF + wr * 64 + m * 16 + fr;
                bf16_t* rb = QKVb + (size_t)row * 3072;
#pragma unroll
                for (int bj = 0; bj < 2; ++bj) {
                    const int hb = pn * BM + bj * HALF + (wc >> 1) * 64;
                    const f32x4 v0 = acc[ai][bj][m][0], v1 = acc[ai][bj][m][1];
                    if (pn < 4 && g8 < 2) {
                        const float2* t = tab + (size_t)row * 40 + 4 * g8;
                        const float2 c0 = t[0], c1 = t[1], c2 = t[2], c3 = t[3];
                        const f32x4 y1 = {v0[0] * c0.x - v1[0] * c0.y, v0[1] * c1.x - v1[1] * c1.y, v0[2] * c2.x - v1[2] * c2.y, v0[3] * c3.x - v1[3] * c3.y};
                        const f32x4 y2 = {v1[0] * c0.x + v0[0] * c0.y, v1[1] * c1.x + v0[1] * c1.y, v1[2] * c2.x + v0[2] * c2.y, v1[3] * c3.x + v0[3] * c3.y};
                        const float sc = pn < 2 ? qscale : 1.f;
                        u32x2 w1, w2; w1.x = cvt_pk_bf16(y1[0] * sc, y1[1] * sc); w1.y = cvt_pk_bf16(y1[2] * sc, y1[3] * sc); w2.x = cvt_pk_bf16(y2[0] * sc, y2[1] * sc); w2.y = cvt_pk_bf16(y2[2] * sc, y2[3] * sc);
                        *(u32x2*)(rb + hb + 4 * g8) = w1; *(u32x2*)(rb + hb + 4 * g8 + 8) = w2;
                        if (pn >= 2 && row >= keep0) { float* o = okp + (size_t)(row - keep0) * 512 + (hb - 512) + 4 * g8; *(f32x4*)o = y1; *(f32x4*)(o + 8) = y2; }
                    } else if (pn == 6 || pn == 7) {
                        const float2* t = tab + (size_t)row * 40 + 8 + 4 * g8;
                        const float2 c0 = t[0], c1 = t[1], c2 = t[2], c3 = t[3];
                        const float sc = pn == 7 ? 0.125f : 1.f;
                        const f32x4 y1 = {(v0[0] * c0.x - v1[0] * c0.y) * sc, (v0[1] * c1.x - v1[1] * c1.y) * sc, (v0[2] * c2.x - v1[2] * c2.y) * sc, (v0[3] * c3.x - v1[3] * c3.y) * sc};
                        const f32x4 y2 = {(v1[0] * c0.x + v0[0] * c0.y) * sc, (v1[1] * c1.x + v0[1] * c1.y) * sc, (v1[2] * c2.x + v0[2] * c2.y) * sc, (v1[3] * c3.x + v0[3] * c3.y) * sc};
                        u32x2 w1, w2; w1.x = cvt_pk_bf16(y1[0], y1[1]); w1.y = cvt_pk_bf16(y1[2], y1[3]); w2.x = cvt_pk_bf16(y2[0], y2[1]); w2.y = cvt_pk_bf16(y2[2], y2[3]);
                        *(u32x2*)(rb + hb + 4 * g8) = w1; *(u32x2*)(rb + hb + 32 + 4 * g8) = w2;
                    } else {
                        const int col = pn * BM + bj * HALF + wc * 32 + 8 * fq;
                        const float sc = pn < 2 ? qscale : 1.f;
                        u32x4 w; w.x = cvt_pk_bf16(v0[0] * sc, v0[1] * sc); w.y = cvt_pk_bf16(v0[2] * sc, v0[3] * sc); w.z = cvt_pk_bf16(v1[0] * sc, v1[1] * sc); w.w = cvt_pk_bf16(v1[2] * sc, v1[3] * sc);
                        *(u32x4*)(rb + col) = w;
                        if (row >= keep0 && pn >= 2 && pn < 6) { float* o = (pn < 4 ? okp + (size_t)(row - keep0) * 512 + (col - 512) : ovp + (size_t)(row - keep0) * 512 + (col - 1024)); *(f32x4*)o = v0; *(f32x4*)(o + 4) = v1; }
                    }
                }
            }
    }
};
struct EpiYb {
    static constexpr bool PERM = true, AFTER_DRAIN = false;
    bf16_t* O; int ldc;
    __device__ __forceinline__ void operator()(const f32x4 (&acc)[2][2][4][2], const Unit& u, int wr, int wc, int fr, int fq) const {
        const int row0 = u.pm * BM + wr * 64 + fr, col0 = u.pn * BM + wc * 32 + 8 * fq;
#pragma unroll
        for (int ai = 0; ai < 2; ++ai)
#pragma unroll
            for (int m = 0; m < 4; ++m) {
                bf16_t* rowp = O + (size_t)(row0 + ai * HALF + m * 16) * ldc + col0;
#pragma unroll
                for (int bj = 0; bj < 2; ++bj) { const f32x4 v0 = acc[ai][bj][m][0], v1 = acc[ai][bj][m][1];
                    u32x4 w; w.x = cvt_pk_bf16(v0[0], v0[1]); w.y = cvt_pk_bf16(v0[2], v0[3]); w.z = cvt_pk_bf16(v1[0], v1[1]); w.w = cvt_pk_bf16(v1[2], v1[3]);
                    *(u32x4*)(rowp + bj * HALF) = w; }
            }
    }
};
__device__ __forceinline__ float silu_fast(float x) { return x * __builtin_amdgcn_rcpf(1.0f + __builtin_amdgcn_exp2f(-1.4426950408889634f * x)); }
struct EpiSwiglu {
    static constexpr bool PERM = true, AFTER_DRAIN = false;
    bf16_t* O; int ldc;
    __device__ __forceinline__ void operator()(const f32x4 (&acc)[2][2][4][2], const Unit& u, int wr, int wc, int fr, int fq) const {
        const int row0 = u.pm * BM + wr * 64 + fr, col0 = u.pn * HALF + wc * 32 + 8 * fq;
#pragma unroll
        for (int ai = 0; ai < 2; ++ai)
#pragma unroll
            for (int m = 0; m < 4; ++m) {
                bf16_t* rowp = O + (size_t)(row0 + ai * HALF + m * 16) * ldc + col0;
                const f32x4 g0 = acc[ai][0][m][0], g1 = acc[ai][0][m][1], u0 = acc[ai][1][m][0], u1 = acc[ai][1][m][1];
                u32x4 w;
                w.x = cvt_pk_bf16(silu_fast(g0[0]) * u0[0], silu_fast(g0[1]) * u0[1]); w.y = cvt_pk_bf16(silu_fast(g0[2]) * u0[2], silu_fast(g0[3]) * u0[3]);
                w.z = cvt_pk_bf16(silu_fast(g1[0]) * u1[0], silu_fast(g1[1]) * u1[1]); w.w = cvt_pk_bf16(silu_fast(g1[2]) * u1[2], silu_fast(g1[3]) * u1[3]);
                *(u32x4*)rowp = w;
            }
    }
};
struct EpiF32 {
    static constexpr bool PERM = false, AFTER_DRAIN = false;
    float* O; int ldc;
    __device__ __forceinline__ void operator()(const f32x4 (&acc)[2][2][4][2], const Unit& u, int wr, int wc, int fr, int fq) const {
        const int row0 = u.pm * BM + wr * 64 + fr, col0 = u.pn * BM + wc * 32 + 4 * fq;
#pragma unroll
        for (int ai = 0; ai < 2; ++ai)
#pragma unroll
            for (int m = 0; m < 4; ++m) {
                float* rowp = O + (size_t)(row0 + ai * HALF + m * 16) * ldc + col0;
#pragma unroll
                for (int bj = 0; bj < 2; ++bj)
#pragma unroll
                    for (int n = 0; n < 2; ++n) *(f32x4*)(rowp + bj * HALF + n * 16) = acc[ai][bj][m][n];
            }
    }
};
template <class Epi, class Sched, bool ALIGN_EPI = false, bool SP2 = false>
__device__ __forceinline__ void gemm_phase(PG8_LAS unsigned char* lds, const Gemm g, const Sched& S, const Epi& E) {
    int tid_ = threadIdx.x; asm volatile("" : "+v"(tid_));
    const int tid = tid_, wid = __builtin_amdgcn_readfirstlane(tid >> 6), lane = tid & 63, wr = wid >> 2, wc = wid & 3, fr = lane & 15, fq = lane >> 4;
    const int K = g.K, nt = K / BK;
    unsigned voffA[2], voffB[2];
#pragma unroll
    for (int i = 0; i < 2; ++i) { int R, C; stage_rc(tid * 16 + i * 8192, R, C); const int Rb = Epi::PERM ? ((R & ~31) + perm32(R & 31)) : R;
        voffA[i] = (unsigned)(R * K + C) * 2u; voffB[i] = (unsigned)(Rb * K + C) * 2u; }
    const size_t kstep = (size_t)(BK * 2);
    const size_t hstep = (size_t)HALF * K * 2;
    const size_t tstep = 2 * hstep;
    const unsigned ldsw = (unsigned)wid * 1024u;
    const int aoff = lds_byte(wr * 64 + fr, fq * 8), boff = lds_byte(wc * 32 + fr, fq * 8);
#define PG8_SA(b, h) (((b) * 2 + (h)) * HTB)
#define PG8_SB(b, h) ((4 + (b) * 2 + (h)) * HTB)
#define PG8_STAGE(bufoff, gbase, voff) do { _Pragma("unroll") for (int _i = 0; _i < 2; ++_i) \
        __builtin_amdgcn_global_load_lds((const unsigned*)((const char*)(gbase) + (voff)[_i]), (PG8_LAS unsigned*)(lds + (bufoff) + ldsw + _i * 8192), 16, 0, 0); } while (0)
#define PG8_LDA(dst, b, h) do { _Pragma("unroll") for (int m = 0; m < 4; ++m) _Pragma("unroll") for (int k = 0; k < 2; ++k) dst[m][k] = *(const PG8_LAS bf16x8*)(lds + PG8_SA(b, h) + aoff + m * 2048 + k * 1024); } while (0)
#define PG8_LDB(dst, b, h) do { _Pragma("unroll") for (int n = 0; n < 2; ++n) _Pragma("unroll") for (int k = 0; k < 2; ++k) dst[n][k] = *(const PG8_LAS bf16x8*)(lds + PG8_SB(b, h) + boff + n * 2048 + k * 1024); } while (0)
#define PG8_MMA(ai, bj, At, Bt) do { __builtin_amdgcn_s_setprio(1); _Pragma("unroll") for (int m = 0; m < 4; ++m) _Pragma("unroll") for (int n = 0; n < 2; ++n) _Pragma("unroll") for (int k = 0; k < 2; ++k) \
        acc[ai][bj][m][n] = __builtin_amdgcn_mfma_f32_16x16x32_bf16(Bt[n][k], At[m][k], acc[ai][bj][m][n], 0, 0, 0); __builtin_amdgcn_s_setprio(0); } while (0)
#define PG8_WAIT_V(n) asm volatile("s_waitcnt vmcnt(" #n ")" ::: "memory")
#define PG8_WAIT_L(n) asm volatile("s_waitcnt lgkmcnt(" #n ")" ::: "memory")
#define PG8_BAR __builtin_amdgcn_s_barrier()
#define PG8_SCHED __builtin_amdgcn_sched_barrier(0)
    Unit cur, nxt; int ui = 0;
    if (!S.next(0, cur)) return;
    f32x4 acc[2][2][4][2];
#pragma unroll
    for (int a = 0; a < 2; ++a)
#pragma unroll
        for (int b = 0; b < 2; ++b)
#pragma unroll
            for (int m = 0; m < 4; ++m)
#pragma unroll
                for (int n = 0; n < 2; ++n) acc[a][b][m][n] = (f32x4){0.f, 0.f, 0.f, 0.f};
    bf16x8 At[4][2], B0[2][2], B1[2][2];
    const char* cA = (const char*)g.A + (size_t)cur.pm * tstep; const char* cB = (const char*)g.Bt + (size_t)cur.pn * tstep;
    S.a_ready(cur);
    if constexpr (SP2) {
        PG8_STAGE(PG8_SB(0, 0), cB, voffB); PG8_STAGE(PG8_SB(0, 1), cB + hstep, voffB); PG8_STAGE(PG8_SA(0, 0), cA, voffA); PG8_STAGE(PG8_SA(0, 1), cA + hstep, voffA);
        if (wr == 1) PG8_BAR;
        PG8_WAIT_V(2); PG8_BAR;
        PG8_STAGE(PG8_SB(1, 0), cB + kstep, voffB); PG8_STAGE(PG8_SA(1, 0), cA + kstep, voffA); PG8_STAGE(PG8_SB(1, 1), cB + hstep + kstep, voffB);
        PG8_WAIT_V(6); PG8_BAR;
    } else {
        PG8_STAGE(PG8_SB(0, 0), cB, voffB); PG8_STAGE(PG8_SA(0, 0), cA, voffA); PG8_STAGE(PG8_SB(0, 1), cB + hstep, voffB); PG8_STAGE(PG8_SA(0, 1), cA + hstep, voffA);
        if (wr == 1) PG8_BAR;
        PG8_WAIT_V(4); PG8_BAR;
        PG8_STAGE(PG8_SB(1, 0), cB + kstep, voffB); PG8_STAGE(PG8_SA(1, 0), cA + kstep, voffA); PG8_STAGE(PG8_SB(1, 1), cB + hstep + kstep, voffB);
        PG8_WAIT_V(6); PG8_BAR;
    }
    for (;;) {
        const bool has_next = S.next(ui + 1, nxt);
        const char* nA = has_next ? (const char*)g.A + (size_t)nxt.pm * tstep : cA; const char* nB = has_next ? (const char*)g.Bt + (size_t)nxt.pn * tstep : cB;
        for (int t = 0; t < nt; t += 2) {
            const bool last = (t == nt - 2);
            const char* a1 = cA + (size_t)(t + 1) * kstep;
            const char* a2 = last ? nA : cA + (size_t)(t + 2) * kstep; const char* b2 = last ? nB : cB + (size_t)(t + 2) * kstep;
            const char* a3 = a2 + kstep; const char* b3 = b2 + kstep;
            if (last && has_next) S.a_ready(nxt);
            if constexpr (SP2) {
            PG8_LDB(B0, 0, 0); PG8_LDB(B1, 0, 1); PG8_SCHED; PG8_LDA(At, 0, 0); PG8_STAGE(PG8_SA(1, 1), a1 + hstep, voffA);
            PG8_WAIT_V(8); PG8_WAIT_L(0); PG8_BAR; PG8_MMA(0, 0, At, B0); PG8_MMA(0, 1, At, B1); PG8_BAR; PG8_SCHED;
            PG8_LDA(At, 0, 1); PG8_STAGE(PG8_SB(0, 0), b2, voffB); PG8_STAGE(PG8_SB(0, 1), b2 + hstep, voffB); PG8_STAGE(PG8_SA(0, 0), a2, voffA);
            PG8_WAIT_V(8); PG8_WAIT_L(0); PG8_BAR; PG8_MMA(1, 0, At, B0); PG8_MMA(1, 1, At, B1); PG8_BAR; PG8_SCHED;
            PG8_LDB(B0, 1, 0); PG8_LDB(B1, 1, 1); PG8_SCHED; PG8_LDA(At, 1, 0); PG8_STAGE(PG8_SA(0, 1), a2 + hstep, voffA);
            PG8_WAIT_V(8); PG8_WAIT_L(0); PG8_BAR; PG8_MMA(0, 0, At, B0); PG8_MMA(0, 1, At, B1); PG8_BAR; PG8_SCHED;
            PG8_LDA(At, 1, 1); PG8_STAGE(PG8_SB(1, 0), b3, voffB); PG8_STAGE(PG8_SB(1, 1), b3 + hstep, voffB); PG8_STAGE(PG8_SA(1, 0), a3, voffA);
            PG8_WAIT_V(8); PG8_WAIT_L(0); PG8_BAR; PG8_MMA(1, 0, At, B0); PG8_MMA(1, 1, At, B1); PG8_BAR; PG8_SCHED;
            } else {
            PG8_LDB(B0, 0, 0); PG8_SCHED; PG8_LDA(At, 0, 0); PG8_STAGE(PG8_SA(1, 1), a1 + hstep, voffA);
            PG8_WAIT_L(8); PG8_BAR; PG8_WAIT_L(0); PG8_MMA(0, 0, At, B0); PG8_BAR; PG8_SCHED;
            PG8_LDB(B1, 0, 1); PG8_STAGE(PG8_SB(0, 0), b2, voffB);
            PG8_BAR; PG8_WAIT_L(0); PG8_MMA(0, 1, At, B1); PG8_BAR;
            PG8_LDA(At, 0, 1); PG8_STAGE(PG8_SA(0, 0), a2, voffA);
            PG8_BAR; PG8_WAIT_L(0); PG8_MMA(1, 0, At, B0); PG8_BAR; PG8_SCHED;
            PG8_STAGE(PG8_SB(0, 1), b2 + hstep, voffB);
            PG8_WAIT_V(6); PG8_BAR; PG8_MMA(1, 1, At, B1); PG8_BAR;
            PG8_LDB(B0, 1, 0); PG8_SCHED; PG8_LDA(At, 1, 0); PG8_STAGE(PG8_SA(0, 1), a2 + hstep, voffA);
            PG8_WAIT_L(8); PG8_BAR; PG8_WAIT_L(0); PG8_MMA(0, 0, At, B0); PG8_BAR; PG8_SCHED;
            PG8_LDB(B1, 1, 1); PG8_STAGE(PG8_SB(1, 0), b3, voffB);
            PG8_BAR; PG8_WAIT_L(0); PG8_MMA(0, 1, At, B1); PG8_BAR;
            PG8_LDA(At, 1, 1); PG8_STAGE(PG8_SA(1, 0), a3, voffA);
            PG8_BAR; PG8_WAIT_L(0); PG8_MMA(1, 0, At, B0); PG8_BAR; PG8_SCHED;
            PG8_STAGE(PG8_SB(1, 1), b3 + hstep, voffB);
            PG8_WAIT_V(6); PG8_BAR; PG8_MMA(1, 1, At, B1); PG8_BAR;
            }
        }
        if constexpr (ALIGN_EPI) { if (wr == 0) PG8_BAR; }
        if constexpr (!Epi::AFTER_DRAIN) { E(acc, cur, wr, wc, fr, fq); S.done(cur); }
        if (!has_next) break;
#pragma unroll
        for (int a = 0; a < 2; ++a)
#pragma unroll
            for (int b = 0; b < 2; ++b)
#pragma unroll
                for (int m = 0; m < 4; ++m)
#pragma unroll
                    for (int n = 0; n < 2; ++n) acc[a][b][m][n] = (f32x4){0.f, 0.f, 0.f, 0.f};
        cur = nxt; cA = nA; cB = nB; ++ui;
        if constexpr (ALIGN_EPI) { if (wr == 1) PG8_BAR; }
    }
    PG8_WAIT_V(0);
    if constexpr (!ALIGN_EPI) { if (wr == 0) PG8_BAR; }
    PG8_BAR;
    if constexpr (Epi::AFTER_DRAIN) { E.fused(acc, cur, wr, wc, fr, fq, lds, wid, lane); S.done(cur); }
#undef PG8_SA
#undef PG8_SB
#undef PG8_STAGE
#undef PG8_LDA
#undef PG8_LDB
#undef PG8_MMA
#undef PG8_WAIT_V
#undef PG8_WAIT_L
#undef PG8_BAR
#undef PG8_SCHED
}
}
#define GAS __attribute__((address_space(1)))
#define LAS __attribute__((address_space(3)))
typedef unsigned short bf16;
typedef unsigned v4u __attribute__((ext_vector_type(4)));
typedef float f32x4 __attribute__((ext_vector_type(4)));
typedef short bf16x8 __attribute__((ext_vector_type(8)));
typedef GAS unsigned gu32;
typedef GAS unsigned long long gu64;
#define RLX_AGENT __ATOMIC_RELAXED, __HIP_MEMORY_SCOPE_AGENT
#define LDS_WAIT() asm volatile("s_waitcnt lgkmcnt(0)" ::: "memory")
#define VM_WAIT() asm volatile("s_waitcnt vmcnt(0)" ::: "memory")
__device__ __forceinline__ unsigned long long rt() { return __builtin_amdgcn_s_memrealtime(); }
__device__ __forceinline__ unsigned f2bf(float f) { unsigned u = __builtin_bit_cast(unsigned, f); return (u + 0x7fffu + ((u >> 16) & 1u)) >> 16; }
__device__ __forceinline__ unsigned pk2(float lo, float hi) { return f2bf(lo) | (f2bf(hi) << 16); }
#define XB_TMO      128
#define XB_XCNT(j)  (256  + 64 * (j))
#define XB_XSUB(j)  (1280 + 64 * (j))
#define XB_XGEN(j)  (2304 + 64 * (j))
#define XB_TOP      3328
#define XB_TOPGEN   3392
#define XCD_BAR_WORDS 3456
#define XB_SPIN_CAP (1u << 18)

__device__ __forceinline__ unsigned xb_ld(unsigned* p)              { return __hip_atomic_load(p, __ATOMIC_RELAXED, __HIP_MEMORY_SCOPE_AGENT); }
__device__ __forceinline__ unsigned xb_add(unsigned* p, unsigned v) { return __hip_atomic_fetch_add(p, v, __ATOMIC_RELAXED, __HIP_MEMORY_SCOPE_AGENT); }
__device__ __forceinline__ unsigned xb_xcc_id() { return (unsigned)__builtin_amdgcn_s_getreg((3 << 11) | 20) & 0xFu; }
#define XB_SPIN(cond, bar) do { unsigned _sp = 0; while (cond) { __builtin_amdgcn_s_sleep(1); \
    if ((++_sp & 255u) == 0u) { if (xb_ld(&(bar)[XB_TMO])) break; if (_sp > XB_SPIN_CAP) { atomicAdd(&(bar)[XB_TMO], 1u); break; } } } } while (0)

struct XcdBarrier {
    unsigned* bar; unsigned x;
    volatile LAS unsigned* st;
};

__device__ __forceinline__ XcdBarrier xcd_barrier_post(unsigned* bar, volatile LAS unsigned* st) {
    XcdBarrier b; b.bar = bar; b.x = xb_xcc_id(); b.st = st;
    if (threadIdx.x == 0) (void)xb_add(&bar[XB_XCNT(b.x)], 1u);
    return b;
}
__device__ __forceinline__ void xcd_barrier_complete(unsigned* bar, unsigned x, unsigned& nloc, unsigned& nx) {
    const unsigned G = gridDim.x * gridDim.y * gridDim.z;
    unsigned sum, cnt, mine, sp = 0u;
    for (;;) {
        sum = 0u; cnt = 0u; mine = 0u;
#pragma unroll
        for (unsigned j = 0; j < 16; ++j) { const unsigned c = xb_ld(&bar[XB_XCNT(j)]); sum += c; cnt += (c > 0u) ? 1u : 0u; mine = (j == x) ? c : mine; }
        if (sum == G) break;
        __builtin_amdgcn_s_sleep(1);
        if ((++sp & 255u) == 0u) { if (xb_ld(&bar[XB_TMO])) break; if (sp > XB_SPIN_CAP) { atomicAdd(&bar[XB_TMO], 1u); break; } }
    }
    nloc = mine > 0u ? mine : 1u; nx = cnt > 0u ? cnt : 1u;
}

__device__ __forceinline__ void xcd_barrier(const XcdBarrier& b) {
    asm volatile("s_waitcnt vmcnt(0)" ::: "memory");
    __syncthreads();
    if (threadIdx.x == 0) {
        unsigned* bar = b.bar;
        __builtin_amdgcn_s_waitcnt(0);
        unsigned nloc = b.st[0], nx = b.st[1];
        if (nloc == 0u) { xcd_barrier_complete(bar, b.x, nloc, nx); b.st[0] = nloc; b.st[1] = nx; }
        const unsigned old = xb_add(&bar[XB_XSUB(b.x)], 1u);
        const unsigned gen = old / nloc;
        if (old + 1u == (gen + 1u) * nloc) {
            __builtin_amdgcn_fence(__ATOMIC_RELEASE, "agent");
            asm volatile("s_waitcnt vmcnt(0)" ::: "memory");
            const unsigned og = xb_add(&bar[XB_TOP], 1u);
            const unsigned tg = og / nx;
            if (og + 1u == (tg + 1u) * nx) xb_add(&bar[XB_TOPGEN], 1u);
            else XB_SPIN(xb_ld(&bar[XB_TOPGEN]) == tg, bar);
            __builtin_amdgcn_fence(__ATOMIC_ACQUIRE, "agent");
            xb_add(&bar[XB_XGEN(b.x)], 1u);
            asm volatile("s_waitcnt vmcnt(0)" ::: "memory");
        } else {
            XB_SPIN(xb_ld(&bar[XB_XGEN(b.x)]) == gen, bar);
            __builtin_amdgcn_fence(__ATOMIC_ACQUIRE, "agent");
            asm volatile("s_waitcnt vmcnt(0)" ::: "memory");
        }
    }
    __syncthreads();
}
constexpr int NWAVES = 8, NTHR = 512;
constexpr int D = 1024, SEQ = 16384, DBATCH = 128, MP = SEQ, MS = 512, M = MP + MS;
constexpr int DFF = 2816, INW = 3072, PAST = 8192, WB = 2048, KEEP = 2048, NH = 8;
constexpr float EPS = 1e-6f;
constexpr int C_QA = 0, C_KA = 512, C_VA = 1024, C_QR = 1536, C_KR = 1792, C_VR = 2048, C_GR = 2560;
constexpr size_t O_Y = 0, O_KP = (size_t)M * D, O_VP = O_KP + (size_t)KEEP * 512, O_SP = O_VP + (size_t)KEEP * 512,
                 O_KS = O_SP + 32768, O_VS = O_KS + (size_t)MS * 512, O_SS = O_VS + (size_t)MS * 512, O_END = O_SS + (size_t)DBATCH * 32768;
constexpr size_t MiB = 1u << 20;
constexpr size_t WS_CTL = 0, CTL_ZERO_BYTES = 1 * MiB;
constexpr size_t WS_W1GU = 1 * MiB, WS_W1D = 12 * MiB, WS_WIN = 18 * MiB, WS_WOUT = 24 * MiB, WS_W2GU = 26 * MiB, WS_W2D = 37 * MiB, WS_TAB = 43 * MiB;
constexpr size_t WS_XN = 48 * MiB, WS_H = 81 * MiB, WS_Y = 172 * MiB, WS_HRES = 238 * MiB, WS_QKV = 304 * MiB, WS_MIX = 502 * MiB, WS_UPD = 535 * MiB, WS_SPREV = 551 * MiB, WS_QKVB = 567 * MiB, WS_OPART = 667 * MiB, WS_ML = 716 * MiB, WS_SPART = 720 * MiB, WS_SML = 736 * MiB, WS_END = 737 * MiB;
constexpr int CW_BAR = 4096;
constexpr int RING_BYTES = 131072, LDSCTL_OFF = RING_BYTES, MISC_OFF = LDSCTL_OFF + 320, LDS_BYTES = 147456;

__constant__ float INVF[40] = {
    1.f, 0.193922743f, 0.0376060307f, 0.00729266461f, 0.00141421356f, 0.000274248188f, 5.3182961e-05f, 1.03133862e-05f,
    1.f, 0.749894261f, 0.562341332f, 0.421696514f, 0.316227764f, 0.237137377f, 0.177827939f, 0.133352131f, 0.100000001f, 0.0749894157f,
    0.0562341325f, 0.0421696529f, 0.0316227749f, 0.0237137377f, 0.0177827943f, 0.0133352149f, 0.00999999978f, 0.00749894185f,
    0.00562341325f, 0.00421696482f, 0.00316227763f, 0.00237137359f, 0.00177827943f, 0.00133352145f, 0.00100000005f, 0.000749894243f,
    0.000562341302f, 0.000421696517f, 0.000316227757f, 0.00023713737f, 0.00017782794f, 0.00013335215f};
__device__ __forceinline__ float log_g(int h) { return h == 0 ? -0.0317486983145803f : h == 1 ? -0.015748356968139168f : h == 2 ? -0.007843177461025893f : -0.003913899321136329f; }
__device__ __forceinline__ float wave_sum(float v) {
#pragma unroll
    for (int o = 32; o >= 1; o >>= 1) v += __shfl_xor(v, o);
    return v;
}
__device__ __forceinline__ float wave_max(float v) {
#pragma unroll
    for (int o = 32; o >= 1; o >>= 1) v = fmaxf(v, __shfl_xor(v, o));
    return v;
}
__device__ __forceinline__ float silu_f(float x) { return x / (1.f + expf(-x)); }

__host__ __device__ __forceinline__ int win_perm(int col) {
    if (col < 1024) { const int dd = col & 63; return dd < 16 ? (col & ~63) + 8 * ((dd >> 2) & 1) + 4 * (dd >> 3) + (dd & 3) : col; }
    if (col >= 1536 && col < 2048) { const int dd = col & 63; return (col & ~63) + 8 * ((dd & 31) >> 2) + 4 * (dd >> 5) + (dd & 3); }
    return col;
}
__device__ __forceinline__ void tr_item(const float* W, int K, int N, bf16* WT, int mode, LAS float* scr, int item, int lane) {
    const int nblk = N / 32, kb = item / nblk, nb = item % nblk, k0 = 64 * kb, n0 = 32 * nb;
    const int rbase = mode == 0 ? n0 : (256 * (n0 >> 7) + (n0 & 127) + (mode == 2 ? 128 : 0));
    {
        const int row8 = lane >> 3, c4 = lane & 7;
        float4 v[8];
#pragma unroll
        for (int i = 0; i < 8; ++i) v[i] = *(const float4*)(W + (size_t)(k0 + 8 * i + row8) * N + n0 + 4 * c4);
#pragma unroll
        for (int i = 0; i < 8; ++i) { LAS float* d = scr + (8 * i + row8) * 33 + 4 * c4; d[0] = v[i].x; d[1] = v[i].y; d[2] = v[i].z; d[3] = v[i].w; }
    }
    LDS_WAIT(); asm volatile("" ::: "memory");
    const int c = lane & 7;
#pragma unroll
    for (int j = 0; j < 4; ++j) { const int n = (lane >> 3) + 8 * j; const LAS float* s = scr + (8 * c) * 33 + n;
        v4u o; o.x = pk2(s[0 * 33], s[1 * 33]); o.y = pk2(s[2 * 33], s[3 * 33]); o.z = pk2(s[4 * 33], s[5 * 33]); o.w = pk2(s[6 * 33], s[7 * 33]);
        const int orow = mode == 3 ? win_perm(n0 + n) : rbase + n;
        *(GAS v4u*)(WT + (size_t)orow * K + k0 + 8 * c) = o; }
    LDS_WAIT(); asm volatile("" ::: "memory");
}
struct Ptrs {
    const float *xp, *xs, *ck, *cv, *st, *g1a, *g1b, *w1g, *w1u, *w1d, *gma, *gmb, *win, *gnw, *wout, *g2a, *g2b, *w2g, *w2u, *w2d;
    float* out;
    bf16 *W1GU, *W1D, *WIN, *WOUT, *W2GU, *W2D, *XN, *H, *MIX;
    float2* TAB; bf16 *Y, *HRES; float *QKV, *UPD; bf16 *SPT, *QKVb, *OPART; float2 *ML, *SML; float* SPART;
};
__device__ __forceinline__ void p0_prologue(const Ptrs& P, LAS unsigned char* lds, int gw, int NGW, int wave, int lane, int gtid, int NGT) {
    LAS float* scr = (LAS float*)(lds + wave * 16384);
    constexpr int I_GU = 16 * 88;
    for (int it = gw; it < 2 * I_GU; it += NGW) {
        if (it < I_GU) tr_item(P.w1g, D, DFF, P.W1GU, 1, scr, it, lane); else tr_item(P.w1u, D, DFF, P.W1GU, 2, scr, it - I_GU, lane);
    }
    for (int idx = gtid; idx < SEQ * 40; idx += NGT) {
        const int pos = idx / 40, f = idx % 40;
        const float ang = (float)pos * INVF[f];
        const double rev = (double)ang * 0.15915494309189535;
        const float fr = (float)(rev - rint(rev));
        P.TAB[idx] = make_float2(__builtin_amdgcn_cosf(fr), __builtin_amdgcn_sinf(fr));
    }
    for (int r = gw; r < M; r += NGW) {
        const float4* x = (const float4*)(r < MP ? P.xp + (size_t)r * D : P.xs + (size_t)(r - MP) * D);
        float4 v[4]; float ss = 0.f;
#pragma unroll
        for (int j = 0; j < 4; ++j) { v[j] = x[lane + 64 * j]; ss += v[j].x * v[j].x + v[j].y * v[j].y + v[j].z * v[j].z + v[j].w * v[j].w; }
        const float rstd = 1.f / sqrtf(wave_sum(ss) * (1.f / D) + EPS);
        uint2* o = (uint2*)(P.XN + (size_t)r * D);
#pragma unroll
        for (int j = 0; j < 4; ++j) { const float4 gg = ((const float4*)P.g1a)[lane + 64 * j];
            o[lane + 64 * j] = make_uint2(pk2(v[j].x * rstd * gg.x, v[j].y * rstd * gg.y), pk2(v[j].z * rstd * gg.z, v[j].w * rstd * gg.w)); }
    }
}
__device__ __forceinline__ void p0_deferred(const Ptrs& P, LAS unsigned char* lds, int gw, int NGW, int wave, int lane) {
    LAS float* scr = (LAS float*)(lds + wave * 16384);
    constexpr int I_GU = 16 * 88, I_D = 44 * 32, I_IN = 16 * 96, I_OUT = 16 * 32;
    constexpr int NITEMS = 2 * I_D + 2 * I_GU + I_IN + I_OUT;
    for (int it = gw; it < NITEMS; it += NGW) {
        int r = it;
        if (r < I_D) { tr_item(P.w1d, DFF, D, P.W1D, 0, scr, r, lane); continue; } r -= I_D;
        if (r < I_IN) { tr_item(P.win, D, INW, P.WIN, 3, scr, r, lane); continue; } r -= I_IN;
        if (r < I_OUT) { tr_item(P.wout, D, D, P.WOUT, 0, scr, r, lane); continue; } r -= I_OUT;
        if (r < I_GU) { tr_item(P.w2g, D, DFF, P.W2GU, 1, scr, r, lane); continue; } r -= I_GU;
        if (r < I_GU) { tr_item(P.w2u, D, DFF, P.W2GU, 2, scr, r, lane); continue; } r -= I_GU;
        tr_item(P.w2d, DFF, D, P.W2D, 0, scr, r, lane);
    }
}
__device__ __forceinline__ void unpack8(const v4u x, float (&f)[8]) { f[0] = __builtin_bit_cast(float, x.x << 16); f[1] = __builtin_bit_cast(float, x.x & 0xffff0000u); f[2] = __builtin_bit_cast(float, x.y << 16); f[3] = __builtin_bit_cast(float, x.y & 0xffff0000u);
    f[4] = __builtin_bit_cast(float, x.z << 16); f[5] = __builtin_bit_cast(float, x.z & 0xffff0000u); f[6] = __builtin_bit_cast(float, x.w << 16); f[7] = __builtin_bit_cast(float, x.w & 0xffff0000u); }
__device__ __forceinline__ v4u pack8(const float (&f)[8]) { v4u w; w.x = pk2(f[0], f[1]); w.y = pk2(f[2], f[3]); w.z = pk2(f[4], f[5]); w.w = pk2(f[6], f[7]); return w; }
template <bool RES_F32, bool OUT_F32>
__device__ __forceinline__ void norm_res_phase(const float* resA, const float* resB, const bf16* resH, const bf16* Y, const float* gpost, float scale, bf16* hout, float* fout, const float* gnext, bf16* XN, int gw, int NGW, int lane) {
    for (int r = gw; r < M; r += NGW) {
        float y[2][8], h[2][8]; float ss = 0.f;
#pragma unroll
        for (int c = 0; c < 2; ++c) {
            const int col = 512 * c + 8 * lane;
            unpack8(*(const v4u*)(Y + (size_t)r * D + col), y[c]);
            if (RES_F32) { const float* x = (r < MP ? resA + (size_t)r * D : resB + (size_t)(r - MP) * D) + col; const float4 a = *(const float4*)x, b = *(const float4*)(x + 4);
                h[c][0] = a.x; h[c][1] = a.y; h[c][2] = a.z; h[c][3] = a.w; h[c][4] = b.x; h[c][5] = b.y; h[c][6] = b.z; h[c][7] = b.w; }
            else unpack8(*(const v4u*)(resH + (size_t)r * D + col), h[c]);
#pragma unroll
            for (int e = 0; e < 8; ++e) ss += y[c][e] * y[c][e];
        }
        const float rstd = scale / sqrtf(wave_sum(ss) * (1.f / D) + EPS);
        float s2 = 0.f;
#pragma unroll
        for (int c = 0; c < 2; ++c) {
            const int col = 512 * c + 8 * lane;
            const float4 g0 = *(const float4*)(gpost + col), g1 = *(const float4*)(gpost + col + 4);
            const float gg[8] = {g0.x, g0.y, g0.z, g0.w, g1.x, g1.y, g1.z, g1.w};
#pragma unroll
            for (int e = 0; e < 8; ++e) { h[c][e] += y[c][e] * rstd * gg[e]; s2 += h[c][e] * h[c][e]; }
            if (OUT_F32) { float* o = fout + (size_t)r * D + col; *(float4*)o = make_float4(h[c][0], h[c][1], h[c][2], h[c][3]); *(float4*)(o + 4) = make_float4(h[c][4], h[c][5], h[c][6], h[c][7]); }
            else *(v4u*)(hout + (size_t)r * D + col) = pack8(h[c]);
        }
        if (gnext) {
            const float r2 = 1.f / sqrtf(wave_sum(s2) * (1.f / D) + EPS);
#pragma unroll
            for (int c = 0; c < 2; ++c) {
                const int col = 512 * c + 8 * lane;
                const float4 g0 = *(const float4*)(gnext + col), g1 = *(const float4*)(gnext + col + 4);
                const float gg[8] = {g0.x, g0.y, g0.z, g0.w, g1.x, g1.y, g1.z, g1.w};
                float o[8];
#pragma unroll
                for (int e = 0; e < 8; ++e) o[e] = h[c][e] * r2 * gg[e];
                *(v4u*)(XN + (size_t)r * D + col) = pack8(o);
            }
        }
    }
}
typedef float f32x16 __attribute__((ext_vector_type(16)));
typedef short s16x4 __attribute__((ext_vector_type(4)));
typedef float f32x2_t __attribute__((ext_vector_type(2)));
typedef __bf16 bf16x2_t __attribute__((ext_vector_type(2)));
__device__ __forceinline__ unsigned cvtpk(float lo, float hi) { f32x2_t v = {lo, hi}; bf16x2_t b = __builtin_convertvector(v, bf16x2_t); return __builtin_bit_cast(unsigned, b); }
__device__ __forceinline__ s16x4 vtr(const LAS unsigned char* p) { return __builtin_bit_cast(s16x4, __builtin_amdgcn_ds_read_tr16_b64_v4i16((LAS s16x4*)p)); }
#define MFMA32(a, b, c) __builtin_amdgcn_mfma_f32_32x32x16_bf16((a), (b), (c), 0, 0, 0)
__device__ __forceinline__ int crow(int reg, int hh) { return (reg & 3) + 8 * (reg >> 2) + 4 * hh; }
__device__ __forceinline__ float bf_lo(unsigned u) { return __builtin_bit_cast(float, u << 16); }
__device__ __forceinline__ float bf_hi(unsigned u) { return __builtin_bit_cast(float, u & 0xffff0000u); }
constexpr float QSCALE = 0.125f * 1.4426950408889634f;

__device__ __forceinline__ void sk_tile(LAS unsigned char* lds, const bf16* A, int lda, const bf16* Wt, int K, int r0, int c0, int tid, int wave, int lane) {
    const int i = lane & 31, hh = lane >> 5;
    const int ksl = K >> 3, k0 = wave * ksl;
    const bf16* ap = A + (size_t)(r0 + i) * lda + k0 + 8 * hh;
    const bf16* bp0 = Wt + (size_t)(c0 + i) * K + k0 + 8 * hh;
    const bf16* bp1 = bp0 + (size_t)32 * K;
    f32x16 acc0, acc1;
#pragma unroll
    for (int e = 0; e < 16; ++e) { acc0[e] = 0.f; acc1[e] = 0.f; }
#pragma unroll 4
    for (int ks = 0; ks < (ksl >> 4); ++ks) {
        const bf16x8 a = *(const bf16x8*)(ap + 16 * ks), b0 = *(const bf16x8*)(bp0 + 16 * ks), b1 = *(const bf16x8*)(bp1 + 16 * ks);
        acc0 = MFMA32(a, b0, acc0); acc1 = MFMA32(a, b1, acc1);
    }
    LAS float* part = (LAS float*)lds + wave * 2048;
#pragma unroll
    for (int e = 0; e < 16; ++e) { const int row = crow(e, hh); part[row * 64 + i] = acc0[e]; part[row * 64 + 32 + i] = acc1[e]; }
    __syncthreads();
    {
        const LAS f32x4* p4 = (const LAS f32x4*)lds + tid;
        f32x4 s = p4[0];
#pragma unroll
        for (int w = 1; w < 8; ++w) s += p4[w * 512];
        ((LAS f32x4*)(lds + 65536))[tid] = s;
    }
    __syncthreads();
}
__device__ __forceinline__ void sk_gemm_y(LAS unsigned char* lds, const bf16* A, int lda, const bf16* Wt, int K, bf16* Y, int tid, int wave, int lane) {
    for (int item = blockIdx.x; item < 256; item += gridDim.x) {
        const int rt = item >> 4, ct = item & 15;
        sk_tile(lds, A, lda, Wt, K, MP + 32 * rt, 64 * ct, tid, wave, lane);
        const f32x4 v = ((const LAS f32x4*)(lds + 65536))[tid];
        *(uint2*)(Y + (size_t)(MP + 32 * rt + (tid >> 4)) * D + 64 * ct + 4 * (tid & 15)) = make_uint2(cvtpk(v[0], v[1]), cvtpk(v[2], v[3]));
        __syncthreads();
    }
}
__device__ __forceinline__ void sk_gemm_qkv(LAS unsigned char* lds, const bf16* XN, const bf16* WIN, bf16* QKVb, const float2* tab, float* out, int tid, int wave, int lane) {
    const LAS float* red = (const LAS float*)(lds + 65536);
    for (int item = blockIdx.x; item < 768; item += gridDim.x) {
        const int rt = item / 48, ct = item % 48;
        sk_tile(lds, XN, D, WIN, D, MP + 32 * rt, 64 * ct, tid, wave, lane);
        const int row = tid >> 4, c4 = tid & 15, srow = 32 * rt + row, pos = PAST + (srow & 3), nc0 = 64 * ct;
        float y[4];
#pragma unroll
        for (int k = 0; k < 4; ++k) {
            const int dd = 4 * c4 + k;
            const float x = red[row * 64 + (win_perm(nc0 + dd) - nc0)];
            float r = x;
            if (ct < 16) {
                if (dd < 16) { const float xp = red[row * 64 + (win_perm(nc0 + (dd ^ 8)) - nc0)]; const float2 cs = tab[pos * 40 + (dd & 7)];
                    r = dd < 8 ? x * cs.x - xp * cs.y : x * cs.x + xp * cs.y; }
                if (ct < 8) r *= QSCALE;
            } else if (ct >= 24 && ct < 32) {
                const float xp = red[row * 64 + (win_perm(nc0 + (dd ^ 32)) - nc0)]; const float2 cs = tab[pos * 40 + 8 + (dd & 31)];
                r = dd < 32 ? x * cs.x - xp * cs.y : x * cs.x + xp * cs.y;
                if (ct >= 28) r *= 0.125f;
            }
            y[k] = r;
        }
        *(uint2*)(QKVb + (size_t)(MP + srow) * INW + nc0 + 4 * c4) = make_uint2(cvtpk(y[0], y[1]), cvtpk(y[2], y[3]));
        if (ct >= 8 && ct < 16) *(float4*)(out + O_KS + (size_t)srow * 512 + (nc0 - C_KA) + 4 * c4) = make_float4(y[0], y[1], y[2], y[3]);
        if (ct >= 16 && ct < 24) *(float4*)(out + O_VS + (size_t)srow * 512 + (nc0 - C_VA) + 4 * c4) = make_float4(y[0], y[1], y[2], y[3]);
        __syncthreads();
    }
}
__device__ __forceinline__ void attn_mfma_phase(LAS unsigned char* lds, const bf16* QKVb, bf16* OPART, float2* ML, int tid, int wave, int lane) {
    constexpr int RSK = 144, RSV = 192;
    LAS unsigned char* kimg = lds;
    LAS unsigned char* vimg = lds + 384 * RSK;
    const int i = lane & 31, hh = lane >> 5, i16 = lane & 15, tq = i16 >> 2, tp = i16 & 3, blk = (lane >> 4) & 1;
    v4u pk[6], pv[6];
    auto decode = [](int item, int& h, int& b, int& r, int& bk) { h = item / 192; const int w = item % 192;
        if (w < 64) { b = 0; r = 0; bk = w; } else if (w < 128) { b = 1; r = (w - 64) >> 4; bk = (w - 64) & 15; } else { b = 2; r = (w - 128) >> 2; bk = (w - 128) & 3; } };
    auto issue = [&](int item) { int h, b, r, bk; decode(item, h, b, r, bk); const int d = 1 << (2 * b), L0 = bk * 256;
#pragma unroll
        for (int c = 0; c < 6; ++c) { const int e = tid + NTHR * c, j = e >> 3, ch = e & 7, l = L0 - 128 + j;
            if (l >= 0) { const bf16* src = QKVb + (size_t)(l * d + r) * INW + h * 64 + 8 * ch; pk[c] = *(const v4u*)(src + C_KA); pv[c] = *(const v4u*)(src + C_VA); } } };
    if ((int)blockIdx.x < 1536) issue(blockIdx.x);
    for (int item = blockIdx.x; item < 1536; item += gridDim.x) {
        int h, b, r, bk; decode(item, h, b, r, bk);
        const int d = 1 << (2 * b), L0 = bk * 256;
#pragma unroll
        for (int c = 0; c < 6; ++c) { const int e = tid + NTHR * c, j = e >> 3, ch = e & 7;
            *(LAS v4u*)(kimg + j * RSK + 16 * ch) = pk[c]; *(LAS v4u*)(vimg + j * RSV + 16 * ch) = pv[c]; }
        const int l0 = L0 + 32 * wave;
        const int tok_q = (l0 + i) * d + r;
        const bf16* qp = QKVb + (size_t)tok_q * INW + C_QA + h * 64 + 8 * hh;
        bf16x8 qf[4];
#pragma unroll
        for (int ks = 0; ks < 4; ++ks) qf[ks] = *(const bf16x8*)(qp + 16 * ks);
        __syncthreads();
        if (item + (int)gridDim.x < 1536) issue(item + gridDim.x);
        f32x16 o0, o1;
#pragma unroll
        for (int e = 0; e < 16; ++e) { o0[e] = 0.f; o1[e] = 0.f; }
        float m = -1e30f, l = 0.f;
        const int kt0 = l0 >= 128 ? 0 : ((128 - l0) >> 5);
        for (int kt = kt0; kt < 5; ++kt) {
            const int jb = 32 * wave + 32 * kt;
            const LAS unsigned char* kp = kimg + (jb + i) * RSK + 16 * hh;
            f32x16 s;
#pragma unroll
            for (int e = 0; e < 16; ++e) s[e] = 0.f;
#pragma unroll
            for (int ks = 0; ks < 4; ++ks) { const bf16x8 kf = *(const LAS bf16x8*)(kp + 32 * ks); s = MFMA32(kf, qf[ks], s); }
            float tm = -1e30f;
#pragma unroll
            for (int e = 0; e < 16; ++e) { const int j = crow(e, hh); const bool bad = (kt == 0 && j < i) || (kt == 4 && j > i); s[e] = bad ? -1e30f : s[e]; tm = fmaxf(tm, s[e]); }
            tm = fmaxf(tm, __shfl_xor(tm, 32));
            const float mn = fmaxf(m, tm), scl = __builtin_amdgcn_exp2f(m - mn);
            m = mn; l *= scl;
#pragma unroll
            for (int e = 0; e < 16; ++e) { o0[e] *= scl; o1[e] *= scl; }
            float psum = 0.f;
#pragma unroll
            for (int e = 0; e < 16; ++e) { s[e] = __builtin_amdgcn_exp2f(s[e] - mn); psum += s[e]; }
            l += psum;
            v4u pw0, pw1;
            pw0.x = cvtpk(s[0], s[1]); pw0.y = cvtpk(s[2], s[3]); pw0.z = cvtpk(s[4], s[5]); pw0.w = cvtpk(s[6], s[7]);
            pw1.x = cvtpk(s[8], s[9]); pw1.y = cvtpk(s[10], s[11]); pw1.z = cvtpk(s[12], s[13]); pw1.w = cvtpk(s[14], s[15]);
            const bf16x8 pf0 = __builtin_bit_cast(bf16x8, pw0), pf1 = __builtin_bit_cast(bf16x8, pw1);
#pragma unroll
            for (int st = 0; st < 2; ++st) {
                const LAS unsigned char* a0 = vimg + (jb + 16 * st + 4 * hh + tq) * RSV + (16 * blk + 4 * tp) * 2;
                const s16x4 lo0 = vtr(a0), hi0 = vtr(a0 + 8 * RSV), lo1 = vtr(a0 + 64), hi1 = vtr(a0 + 8 * RSV + 64);
                const bf16x8 v0 = __builtin_shufflevector(lo0, hi0, 0, 1, 2, 3, 4, 5, 6, 7), v1 = __builtin_shufflevector(lo1, hi1, 0, 1, 2, 3, 4, 5, 6, 7);
                o0 = MFMA32(v0, st == 0 ? pf0 : pf1, o0);
                o1 = MFMA32(v1, st == 0 ? pf0 : pf1, o1);
            }
        }
        const float lt = l + __shfl_xor(l, 32), inv = 1.f / lt;
        bf16* op = OPART + ((size_t)b * MP + tok_q) * 512 + h * 64 + 4 * hh;
#pragma unroll
        for (int g = 0; g < 4; ++g) {
            *(uint2*)(op + 8 * g) = make_uint2(cvtpk(o0[4 * g] * inv, o0[4 * g + 1] * inv), cvtpk(o0[4 * g + 2] * inv, o0[4 * g + 3] * inv));
            *(uint2*)(op + 32 + 8 * g) = make_uint2(cvtpk(o1[4 * g] * inv, o1[4 * g + 1] * inv), cvtpk(o1[4 * g + 2] * inv, o1[4 * g + 3] * inv));
        }
        if (hh == 0) ML[((size_t)b * MP + tok_q) * 8 + h] = make_float2(m, lt);
        __syncthreads();
    }
}
__device__ __forceinline__ void attn_combine_phase(const bf16* OPART, const float2* ML, bf16* MIX, int gtid, int NGT) {
    for (int idx = gtid; idx < MP * 64; idx += NGT) {
        const int tok = idx >> 6, h = (idx >> 3) & 7, c = idx & 7;
        const float2 a0 = ML[((size_t)0 * MP + tok) * 8 + h], a1 = ML[((size_t)1 * MP + tok) * 8 + h], a2 = ML[((size_t)2 * MP + tok) * 8 + h];
        const float mx = fmaxf(a0.x, fmaxf(a1.x, a2.x));
        float w0 = a0.y * __builtin_amdgcn_exp2f(a0.x - mx), w1 = a1.y * __builtin_amdgcn_exp2f(a1.x - mx), w2 = a2.y * __builtin_amdgcn_exp2f(a2.x - mx);
        const float iw = 1.f / (w0 + w1 + w2); w0 *= iw; w1 *= iw; w2 *= iw;
        const v4u x0 = *(const v4u*)(OPART + ((size_t)0 * MP + tok) * 512 + h * 64 + 8 * c);
        const v4u x1 = *(const v4u*)(OPART + ((size_t)1 * MP + tok) * 512 + h * 64 + 8 * c);
        const v4u x2 = *(const v4u*)(OPART + ((size_t)2 * MP + tok) * 512 + h * 64 + 8 * c);
        v4u o;
        o.x = cvtpk(w0 * bf_lo(x0.x) + w1 * bf_lo(x1.x) + w2 * bf_lo(x2.x), w0 * bf_hi(x0.x) + w1 * bf_hi(x1.x) + w2 * bf_hi(x2.x));
        o.y = cvtpk(w0 * bf_lo(x0.y) + w1 * bf_lo(x1.y) + w2 * bf_lo(x2.y), w0 * bf_hi(x0.y) + w1 * bf_hi(x1.y) + w2 * bf_hi(x2.y));
        o.z = cvtpk(w0 * bf_lo(x0.z) + w1 * bf_lo(x1.z) + w2 * bf_lo(x2.z), w0 * bf_hi(x0.z) + w1 * bf_hi(x1.z) + w2 * bf_hi(x2.z));
        o.w = cvtpk(w0 * bf_lo(x0.w) + w1 * bf_lo(x1.w) + w2 * bf_lo(x2.w), w0 * bf_hi(x0.w) + w1 * bf_hi(x1.w) + w2 * bf_hi(x2.w));
        *(v4u*)(MIX + (size_t)tok * D + h * 64 + 8 * c) = o;
    }
}
__device__ __forceinline__ void ret_out_mfma_phase(LAS unsigned char* lds, const bf16* QKVb, const bf16* SPT, const float* gnw, bf16* MIX, int tid, int wave, int lane) {
    constexpr int RSV = 272, RSK = 144, GRP = 128 * RSV + 128 * RSK;
    const int grp = wave >> 2, itile = grp ? 3 - (wave & 3) : (wave & 3);
    LAS unsigned char* vb = lds + grp * GRP;
    LAS unsigned char* kb = vb + 128 * RSV;
    const int i = lane & 31, hh = lane >> 5, i16 = lane & 15, tq = i16 >> 2, tp = i16 & 3, blk = (lane >> 4) & 1;
    for (int it = blockIdx.x; it < 256; it += gridDim.x) {
        const int item = it * 2 + grp, n = item >> 2, h = item & 3;
        const float lg2 = log_g(h) * 1.4426950408889634f;
        const int row_i = n * 128 + 32 * itile + i;
        bf16x8 qf[4], sf[4][4];
#pragma unroll
        for (int ks = 0; ks < 4; ++ks) qf[ks] = *(const bf16x8*)(QKVb + (size_t)row_i * INW + C_QR + h * 64 + 16 * ks + 8 * hh);
#pragma unroll
        for (int dt = 0; dt < 4; ++dt)
#pragma unroll
            for (int ks = 0; ks < 4; ++ks) sf[dt][ks] = *(const bf16x8*)(SPT + ((size_t)(n * 4 + h) * 128 + 32 * dt + i) * 64 + 16 * ks + 8 * hh);
        {
            const int t4 = tid & 255;
#pragma unroll
            for (int c = 0; c < 8; ++c) { const int e = t4 + 256 * c, rowk = e >> 4, ch = e & 15;
                *(LAS v4u*)(vb + rowk * RSV + 16 * ch) = *(const v4u*)(QKVb + (size_t)(n * 128 + rowk) * INW + C_VR + h * 128 + 8 * ch); }
#pragma unroll
            for (int c = 0; c < 4; ++c) { const int e = t4 + 256 * c, rowk = e >> 3, ch = e & 7;
                *(LAS v4u*)(kb + rowk * RSK + 16 * ch) = *(const v4u*)(QKVb + (size_t)(n * 128 + rowk) * INW + C_KR + h * 64 + 8 * ch); }
        }
        __syncthreads();
        f32x16 acc[4];
#pragma unroll
        for (int dt = 0; dt < 4; ++dt) {
#pragma unroll
            for (int e = 0; e < 16; ++e) acc[dt][e] = 0.f;
#pragma unroll
            for (int ks = 0; ks < 4; ++ks) acc[dt] = MFMA32(sf[dt][ks], qf[ks], acc[dt]);
        }
        const float wh = __builtin_amdgcn_exp2f((float)(32 * itile + i + 1) * lg2);
#pragma unroll
        for (int dt = 0; dt < 4; ++dt)
#pragma unroll
            for (int e = 0; e < 16; ++e) acc[dt][e] *= wh;
        for (int jt = 0; jt <= itile; ++jt) {
            bf16x8 kf[4];
#pragma unroll
            for (int ks = 0; ks < 4; ++ks) kf[ks] = *(const LAS bf16x8*)(kb + (32 * jt + i) * RSK + 32 * ks + 16 * hh);
            f32x16 s;
#pragma unroll
            for (int e = 0; e < 16; ++e) s[e] = 0.f;
#pragma unroll
            for (int ks = 0; ks < 4; ++ks) s = MFMA32(kf[ks], qf[ks], s);
#pragma unroll
            for (int e = 0; e < 16; ++e) { const int dl = 32 * (itile - jt) + i - crow(e, hh); s[e] = dl >= 0 ? s[e] * __builtin_amdgcn_exp2f((float)dl * lg2) : 0.f; }
            v4u pw0, pw1;
            pw0.x = cvtpk(s[0], s[1]); pw0.y = cvtpk(s[2], s[3]); pw0.z = cvtpk(s[4], s[5]); pw0.w = cvtpk(s[6], s[7]);
            pw1.x = cvtpk(s[8], s[9]); pw1.y = cvtpk(s[10], s[11]); pw1.z = cvtpk(s[12], s[13]); pw1.w = cvtpk(s[14], s[15]);
            const bf16x8 pf0 = __builtin_bit_cast(bf16x8, pw0), pf1 = __builtin_bit_cast(bf16x8, pw1);
#pragma unroll
            for (int st = 0; st < 2; ++st) {
                const LAS unsigned char* a0 = vb + (32 * jt + 16 * st + 4 * hh + tq) * RSV + (16 * blk + 4 * tp) * 2;
#pragma unroll
                for (int dt = 0; dt < 4; ++dt) {
                    const s16x4 lo = vtr(a0 + 64 * dt), hi = vtr(a0 + 8 * RSV + 64 * dt);
                    const bf16x8 vf = __builtin_shufflevector(lo, hi, 0, 1, 2, 3, 4, 5, 6, 7);
                    acc[dt] = MFMA32(vf, st == 0 ? pf0 : pf1, acc[dt]);
                }
            }
        }
        float s1 = 0.f;
#pragma unroll
        for (int dt = 0; dt < 4; ++dt)
#pragma unroll
            for (int e = 0; e < 16; ++e) s1 += acc[dt][e];
        s1 += __shfl_xor(s1, 32);
        const float mu = s1 * (1.f / 128.f);
        float s2 = 0.f;
#pragma unroll
        for (int dt = 0; dt < 4; ++dt)
#pragma unroll
            for (int e = 0; e < 16; ++e) { const float dd = acc[dt][e] - mu; s2 += dd * dd; }
        s2 += __shfl_xor(s2, 32);
        const float rstd = 1.f / sqrtf(s2 * (1.f / 128.f) + EPS);
#pragma unroll
        for (int dt = 0; dt < 4; ++dt)
#pragma unroll
            for (int g = 0; g < 4; ++g) {
                const int dv0 = 32 * dt + 8 * g + 4 * hh;
                const uint2 gr = *(const uint2*)(QKVb + (size_t)row_i * INW + C_GR + h * 128 + dv0);
                const float4 gw4 = *(const float4*)(gnw + h * 128 + dv0);
                const float y0 = (acc[dt][4 * g] - mu) * rstd * gw4.x * silu_f(bf_lo(gr.x)), y1 = (acc[dt][4 * g + 1] - mu) * rstd * gw4.y * silu_f(bf_hi(gr.x));
                const float y2 = (acc[dt][4 * g + 2] - mu) * rstd * gw4.z * silu_f(bf_lo(gr.y)), y3 = (acc[dt][4 * g + 3] - mu) * rstd * gw4.w * silu_f(bf_hi(gr.y));
                *(uint2*)(MIX + (size_t)row_i * D + 512 + h * 128 + dv0) = make_uint2(cvtpk(y0, y1), cvtpk(y2, y3));
            }
        __syncthreads();
    }
}
template <int CTRL> __device__ __forceinline__ float dppf(float x) { return __builtin_bit_cast(float, __builtin_amdgcn_mov_dpp(__builtin_bit_cast(int, x), CTRL, 0xf, 0xf, true)); }
__device__ __forceinline__ float row16_sum(float v) { v += dppf<0xB1>(v); v += dppf<0x4E>(v); v += dppf<0x141>(v); v += dppf<0x128>(v); return v; }
constexpr int SA_CH = 15, SA_KPC = 60;
__device__ __forceinline__ void sa_rows(int kk, int b, const float* ck, const float* cv, const float* out, const float*& kr, const float*& vr, int& e) {
    e = kk < 516 ? kk : 528 + 16 * ((kk - 516) >> 2) + ((kk - 516) & 3);
    const int idx = 2051 - e;
    if (idx >= WB) { kr = out + O_KS + (size_t)(b * 4 + idx - WB) * 512; vr = out + O_VS + (size_t)(b * 4 + idx - WB) * 512; }
    else { kr = ck + ((size_t)b * WB + idx) * 512; vr = cv + ((size_t)b * WB + idx) * 512; }
}
__device__ __forceinline__ void attn_sample_phase(const bf16* QKVb, const float* ck, const float* cv, const float* out, float* SPART, float2* SML, int gw, int NGW, int lane) {
    const int l16 = lane & 15, hq = lane >> 4;
    for (int item = gw; item < DBATCH * SA_CH; item += NGW) {
        const int b = item / SA_CH, c = item % SA_CH;
        f32x4 q[4][2], o[4][2]; float m[4][2], l[4][2];
#pragma unroll
        for (int i = 0; i < 4; ++i)
#pragma unroll
            for (int u = 0; u < 2; ++u) {
                { const uint2 qq = *(const uint2*)(QKVb + (size_t)(MP + b * 4 + i) * INW + C_QA + (4 * u + hq) * 64 + 4 * l16); q[i][u] = (f32x4){bf_lo(qq.x), bf_hi(qq.x), bf_lo(qq.y), bf_hi(qq.y)}; }
                o[i][u] = (f32x4){0.f, 0.f, 0.f, 0.f}; m[i][u] = -1e30f; l[i][u] = 0.f;
            }
        for (int g = 0; g < SA_KPC / 4; ++g) {
            f32x4 kx[4][2], vx[4][2]; int ee[4];
#pragma unroll
            for (int t = 0; t < 4; ++t) {
                const float *kr, *vr; sa_rows(c * SA_KPC + g * 4 + t, b, ck, cv, out, kr, vr, ee[t]);
                kx[t][0] = __builtin_nontemporal_load((const f32x4*)(kr + 4 * lane)); kx[t][1] = __builtin_nontemporal_load((const f32x4*)(kr + 256 + 4 * lane));
                vx[t][0] = __builtin_nontemporal_load((const f32x4*)(vr + 4 * lane)); vx[t][1] = __builtin_nontemporal_load((const f32x4*)(vr + 256 + 4 * lane));
            }
#pragma unroll
            for (int t = 0; t < 4; ++t)
#pragma unroll
                for (int i = 0; i < 4; ++i) {
                    const int dl = ee[t] - 3 + i;
                    const int mult = dl >= 0 ? (int)(dl <= 128) + (int)(((dl & 3) == 0) && dl <= 512) + (int)(((dl & 15) == 0) && dl <= 2048) : 0;
                    if (mult) {
                        const float fm = (float)mult;
#pragma unroll
                        for (int u = 0; u < 2; ++u) {
                            const f32x4 pr = q[i][u] * kx[t][u];
                            const float s = row16_sum((pr[0] + pr[1]) + (pr[2] + pr[3]));
                            const float mn = fmaxf(m[i][u], s), scl = __builtin_amdgcn_exp2f(m[i][u] - mn), p = fm * __builtin_amdgcn_exp2f(s - mn);
                            m[i][u] = mn; l[i][u] = l[i][u] * scl + p; o[i][u] = o[i][u] * scl + vx[t][u] * p;
                        }
                    }
                }
        }
#pragma unroll
        for (int i = 0; i < 4; ++i)
#pragma unroll
            for (int u = 0; u < 2; ++u) {
                const size_t base = ((size_t)(b * SA_CH + c) * 4 + i) * 8 + 4 * u + hq;
                *(f32x4*)(SPART + base * 64 + 4 * l16) = o[i][u];
                if (l16 == 0) SML[base] = make_float2(m[i][u], l[i][u]);
            }
    }
}
__device__ __forceinline__ void attn_sample_merge_phase(const float* SPART, const float2* SML, bf16* MIX, int gw, int NGW, int lane) {
    for (int item = gw; item < DBATCH * 32; item += NGW) {
        const int b = item >> 5, i = (item >> 3) & 3, h = item & 7;
        float2 ml[SA_CH]; float mx = -1e30f;
#pragma unroll
        for (int c = 0; c < SA_CH; ++c) { ml[c] = SML[((size_t)(b * SA_CH + c) * 4 + i) * 8 + h]; mx = fmaxf(mx, ml[c].x); }
        float acc = 0.f, L = 0.f;
#pragma unroll
        for (int c = 0; c < SA_CH; ++c) { const float w = __builtin_amdgcn_exp2f(ml[c].x - mx); L += w * ml[c].y; acc += w * SPART[(((size_t)(b * SA_CH + c) * 4 + i) * 8 + h) * 64 + lane]; }
        MIX[(size_t)(MP + b * 4 + i) * D + h * 64 + lane] = (bf16)f2bf(acc / L);
    }
}
__device__ __forceinline__ void ret_upd_phase(LAS unsigned char* lds, const bf16* __restrict__ QKVb, float* __restrict__ UPD, int tid, int wave, int lane) {
    constexpr int RSV = 272, RSK = 144, GRP = 128 * RSV + 128 * RSK;
    const int grp = wave >> 2, dt = wave & 3;
    LAS unsigned char* vb = lds + grp * GRP;
    LAS unsigned char* kb = vb + 128 * RSV;
    const int i = lane & 31, hh = lane >> 5, i16 = lane & 15, tq = i16 >> 2, tp = i16 & 3, blk = (lane >> 4) & 1;
    for (int it = blockIdx.x; it < 256; it += gridDim.x) {
        const int item = it * 2 + grp, n = item >> 2, h = item & 3;
        const float lg2 = log_g(h) * 1.4426950408889634f;
        const int t4 = tid & 255;
#pragma unroll
        for (int c = 0; c < 8; ++c) { const int e = t4 + 256 * c, rowk = e >> 4, ch = e & 15;
            *(LAS v4u*)(vb + rowk * RSV + 16 * ch) = *(const v4u*)(QKVb + (size_t)(n * 128 + rowk) * INW + C_VR + h * 128 + 8 * ch); }
#pragma unroll
        for (int c = 0; c < 4; ++c) { const int e = t4 + 256 * c, rowk = e >> 3, ch = e & 7;
            const v4u x = *(const v4u*)(QKVb + (size_t)(n * 128 + rowk) * INW + C_KR + h * 64 + 8 * ch);
            const float w = __builtin_amdgcn_exp2f((float)(127 - rowk) * lg2);
            v4u y; y.x = cvtpk(bf_lo(x.x) * w, bf_hi(x.x) * w); y.y = cvtpk(bf_lo(x.y) * w, bf_hi(x.y) * w); y.z = cvtpk(bf_lo(x.z) * w, bf_hi(x.z) * w); y.w = cvtpk(bf_lo(x.w) * w, bf_hi(x.w) * w);
            *(LAS v4u*)(kb + rowk * RSK + 16 * ch) = y; }
        __syncthreads();
        f32x16 a0, a1;
#pragma unroll
        for (int e = 0; e < 16; ++e) { a0[e] = 0.f; a1[e] = 0.f; }
#pragma unroll
        for (int ks = 0; ks < 8; ++ks) {
            const LAS unsigned char* va = vb + (16 * ks + 8 * hh + tq) * RSV + (32 * dt + 16 * blk + 4 * tp) * 2;
            const LAS unsigned char* ka = kb + (16 * ks + 8 * hh + tq) * RSK + (16 * blk + 4 * tp) * 2;
            const s16x4 vlo = vtr(va), vhi = vtr(va + 4 * RSV), k0lo = vtr(ka), k0hi = vtr(ka + 4 * RSK), k1lo = vtr(ka + 64), k1hi = vtr(ka + 4 * RSK + 64);
            const bf16x8 vf = __builtin_shufflevector(vlo, vhi, 0, 1, 2, 3, 4, 5, 6, 7);
            a0 = MFMA32(vf, __builtin_shufflevector(k0lo, k0hi, 0, 1, 2, 3, 4, 5, 6, 7), a0);
            a1 = MFMA32(vf, __builtin_shufflevector(k1lo, k1hi, 0, 1, 2, 3, 4, 5, 6, 7), a1);
        }
        float* up = UPD + ((size_t)(n * 4 + h) * 128 + 32 * dt) * 64 + i;
#pragma unroll
        for (int e = 0; e < 16; ++e) { const int dv = crow(e, hh); up[dv * 64] = a0[e]; up[dv * 64 + 32] = a1[e]; }
        __syncthreads();
    }
}
__device__ __forceinline__ void ret_scan_phase(const float* __restrict__ UPDT, bf16* __restrict__ SPT, float* __restrict__ out, int tid) {
    if (tid < 128)
    for (int e = blockIdx.x * 128 + tid; e < 32768; e += gridDim.x * 128) {
        const int h = e >> 13, dv = (e >> 6) & 127, dk = e & 63;
        const float G = expf(128.f * log_g(h));
        float S = 0.f;
#pragma unroll 1
        for (int n0 = 0; n0 < 128; n0 += 32) {
            float u[32];
#pragma unroll
            for (int k = 0; k < 32; ++k) u[k] = UPDT[(size_t)(n0 + k) * 32768 + e];
#pragma unroll
            for (int k = 0; k < 32; ++k) { SPT[(size_t)(n0 + k) * 32768 + e] = (bf16)f2bf(S); S = G * S + u[k]; }
        }
        out[O_SP + h * 8192 + dk * 128 + dv] = S;
    }
}
__device__ __forceinline__ void ret_sample_phase(LAS unsigned char* lds, const bf16* __restrict__ QKVb, const float* __restrict__ state, const float* __restrict__ gnw, bf16* __restrict__ MIX, float* __restrict__ out, int tid) {
    const int grp = tid >> 7, t = tid & 127, dv = t;
    LAS float* qs = (LAS float*)(lds + grp * 4096);
    LAS float* ks = qs + 256;
    LAS float* red = ks + 256;
    for (int it = blockIdx.x; it < 128; it += gridDim.x) {
        const int sub = it * 4 + grp, b = sub >> 2, h = sub & 3;
        const float g = 1.f - exp2f(-5.f - (float)h);
        const float g2 = g * g, g3 = g2 * g, g4 = g2 * g2;
        const int row0 = MP + b * 4;
        const float* s0p = state + (size_t)(b * 4 + h) * 64 * 128 + dv;
        float* snp = out + O_SS + (size_t)(b * 4 + h) * 64 * 128 + dv;
        for (int e = t; e < 256; e += 128) { const int i = e >> 6, dk = e & 63;
            qs[e] = bf_lo((unsigned)QKVb[(size_t)(row0 + i) * INW + C_QR + h * 64 + dk]); ks[e] = bf_lo((unsigned)QKVb[(size_t)(row0 + i) * INW + C_KR + h * 64 + dk]); }
        float v[4];
#pragma unroll
        for (int i = 0; i < 4; ++i) v[i] = bf_lo((unsigned)QKVb[(size_t)(row0 + i) * INW + C_VR + h * 128 + dv]);
        __syncthreads();
        float c0 = 0.f, c1 = 0.f, c2 = 0.f, c3 = 0.f;
#pragma unroll 1
        for (int d0 = 0; d0 < 64; d0 += 16) {
            float s0v[16];
#pragma unroll
            for (int dk = 0; dk < 16; ++dk) s0v[dk] = __builtin_nontemporal_load(s0p + (d0 + dk) * 128);
#pragma unroll
            for (int dk = 0; dk < 16; ++dk) {
                const float s0 = s0v[dk]; const int kk = d0 + dk;
                c0 += qs[kk] * s0; c1 += qs[64 + kk] * s0; c2 += qs[128 + kk] * s0; c3 += qs[192 + kk] * s0;
                __builtin_nontemporal_store(g4 * s0 + g3 * ks[kk] * v[0] + g2 * ks[64 + kk] * v[1] + g * ks[128 + kk] * v[2] + ks[192 + kk] * v[3], snp + kk * 128);
            }
        }
        float d00 = 0.f, d10 = 0.f, d11 = 0.f, d20 = 0.f, d21 = 0.f, d22 = 0.f, d30 = 0.f, d31 = 0.f, d32 = 0.f, d33 = 0.f;
        for (int dk = 0; dk < 64; ++dk) {
            const float q0 = qs[dk], q1 = qs[64 + dk], q2 = qs[128 + dk], q3 = qs[192 + dk];
            const float k0 = ks[dk], k1 = ks[64 + dk], k2 = ks[128 + dk], k3 = ks[192 + dk];
            d00 += q0 * k0; d10 += q1 * k0; d11 += q1 * k1; d20 += q2 * k0; d21 += q2 * k1; d22 += q2 * k2;
            d30 += q3 * k0; d31 += q3 * k1; d32 += q3 * k2; d33 += q3 * k3;
        }
        float o[4];
        o[0] = g * c0 + d00 * v[0];
        o[1] = g2 * c1 + g * d10 * v[0] + d11 * v[1];
        o[2] = g3 * c2 + g2 * d20 * v[0] + g * d21 * v[1] + d22 * v[2];
        o[3] = g4 * c3 + g3 * d30 * v[0] + g2 * d31 * v[1] + g * d32 * v[2] + d33 * v[3];
#pragma unroll
        for (int i = 0; i < 4; ++i) { const float s1 = wave_sum(o[i]); if ((t & 63) == 0) red[i * 2 + (t >> 6)] = s1; }
        __syncthreads();
        float dl[4];
#pragma unroll
        for (int i = 0; i < 4; ++i) { const float mu = (red[i * 2] + red[i * 2 + 1]) * (1.f / 128.f); dl[i] = o[i] - mu; }
#pragma unroll
        for (int i = 0; i < 4; ++i) { const float s2 = wave_sum(dl[i] * dl[i]); if ((t & 63) == 0) red[8 + i * 2 + (t >> 6)] = s2; }
        __syncthreads();
#pragma unroll
        for (int i = 0; i < 4; ++i) {
            const float var = (red[8 + i * 2] + red[8 + i * 2 + 1]) * (1.f / 128.f);
            const float y = dl[i] / sqrtf(var + EPS) * gnw[h * 128 + dv];
            const float gg = bf_lo((unsigned)QKVb[(size_t)(row0 + i) * INW + C_GR + h * 128 + dv]);
            MIX[(size_t)(row0 + i) * D + 512 + h * 128 + dv] = (bf16)f2bf(silu_f(gg) * y);
        }
        __syncthreads();
    }
}

struct Args { const float* in[20]; float* out; unsigned char* ws; };
__global__ void __launch_bounds__(NTHR, 2) mk_fwd(Args a) {
    extern __shared__ __attribute__((aligned(16))) unsigned char lds_raw[];
    LAS unsigned char* lds = (LAS unsigned char*)lds_raw;
    volatile LAS unsigned* MISC = (volatile LAS unsigned*)(lds + MISC_OFF);
    const int tid = threadIdx.x, lane = tid & 63, wave = __builtin_amdgcn_readfirstlane(tid >> 6);
    const int G = gridDim.x;
    const int gw = blockIdx.x * NWAVES + wave, NGW = G * NWAVES, gtid = blockIdx.x * NTHR + tid, NGT = G * NTHR;
    unsigned char* ws = a.ws;
    Ptrs P;
    P.xp = a.in[0]; P.xs = a.in[1]; P.ck = a.in[2]; P.cv = a.in[3]; P.st = a.in[4]; P.g1a = a.in[5]; P.g1b = a.in[6]; P.w1g = a.in[7]; P.w1u = a.in[8]; P.w1d = a.in[9];
    P.gma = a.in[10]; P.gmb = a.in[11]; P.win = a.in[12]; P.gnw = a.in[13]; P.wout = a.in[14]; P.g2a = a.in[15]; P.g2b = a.in[16]; P.w2g = a.in[17]; P.w2u = a.in[18]; P.w2d = a.in[19];
    P.out = a.out;
    P.W1GU = (bf16*)(ws + WS_W1GU); P.W1D = (bf16*)(ws + WS_W1D); P.WIN = (bf16*)(ws + WS_WIN); P.WOUT = (bf16*)(ws + WS_WOUT); P.W2GU = (bf16*)(ws + WS_W2GU); P.W2D = (bf16*)(ws + WS_W2D);
    P.XN = (bf16*)(ws + WS_XN); P.H = (bf16*)(ws + WS_H); P.MIX = (bf16*)(ws + WS_MIX);
    P.TAB = (float2*)(ws + WS_TAB); P.Y = (bf16*)(ws + WS_Y); P.HRES = (bf16*)(ws + WS_HRES); P.QKV = (float*)(ws + WS_QKV); P.UPD = (float*)(ws + WS_UPD); P.SPT = (bf16*)(ws + WS_SPREV); P.QKVb = (bf16*)(ws + WS_QKVB); P.OPART = (bf16*)(ws + WS_OPART); P.ML = (float2*)(ws + WS_ML); P.SPART = (float*)(ws + WS_SPART); P.SML = (float2*)(ws + WS_SML);
    for (int u = tid; u < (LDS_BYTES - LDSCTL_OFF) / 4; u += NTHR) ((LAS unsigned*)(lds + LDSCTL_OFF))[u] = 0u;
    __syncthreads();
    XcdBarrier bar = xcd_barrier_post((unsigned*)(ws + WS_CTL) + CW_BAR, MISC + 8);

    p0_prologue(P, lds, gw, NGW, wave, lane, gtid, NGT);
    xcd_barrier(bar);
    { pg8::Gemm g{P.XN, P.W1GU, M, 2 * DFF, D}; pg8::StaticOrder S; S.init(M, 2 * DFF, G, (int)blockIdx.x); pg8::EpiSwiglu E{P.H, DFF};
      pg8::gemm_phase<pg8::EpiSwiglu, pg8::StaticOrder, true, true>(lds, g, S, E); }
    {
        constexpr int NU1 = (M / 256) * (2 * DFF / 256);
        const int rounds = (NU1 + G - 1) / G, idle0 = NU1 - (rounds - 1) * G;
        if (idle0 >= G) p0_deferred(P, lds, gw, NGW, wave, lane);
        else if ((int)blockIdx.x >= idle0) p0_deferred(P, lds, ((int)blockIdx.x - idle0) * NWAVES + wave, (G - idle0) * NWAVES, wave, lane);
    }
    xcd_barrier(bar);
    { pg8::Gemm g{P.H, P.W1D, MP, D, DFF}; pg8::StaticOrder S; S.init(MP, D, G, (int)blockIdx.x); pg8::EpiYb E{P.Y, D};
      pg8::gemm_phase<pg8::EpiYb, pg8::StaticOrder, true, true>(lds, g, S, E); }
    sk_gemm_y(lds, P.H, DFF, P.W1D, DFF, P.Y, tid, wave, lane);
    xcd_barrier(bar);
    norm_res_phase<true, false>(P.xp, P.xs, nullptr, P.Y, P.g1b, 0.5f, P.HRES, nullptr, P.gma, P.XN, gw, NGW, lane);
    xcd_barrier(bar);
    { pg8::Gemm g{P.XN, P.WIN, MP, INW, D}; pg8::StaticOrder S; S.init(MP, INW, G, (int)blockIdx.x);
      pg8::EpiQKV E{P.QKVb, P.TAB, P.out + O_KP, P.out + O_VP, QSCALE, MP - KEEP};
      pg8::gemm_phase<pg8::EpiQKV, pg8::StaticOrder, true, true>(lds, g, S, E); }
    sk_gemm_qkv(lds, P.XN, P.WIN, P.QKVb, P.TAB, P.out, tid, wave, lane);
    xcd_barrier(bar);
    ret_upd_phase(lds, P.QKVb, P.UPD, tid, wave, lane);
    ret_sample_phase(lds, P.QKVb, P.st, P.gnw, P.MIX, P.out, tid);
    attn_mfma_phase(lds, P.QKVb, P.OPART, P.ML, tid, wave, lane);
    attn_sample_phase(P.QKVb, P.ck, P.cv, P.out, P.SPART, P.SML, gw, NGW, lane);
    xcd_barrier(bar);
    ret_scan_phase(P.UPD, P.SPT, P.out, tid);
    attn_combine_phase(P.OPART, P.ML, P.MIX, gtid, NGT);
    attn_sample_merge_phase(P.SPART, P.SML, P.MIX, gw, NGW, lane);
    xcd_barrier(bar);
    ret_out_mfma_phase(lds, P.QKVb, P.SPT, P.gnw, P.MIX, tid, wave, lane);
    xcd_barrier(bar);
    { pg8::Gemm g{P.MIX, P.WOUT, MP, D, D}; pg8::StaticOrder S; S.init(MP, D, G, (int)blockIdx.x); pg8::EpiYb E{P.Y, D};
      pg8::gemm_phase<pg8::EpiYb, pg8::StaticOrder, true, true>(lds, g, S, E); }
    sk_gemm_y(lds, P.MIX, D, P.WOUT, D, P.Y, tid, wave, lane);
    xcd_barrier(bar);
    norm_res_phase<false, false>(nullptr, nullptr, P.HRES, P.Y, P.gmb, 1.0f, P.HRES, nullptr, P.g2a, P.XN, gw, NGW, lane);
    xcd_barrier(bar);
    { pg8::Gemm g{P.XN, P.W2GU, M, 2 * DFF, D}; pg8::StaticOrder S; S.init(M, 2 * DFF, G, (int)blockIdx.x); pg8::EpiSwiglu E{P.H, DFF};
      pg8::gemm_phase<pg8::EpiSwiglu, pg8::StaticOrder, true, true>(lds, g, S, E); }
    xcd_barrier(bar);
    { pg8::Gemm g{P.H, P.W2D, MP, D, DFF}; pg8::StaticOrder S; S.init(MP, D, G, (int)blockIdx.x); pg8::EpiYb E{P.Y, D};
      pg8::gemm_phase<pg8::EpiYb, pg8::StaticOrder, true, true>(lds, g, S, E); }
    sk_gemm_y(lds, P.H, DFF, P.W2D, DFF, P.Y, tid, wave, lane);
    xcd_barrier(bar);
    norm_res_phase<false, true>(nullptr, nullptr, P.HRES, P.Y, P.g2b, 0.5f, nullptr, P.out + O_Y, nullptr, nullptr, gw, NGW, lane);
}

extern "C" void kernel_launch(void* const* d_in, const int* in_sizes, int n_in, void* d_out, int out_size, void* d_ws, size_t ws_size, hipStream_t stream) {
    static int grid = 0;
    if (grid == 0) {
        if (n_in != 20 || (size_t)out_size != O_END || ws_size < WS_END) { fprintf(stderr, "kernel_launch: unexpected sizes (n_in %d out %d ws %zu)\n", n_in, out_size, ws_size); grid = -1; return; }
        int dev = 0, cus = 0;
        if (hipGetDevice(&dev) != hipSuccess || hipDeviceGetAttribute(&cus, hipDeviceAttributeMultiprocessorCount, dev) != hipSuccess) { grid = -1; return; }
        if (hipFuncSetAttribute((const void*)mk_fwd, hipFuncAttributeMaxDynamicSharedMemorySize, LDS_BYTES) != hipSuccess) { fprintf(stderr, "kernel_launch: hipFuncSetAttribute failed\n"); grid = -1; return; }
        int per_cu = 0;
        if (hipOccupancyMaxActiveBlocksPerMultiprocessor(&per_cu, (const void*)mk_fwd, NTHR, LDS_BYTES) != hipSuccess || per_cu < 1) fprintf(stderr, "kernel_launch: occupancy query says %d\n", per_cu);
        (void)hipGetLastError();
        grid = cus;
    }
    if (grid < 0) return;
    (void)hipMemsetAsync((char*)d_ws + WS_CTL, 0, CTL_ZERO_BYTES, stream);
    Args a{};
    for (int i = 0; i < 20; ++i) a.in[i] = (const float*)d_in[i];
    a.out = (float*)d_out; a.ws = (unsigned char*)d_ws;
    hipLaunchKernelGGL(mk_fwd, dim3(grid), dim3(NTHR), LDS_BYTES, stream, a);
}
```
